# Optimizing an MI355X kernel written in HIP

```python
import math
import jax, jax.numpy as jnp
from jax import lax
import numpy as np

D_MODEL = 1024
BATCH = 2
SEQ = 16384
DEPTH = 1
DEC_BATCH = 16
DEC_SEQ = 4096
PAST_LEN = 128

PLE_DIM = 256
D_FF = 2816
EPS = 1e-6
MLA_HEADS = 8
QK_NOPE = 64
QK_ROPE = 32
V_HEAD = 64
Q_LORA = 384
KV_LORA = 256
MLA_WIDTH = MLA_HEADS * V_HEAD
ROPE_BASE = 10000.0
Q_BLOCK = 128
HG_HEADS = 4
HG_DK = 128
HG_DV = 128
HG_KDIM = HG_HEADS * HG_DK
HG_WIDTH = HG_HEADS * HG_DV
CHUNK = 64
D_MIX = MLA_WIDTH + HG_WIDTH
IN_SIZES = (Q_LORA, KV_LORA, QK_ROPE, HG_KDIM, HG_WIDTH, HG_KDIM, HG_KDIM, HG_WIDTH)
D_IN = Q_LORA + KV_LORA + QK_ROPE + 3 * HG_KDIM + 2 * HG_WIDTH

kernel_name = "hybrid_mla_hgrn2_macaron_encoder"


def _rms(x, g):
    xf = x.astype(jnp.float32)
    y = xf * lax.rsqrt(jnp.mean(xf * xf, axis=-1, keepdims=True) + EPS)
    return y.astype(x.dtype) * g


def _swiglu(x, wg, wu, wd):
    return (jax.nn.silu(x @ wg) * (x @ wu)) @ wd


def _rope(x, cos, sin):
    x1, x2 = jnp.split(x, 2, axis=-1)
    return jnp.concatenate([x1 * cos - x2 * sin, x1 * sin + x2 * cos], axis=-1)


def _split_cols(u):
    out = []
    start = 0
    for n in IN_SIZES:
        out.append(u[..., start:start + n])
        start += n
    return out


def _mla(c_q, c_kv, k_r, q_norm, kv_norm, w_uq, w_uk, w_uv):
    B, S, _ = c_q.shape
    q = (_rms(c_q, q_norm) @ w_uq).reshape(B, S, MLA_HEADS, QK_NOPE + QK_ROPE)
    q_nope, q_rope = q[..., :QK_NOPE], q[..., QK_NOPE:]
    ckv = _rms(c_kv, kv_norm)
    k_nope = (ckv @ w_uk).reshape(B, S, MLA_HEADS, QK_NOPE)
    v = (ckv @ w_uv).reshape(B, S, MLA_HEADS, V_HEAD)
    inv_freq = jnp.exp(jnp.arange(0, QK_ROPE, 2, dtype=jnp.float32) * (-math.log(ROPE_BASE) / QK_ROPE))
    ang = jnp.arange(S, dtype=jnp.float32)[:, None] * inv_freq[None, :]
    cos = jnp.cos(ang).astype(c_q.dtype)
    sin = jnp.sin(ang).astype(c_q.dtype)
    q_rope = _rope(q_rope, cos[:, None, :], sin[:, None, :])
    k_r = _rope(k_r, cos, sin)
    nb = S // Q_BLOCK
    qn = q_nope.reshape(B, nb, Q_BLOCK, MLA_HEADS, QK_NOPE).transpose(1, 0, 2, 3, 4)
    qr = q_rope.reshape(B, nb, Q_BLOCK, MLA_HEADS, QK_ROPE).transpose(1, 0, 2, 3, 4)
    scale = (QK_NOPE + QK_ROPE) ** -0.5

    def block(args):
        qn_b, qr_b = args
        s = (jnp.einsum('bqhd,bkhd->bhqk', qn_b, k_nope)
             + jnp.einsum('bqhr,bkr->bhqk', qr_b, k_r))
        pr = jax.nn.softmax(s.astype(jnp.float32) * scale, axis=-1).astype(v.dtype)
        return jnp.einsum('bhqk,bkhd->bqhd', pr, v)

    o = lax.map(block, (qn, qr))
    return o.transpose(1, 0, 2, 3, 4).reshape(B, S, MLA_WIDTH)


def _hgrn_chunk_scan(q, k, v, logf):
    B, H, S, dk = q.shape
    dv = v.shape[-1]
    n = S // CHUNK

    def chunks(t):
        return t.reshape(B, H, n, CHUNK, t.shape[-1]).transpose(2, 0, 1, 3, 4)

    lower = jnp.tril(jnp.ones((CHUNK, CHUNK), dtype=bool))[:, :, None]

    def step(state, inp):
        qc, kc, vc, gc = inp
        b = jnp.cumsum(gc, axis=2)
        o_inter = jnp.einsum('bhtk,bhkv->bhtv', qc * jnp.exp(b), state)
        diff = b[:, :, :, None, :] - b[:, :, None, :, :]
        dec = jnp.exp(jnp.where(lower, diff, -jnp.inf))
        a = jnp.einsum('bhtsk,bhsk->bhts', qc[:, :, :, None, :] * dec, kc)
        o = o_inter + jnp.einsum('bhts,bhsv->bhtv', a, vc)
        b_last = b[:, :, -1:, :]
        state = (jnp.exp(b_last[:, :, 0, :])[..., None] * state
                 + jnp.einsum('bhsk,bhsv->bhkv', kc * jnp.exp(b_last - b), vc))
        return state, o

    state0 = jnp.zeros((B, H, dk, dv), jnp.float32)
    _, o = lax.scan(step, state0, (chunks(q), chunks(k), chunks(v), chunks(logf)))
    return o.transpose(1, 2, 0, 3, 4).reshape(B, H, S, dv)


def _hgrn(h_q, h_i, h_ff, h_fb, h_g, lb_f, lb_b, o_norm):
    B, S, _ = h_q.shape

    def heads(t):
        return t.astype(jnp.float32).reshape(B, S, HG_HEADS, -1).transpose(0, 2, 1, 3)

    q = heads(jax.nn.silu(h_q))
    v = heads(h_i)

    def decay(h_f, lb):
        z = h_f.astype(jnp.float32)
        lb = lb.astype(jnp.float32)
        f = lb + (1.0 - lb) * jax.nn.sigmoid(z)
        return heads((1.0 - lb) * jax.nn.sigmoid(-z)), heads(jnp.log(f))

    k_f, g_f = decay(h_ff, lb_f)
    k_b, g_b = decay(h_fb, lb_b)
    o_fwd = _hgrn_chunk_scan(q, k_f, v, g_f)
    o_bwd = jnp.flip(_hgrn_chunk_scan(jnp.flip(q, axis=2), jnp.flip(k_b, axis=2),
                                      jnp.flip(v, axis=2), jnp.flip(g_b, axis=2)), axis=2)
    o = o_fwd + o_bwd
    o = (o * lax.rsqrt(jnp.mean(o * o, axis=-1, keepdims=True) + EPS)
         * o_norm.astype(jnp.float32).reshape(HG_HEADS, 1, HG_DV))
    o = o.transpose(0, 2, 1, 3).reshape(B, S, HG_WIDTH).astype(h_q.dtype)
    return o * jax.nn.silu(h_g)


def _trunk(x, p, ffn1_norm, ffn1_wg, ffn1_wu, ffn1_wd, mix_norm, w_in, q_norm, w_uq,
           kv_norm, w_uk, w_uv, hg_lb, hg_norm, w_o, ffn2_norm, ffn2_wg, ffn2_wu, ffn2_wd,
           ple_norm, w_ple_gate, w_ple_proj, final_norm):
    lb = jnp.cumsum(jax.nn.softmax(hg_lb.astype(jnp.float32), axis=1), axis=1)
    h = x
    for l in range(DEPTH):
        h = h + 0.5 * _swiglu(_rms(h, ffn1_norm[l]), ffn1_wg[l], ffn1_wu[l], ffn1_wd[l])
        u = _rms(h, mix_norm[l]) @ w_in[l]
        c_q, c_kv, k_r, h_q, h_i, h_ff, h_fb, h_g = _split_cols(u)
        mix = jnp.concatenate([
            _mla(c_q, c_kv, k_r, q_norm[l], kv_norm[l], w_uq[l], w_uk[l], w_uv[l]),
            _hgrn(h_q, h_i, h_ff, h_fb, h_g, lb[0, l], lb[1, l], hg_norm[l]),
        ], axis=-1)
        h = h + mix @ w_o[l]
        h = h + 0.5 * _swiglu(_rms(h, ffn2_norm[l]), ffn2_wg[l], ffn2_wu[l], ffn2_wd[l])
        gate = jax.nn.sigmoid(_rms(h, ple_norm[l]) @ w_ple_gate[l])
        h = h + gate * (p[l].astype(h.dtype) @ w_ple_proj[l])
    return _rms(h, final_norm)


def setup_inputs(seed: int = 0) -> dict:
    key = jax.random.key(seed)
    ks = jax.random.split(key, 32)
    f32 = jnp.float32

    def nrm(k, shape, fan_in):
        return jax.random.normal(k, shape, f32) * (fan_in ** -0.5)

    def gain(k, shape):
        return 1.0 + 0.05 * jax.random.normal(k, shape, f32)

    L = DEPTH
    return {
        "x_prompt": jax.random.normal(ks[0], (BATCH, SEQ, D_MODEL), f32),
        "x_sample": jax.random.normal(ks[1], (DEC_BATCH, DEC_SEQ, D_MODEL), f32),
        "p_prompt": jax.random.normal(ks[2], (DEPTH, BATCH, SEQ, PLE_DIM), f32),
        "p_sample": jax.random.normal(ks[3], (DEPTH, DEC_BATCH, DEC_SEQ, PLE_DIM), f32),
        "ffn1_norm": gain(ks[4], (L, D_MODEL)),
        "ffn1_wg": nrm(ks[5], (L, D_MODEL, D_FF), D_MODEL),
        "ffn1_wu": nrm(ks[6], (L, D_MODEL, D_FF), D_MODEL),
        "ffn1_wd": nrm(ks[7], (L, D_FF, D_MODEL), D_FF),
        "mix_norm": gain(ks[8], (L, D_MODEL)),
        "w_in": nrm(ks[9], (L, D_MODEL, D_IN), D_MODEL),
        "q_norm": gain(ks[10], (L, Q_LORA)),
        "w_uq": nrm(ks[11], (L, Q_LORA, MLA_HEADS * (QK_NOPE + QK_ROPE)), Q_LORA),
        "kv_norm": gain(ks[12], (L, KV_LORA)),
        "w_uk": nrm(ks[13], (L, KV_LORA, MLA_HEADS * QK_NOPE), KV_LORA),
        "w_uv": nrm(ks[14], (L, KV_LORA, MLA_HEADS * V_HEAD), KV_LORA),
        "hg_lb": 0.5 * jax.random.normal(ks[15], (2, L + 1, HG_KDIM), f32),
        "hg_norm": gain(ks[16], (L, HG_WIDTH)),
        "w_o": nrm(ks[17], (L, D_MIX, D_MODEL), D_MIX),
        "ffn2_norm": gain(ks[18], (L, D_MODEL)),
        "ffn2_wg": nrm(ks[19], (L, D_MODEL, D_FF), D_MODEL),
        "ffn2_wu": nrm(ks[20], (L, D_MODEL, D_FF), D_MODEL),
        "ffn2_wd": nrm(ks[21], (L, D_FF, D_MODEL), D_FF),
        "ple_norm": gain(ks[22], (L, D_MODEL)),
        "w_ple_gate": nrm(ks[23], (L, D_MODEL, D_MODEL), D_MODEL),
        "w_ple_proj": nrm(ks[24], (L, PLE_DIM, D_MODEL), PLE_DIM),
        "final_norm": gain(ks[25], (D_MODEL,)),
    }


def reference(x_prompt, x_sample, p_prompt, p_sample, ffn1_norm, ffn1_wg, ffn1_wu, ffn1_wd,
              mix_norm, w_in, q_norm, w_uq, kv_norm, w_uk, w_uv, hg_lb, hg_norm, w_o,
              ffn2_norm, ffn2_wg, ffn2_wu, ffn2_wd, ple_norm, w_ple_gate, w_ple_proj, final_norm):
    w = (ffn1_norm, ffn1_wg, ffn1_wu, ffn1_wd, mix_norm, w_in, q_norm, w_uq, kv_norm, w_uk, w_uv,
         hg_lb, hg_norm, w_o, ffn2_norm, ffn2_wg, ffn2_wu, ffn2_wd, ple_norm, w_ple_gate,
         w_ple_proj, final_norm)
    y_prompt = _trunk(x_prompt, p_prompt, *w)
    y_sample = _trunk(x_sample, p_sample, *w)
    return (y_prompt, y_sample)
```

```cpp
#include <hip/hip_runtime.h>
#include <hip/hip_cooperative_groups.h>
#include <cstdio>
#include <cstdint>
namespace cg = cooperative_groups;

constexpr int DM = 1024, T_P = 32768, T_ALL = 98304, S_P = 16384, S_S = 4096;
constexpr int DFF = 2816, NGU = 5632, NIN = 3328, NMLA = 768, NHG = 2560, PLE = 256;
constexpr float EPS = 1e-6f;
__device__ __forceinline__ int row_pos(int row) { return row < T_P ? (row & (S_P - 1)) : (row & (S_S - 1)); }

namespace pg8 {
#define PG8_LAS __attribute__((address_space(3)))
typedef unsigned short bf16_t;
typedef short bf16x8 __attribute__((ext_vector_type(8)));
typedef float f32x4 __attribute__((ext_vector_type(4)));
typedef unsigned u32x4 __attribute__((ext_vector_type(4)));
constexpr int BM = 256, BK = 64, HALF = 128, HTB = HALF * BK * 2  , STAGE_BYTES = 8 * HTB, NXCD = 8, WGM = 8;

__host__ __device__ __forceinline__ int lds_byte(int r, int c) { const int st = (r >> 4) * 2 + (c >> 5), rr = r & 15, cc = c & 31, ob = rr * 64 + cc * 2; return st * 1024 + (ob ^ (((ob >> 9) & 1) << 5)); }
__host__ __device__ __forceinline__ void stage_rc(int b, int& R, int& C) { const int st = b / 1024, sb = b % 1024, swz = sb ^ (((sb >> 9) & 1) << 5); R = (st >> 1) * 16 + swz / 64; C = (st & 1) * 32 + (swz % 64) / 2; }
__host__ __device__ __forceinline__ int perm32(int rho) { const int n = rho >> 4, i = rho & 15; return 8 * (i >> 2) + 4 * n + (i & 3); }

struct Unit { int pm, pn; };
struct Gemm { const bf16_t* A; const bf16_t* Bt; int M, N, K, lda, ldb; };

struct StaticOrder {
    int nM, nN, nwg, G, c;
    __host__ __device__ void init(int M, int N, int G_, int c_) { nM = M / BM; nN = N / BM; nwg = nM * nN; G = G_; c = c_; }
    __host__ __device__ bool next(int i, Unit& u) const {
        const long L = (long)i * G + c; if (L >= nwg) return false;
        int wgid = (int)L; { const int q = nwg / NXCD, r = nwg % NXCD, xcd = wgid % NXCD, off = wgid / NXCD; wgid = (xcd < r ? xcd * (q + 1) : r * (q + 1) + (xcd - r) * q) + off; }
        const int nig = WGM * nN, gid = wgid / nig, fm = gid * WGM, gsz = (nM - fm) < WGM ? (nM - fm) : WGM;
        u.pm = fm + ((wgid % nig) % gsz); u.pn = (wgid % nig) / gsz; return true;
    }
    __device__ __forceinline__ void a_ready(const Unit&) const {}
    __device__ __forceinline__ void done(const Unit&) const {}
};
__device__ __forceinline__ unsigned cvt_pk_bf16(float lo, float hi) { unsigned r; asm volatile("v_cvt_pk_bf16_f32 %0, %1, %2" : "=v"(r) : "v"(lo), "v"(hi)); return r; }
typedef unsigned u32x2 __attribute__((ext_vector_type(2)));
__device__ __forceinline__ float bf2f(unsigned short h) { return __uint_as_float(((unsigned)h) << 16); }
__device__ __forceinline__ float fsigmoid(float x) { return __builtin_amdgcn_rcpf(1.0f + __expf(-x)); }
__device__ __forceinline__ float row_sum4(float s) { s += __shfl_xor(s, 16); s += __shfl_xor(s, 32); return s; }

struct EpiSwiGLU {
    static constexpr bool PERM = true, AFTER_DRAIN = false;
    bf16_t* O; const float* ss;
    __device__ __forceinline__ void operator()(const f32x4 (&acc)[2][2][4][2], const Unit& u, int wr, int wc, int fr, int fq) const {
        const int row0 = u.pm * BM + wr * 64 + fr; const int col0 = u.pn * HALF + wc * 32 + 8 * fq;
#pragma unroll
        for (int ai = 0; ai < 2; ++ai)
#pragma unroll
            for (int m = 0; m < 4; ++m) { const int row = row0 + ai * HALF + m * 16; const float r = rsqrtf(ss[row] * (1.0f / 1024.0f) + 1e-6f);
                float v[8];
#pragma unroll
                for (int n = 0; n < 2; ++n)
#pragma unroll
                    for (int j = 0; j < 4; ++j) { const float g = acc[ai][0][m][n][j] * r, uu = acc[ai][1][m][n][j] * r; v[n * 4 + j] = g * fsigmoid(g) * uu; }
                u32x4 w; w.x = cvt_pk_bf16(v[0], v[1]); w.y = cvt_pk_bf16(v[2], v[3]); w.z = cvt_pk_bf16(v[4], v[5]); w.w = cvt_pk_bf16(v[6], v[7]);
                *(u32x4*)(O + (size_t)row * 2816 + col0) = w; }
    }
};
template <int MODE> struct EpiRes {
    static constexpr bool PERM = false, AFTER_DRAIN = false;
    const float* xp; const float* xs; float* out; bf16_t* hb; float* ssout; const float* ssin; const bf16_t* proj;
    __device__ __forceinline__ void operator()(const f32x4 (&acc)[2][2][4][2], const Unit& u, int wr, int wc, int fr, int fq) const {
        const int row0 = u.pm * BM + wr * 64 + fr; const int col0 = u.pn * BM + wc * 32 + 4 * fq;
#pragma unroll
        for (int ai = 0; ai < 2; ++ai)
#pragma unroll
            for (int m = 0; m < 4; ++m) { const int row = row0 + ai * HALF + m * 16; float sq = 0.f; float r3 = 0.f;
                if (MODE == 3) r3 = rsqrtf(ssin[row] * (1.0f / 1024.0f) + 1e-6f);
#pragma unroll
                for (int bj = 0; bj < 2; ++bj)
#pragma unroll
                    for (int n = 0; n < 2; ++n) { const int col = col0 + bj * HALF + n * 16; const size_t off = (size_t)row * 1024 + col; f32x4 b, v;
                        if (MODE == 0) { b = (row < 32768) ? *(const f32x4*)(xp + off) : *(const f32x4*)(xs + (off - (size_t)32768 * 1024)); v = b + acc[ai][bj][m][n] * 0.5f; }
                        else if (MODE == 1) { const u32x2 hb2 = *(const u32x2*)(hb + off); b[0] = __uint_as_float(hb2.x << 16); b[1] = __uint_as_float(hb2.x & 0xffff0000u); b[2] = __uint_as_float(hb2.y << 16); b[3] = __uint_as_float(hb2.y & 0xffff0000u); v = b + acc[ai][bj][m][n]; }
                        else if (MODE == 2) { b = *(const f32x4*)(out + off); v = b + acc[ai][bj][m][n] * 0.5f; }
                        else { b = *(const f32x4*)(out + off); const u32x2 p2 = *(const u32x2*)(proj + off); f32x4 pr; pr[0] = __uint_as_float(p2.x << 16); pr[1] = __uint_as_float(p2.x & 0xffff0000u); pr[2] = __uint_as_float(p2.y << 16); pr[3] = __uint_as_float(p2.y & 0xffff0000u);
                            const f32x4 a = acc[ai][bj][m][n] * r3; f32x4 gt; gt[0] = fsigmoid(a[0]); gt[1] = fsigmoid(a[1]); gt[2] = fsigmoid(a[2]); gt[3] = fsigmoid(a[3]); v = b + gt * pr; }
                        sq += (v[0] * v[0] + v[1] * v[1]) + (v[2] * v[2] + v[3] * v[3]);
                        if (MODE != 0) *(f32x4*)(out + off) = v;
                        if (MODE != 3) { u32x2 w; w.x = cvt_pk_bf16(v[0], v[1]); w.y = cvt_pk_bf16(v[2], v[3]); *(u32x2*)(hb + off) = w; } }
                sq = row_sum4(sq);
                if (fq == 0) atomicAdd(ssout + row, sq); }
    }
};
struct EpiWin {
    static constexpr bool PERM = false, AFTER_DRAIN = false;
    bf16_t* umla; bf16_t* uhg; bf16_t* kr; const float* ss1; float* ssq; float* sskv; const float* ropec; const float* ropes;
    __device__ __forceinline__ void operator()(const f32x4 (&acc)[2][2][4][2], const Unit& u, int wr, int wc, int fr, int fq) const {
        const int row0 = u.pm * BM + wr * 64 + fr; const int pn = u.pn;
        bf16_t* dst; int ld, colt;
        if (pn < 3) { dst = umla; ld = 768; colt = pn * BM; } else { dst = uhg; ld = 2560; colt = (pn - 3) * BM; }
        const int col0 = colt + wc * 32 + 4 * fq;
#pragma unroll
        for (int ai = 0; ai < 2; ++ai)
#pragma unroll
            for (int m = 0; m < 4; ++m) { const int row = row0 + ai * HALF + m * 16; const float r = rsqrtf(ss1[row] * (1.0f / 1024.0f) + 1e-6f);
                float sq0 = 0.f, sq1 = 0.f; f32x4 v[2][2];
#pragma unroll
                for (int bj = 0; bj < 2; ++bj)
#pragma unroll
                    for (int n = 0; n < 2; ++n) { v[bj][n] = acc[ai][bj][m][n] * r; const f32x4 x = v[bj][n]; const float s = (x[0] * x[0] + x[1] * x[1]) + (x[2] * x[2] + x[3] * x[3]); if (bj == 0) sq0 += s; else sq1 += s;
                        u32x2 w; w.x = cvt_pk_bf16(x[0], x[1]); w.y = cvt_pk_bf16(x[2], x[3]); *(u32x2*)(dst + (size_t)row * ld + col0 + bj * HALF + n * 16) = w; }
                if (pn < 3) { float s = (pn == 1) ? sq0 : (sq0 + sq1); s = row_sum4(s); if (fq == 0) atomicAdd((pn == 2 ? sskv : ssq) + row, s); }
                if (pn == 1 && wc == 0) {
                    const int pos = row_pos(row); const f32x4 cs = *(const f32x4*)(ropec + pos * 16 + 4 * fq), sn = *(const f32x4*)(ropes + pos * 16 + 4 * fq);
                    const f32x4 x1 = v[1][0], x2 = v[1][1]; const f32x4 o1 = x1 * cs - x2 * sn, o2 = x1 * sn + x2 * cs;
                    u32x2 w1, w2; w1.x = cvt_pk_bf16(o1[0], o1[1]); w1.y = cvt_pk_bf16(o1[2], o1[3]); w2.x = cvt_pk_bf16(o2[0], o2[1]); w2.y = cvt_pk_bf16(o2[2], o2[3]);
                    *(u32x2*)(kr + (size_t)row * 32 + 4 * fq) = w1; *(u32x2*)(kr + (size_t)row * 32 + 16 + 4 * fq) = w2; } }
    }
};
struct EpiBf {
    static constexpr bool PERM = true, AFTER_DRAIN = false;
    bf16_t* O0; bf16_t* O1; int ld; int split; const float* ss; float inv_n;
    __device__ __forceinline__ void operator()(const f32x4 (&acc)[2][2][4][2], const Unit& u, int wr, int wc, int fr, int fq) const {
        const int row0 = u.pm * BM + wr * 64 + fr; bf16_t* base = O0; int colt = u.pn * BM; if (u.pn >= split) { base = O1; colt = (u.pn - split) * BM; }
        const int col0 = colt + wc * 32 + 8 * fq;
#pragma unroll
        for (int ai = 0; ai < 2; ++ai)
#pragma unroll
            for (int m = 0; m < 4; ++m) { const int row = row0 + ai * HALF + m * 16; const float r = ss ? rsqrtf(ss[row] * inv_n + 1e-6f) : 1.0f;
#pragma unroll
                for (int bj = 0; bj < 2; ++bj) { const f32x4 v0 = acc[ai][bj][m][0] * r, v1 = acc[ai][bj][m][1] * r;
                    u32x4 w; w.x = cvt_pk_bf16(v0[0], v0[1]); w.y = cvt_pk_bf16(v0[2], v0[3]); w.z = cvt_pk_bf16(v1[0], v1[1]); w.w = cvt_pk_bf16(v1[2], v1[3]);
                    *(u32x4*)(base + (size_t)row * ld + col0 + bj * HALF) = w; } }
    }
};
template <class Epi, class Sched, bool ALIGN_EPI = false, bool SP2 = false>
__device__ __forceinline__ void gemm_phase(PG8_LAS unsigned char* lds, const Gemm g, const Sched& S, const Epi& E) {
    int tid_ = threadIdx.x; asm volatile("" : "+v"(tid_)); const int tid = tid_, wid = __builtin_amdgcn_readfirstlane(tid >> 6), lane = tid & 63, wr = wid >> 2, wc = wid & 3, fr = lane & 15, fq = lane >> 4;
    const int K = g.K, nt = K / BK;
    unsigned voffA[2], voffB[2];
#pragma unroll
    for (int i = 0; i < 2; ++i) { int R, C; stage_rc(tid * 16 + i * 8192, R, C); const int Rb = Epi::PERM ? ((R & ~31) + perm32(R & 31)) : R;
        voffA[i] = (unsigned)(R * g.lda + C) * 2u; voffB[i] = (unsigned)(Rb * g.ldb + C) * 2u; }
    const size_t kstep = (size_t)(BK * 2);
    const size_t hstepA = (size_t)HALF * g.lda * 2, hstepB = (size_t)HALF * g.ldb * 2;
    const size_t tstepA = 2 * hstepA, tstepB = 2 * hstepB;
    const unsigned ldsw = (unsigned)wid * 1024u;
    const int aoff = lds_byte(wr * 64 + fr, fq * 8), boff = lds_byte(wc * 32 + fr, fq * 8);
#define PG8_SA(b, h) (((b) * 2 + (h)) * HTB)
#define PG8_SB(b, h) ((4 + (b) * 2 + (h)) * HTB)
#define PG8_STAGE(bufoff, gbase, voff) do { _Pragma("unroll") for (int _i = 0; _i < 2; ++_i) \
        __builtin_amdgcn_global_load_lds((const unsigned*)((const char*)(gbase) + (voff)[_i]), (PG8_LAS unsigned*)(lds + (bufoff) + ldsw + _i * 8192), 16, 0, 0); } while (0)
#define PG8_LDA(dst, b, h) do { _Pragma("unroll") for (int m = 0; m < 4; ++m) _Pragma("unroll") for (int k = 0; k < 2; ++k) dst[m][k] = *(const PG8_LAS bf16x8*)(lds + PG8_SA(b, h) + aoff + m * 2048 + k * 1024); } while (0)
#define PG8_LDB(dst, b, h) do { _Pragma("unroll") for (int n = 0; n < 2; ++n) _Pragma("unroll") for (int k = 0; k < 2; ++k) dst[n][k] = *(const PG8_LAS bf16x8*)(lds + PG8_SB(b, h) + boff + n * 2048 + k * 1024); } while (0)
#define PG8_MMA(ai, bj, At, Bt) do { __builtin_amdgcn_s_setprio(1); _Pragma("unroll") for (int m = 0; m < 4; ++m) _Pragma("unroll") for (int n = 0; n < 2; ++n) _Pragma("unroll") for (int k = 0; k < 2; ++k) \
        acc[ai][bj][m][n] = __builtin_amdgcn_mfma_f32_16x16x32_bf16(Bt[n][k], At[m][k], acc[ai][bj][m][n], 0, 0, 0); __builtin_amdgcn_s_setprio(0); } while (0)
#define PG8_WAIT_V(n) asm volatile("s_waitcnt vmcnt(" #n ")" ::: "memory")
#define PG8_WAIT_L(n) asm volatile("s_waitcnt lgkmcnt(" #n ")" ::: "memory")
#define PG8_BAR __builtin_amdgcn_s_barrier()
#define PG8_SCHED __builtin_amdgcn_sched_barrier(0)
    Unit cur, nxt; int ui = 0;
    if (!S.next(0, cur)) return;
    f32x4 acc[2][2][4][2];
#pragma unroll
    for (int a = 0; a < 2; ++a)
#pragma unroll
        for (int b = 0; b < 2; ++b)
#pragma unroll
            for (int m = 0; m < 4; ++m)
#pragma unroll
                for (int n = 0; n < 2; ++n) acc[a][b][m][n] = (f32x4){0.f, 0.f, 0.f, 0.f};
    bf16x8 At[4][2], B0[2][2], B1[2][2];
    const char* cA = (const char*)g.A + (size_t)cur.pm * tstepA; const char* cB = (const char*)g.Bt + (size_t)cur.pn * tstepB;
    S.a_ready(cur);
    if constexpr (SP2) {
        PG8_STAGE(PG8_SB(0, 0), cB, voffB); PG8_STAGE(PG8_SB(0, 1), cB + hstepB, voffB); PG8_STAGE(PG8_SA(0, 0), cA, voffA); PG8_STAGE(PG8_SA(0, 1), cA + hstepA, voffA);
        if (wr == 1) PG8_BAR;
        PG8_WAIT_V(2); PG8_BAR;
        PG8_STAGE(PG8_SB(1, 0), cB + kstep, voffB); PG8_STAGE(PG8_SA(1, 0), cA + kstep, voffA); PG8_STAGE(PG8_SB(1, 1), cB + hstepB + kstep, voffB);
        PG8_WAIT_V(6); PG8_BAR;
    } else {
        PG8_STAGE(PG8_SB(0, 0), cB, voffB); PG8_STAGE(PG8_SA(0, 0), cA, voffA); PG8_STAGE(PG8_SB(0, 1), cB + hstepB, voffB); PG8_STAGE(PG8_SA(0, 1), cA + hstepA, voffA);
        if (wr == 1) PG8_BAR;
        PG8_WAIT_V(4); PG8_BAR;
        PG8_STAGE(PG8_SB(1, 0), cB + kstep, voffB); PG8_STAGE(PG8_SA(1, 0), cA + kstep, voffA); PG8_STAGE(PG8_SB(1, 1), cB + hstepB + kstep, voffB);
        PG8_WAIT_V(6); PG8_BAR;
    }
    for (;;) {
        const bool has_next = S.next(ui + 1, nxt);
        const char* nA = has_next ? (const char*)g.A + (size_t)nxt.pm * tstepA : cA; const char* nB = has_next ? (const char*)g.Bt + (size_t)nxt.pn * tstepB : cB;
        for (int t = 0; t < nt; t += 2) {
            const bool last = (t == nt - 2);
            const char* a1 = cA + (size_t)(t + 1) * kstep;
            const char* a2 = last ? nA : cA + (size_t)(t + 2) * kstep; const char* b2 = last ? nB : cB + (size_t)(t + 2) * kstep;
            const char* a3 = a2 + kstep; const char* b3 = b2 + kstep;
            if (last && has_next) S.a_ready(nxt);
            if constexpr (SP2) {
            PG8_LDB(B0, 0, 0); PG8_LDB(B1, 0, 1); PG8_SCHED; PG8_LDA(At, 0, 0); PG8_STAGE(PG8_SA(1, 1), a1 + hstepA, voffA);
            PG8_WAIT_V(8); PG8_WAIT_L(0); PG8_BAR; PG8_MMA(0, 0, At, B0); PG8_MMA(0, 1, At, B1); PG8_BAR; PG8_SCHED;
            PG8_LDA(At, 0, 1); PG8_STAGE(PG8_SB(0, 0), b2, voffB); PG8_STAGE(PG8_SB(0, 1), b2 + hstepB, voffB); PG8_STAGE(PG8_SA(0, 0), a2, voffA);
            PG8_WAIT_V(8); PG8_WAIT_L(0); PG8_BAR; PG8_MMA(1, 0, At, B0); PG8_MMA(1, 1, At, B1); PG8_BAR; PG8_SCHED;
            PG8_LDB(B0, 1, 0); PG8_LDB(B1, 1, 1); PG8_SCHED; PG8_LDA(At, 1, 0); PG8_STAGE(PG8_SA(0, 1), a2 + hstepA, voffA);
            PG8_WAIT_V(8); PG8_WAIT_L(0); PG8_BAR; PG8_MMA(0, 0, At, B0); PG8_MMA(0, 1, At, B1); PG8_BAR; PG8_SCHED;
            PG8_LDA(At, 1, 1); PG8_STAGE(PG8_SB(1, 0), b3, voffB); PG8_STAGE(PG8_SB(1, 1), b3 + hstepB, voffB); PG8_STAGE(PG8_SA(1, 0), a3, voffA);
            PG8_WAIT_V(8); PG8_WAIT_L(0); PG8_BAR; PG8_MMA(1, 0, At, B0); PG8_MMA(1, 1, At, B1); PG8_BAR; PG8_SCHED;
            } else {
            PG8_LDB(B0, 0, 0); PG8_SCHED; PG8_LDA(At, 0, 0); PG8_STAGE(PG8_SA(1, 1), a1 + hstepA, voffA);
            PG8_WAIT_L(8); PG8_BAR; PG8_WAIT_L(0); PG8_MMA(0, 0, At, B0); PG8_BAR; PG8_SCHED;
            PG8_LDB(B1, 0, 1); PG8_STAGE(PG8_SB(0, 0), b2, voffB);
            PG8_BAR; PG8_WAIT_L(0); PG8_MMA(0, 1, At, B1); PG8_BAR;
            PG8_LDA(At, 0, 1); PG8_STAGE(PG8_SA(0, 0), a2, voffA);
            PG8_BAR; PG8_WAIT_L(0); PG8_MMA(1, 0, At, B0); PG8_BAR; PG8_SCHED;
            PG8_STAGE(PG8_SB(0, 1), b2 + hstepB, voffB);
            PG8_WAIT_V(6); PG8_BAR; PG8_MMA(1, 1, At, B1); PG8_BAR;
            PG8_LDB(B0, 1, 0); PG8_SCHED; PG8_LDA(At, 1, 0); PG8_STAGE(PG8_SA(0, 1), a2 + hstepA, voffA);
            PG8_WAIT_L(8); PG8_BAR; PG8_WAIT_L(0); PG8_MMA(0, 0, At, B0); PG8_BAR; PG8_SCHED;
            PG8_LDB(B1, 1, 1); PG8_STAGE(PG8_SB(1, 0), b3, voffB);
            PG8_BAR; PG8_WAIT_L(0); PG8_MMA(0, 1, At, B1); PG8_BAR;
            PG8_LDA(At, 1, 1); PG8_STAGE(PG8_SA(1, 0), a3, voffA);
            PG8_BAR; PG8_WAIT_L(0); PG8_MMA(1, 0, At, B0); PG8_BAR; PG8_SCHED;
            PG8_STAGE(PG8_SB(1, 1), b3 + hstepB, voffB);
            PG8_WAIT_V(6); PG8_BAR; PG8_MMA(1, 1, At, B1); PG8_BAR;
            }
        }
        if constexpr (ALIGN_EPI) { if (wr == 0) PG8_BAR; }
        if constexpr (!Epi::AFTER_DRAIN) { E(acc, cur, wr, wc, fr, fq); S.done(cur); }
        if (!has_next) break;
#pragma unroll
        for (int a = 0; a < 2; ++a)
#pragma unroll
            for (int b = 0; b < 2; ++b)
#pragma unroll
                for (int m = 0; m < 4; ++m)
#pragma unroll
                    for (int n = 0; n < 2; ++n) acc[a][b][m][n] = (f32x4){0.f, 0.f, 0.f, 0.f};
        cur = nxt; cA = nA; cB = nB; ++ui;
        if constexpr (ALIGN_EPI) { if (wr == 1) PG8_BAR; }
    }
    PG8_WAIT_V(0);
    if constexpr (!ALIGN_EPI) { if (wr == 0) PG8_BAR; }
    PG8_BAR;
    if constexpr (Epi::AFTER_DRAIN) { E.fused(acc, cur, wr, wc, fr, fq, lds, wid, lane); S.done(cur); }
#undef PG8_SA
#undef PG8_SB
#undef PG8_STAGE
#undef PG8_LDA
#undef PG8_LDB
#undef PG8_MMA
#undef PG8_WAIT_V
#undef PG8_WAIT_L
#undef PG8_BAR
#undef PG8_SCHED
}
}

namespace att {
typedef unsigned short bf16_t;
using bf16x8 = __attribute__((ext_vector_type(8))) short;
using s16x4  = __attribute__((ext_vector_type(4))) short;
using f32x16 = __attribute__((ext_vector_type(16))) float;
using u32x4  = __attribute__((ext_vector_type(4))) unsigned;
constexpr int NW = 8, QBLK = 32, KVBLK = 64;
constexpr float SCALE = 0.10206207261596575f;
constexpr float THR = 8.f;
constexpr int LDQ = 768, LDKN = 512, LDKR = 32, LDV = 512, LDO = 1024;
constexpr int SHM_V = 64 * 128 * 2, SHM_K = 64 * 128 * 2;
#define KSWZ(row, colB) ((row) * 256 + ((colB) ^ (((row) & 7) << 4)))
#define SBAR() __builtin_amdgcn_sched_barrier(0)
__device__ __forceinline__ int crow(int r, int hi) { return (r & 3) + 8 * (r >> 2) + 4 * hi; }
__device__ __forceinline__ unsigned cvtpk(float lo, float hi) { unsigned r; asm volatile("v_cvt_pk_bf16_f32 %0, %1, %2" : "=v"(r) : "v"(lo), "v"(hi)); return r; }
__device__ __forceinline__ void partialSM(f32x16& p0, f32x16& p1, float& m_reg, float& mn, float& alpha) {
  constexpr float C = SCALE * 1.4426950408889634f;
  float pmax = p0[0];
#pragma unroll
  for (int r = 1; r < 16; ++r) pmax = fmaxf(pmax, p0[r]);
#pragma unroll
  for (int r = 0; r < 16; ++r) pmax = fmaxf(pmax, p1[r]);
  { auto rr = __builtin_amdgcn_permlane32_swap(__float_as_uint(pmax), __float_as_uint(pmax), false, false);
    pmax = fmaxf(__uint_as_float(rr[0]), __uint_as_float(rr[1])); }
  if (__builtin_expect(__all(pmax - m_reg <= THR / SCALE), 1)) { mn = m_reg; alpha = 1.f; }
  else { mn = fmaxf(m_reg, pmax); alpha = __builtin_amdgcn_exp2f((m_reg - mn) * C); m_reg = mn; }
  float mnC = -mn * C;
#pragma unroll
  for (int r = 0; r < 16; ++r) p0[r] = fmaf(p0[r], C, mnC);
#pragma unroll
  for (int r = 0; r < 16; ++r) p1[r] = fmaf(p1[r], C, mnC);
#pragma unroll
  for (int r = 0; r < 16; ++r) p0[r] = __builtin_amdgcn_exp2f(p0[r]);
}
__device__ __forceinline__ void finishSM(f32x16& p0, f32x16& p1, float alpha, float& l_reg, bf16x8& pa0, bf16x8& pa1, bf16x8& pa2, bf16x8& pa3) {
#pragma unroll
  for (int r = 0; r < 16; ++r) p1[r] = __builtin_amdgcn_exp2f(p1[r]);
  float ps = 0;
#pragma unroll
  for (int r = 0; r < 16; ++r) ps += p0[r];
#pragma unroll
  for (int r = 0; r < 16; ++r) ps += p1[r];
  { auto rr = __builtin_amdgcn_permlane32_swap(__float_as_uint(ps), __float_as_uint(ps), false, false);
    ps = __uint_as_float(rr[0]) + __uint_as_float(rr[1]); }
  l_reg = l_reg * alpha + ps;
#define PK4(P, BASE, OUT) do { unsigned a0 = cvtpk(P[BASE + 0], P[BASE + 1]), a1 = cvtpk(P[BASE + 2], P[BASE + 3]);   \
    unsigned b0 = cvtpk(P[BASE + 4], P[BASE + 5]), b1 = cvtpk(P[BASE + 6], P[BASE + 7]);                              \
    auto r0 = __builtin_amdgcn_permlane32_swap(a0, b0, false, false); auto r1 = __builtin_amdgcn_permlane32_swap(a1, b1, false, false); \
    u32x4 w = {r0[0], r1[0], r0[1], r1[1]}; OUT = *reinterpret_cast<bf16x8*>(&w); } while (0)
  PK4(p0, 0, pa0); PK4(p0, 8, pa1); PK4(p1, 0, pa2); PK4(p1, 8, pa3);
#undef PK4
}
__device__ __forceinline__ void qkt(f32x16& p0, f32x16& p1, const bf16_t* Ks, const bf16x8* qr, int r32, int hi) {
  p0 = f32x16{}; p1 = f32x16{};
#pragma unroll
  for (int d0 = 0; d0 < 6; ++d0) { int cb = (d0 * 16 + hi * 8) * 2;
    bf16x8 b0 = *reinterpret_cast<const bf16x8*>((const char*)Ks + KSWZ(r32, cb));
    bf16x8 b1 = *reinterpret_cast<const bf16x8*>((const char*)Ks + KSWZ(32 + r32, cb));
    p0 = __builtin_amdgcn_mfma_f32_32x32x16_bf16(b0, qr[d0], p0, 0, 0, 0);
    p1 = __builtin_amdgcn_mfma_f32_32x32x16_bf16(b1, qr[d0], p1, 0, 0, 0); }
}
__device__ __forceinline__ int v_st(int k, int c) { const int kk = (k & ~0xC) | ((k & 4) << 1) | ((k & 8) >> 1); return ((kk >> 3) * 4 + (c >> 5)) * 512 + ((kk & 7) * 32 + (c & 31)) * 2; }
__device__ __forceinline__ int v_rd_base(int lane) { return ((lane & 3) << 3) | (((lane >> 2) & 3) << 6) | (((lane >> 4) & 1) << 5) | (((lane >> 5) & 1) << 8); }
constexpr int v_rd_off(int d0, int ks, int half) { return d0 * 512 + ks * 4096 + half * 2048; }
template <int OFF> __device__ __forceinline__ s16x4 tr_read(int vb) {
  s16x4 r; asm volatile("ds_read_b64_tr_b16 %0, %1 offset:%2" : "=&v"(r) : "v"(vb), "i"(OFF) : "memory"); return r;
}
template <int D0> __device__ __forceinline__ void pv_one(f32x16& od, int vb, bf16x8 pa0, bf16x8 pa1, bf16x8 pa2, bf16x8 pa3) {
  const s16x4 l0 = tr_read<v_rd_off(D0, 0, 0)>(vb), h0 = tr_read<v_rd_off(D0, 0, 1)>(vb), l1 = tr_read<v_rd_off(D0, 1, 0)>(vb), h1 = tr_read<v_rd_off(D0, 1, 1)>(vb);
  const s16x4 l2 = tr_read<v_rd_off(D0, 2, 0)>(vb), h2 = tr_read<v_rd_off(D0, 2, 1)>(vb), l3 = tr_read<v_rd_off(D0, 3, 0)>(vb), h3 = tr_read<v_rd_off(D0, 3, 1)>(vb);
  asm volatile("s_waitcnt lgkmcnt(0)" ::: "memory"); SBAR();
#define PK(L, H) (bf16x8){L[0], L[1], L[2], L[3], H[0], H[1], H[2], H[3]}
  od = __builtin_amdgcn_mfma_f32_32x32x16_bf16(pa0, PK(l0, h0), od, 0, 0, 0);
  od = __builtin_amdgcn_mfma_f32_32x32x16_bf16(pa1, PK(l1, h1), od, 0, 0, 0);
  od = __builtin_amdgcn_mfma_f32_32x32x16_bf16(pa2, PK(l2, h2), od, 0, 0, 0);
  od = __builtin_amdgcn_mfma_f32_32x32x16_bf16(pa3, PK(l3, h3), od, 0, 0, 0);
#undef PK
}
__device__ __forceinline__ void pv_d0(f32x16* o, int vb, bf16x8 pa0, bf16x8 pa1, bf16x8 pa2, bf16x8 pa3) {
  pv_one<0>(o[0], vb, pa0, pa1, pa2, pa3); pv_one<1>(o[1], vb, pa0, pa1, pa2, pa3);
}
__device__ __forceinline__ void attn_unit(const bf16_t* __restrict__ Qb, const bf16_t* __restrict__ KNh, const bf16_t* __restrict__ KRb, const bf16_t* __restrict__ Vh,
                                          bf16_t* __restrict__ Ob, int seq, int qrow0, const float* __restrict__ ropec, const float* __restrict__ ropes, char* lds) {
  int tid_ = threadIdx.x; asm volatile("" : "+v"(tid_)); const int tid = tid_, wid = __builtin_amdgcn_readfirstlane(tid >> 6), lane = tid & 63, r32 = lane & 31, hi = lane >> 5;
  bf16_t* V_lds = (bf16_t*)lds; bf16_t* K_lds = (bf16_t*)(lds + 2 * SHM_V);
  float* ws = (float*)(lds + 2 * SHM_V + 2 * SHM_K) + wid * 64; float* li_l = ws; float* al_l = ws + 32;
  float m_reg = -1e30f, l_reg = 0; f32x16 o[2] = {}; bf16x8 qr[6];
  const bf16_t* Qw = Qb + (long)(wid * QBLK + r32) * LDQ + hi * 8;
#pragma unroll
  for (int d0 = 0; d0 < 6; ++d0) qr[d0] = *reinterpret_cast<const bf16x8*>(Qw + d0 * 16);
  {
    const int pos = row_pos(qrow0 + wid * QBLK + r32); const float* cp = ropec + pos * 16 + 8 * hi; const float* sp = ropes + pos * 16 + 8 * hi;
    unsigned w1[4], w2[4];
#pragma unroll
    for (int e = 0; e < 8; e += 2) { float o1[2], o2[2];
#pragma unroll
      for (int f = 0; f < 2; ++f) { const float x1 = __uint_as_float(((unsigned)(unsigned short)qr[4][e + f]) << 16), x2 = __uint_as_float(((unsigned)(unsigned short)qr[5][e + f]) << 16); const float c = cp[e + f], s = sp[e + f];
        o1[f] = x1 * c - x2 * s; o2[f] = x1 * s + x2 * c; }
      w1[e >> 1] = cvtpk(o1[0], o1[1]); w2[e >> 1] = cvtpk(o2[0], o2[1]); }
    u32x4 v1 = {w1[0], w1[1], w1[2], w1[3]}, v2 = {w2[0], w2[1], w2[2], w2[3]}; qr[4] = *reinterpret_cast<bf16x8*>(&v1); qr[5] = *reinterpret_cast<bf16x8*>(&v2); }
  const int sr = tid >> 4, sc = (tid & 15) * 8, vst0 = v_st(sr, sc), vst1 = v_st(32 + sr, sc);
  const bf16_t* kp = (sc < 64) ? (KNh + sc) : (KRb + ((sc - 64) & 31)); const int kld = (sc < 64) ? LDKN : LDKR;
  const bf16_t* vp = Vh + (sc & 63);
  const int vb0 = (int)(uintptr_t)V_lds + v_rd_base(lane);
  struct { bf16x8 vs0, vs1, ks0, ks1; } sr_[2];
#define SLOAD(i, k0) do { sr_[i].vs0 = *reinterpret_cast<const bf16x8*>(&vp[(long)((k0) + sr) * LDV]); sr_[i].vs1 = *reinterpret_cast<const bf16x8*>(&vp[(long)((k0) + 32 + sr) * LDV]); \
    sr_[i].ks0 = *reinterpret_cast<const bf16x8*>(&kp[(long)((k0) + sr) * kld]); sr_[i].ks1 = *reinterpret_cast<const bf16x8*>(&kp[(long)((k0) + 32 + sr) * kld]); } while (0)
#define SWRITE(b, i) do { *(bf16x8*)((char*)V_lds + (b) * SHM_V + vst0) = sr_[i].vs0;          \
    *(bf16x8*)((char*)V_lds + (b) * SHM_V + vst1) = sr_[i].vs1; int kc = sc * 2;               \
    *(bf16x8*)((char*)K_lds + (b) * SHM_K + KSWZ(sr, kc)) = sr_[i].ks0;                       \
    *(bf16x8*)((char*)K_lds + (b) * SHM_K + KSWZ(32 + sr, kc)) = sr_[i].ks1; } while (0)
#define SWAIT() asm volatile("s_waitcnt vmcnt(4)" ::: "memory")
#define RESC(a) do { if (__any((a) < 1.f)) { if (hi == 0) al_l[r32] = (a); asm volatile("s_waitcnt lgkmcnt(0)" ::: "memory"); \
    _Pragma("unroll") for (int d = 0; d < 2; ++d) _Pragma("unroll") for (int r = 0; r < 16; ++r) o[d][r] *= al_l[crow(r, hi)]; } } while (0)
  f32x16 pA0, pA1, pB0, pB1; float mnA, mnB, alA, alB; bf16x8 pa0, pa1, pa2, pa3; const int NT = seq / KVBLK;
  constexpr int SE = 0, SO = 1;
  SLOAD(SE, 0); asm volatile("s_waitcnt vmcnt(0)" ::: "memory"); SWRITE(0, SE); __syncthreads();
  qkt(pA0, pA1, K_lds, qr, r32, hi); partialSM(pA0, pA1, m_reg, mnA, alA);
  SLOAD(SO, KVBLK); if (2 < NT) SLOAD(SE, 2 * KVBLK);
  SWAIT(); SWRITE(1, SO); __syncthreads();
  for (int j = 1; j + 1 < NT; j += 2) {
    SBAR(); qkt(pB0, pB1, (bf16_t*)((char*)K_lds + SHM_K), qr, r32, hi);
    finishSM(pA0, pA1, alA, l_reg, pa0, pa1, pa2, pa3); SBAR();
    SLOAD(SO, (j + 2) * KVBLK); SBAR();
    pv_d0(o, vb0, pa0, pa1, pa2, pa3); partialSM(pB0, pB1, m_reg, mnB, alB);
    __syncthreads(); SWAIT(); SWRITE(0, SE);
    RESC(alB); __syncthreads();
    SBAR(); qkt(pA0, pA1, K_lds, qr, r32, hi);
    finishSM(pB0, pB1, alB, l_reg, pa0, pa1, pa2, pa3); SBAR();
    if (j + 3 < NT) SLOAD(SE, (j + 3) * KVBLK); SBAR();
    pv_d0(o, vb0 + (int)SHM_V, pa0, pa1, pa2, pa3); partialSM(pA0, pA1, m_reg, mnA, alA);
    __syncthreads(); SWAIT(); SWRITE(1, SO);
    RESC(alA); __syncthreads();
  }
  SBAR(); qkt(pB0, pB1, (bf16_t*)((char*)K_lds + SHM_K), qr, r32, hi);
  finishSM(pA0, pA1, alA, l_reg, pa0, pa1, pa2, pa3); SBAR();
  pv_d0(o, vb0, pa0, pa1, pa2, pa3); partialSM(pB0, pB1, m_reg, mnB, alB);
  __syncthreads(); RESC(alB);
  finishSM(pB0, pB1, alB, l_reg, pa0, pa1, pa2, pa3); SBAR();
  pv_d0(o, vb0 + (int)SHM_V, pa0, pa1, pa2, pa3);
  if (hi == 0) li_l[r32] = l_reg; asm volatile("s_waitcnt lgkmcnt(0)" ::: "memory");
  float rli[16];
#pragma unroll
  for (int r = 0; r < 16; ++r) rli[r] = __builtin_amdgcn_rcpf(li_l[crow(r, hi)]);
  bf16_t* Ow = Ob + (long)(wid * QBLK) * LDO;
#pragma unroll
  for (int r = 0; r < 16; ++r) { int orow = crow(r, hi);
#pragma unroll
    for (int d0 = 0; d0 < 2; ++d0) { const unsigned w = cvtpk(o[d0][r] * rli[r], 0.f); Ow[(long)orow * LDO + d0 * 32 + r32] = (bf16_t)(w & 0xffffu); } }
  __syncthreads();
#undef SLOAD
#undef SWRITE
#undef SWAIT
#undef RESC
}
#undef KSWZ
#undef SBAR
}
namespace hg {
typedef unsigned short bf16_t;
using bf16x8 = __attribute__((ext_vector_type(8))) short;
using f32x16 = __attribute__((ext_vector_type(16))) float;
using f32x4  = __attribute__((ext_vector_type(4))) float;
using u32x4  = __attribute__((ext_vector_type(4))) unsigned;
#define SWZ256(row, colB) ((row) * 256 + ((colB) ^ (((row) & 7) << 4)))
#define SWZ128(row, colB) ((row) * 128 + ((colB) ^ (((row) & 7) << 4)))
constexpr int L_ST = 0, L_QH = 32768, L_KH = 49152, L_KT = 65536, L_VT = 81920, L_GB = 98304, L_SEG = 131072, L_DD = 133120, L_LB = 133632;
__device__ __forceinline__ int crow(int r, int hi) { return (r & 3) + 8 * (r >> 2) + 4 * hi; }
__device__ __forceinline__ unsigned cvtpk(float lo, float hi) { unsigned r; asm volatile("v_cvt_pk_bf16_f32 %0, %1, %2" : "=v"(r) : "v"(lo), "v"(hi)); return r; }
__device__ __forceinline__ float bf2f(unsigned short h) { return __uint_as_float(((unsigned)h) << 16); }
__device__ __forceinline__ void chain(const bf16_t* __restrict__ U, float* __restrict__ OP, const float* __restrict__ hg_lb, int rowbase, int S, int h, int dir, char* lds) {
  int tid_ = threadIdx.x; asm volatile("" : "+v"(tid_)); const int tid = tid_, wid = __builtin_amdgcn_readfirstlane(tid >> 6), lane = tid & 63, r32 = lane & 31, hi = lane >> 5;
  float* GB = (float*)(lds + L_GB); float* SEG = (float*)(lds + L_SEG); float* DD = (float*)(lds + L_DD); float* LB = (float*)(lds + L_LB);
  char* ST = lds + L_ST; char* QH = lds + L_QH; char* KH = lds + L_KH; char* KT = lds + L_KT; char* VT = lds + L_VT; char* AL = lds + L_GB;
  for (int i = tid; i < 32768 / 16; i += 512) *(u32x4*)(ST + i * 16) = (u32x4){0u, 0u, 0u, 0u};
  if (tid < 128) { const float a0 = hg_lb[dir * 1024 + h * 128 + tid], a1 = hg_lb[dir * 1024 + 512 + h * 128 + tid]; LB[tid] = 1.0f / (1.0f + __expf(a1 - a0)); }
  f32x16 sacc[2]; sacc[0] = f32x16{}; sacc[1] = f32x16{};
  const int tau = tid >> 3, c0 = (tid & 7) * 16, segt = tau >> 4;
  const int nchunk = S / 64;
  const bf16_t* Ub = U + (size_t)rowbase * 2560 + h * 128 + c0;
  const size_t offq = 0, offv = 512, offf = (size_t)(2 + dir) * 512;
  float* OPd = OP + (size_t)dir * T_ALL * 512;
  bf16x8 nq0, nq1, nv0, nv1, nf0, nf1;
  { const int tok = dir ? (S - 1 - tau) : tau; const bf16_t* p = Ub + (size_t)tok * 2560;
    nq0 = *(const bf16x8*)(p + offq); nq1 = *(const bf16x8*)(p + offq + 8); nv0 = *(const bf16x8*)(p + offv); nv1 = *(const bf16x8*)(p + offv + 8); nf0 = *(const bf16x8*)(p + offf); nf1 = *(const bf16x8*)(p + offf + 8); }
  __syncthreads();
  for (int ci = 0; ci < nchunk; ++ci) {
    const bf16x8 qv[2] = {nq0, nq1}, vv[2] = {nv0, nv1}, fv[2] = {nf0, nf1};
    { const int cn = (ci + 1 < nchunk) ? ci + 1 : ci; const int t2 = cn * 64 + tau; const int tok = dir ? (S - 1 - t2) : t2; const bf16_t* p = Ub + (size_t)tok * 2560;
      nq0 = *(const bf16x8*)(p + offq); nq1 = *(const bf16x8*)(p + offq + 8); nv0 = *(const bf16x8*)(p + offv); nv1 = *(const bf16x8*)(p + offv + 8); nf0 = *(const bf16x8*)(p + offf); nf1 = *(const bf16x8*)(p + offf + 8); }
    float qq[16], kk[16];
#pragma unroll
    for (int j = 0; j < 16; ++j) {
      const float z = bf2f((unsigned short)fv[j >> 3][j & 7]); const float x = bf2f((unsigned short)qv[j >> 3][j & 7]);
      const float lbv = LB[c0 + j]; const float sg = __builtin_amdgcn_rcpf(1.0f + __expf(-z)); const float f = lbv + (1.0f - lbv) * sg;
      kk[j] = 1.0f - f; qq[j] = x * __builtin_amdgcn_rcpf(1.0f + __expf(-x));
      GB[tau * 128 + c0 + j] = __logf(f);
    }
    __syncthreads();
    { const int k = tid & 127, seg = tid >> 7; float run = 0.f;
#pragma unroll
      for (int j = 0; j < 16; ++j) { run += GB[(16 * seg + j) * 128 + k]; GB[(16 * seg + j) * 128 + k] = run; }
      SEG[seg * 128 + k] = run; }
    __syncthreads();
    { unsigned qh[8], kh[8];
#pragma unroll
      for (int j = 0; j < 16; j += 2) {
        float g2[2], gl2[2];
#pragma unroll
        for (int e = 0; e < 2; ++e) { const int col = c0 + j + e; const float s0 = SEG[col], s1 = SEG[128 + col], s2 = SEG[256 + col];
          const float off = (segt >= 1 ? s0 : 0.f) + (segt >= 2 ? s1 : 0.f) + (segt >= 3 ? s2 : 0.f);
          g2[e] = GB[tau * 128 + col] + off; gl2[e] = GB[63 * 128 + col] + ((s0 + s1) + s2); }
        const float ea = __expf(g2[0]), eb = __expf(g2[1]);
        qh[j >> 1] = cvtpk(qq[j] * ea, qq[j + 1] * eb);
        kh[j >> 1] = cvtpk(kk[j] * __expf(fminf(-g2[0], 80.f)), kk[j + 1] * __expf(fminf(-g2[1], 80.f)));
        const unsigned kt = cvtpk(kk[j] * __expf(gl2[0] - g2[0]), kk[j + 1] * __expf(gl2[1] - g2[1]));
        *(bf16_t*)(KT + SWZ128(c0 + j, 2 * tau)) = (bf16_t)(kt & 0xffffu); *(bf16_t*)(KT + SWZ128(c0 + j + 1, 2 * tau)) = (bf16_t)(kt >> 16);
        *(bf16_t*)(VT + SWZ128(c0 + j, 2 * tau)) = (bf16_t)vv[j >> 3][j & 7]; *(bf16_t*)(VT + SWZ128(c0 + j + 1, 2 * tau)) = (bf16_t)vv[(j + 1) >> 3][(j + 1) & 7];
        if (tau == 63) { DD[c0 + j] = __expf(gl2[0]); DD[c0 + j + 1] = __expf(gl2[1]); }
      }
      *(u32x4*)(QH + SWZ256(tau, 2 * c0)) = (u32x4){qh[0], qh[1], qh[2], qh[3]}; *(u32x4*)(QH + SWZ256(tau, 2 * c0 + 16)) = (u32x4){qh[4], qh[5], qh[6], qh[7]};
      *(u32x4*)(KH + SWZ256(tau, 2 * c0)) = (u32x4){kh[0], kh[1], kh[2], kh[3]}; *(u32x4*)(KH + SWZ256(tau, 2 * c0 + 16)) = (u32x4){kh[4], kh[5], kh[6], kh[7]};
    }
    __syncthreads();
    if (wid < 4 && wid != 1) { const int ti = wid >> 1, si = wid & 1; f32x16 a = f32x16{};
#pragma unroll
      for (int k8 = 0; k8 < 8; ++k8) { const int cb = (16 * k8 + 8 * hi) * 2;
        const bf16x8 av = *(const bf16x8*)(QH + SWZ256(32 * ti + r32, cb)); const bf16x8 bv = *(const bf16x8*)(KH + SWZ256(32 * si + r32, cb));
        a = __builtin_amdgcn_mfma_f32_32x32x16_bf16(av, bv, a, 0, 0, 0); }
#pragma unroll
      for (int r = 0; r < 16; ++r) { const int tl = 32 * ti + crow(r, hi), sl = 32 * si + r32; const float val = (sl <= tl) ? a[r] : 0.f;
        *(bf16_t*)(AL + SWZ128(tl, 2 * sl)) = (bf16_t)(cvtpk(val, 0.f) & 0xffffu); } }
    __syncthreads();
    { const int th = wid >> 2, vb = wid & 3; f32x16 o = f32x16{};
      const int nks = th ? 4 : 2;
      for (int ks = 0; ks < nks; ++ks) { const int cb = (16 * ks + 8 * hi) * 2;
        const bf16x8 av = *(const bf16x8*)(AL + SWZ128(32 * th + r32, cb)); const bf16x8 bv = *(const bf16x8*)(VT + SWZ128(32 * vb + r32, cb));
        o = __builtin_amdgcn_mfma_f32_32x32x16_bf16(av, bv, o, 0, 0, 0); }
#pragma unroll
      for (int k8 = 0; k8 < 8; ++k8) { const int cb = (16 * k8 + 8 * hi) * 2;
        const bf16x8 av = *(const bf16x8*)(QH + SWZ256(32 * th + r32, cb)); const bf16x8 bv = *(const bf16x8*)(ST + SWZ256(32 * vb + r32, cb));
        o = __builtin_amdgcn_mfma_f32_32x32x16_bf16(av, bv, o, 0, 0, 0); }
#pragma unroll
      for (int r = 0; r < 16; ++r) { const int t2 = ci * 64 + 32 * th + crow(r, hi); const int tok = dir ? (S - 1 - t2) : t2;
        OPd[(size_t)(rowbase + tok) * 512 + h * 128 + 32 * vb + r32] = o[r]; }
#pragma unroll
      for (int i = 0; i < 2; ++i) { const int kb = 2 * th + i; const float dk = DD[32 * kb + r32];
#pragma unroll
        for (int r = 0; r < 16; ++r) sacc[i][r] *= dk;
#pragma unroll
        for (int ks = 0; ks < 4; ++ks) { const int cb = (16 * ks + 8 * hi) * 2;
          const bf16x8 av = *(const bf16x8*)(VT + SWZ128(32 * vb + r32, cb)); const bf16x8 bv = *(const bf16x8*)(KT + SWZ128(32 * kb + r32, cb));
          sacc[i] = __builtin_amdgcn_mfma_f32_32x32x16_bf16(av, bv, sacc[i], 0, 0, 0); } }
    }
    __syncthreads();
    { const int th = wid >> 2, vb = wid & 3;
#pragma unroll
      for (int i = 0; i < 2; ++i) { const int kb = 2 * th + i;
#pragma unroll
        for (int r = 0; r < 16; ++r) *(bf16_t*)(ST + SWZ256(32 * vb + crow(r, hi), 2 * (32 * kb + r32))) = (bf16_t)(cvtpk(sacc[i][r], 0.f) & 0xffffu); } }
  }
  __syncthreads();
}
#undef SWZ256
#undef SWZ128
}
typedef unsigned short bf16_t;
typedef float f32x4 __attribute__((ext_vector_type(4)));
typedef unsigned u32x4 __attribute__((ext_vector_type(4)));
typedef unsigned u32x2 __attribute__((ext_vector_type(2)));
typedef short bf16x8 __attribute__((ext_vector_type(8)));
#define LAS __attribute__((address_space(3)))
constexpr size_t MiB = 1u << 20;
constexpr size_t WS_SS = 0;
constexpr size_t WS_ROPEC = 4 * MiB, WS_ROPES = 5 * MiB;
constexpr size_t WS_W1GU = 16 * MiB, WS_W1D = 27 * MiB, WS_WIN = 33 * MiB, WS_WUQ = 40 * MiB, WS_WUKV = 41 * MiB, WS_WO = 42 * MiB, WS_W2GU = 44 * MiB, WS_W2D = 55 * MiB, WS_WPG = 61 * MiB, WS_WPP = 63 * MiB;
constexpr size_t WS_HB = 64 * MiB;
constexpr size_t WS_BIG = 256 * MiB;
constexpr size_t WS_UHG = WS_BIG, WS_UMLA = WS_BIG + 480 * MiB, WS_MIX = WS_BIG + 480 * MiB, WS_ACT = WS_BIG, WS_PROJ = WS_BIG;
constexpr size_t WS_PB = 928 * MiB;
constexpr size_t WS_END = 976 * MiB;
constexpr size_t DO_Q = 0, DO_KN = 144 * MiB, DO_V = 240 * MiB, DO_KR = 336 * MiB;
constexpr int LDS_BYTES = 147456;

struct Params {
  const float* in[26];
  float* out; unsigned char* ws;
};

__device__ __forceinline__ unsigned f2bf(float f) { unsigned u = __builtin_bit_cast(unsigned, f); return (u + 0x7fffu + ((u >> 16) & 1u)) >> 16; }
__device__ __forceinline__ unsigned pk2(float lo, float hi) { return f2bf(lo) | (f2bf(hi) << 16); }
__device__ __forceinline__ float wave_sum(float v) {
#pragma unroll
  for (int o = 1; o < 64; o <<= 1) v += __shfl_xor(v, o);
  return v;
}
__device__ __forceinline__ void prep_item(const float* W, int ld, int col0, const float* fold, bf16_t* WT, int K, int n0, int k0, float* scr, int lane) {
#pragma unroll 8
  for (int i = 0; i < 32; ++i) { const int kk = 2 * i + (lane >> 5); float v = 0.f; if (W) { v = W[(size_t)(k0 + kk) * ld + col0 + (lane & 31)]; if (fold) v *= fold[k0 + kk]; } scr[kk * 33 + (lane & 31)] = v; }
  asm volatile("s_waitcnt lgkmcnt(0)" ::: "memory");
  const int c = lane & 7;
#pragma unroll
  for (int j = 0; j < 4; ++j) { const int n = (lane >> 3) + 8 * j; const float* s = scr + (8 * c) * 33 + n;
    u32x4 o; o.x = pk2(s[0 * 33], s[1 * 33]); o.y = pk2(s[2 * 33], s[3 * 33]); o.z = pk2(s[4 * 33], s[5 * 33]); o.w = pk2(s[6 * 33], s[7 * 33]);
    *(u32x4*)(WT + (size_t)(n0 + n) * K + k0 + 8 * c) = o; }
  asm volatile("s_waitcnt lgkmcnt(0)" ::: "memory");
}
__device__ __forceinline__ void sincos_d(double x, float& s, float& c) {
  const double TWO_PI = 6.283185307179586476925286766559, INV_2PI = 0.15915494309189533576888376337251;
  double k = __builtin_rint(x * INV_2PI); double r = x - k * TWO_PI;
  const double HALF_PI = 1.5707963267948966192313216916398;
  double q = __builtin_rint(r * 0.63661977236758134308); double y = r - q * HALF_PI; int qi = ((int)q) & 3;
  double y2 = y * y;
  double sp = y * (1.0 + y2 * (-1.0 / 6 + y2 * (1.0 / 120 + y2 * (-1.0 / 5040 + y2 * (1.0 / 362880 + y2 * (-1.0 / 39916800 + y2 * (1.0 / 6227020800.0)))))));
  double cp = 1.0 + y2 * (-0.5 + y2 * (1.0 / 24 + y2 * (-1.0 / 720 + y2 * (1.0 / 40320 + y2 * (-1.0 / 3628800 + y2 * (1.0 / 479001600.0 + y2 * (-1.0 / 87178291200.0)))))));
  double ss, cc;
  if (qi == 0) { ss = sp; cc = cp; } else if (qi == 1) { ss = cp; cc = -sp; } else if (qi == 2) { ss = -sp; cc = -cp; } else { ss = -cp; cc = sp; }
  s = (float)ss; c = (float)cc;
}

__device__ __forceinline__ void p0_prologue(const Params& P, unsigned char* ws, char* lds) {
  int tid_ = threadIdx.x; asm volatile("" : "+v"(tid_)); const int tid = tid_, lane = tid & 63, wave = tid >> 6;
  const int gw = blockIdx.x * 8 + wave, NGW = gridDim.x * 8;
  float* scr = (float*)(lds + wave * 16384);
  constexpr int NJ = 10;
  const int jN[NJ] = {NGU, 1024, NIN, 768, 1024, 1024, NGU, 1024, 1024, 1024};
  const int jK[NJ] = {1024, DFF, 1024, 384, 256, 1024, 1024, DFF, 1024, 256};
  int total = 0;
#pragma unroll
  for (int j = 0; j < NJ; ++j) total += (jN[j] / 32) * (jK[j] / 64);
  for (int it = gw; it < total; it += NGW) {
    int r = it, job = 0;
#pragma unroll
    for (int j = 0; j < NJ; ++j) { const int cnt = (jN[j] / 32) * (jK[j] / 64); if (job == j && r >= cnt) { r -= cnt; job = j + 1; } }
    int N = 0, K = 0;
#pragma unroll
    for (int j = 0; j < NJ; ++j) if (job == j) { N = jN[j]; K = jK[j]; }
    const int nblk = N / 32, kb = r / nblk, nb = r % nblk, k0 = 64 * kb, n0 = 32 * nb;
    const float* W = nullptr; int ld = 0, col0 = 0; const float* fold = nullptr; bf16_t* WT = nullptr;
    if (job == 0 || job == 6) { const int t = n0 >> 8, half = (n0 >> 7) & 1, j0 = n0 & 127; const int b = (job == 0) ? 5 : 19;
      W = P.in[b + half]; ld = DFF; col0 = 128 * t + j0; fold = P.in[(job == 0) ? 4 : 18]; WT = (bf16_t*)(ws + ((job == 0) ? WS_W1GU : WS_W2GU)); }
    else if (job == 1 || job == 7) { W = P.in[(job == 1) ? 7 : 21]; ld = 1024; col0 = n0; WT = (bf16_t*)(ws + ((job == 1) ? WS_W1D : WS_W2D)); }
    else if (job == 2) { ld = 3232; fold = P.in[8]; WT = (bf16_t*)(ws + WS_WIN); W = P.in[9];
      if (n0 < 384) col0 = n0; else if (n0 < 416) col0 = 640 + (n0 - 384); else if (n0 < 512) W = nullptr; else if (n0 < 768) col0 = 384 + (n0 - 512); else col0 = 672 + (n0 - 768); }
    else if (job == 3) { W = P.in[11]; ld = 768; col0 = n0; fold = P.in[10]; WT = (bf16_t*)(ws + WS_WUQ); }
    else if (job == 4) { if (n0 < 512) { W = P.in[13]; col0 = n0; } else { W = P.in[14]; col0 = n0 - 512; } ld = 512; fold = P.in[12]; WT = (bf16_t*)(ws + WS_WUKV); }
    else if (job == 5) { W = P.in[17]; ld = 1024; col0 = n0; WT = (bf16_t*)(ws + WS_WO); }
    else if (job == 8) { W = P.in[23]; ld = 1024; col0 = n0; fold = P.in[22]; WT = (bf16_t*)(ws + WS_WPG); }
    else { W = P.in[24]; ld = 1024; col0 = n0; WT = (bf16_t*)(ws + WS_WPP); }
    prep_item(W, ld, col0, fold, WT, K, n0, k0, scr, lane);
  }
  float* ss = (float*)(ws + WS_SS); bf16_t* HB = (bf16_t*)(ws + WS_HB); bf16_t* PB = (bf16_t*)(ws + WS_PB);
  for (int m = gw; m < T_ALL; m += NGW) {
    const float* xr = (m < T_P) ? P.in[0] + (size_t)m * DM : P.in[1] + (size_t)(m - T_P) * DM;
    const f32x4* x4 = (const f32x4*)xr + lane; float s = 0.f; f32x4 v[4];
#pragma unroll
    for (int j = 0; j < 4; ++j) { v[j] = x4[64 * j]; s += (v[j][0] * v[j][0] + v[j][1] * v[j][1]) + (v[j][2] * v[j][2] + v[j][3] * v[j][3]); }
    s = wave_sum(s);
    u32x2* o8 = (u32x2*)(HB + (size_t)m * DM) + lane;
#pragma unroll
    for (int j = 0; j < 4; ++j) { u32x2 w; w.x = pk2(v[j][0], v[j][1]); w.y = pk2(v[j][2], v[j][3]); o8[64 * j] = w; }
    const float* pr = (m < T_P) ? P.in[2] + (size_t)m * PLE : P.in[3] + (size_t)(m - T_P) * PLE;
    const f32x4 pv = ((const f32x4*)pr)[lane]; u32x2 w; w.x = pk2(pv[0], pv[1]); w.y = pk2(pv[2], pv[3]); ((u32x2*)(PB + (size_t)m * PLE))[lane] = w;
    if (lane < 7) ss[(size_t)lane * T_ALL + m] = (lane == 0) ? s : 0.f;
  }
  float* rc = (float*)(ws + WS_ROPEC); float* rs = (float*)(ws + WS_ROPES);
  for (int e = blockIdx.x * 512 + tid; e < S_P * 16; e += gridDim.x * 512) {
    const int pos = e >> 4, i = e & 15;
    const float cst = (float)(-9.210340371976184 / 32.0); const float arg = (float)(2 * i) * cst;
    const double a = (double)arg; const double nn = __builtin_rint(a * 1.4426950408889634); const double rr = a - nn * 0.69314718055994530942;
    double ex = 1.0 + rr * (1.0 + rr * (0.5 + rr * (1.0 / 6 + rr * (1.0 / 24 + rr * (1.0 / 120 + rr * (1.0 / 720 + rr * (1.0 / 5040 + rr * (1.0 / 40320 + rr * (1.0 / 362880 + rr * (1.0 / 3628800 + rr * (1.0 / 39916800)))))))))));
    ex = ex * __builtin_ldexp(1.0, (int)nn);
    const float invf = (float)ex; const float ang = (float)pos * invf;
    float sv, cv; sincos_d((double)ang, sv, cv); rc[e] = cv; rs[e] = sv;
  }
}
__device__ __forceinline__ void hg_combine(const float* OP, const bf16_t* U, const float* hg_norm, bf16_t* MIX) {
  int tid_ = threadIdx.x; asm volatile("" : "+v"(tid_)); const int lane = tid_ & 63, wave = tid_ >> 6; const int gw = blockIdx.x * 8 + wave, NGW = gridDim.x * 8;
  f32x4 gn0 = *(const f32x4*)(hg_norm + 8 * lane), gn1 = *(const f32x4*)(hg_norm + 8 * lane + 4);
  for (int m = gw; m < T_ALL; m += NGW) {
    const float* a = OP + (size_t)m * 512 + 8 * lane; const float* b = a + (size_t)T_ALL * 512;
    f32x4 o0 = *(const f32x4*)a + *(const f32x4*)b, o1 = *(const f32x4*)(a + 4) + *(const f32x4*)(b + 4);
    float s = (o0[0] * o0[0] + o0[1] * o0[1]) + (o0[2] * o0[2] + o0[3] * o0[3]) + (o1[0] * o1[0] + o1[1] * o1[1]) + (o1[2] * o1[2] + o1[3] * o1[3]);
    s += __shfl_xor(s, 1); s += __shfl_xor(s, 2); s += __shfl_xor(s, 4); s += __shfl_xor(s, 8);
    const float r = rsqrtf(s * (1.0f / 128.0f) + EPS);
    const bf16x8 g = *(const bf16x8*)(U + (size_t)m * 2560 + 2048 + 8 * lane);
    float ov[8] = {o0[0], o0[1], o0[2], o0[3], o1[0], o1[1], o1[2], o1[3]}; float gnv[8] = {gn0[0], gn0[1], gn0[2], gn0[3], gn1[0], gn1[1], gn1[2], gn1[3]};
    unsigned w[4];
#pragma unroll
    for (int j = 0; j < 8; j += 2) { float r2[2];
#pragma unroll
      for (int e = 0; e < 2; ++e) { const float x = __uint_as_float(((unsigned)(unsigned short)g[j + e]) << 16); const float sl = x * __builtin_amdgcn_rcpf(1.0f + __expf(-x)); r2[e] = ov[j + e] * r * gnv[j + e] * sl; }
      w[j >> 1] = pk2(r2[0], r2[1]); }
    *(u32x4*)(MIX + (size_t)m * 1024 + 512 + 8 * lane) = (u32x4){w[0], w[1], w[2], w[3]};
  }
}
__device__ __forceinline__ void final_norm(float* out, const float* ss4, const float* fn) {
  int tid_ = threadIdx.x; asm volatile("" : "+v"(tid_)); const int lane = tid_ & 63, wave = tid_ >> 6; const int gw = blockIdx.x * 8 + wave, NGW = gridDim.x * 8;
  f32x4 g[4];
#pragma unroll
  for (int j = 0; j < 4; ++j) g[j] = ((const f32x4*)fn)[lane + 64 * j];
  for (int m = gw; m < T_ALL; m += NGW) {
    const float r = rsqrtf(ss4[m] * (1.0f / 1024.0f) + EPS);
    f32x4* p = (f32x4*)(out + (size_t)m * DM) + lane;
#pragma unroll
    for (int j = 0; j < 4; ++j) { const f32x4 v = p[64 * j]; p[64 * j] = v * r * g[j]; }
  }
}

#define GSYNC() cg::this_grid().sync()

template <class Epi> __device__ __forceinline__ void run_gemm(LAS unsigned char* lds, const bf16_t* A, int lda, const bf16_t* Bt, int ldb, int N, int K, const Epi& E) {
  pg8::Gemm g{A, Bt, T_ALL, N, K, lda, ldb}; pg8::StaticOrder S; S.init(T_ALL, N, (int)gridDim.x, (int)blockIdx.x);
  pg8::gemm_phase<Epi, pg8::StaticOrder, true, true>(lds, g, S, E);
}

__global__ void __launch_bounds__(512, 2) mk_fwd(Params P) {
  extern __shared__ __attribute__((aligned(16))) unsigned char lds[];
  unsigned char* ws = P.ws; float* out = P.out; unsigned char* dob = (unsigned char*)P.out;
  LAS unsigned char* l3 = (LAS unsigned char*)lds;
  float* ss = (float*)(ws + WS_SS);
  float* ss0 = ss, *ss1 = ss + T_ALL, *ss2 = ss + 2 * (size_t)T_ALL, *ss3 = ss + 3 * (size_t)T_ALL, *ss4 = ss + 4 * (size_t)T_ALL, *ssq = ss + 5 * (size_t)T_ALL, *sskv = ss + 6 * (size_t)T_ALL;
  const float* ropec = (const float*)(ws + WS_ROPEC); const float* ropes = (const float*)(ws + WS_ROPES);
  bf16_t* HB = (bf16_t*)(ws + WS_HB); bf16_t* ACT = (bf16_t*)(ws + WS_ACT); bf16_t* UHG = (bf16_t*)(ws + WS_UHG); bf16_t* UMLA = (bf16_t*)(ws + WS_UMLA);
  bf16_t* MIX = (bf16_t*)(ws + WS_MIX); bf16_t* PROJ = (bf16_t*)(ws + WS_PROJ); bf16_t* PB = (bf16_t*)(ws + WS_PB);
  bf16_t* Qb = (bf16_t*)(dob + DO_Q); bf16_t* KN = (bf16_t*)(dob + DO_KN); bf16_t* Vb = (bf16_t*)(dob + DO_V); bf16_t* KR = (bf16_t*)(dob + DO_KR);

  p0_prologue(P, ws, (char*)lds);
  GSYNC();
  { pg8::EpiSwiGLU E{ACT, ss0}; run_gemm(l3, HB, 1024, (const bf16_t*)(ws + WS_W1GU), 1024, NGU, 1024, E); }
  GSYNC();
  { pg8::EpiRes<0> E{P.in[0], P.in[1], out, HB, ss1, nullptr, nullptr}; run_gemm(l3, ACT, DFF, (const bf16_t*)(ws + WS_W1D), DFF, 1024, DFF, E); }
  GSYNC();
  { pg8::EpiWin E{UMLA, UHG, KR, ss1, ssq, sskv, ropec, ropes}; run_gemm(l3, HB, 1024, (const bf16_t*)(ws + WS_WIN), 1024, NIN, 1024, E); }
  GSYNC();
  { pg8::EpiBf E{Qb, Qb, 768, 1000, ssq, 1.0f / 384.0f}; run_gemm(l3, UMLA, 768, (const bf16_t*)(ws + WS_WUQ), 384, 768, 384, E); }
  { pg8::EpiBf E{KN, Vb, 512, 2, sskv, 1.0f / 256.0f}; run_gemm(l3, UMLA + 512, 768, (const bf16_t*)(ws + WS_WUKV), 256, 1024, 256, E); }
  GSYNC();
  {
    const int G = gridDim.x, bx = blockIdx.x;
    if (G == 256) {
      const int xcd = bx & 7, idx = bx >> 3;
      for (int i = 0; i < 12; ++i) {
        int rowbase, seq, h, qb;
        if (i < 4) { const int pair = 2 * xcd + (i >> 1); const int b = pair >> 3; h = pair & 7; qb = idx * 2 + (i & 1); rowbase = b * S_P; seq = S_P; }
        else { const int j = i - 4; const int pair = 16 * xcd + 2 * j + (idx >> 4); const int b = pair >> 3; h = pair & 7; qb = idx & 15; rowbase = T_P + b * S_S; seq = S_S; }
        att::attn_unit(Qb + (size_t)(rowbase + qb * 256) * 768 + h * 96, KN + (size_t)rowbase * 512 + h * 64, KR + (size_t)rowbase * 32, Vb + (size_t)rowbase * 512 + h * 64,
                       MIX + (size_t)(rowbase + qb * 256) * 1024 + h * 64, seq, rowbase + qb * 256, ropec, ropes, (char*)lds);
      }
    } else {
      for (int u = bx; u < 3072; u += G) {
        int rowbase, seq, h, qb;
        if (u < 1024) { const int pair = u >> 6; const int b = pair >> 3; h = pair & 7; qb = u & 63; rowbase = b * S_P; seq = S_P; }
        else { const int v = u - 1024; const int pair = v >> 4; const int b = pair >> 3; h = pair & 7; qb = v & 15; rowbase = T_P + b * S_S; seq = S_S; }
        att::attn_unit(Qb + (size_t)(rowbase + qb * 256) * 768 + h * 96, KN + (size_t)rowbase * 512 + h * 64, KR + (size_t)rowbase * 32, Vb + (size_t)rowbase * 512 + h * 64,
                       MIX + (size_t)(rowbase + qb * 256) * 1024 + h * 64, seq, rowbase + qb * 256, ropec, ropes, (char*)lds);
      }
    }
  }
  GSYNC();
  for (int c = blockIdx.x; c < 144; c += gridDim.x) {
    int rowbase, S, h, dir;
    if (c < 16) { const int b = c >> 3; h = (c >> 1) & 3; dir = c & 1; rowbase = b * S_P; S = S_P; }
    else { const int c2 = c - 16; const int b = c2 >> 3; h = (c2 >> 1) & 3; dir = c2 & 1; rowbase = T_P + b * S_S; S = S_S; }
    hg::chain(UHG, out, P.in[15], rowbase, S, h, dir, (char*)lds);
  }
  GSYNC();
  hg_combine(out, UHG, P.in[16], MIX);
  GSYNC();
  { pg8::EpiRes<1> E{nullptr, nullptr, out, HB, ss2, nullptr, nullptr}; run_gemm(l3, MIX, 1024, (const bf16_t*)(ws + WS_WO), 1024, 1024, 1024, E); }
  GSYNC();
  { pg8::EpiSwiGLU E{ACT, ss2}; run_gemm(l3, HB, 1024, (const bf16_t*)(ws + WS_W2GU), 1024, NGU, 1024, E); }
  GSYNC();
  { pg8::EpiRes<2> E{nullptr, nullptr, out, HB, ss3, nullptr, nullptr}; run_gemm(l3, ACT, DFF, (const bf16_t*)(ws + WS_W2D), DFF, 1024, DFF, E); }
  GSYNC();
  { pg8::EpiBf E{PROJ, PROJ, 1024, 1000, nullptr, 0.f}; run_gemm(l3, PB, 256, (const bf16_t*)(ws + WS_WPP), 256, 1024, 256, E); }
  GSYNC();
  { pg8::EpiRes<3> E{nullptr, nullptr, out, HB, ss4, ss3, PROJ}; run_gemm(l3, HB, 1024, (const bf16_t*)(ws + WS_WPG), 1024, 1024, 1024, E); }
  GSYNC();
  final_norm(out, ss4, P.in[25]);
}

extern "C" void kernel_launch(void* const* d_in, const int* in_sizes, int n_in, void* d_out, int out_size, void* d_ws, size_t ws_size, hipStream_t stream) {
  static int grid = 0;
  if (grid == 0) {
    if (n_in != 26 || out_size != T_ALL * DM || ws_size < WS_END) { fprintf(stderr, "kernel_launch: unexpected shapes n_in %d out %d ws %zu\n", n_in, out_size, ws_size); grid = -1; return; }
    int dev = 0, cus = 0, per_cu = 0;
    if (hipGetDevice(&dev) != hipSuccess || hipDeviceGetAttribute(&cus, hipDeviceAttributeMultiprocessorCount, dev) != hipSuccess) { grid = -1; return; }
    if (hipFuncSetAttribute((const void*)mk_fwd, hipFuncAttributeMaxDynamicSharedMemorySize, LDS_BYTES) != hipSuccess) { fprintf(stderr, "kernel_launch: LDS attribute failed\n"); grid = -1; return; }
    if (hipOccupancyMaxActiveBlocksPerMultiprocessor(&per_cu, (const void*)mk_fwd, 512, LDS_BYTES) != hipSuccess || per_cu < 1) { fprintf(stderr, "kernel_launch: occupancy query says %d\n", per_cu); per_cu = 1; }
    (void)hipGetLastError();
    grid = cus;
  }
  if (grid < 0) return;
  Params p{};
  for (int i = 0; i < 26; ++i) p.in[i] = (const float*)d_in[i];
  p.out = (float*)d_out; p.ws = (unsigned char*)d_ws;
  void* args[] = {&p};
  hipError_t e = hipLaunchCooperativeKernel((void*)mk_fwd, dim3(grid), dim3(512), args, LDS_BYTES, stream);
  if (e != hipSuccess) fprintf(stderr, "cooperative launch failed: %s (grid %d)\n", hipGetErrorString(e), grid);
}
```

```cpp
#include <hip/hip_runtime.h>
#include <hip/hip_cooperative_groups.h>
#include <cstdio>
#include <cstdint>
namespace cg = cooperative_groups;

constexpr int DM = 1024, T_P = 32768, T_ALL = 98304, S_P = 16384, S_S = 4096;
constexpr int DFF = 2816, NGU = 5632, NIN = 3328, NMLA = 768, NHG = 2560, PLE = 256;
constexpr float EPS = 1e-6f;
__device__ __forceinline__ int row_pos(int row) { return row < T_P ? (row & (S_P - 1)) : (row & (S_S - 1)); }

namespace pg8 {
#define PG8_LAS __attribute__((address_space(3)))
typedef unsigned short bf16_t;
typedef short bf16x8 __attribute__((ext_vector_type(8)));
typedef float f32x4 __attribute__((ext_vector_type(4)));
typedef unsigned u32x4 __attribute__((ext_vector_type(4)));
constexpr int BM = 256, BK = 64, HALF = 128, HTB = HALF * BK * 2  , STAGE_BYTES = 8 * HTB, NXCD = 8, WGM = 8;

__host__ __device__ __forceinline__ int lds_byte(int r, int c) { const int st = (r >> 4) * 2 + (c >> 5), rr = r & 15, cc = c & 31, ob = rr * 64 + cc * 2; return st * 1024 + (ob ^ (((ob >> 9) & 1) << 5)); }
__host__ __device__ __forceinline__ void stage_rc(int b, int& R, int& C) { const int st = b / 1024, sb = b % 1024, swz = sb ^ (((sb >> 9) & 1) << 5); R = (st >> 1) * 16 + swz / 64; C = (st & 1) * 32 + (swz % 64) / 2; }
__host__ __device__ __forceinline__ int perm32(int rho) { const int n = rho >> 4, i = rho & 15; return 8 * (i >> 2) + 4 * n + (i & 3); }

struct Unit { int pm, pn; };
struct Gemm { const bf16_t* A; const bf16_t* Bt; int M, N, K, lda, ldb; };

struct StaticOrder {
    int nM, nN, nwg, G, c;
    __host__ __device__ void init(int M, int N, int G_, int c_) { nM = M / BM; nN = N / BM; nwg = nM * nN; G = G_; c = c_; }
    __host__ __device__ bool next(int i, Unit& u) const {
        const long L = (long)i * G + c; if (L >= nwg) return false;
        int wgid = (int)L; { const int q = nwg / NXCD, r = nwg % NXCD, xcd = wgid % NXCD, off = wgid / NXCD; wgid = (xcd < r ? xcd * (q + 1) : r * (q + 1) + (xcd - r) * q) + off; }
        const int nig = WGM * nN, gid = wgid / nig, fm = gid * WGM, gsz = (nM - fm) < WGM ? (nM - fm) : WGM;
        u.pm = fm + ((wgid % nig) % gsz); u.pn = (wgid % nig) / gsz; return true;
    }
    __device__ __forceinline__ void a_ready(const Unit&) const {}
    __device__ __forceinline__ void done(const Unit&) const {}
};
__device__ __forceinline__ unsigned cvt_pk_bf16(float lo, float hi) { unsigned r; asm volatile("v_cvt_pk_bf16_f32 %0, %1, %2" : "=v"(r) : "v"(lo), "v"(hi)); return r; }
typedef unsigned u32x2 __attribute__((ext_vector_type(2)));
__device__ __forceinline__ float bf2f(unsigned short h) { return __uint_as_float(((unsigned)h) << 16); }
__device__ __forceinline__ float fsigmoid(float x) { return __builtin_amdgcn_rcpf(1.0f + __expf(-x)); }
__device__ __forceinline__ float row_sum4(float s) { s += __shfl_xor(s, 16); s += __shfl_xor(s, 32); return s; }

struct EpiSwiGLU {
    static constexpr bool PERM = true, AFTER_DRAIN = false;
    bf16_t* O; const float* ss;
    __device__ __forceinline__ void operator()(const f32x4 (&acc)[2][2][4][2], const Unit& u, int wr, int wc, int fr, int fq) const {
        const int row0 = u.pm * BM + wr * 64 + fr; const int col0 = u.pn * HALF + wc * 32 + 8 * fq;
#pragma unroll
        for (int ai = 0; ai < 2; ++ai)
#pragma unroll
            for (int m = 0; m < 4; ++m) { const int row = row0 + ai * HALF + m * 16; const float r = rsqrtf(ss[row] * (1.0f / 1024.0f) + 1e-6f);
                float v[8];
#pragma unroll
                for (int n = 0; n < 2; ++n)
#pragma unroll
                    for (int j = 0; j < 4; ++j) { const float g = acc[ai][0][m][n][j] * r, uu = acc[ai][1][m][n][j] * r; v[n * 4 + j] = g * fsigmoid(g) * uu; }
                u32x4 w; w.x = cvt_pk_bf16(v[0], v[1]); w.y = cvt_pk_bf16(v[2], v[3]); w.z = cvt_pk_bf16(v[4], v[5]); w.w = cvt_pk_bf16(v[6], v[7]);
                *(u32x4*)(O + (size_t)row * 2816 + col0) = w; }
    }
};
template <int MODE> struct EpiRes {
    static constexpr bool PERM = false, AFTER_DRAIN = false;
    const float* xp; const float* xs; float* out; bf16_t* hb; float* ssout; const float* ssin; const bf16_t* proj;
    __device__ __forceinline__ void operator()(const f32x4 (&acc)[2][2][4][2], const Unit& u, int wr, int wc, int fr, int fq) const {
        const int row0 = u.pm * BM + wr * 64 + fr; const int col0 = u.pn * BM + wc * 32 + 4 * fq;
#pragma unroll
        for (int ai = 0; ai < 2; ++ai)
#pragma unroll
            for (int m = 0; m < 4; ++m) { const int row = row0 + ai * HALF + m * 16; float sq = 0.f; float r3 = 0.f;
                if (MODE == 3) r3 = rsqrtf(ssin[row] * (1.0f / 1024.0f) + 1e-6f);
#pragma unroll
                for (int bj = 0; bj < 2; ++bj)
#pragma unroll
                    for (int n = 0; n < 2; ++n) { const int col = col0 + bj * HALF + n * 16; const size_t off = (size_t)row * 1024 + col; f32x4 b, v;
                        if (MODE == 0) { b = (row < 32768) ? *(const f32x4*)(xp + off) : *(const f32x4*)(xs + (off - (size_t)32768 * 1024)); v = b + acc[ai][bj][m][n] * 0.5f; }
                        else if (MODE == 1) { const u32x2 hb2 = *(const u32x2*)(hb + off); b[0] = __uint_as_float(hb2.x << 16); b[1] = __uint_as_float(hb2.x & 0xffff0000u); b[2] = __uint_as_float(hb2.y << 16); b[3] = __uint_as_float(hb2.y & 0xffff0000u); v = b + acc[ai][bj][m][n]; }
                        else if (MODE == 2) { b = *(const f32x4*)(out + off); v = b + acc[ai][bj][m][n] * 0.5f; }
                        else { b = *(const f32x4*)(out + off); const u32x2 p2 = *(const u32x2*)(proj + off); f32x4 pr; pr[0] = __uint_as_float(p2.x << 16); pr[1] = __uint_as_float(p2.x & 0xffff0000u); pr[2] = __uint_as_float(p2.y << 16); pr[3] = __uint_as_float(p2.y & 0xffff0000u);
                            const f32x4 a = acc[ai][bj][m][n] * r3; f32x4 gt; gt[0] = fsigmoid(a[0]); gt[1] = fsigmoid(a[1]); gt[2] = fsigmoid(a[2]); gt[3] = fsigmoid(a[3]); v = b + gt * pr; }
                        sq += (v[0] * v[0] + v[1] * v[1]) + (v[2] * v[2] + v[3] * v[3]);
                        if (MODE != 0) *(f32x4*)(out + off) = v;
                        if (MODE != 3) { u32x2 w; w.x = cvt_pk_bf16(v[0], v[1]); w.y = cvt_pk_bf16(v[2], v[3]); *(u32x2*)(hb + off) = w; } }
                sq = row_sum4(sq);
                if (fq == 0) atomicAdd(ssout + row, sq); }
    }
};
struct EpiWin {
    static constexpr bool PERM = false, AFTER_DRAIN = false;
    bf16_t* umla; bf16_t* uhg; bf16_t* kr; const float* ss1; float* ssq; float* sskv; const float* ropec; const float* ropes;
    __device__ __forceinline__ void operator()(const f32x4 (&acc)[2][2][4][2], const Unit& u, int wr, int wc, int fr, int fq) const {
        const int row0 = u.pm * BM + wr * 64 + fr; const int pn = u.pn;
        bf16_t* dst; int ld, colt;
        if (pn < 3) { dst = umla; ld = 768; colt = pn * BM; } else { dst = uhg; ld = 2560; colt = (pn - 3) * BM; }
        const int col0 = colt + wc * 32 + 4 * fq;
#pragma unroll
        for (int ai = 0; ai < 2; ++ai)
#pragma unroll
            for (int m = 0; m < 4; ++m) { const int row = row0 + ai * HALF + m * 16; const float r = rsqrtf(ss1[row] * (1.0f / 1024.0f) + 1e-6f);
                float sq0 = 0.f, sq1 = 0.f; f32x4 v[2][2];
#pragma unroll
                for (int bj = 0; bj < 2; ++bj)
#pragma unroll
                    for (int n = 0; n < 2; ++n) { v[bj][n] = acc[ai][bj][m][n] * r; const f32x4 x = v[bj][n]; const float s = (x[0] * x[0] + x[1] * x[1]) + (x[2] * x[2] + x[3] * x[3]); if (bj == 0) sq0 += s; else sq1 += s;
                        u32x2 w; w.x = cvt_pk_bf16(x[0], x[1]); w.y = cvt_pk_bf16(x[2], x[3]); *(u32x2*)(dst + (size_t)row * ld + col0 + bj * HALF + n * 16) = w; }
                if (pn < 3) { float s = (pn == 1) ? sq0 : (sq0 + sq1); s = row_sum4(s); if (fq == 0) atomicAdd((pn == 2 ? sskv : ssq) + row, s); }
                if (pn == 1 && wc == 0) {
                    const int pos = row_pos(row); const f32x4 cs = *(const f32x4*)(ropec + pos * 16 + 4 * fq), sn = *(const f32x4*)(ropes + pos * 16 + 4 * fq);
                    const f32x4 x1 = v[1][0], x2 = v[1][1]; const f32x4 o1 = x1 * cs - x2 * sn, o2 = x1 * sn + x2 * cs;
                    u32x2 w1, w2; w1.x = cvt_pk_bf16(o1[0], o1[1]); w1.y = cvt_pk_bf16(o1[2], o1[3]); w2.x = cvt_pk_bf16(o2[0], o2[1]); w2.y = cvt_pk_bf16(o2[2], o2[3]);
                    *(u32x2*)(kr + (size_t)row * 32 + 4 * fq) = w1; *(u32x2*)(kr + (size_t)row * 32 + 16 + 4 * fq) = w2; } }
    }
};
struct EpiBf {
    static constexpr bool PERM = true, AFTER_DRAIN = false;
    bf16_t* O0; bf16_t* O1; int ld; int split; const float* ss; float inv_n;
    __device__ __forceinline__ void operator()(const f32x4 (&acc)[2][2][4][2], const Unit& u, int wr, int wc, int fr, int fq) const {
        const int row0 = u.pm * BM + wr * 64 + fr; bf16_t* base = O0; int colt = u.pn * BM; if (u.pn >= split) { base = O1; colt = (u.pn - split) * BM; }
        const int col0 = colt + wc * 32 + 8 * fq;
#pragma unroll
        for (int ai = 0; ai < 2; ++ai)
#pragma unroll
            for (int m = 0; m < 4; ++m) { const int row = row0 + ai * HALF + m * 16; const float r = ss ? rsqrtf(ss[row] * inv_n + 1e-6f) : 1.0f;
#pragma unroll
                for (int bj = 0; bj < 2; ++bj) { const f32x4 v0 = acc[ai][bj][m][0] * r, v1 = acc[ai][bj][m][1] * r;
                    u32x4 w; w.x = cvt_pk_bf16(v0[0], v0[1]); w.y = cvt_pk_bf16(v0[2], v0[3]); w.z = cvt_pk_bf16(v1[0], v1[1]); w.w = cvt_pk_bf16(v1[2], v1[3]);
                    *(u32x4*)(base + (size_t)row * ld + col0 + bj * HALF) = w; } }
    }
};
template <class Epi, class Sched, bool ALIGN_EPI = false, bool SP2 = false>
__device__ __forceinline__ void gemm_phase(PG8_LAS unsigned char* lds, const Gemm g, const Sched& S, const Epi& E) {
    int tid_ = threadIdx.x; asm volatile("" : "+v"(tid_)); const int tid = tid_, wid = __builtin_amdgcn_readfirstlane(tid >> 6), lane = tid & 63, wr = wid >> 2, wc = wid & 3, fr = lane & 15, fq = lane >> 4;
    const int K = g.K, nt = K / BK;
    unsigned voffA[2], voffB[2];
#pragma unroll
    for (int i = 0; i < 2; ++i) { int R, C; stage_rc(tid * 16 + i * 8192, R, C); const int Rb = Epi::PERM ? ((R & ~31) + perm32(R & 31)) : R;
        voffA[i] = (unsigned)(R * g.lda + C) * 2u; voffB[i] = (unsigned)(Rb * g.ldb + C) * 2u; }
    const size_t kstep = (size_t)(BK * 2);
    const size_t hstepA = (size_t)HALF * g.lda * 2, hstepB = (size_t)HALF * g.ldb * 2;
    const size_t tstepA = 2 * hstepA, tstepB = 2 * hstepB;
    const unsigned ldsw = (unsigned)wid * 1024u;
    const int aoff = lds_byte(wr * 64 + fr, fq * 8), boff = lds_byte(wc * 32 + fr, fq * 8);
#define PG8_SA(b, h) (((b) * 2 + (h)) * HTB)
#define PG8_SB(b, h) ((4 + (b) * 2 + (h)) * HTB)
#define PG8_STAGE(bufoff, gbase, voff) do { _Pragma("unroll") for (int _i = 0; _i < 2; ++_i) \
        __builtin_amdgcn_global_load_lds((const unsigned*)((const char*)(gbase) + (voff)[_i]), (PG8_LAS unsigned*)(lds + (bufoff) + ldsw + _i * 8192), 16, 0, 0); } while (0)
#define PG8_LDA(dst, b, h) do { _Pragma("unroll") for (int m = 0; m < 4; ++m) _Pragma("unroll") for (int k = 0; k < 2; ++k) dst[m][k] = *(const PG8_LAS bf16x8*)(lds + PG8_SA(b, h) + aoff + m * 2048 + k * 1024); } while (0)
#define PG8_LDB(dst, b, h) do { _Pragma("unroll") for (int n = 0; n < 2; ++n) _Pragma("unroll") for (int k = 0; k < 2; ++k) dst[n][k] = *(const PG8_LAS bf16x8*)(lds + PG8_SB(b, h) + boff + n * 2048 + k * 1024); } while (0)
#define PG8_MMA(ai, bj, At, Bt) do { __builtin_amdgcn_s_setprio(1); _Pragma("unroll") for (int m = 0; m < 4; ++m) _Pragma("unroll") for (int n = 0; n < 2; ++n) _Pragma("unroll") for (int k = 0; k < 2; ++k) \
        acc[ai][bj][m][n] = __builtin_amdgcn_mfma_f32_16x16x32_bf16(Bt[n][k], At[m][k], acc[ai][bj][m][n], 0, 0, 0); __builtin_amdgcn_s_setprio(0); } while (0)
#define PG8_WAIT_V(n) asm volatile("s_waitcnt vmcnt(" #n ")" ::: "memory")
#define PG8_WAIT_L(n) asm volatile("s_waitcnt lgkmcnt(" #n ")" ::: "memory")
#define PG8_BAR __builtin_amdgcn_s_barrier()
#define PG8_SCHED __builtin_amdgcn_sched_barrier(0)
    Unit cur, nxt; int ui = 0;
    if (!S.next(0, cur)) return;
    f32x4 acc[2][2][4][2];
#pragma unroll
    for (int a = 0; a < 2; ++a)
#pragma unroll
        for (int b = 0; b < 2; ++b)
#pragma unroll
            for (int m = 0; m < 4; ++m)
#pragma unroll
                for (int n = 0; n < 2; ++n) acc[a][b][m][n] = (f32x4){0.f, 0.f, 0.f, 0.f};
    bf16x8 At[4][2], B0[2][2], B1[2][2];
    const char* cA = (const char*)g.A + (size_t)cur.pm * tstepA; const char* cB = (const char*)g.Bt + (size_t)cur.pn * tstepB;
    S.a_ready(cur);
    if constexpr (SP2) {
        PG8_STAGE(PG8_SB(0, 0), cB, voffB); PG8_STAGE(PG8_SB(0, 1), cB + hstepB, voffB); PG8_STAGE(PG8_SA(0, 0), cA, voffA); PG8_STAGE(PG8_SA(0, 1), cA + hstepA, voffA);
        if (wr == 1) PG8_BAR;
        PG8_WAIT_V(2); PG8_BAR;
        PG8_STAGE(PG8_SB(1, 0), cB + kstep, voffB); PG8_STAGE(PG8_SA(1, 0), cA + kstep, voffA); PG8_STAGE(PG8_SB(1, 1), cB + hstepB + kstep, voffB);
        PG8_WAIT_V(6); PG8_BAR;
    } else {
        PG8_STAGE(PG8_SB(0, 0), cB, voffB); PG8_STAGE(PG8_SA(0, 0), cA, voffA); PG8_STAGE(PG8_SB(0, 1), cB + hstepB, voffB); PG8_STAGE(PG8_SA(0, 1), cA + hstepA, voffA);
        if (wr == 1) PG8_BAR;
        PG8_WAIT_V(4); PG8_BAR;
        PG8_STAGE(PG8_SB(1, 0), cB + kstep, voffB); PG8_STAGE(PG8_SA(1, 0), cA + kstep, voffA); PG8_STAGE(PG8_SB(1, 1), cB + hstepB + kstep, voffB);
        PG8_WAIT_V(6); PG8_BAR;
    }
    for (;;) {
        const bool has_next = S.next(ui + 1, nxt);
        const char* nA = has_next ? (const char*)g.A + (size_t)nxt.pm * tstepA : cA; const char* nB = has_next ? (const char*)g.Bt + (size_t)nxt.pn * tstepB : cB;
        for (int t = 0; t < nt; t += 2) {
            const bool last = (t == nt - 2);
            const char* a1 = cA + (size_t)(t + 1) * kstep;
            const char* a2 = last ? nA : cA + (size_t)(t + 2) * kstep; const char* b2 = last ? nB : cB + (size_t)(t + 2) * kstep;
            const char* a3 = a2 + kstep; const char* b3 = b2 + kstep;
            if (last && has_next) S.a_ready(nxt);
            if constexpr (SP2) {
            PG8_LDB(B0, 0, 0); PG8_LDB(B1, 0, 1); PG8_SCHED; PG8_LDA(At, 0, 0); PG8_STAGE(PG8_SA(1, 1), a1 + hstepA, voffA);
            PG8_WAIT_V(8); PG8_WAIT_L(0); PG8_BAR; PG8_MMA(0, 0, At, B0); PG8_MMA(0, 1, At, B1); PG8_BAR; PG8_SCHED;
            PG8_LDA(At, 0, 1); PG8_STAGE(PG8_SB(0, 0), b2, voffB); PG8_STAGE(PG8_SB(0, 1), b2 + hstepB, voffB); PG8_STAGE(PG8_SA(0, 0), a2, voffA);
            PG8_WAIT_V(8); PG8_WAIT_L(0); PG8_BAR; PG8_MMA(1, 0, At, B0); PG8_MMA(1, 1, At, B1); PG8_BAR; PG8_SCHED;
            PG8_LDB(B0, 1, 0); PG8_LDB(B1, 1, 1); PG8_SCHED; PG8_LDA(At, 1, 0); PG8_STAGE(PG8_SA(0, 1), a2 + hstepA, voffA);
            PG8_WAIT_V(8); PG8_WAIT_L(0); PG8_BAR; PG8_MMA(0, 0, At, B0); PG8_MMA(0, 1, At, B1); PG8_BAR; PG8_SCHED;
            PG8_LDA(At, 1, 1); PG8_STAGE(PG8_SB(1, 0), b3, voffB); PG8_STAGE(PG8_SB(1, 1), b3 + hstepB, voffB); PG8_STAGE(PG8_SA(1, 0), a3, voffA);
            PG8_WAIT_V(8); PG8_WAIT_L(0); PG8_BAR; PG8_MMA(1, 0, At, B0); PG8_MMA(1, 1, At, B1); PG8_BAR; PG8_SCHED;
            } else {
            PG8_LDB(B0, 0, 0); PG8_SCHED; PG8_LDA(At, 0, 0); PG8_STAGE(PG8_SA(1, 1), a1 + hstepA, voffA);
            PG8_WAIT_L(8); PG8_BAR; PG8_WAIT_L(0); PG8_MMA(0, 0, At, B0); PG8_BAR; PG8_SCHED;
            PG8_LDB(B1, 0, 1); PG8_STAGE(PG8_SB(0, 0), b2, voffB);
            PG8_BAR; PG8_WAIT_L(0); PG8_MMA(0, 1, At, B1); PG8_BAR;
            PG8_LDA(At, 0, 1); PG8_STAGE(PG8_SA(0, 0), a2, voffA);
            PG8_BAR; PG8_WAIT_L(0); PG8_MMA(1, 0, At, B0); PG8_BAR; PG8_SCHED;
            PG8_STAGE(PG8_SB(0, 1), b2 + hstepB, voffB);
            PG8_WAIT_V(6); PG8_BAR; PG8_MMA(1, 1, At, B1); PG8_BAR;
            PG8_LDB(B0, 1, 0); PG8_SCHED; PG8_LDA(At, 1, 0); PG8_STAGE(PG8_SA(0, 1), a2 + hstepA, voffA);
            PG8_WAIT_L(8); PG8_BAR; PG8_WAIT_L(0); PG8_MMA(0, 0, At, B0); PG8_BAR; PG8_SCHED;
            PG8_LDB(B1, 1, 1); PG8_STAGE(PG8_SB(1, 0), b3, voffB);
            PG8_BAR; PG8_WAIT_L(0); PG8_MMA(0, 1, At, B1); PG8_BAR;
            PG8_LDA(At, 1, 1); PG8_STAGE(PG8_SA(1, 0), a3, voffA);
            PG8_BAR; PG8_WAIT_L(0); PG8_MMA(1, 0, At, B0); PG8_BAR; PG8_SCHED;
            PG8_STAGE(PG8_SB(1, 1), b3 + hstepB, voffB);
            PG8_WAIT_V(6); PG8_BAR; PG8_MMA(1, 1, At, B1); PG8_BAR;
            }
        }
        if constexpr (ALIGN_EPI) { if (wr == 0) PG8_BAR; }
        if constexpr (!Epi::AFTER_DRAIN) { E(acc, cur, wr, wc, fr, fq); S.done(cur); }
        if (!has_next) break;
#pragma unroll
        for (int a = 0; a < 2; ++a)
#pragma unroll
            for (int b = 0; b < 2; ++b)
#pragma unroll
                for (int m = 0; m < 4; ++m)
#pragma unroll
                    for (int n = 0; n < 2; ++n) acc[a][b][m][n] = (f32x4){0.f, 0.f, 0.f, 0.f};
        cur = nxt; cA = nA; cB = nB; ++ui;
        if constexpr (ALIGN_EPI) { if (wr == 1) PG8_BAR; }
    }
    PG8_WAIT_V(0);
    if constexpr (!ALIGN_EPI) { if (wr == 0) PG8_BAR; }
    PG8_BAR;
    if constexpr (Epi::AFTER_DRAIN) { E.fused(acc, cur, wr, wc, fr, fq, lds, wid, lane); S.done(cur); }
#undef PG8_SA
#undef PG8_SB
#undef PG8_STAGE
#undef PG8_LDA
#undef PG8_LDB
#undef PG8_MMA
#undef PG8_WAIT_V
#undef PG8_WAIT_L
#undef PG8_BAR
#undef PG8_SCHED
}
}

namespace att {
typedef unsigned short bf16_t;
using bf16x8 = __attribute__((ext_vector_type(8))) short;
using s16x4  = __attribute__((ext_vector_type(4))) short;
using f32x16 = __attribute__((ext_vector_type(16))) float;
using u32x4  = __attribute__((ext_vector_type(4))) unsigned;
constexpr int NW = 8, QBLK = 32, KVBLK = 64;
constexpr float SCALE = 0.10206207261596575f;
constexpr float THR = 8.f;
constexpr int LDQ = 768, LDKN = 512, LDKR = 32, LDV = 512, LDO = 1024;
constexpr int SHM_V = 64 * 128 * 2, SHM_K = 64 * 128 * 2;
#define KSWZ(row, colB) ((row) * 256 + ((colB) ^ (((row) & 7) << 4)))
#define SBAR() __builtin_amdgcn_sched_barrier(0)
__device__ __forceinline__ int crow(int r, int hi) { return (r & 3) + 8 * (r >> 2) + 4 * hi; }
__device__ __forceinline__ unsigned cvtpk(float lo, float hi) { unsigned r; asm volatile("v_cvt_pk_bf16_f32 %0, %1, %2" : "=v"(r) : "v"(lo), "v"(hi)); return r; }
__device__ __forceinline__ void partialSM(f32x16& p0, f32x16& p1, float& m_reg, float& mn, float& alpha) {
  constexpr float C = SCALE * 1.4426950408889634f;
  float pmax = p0[0];
#pragma unroll
  for (int r = 1; r < 16; ++r) pmax = fmaxf(pmax, p0[r]);
#pragma unroll
  for (int r = 0; r < 16; ++r) pmax = fmaxf(pmax, p1[r]);
  { auto rr = __builtin_amdgcn_permlane32_swap(__float_as_uint(pmax), __float_as_uint(pmax), false, false);
    pmax = fmaxf(__uint_as_float(rr[0]), __uint_as_float(rr[1])); }
  if (__builtin_expect(__all(pmax - m_reg <= THR / SCALE), 1)) { mn = m_reg; alpha = 1.f; }
  else { mn = fmaxf(m_reg, pmax); alpha = __builtin_amdgcn_exp2f((m_reg - mn) * C); m_reg = mn; }
  float mnC = -mn * C;
#pragma unroll
  for (int r = 0; r < 16; ++r) p0[r] = fmaf(p0[r], C, mnC);
#pragma unroll
  for (int r = 0; r < 16; ++r) p1[r] = fmaf(p1[r], C, mnC);
#pragma unroll
  for (int r = 0; r < 16; ++r) p0[r] = __builtin_amdgcn_exp2f(p0[r]);
}
__device__ __forceinline__ void finishSM(f32x16& p0, f32x16& p1, float alpha, float& l_reg, bf16x8& pa0, bf16x8& pa1, bf16x8& pa2, bf16x8& pa3) {
#pragma unroll
  for (int r = 0; r < 16; ++r) p1[r] = __builtin_amdgcn_exp2f(p1[r]);
  float ps = 0;
#pragma unroll
  for (int r = 0; r < 16; ++r) ps += p0[r];
#pragma unroll
  for (int r = 0; r < 16; ++r) ps += p1[r];
  { auto rr = __builtin_amdgcn_permlane32_swap(__float_as_uint(ps), __float_as_uint(ps), false, false);
    ps = __uint_as_float(rr[0]) + __uint_as_float(rr[1]); }
  l_reg = l_reg * alpha + ps;
#define PK4(P, BASE, OUT) do { unsigned a0 = cvtpk(P[BASE + 0], P[BASE + 1]), a1 = cvtpk(P[BASE + 2], P[BASE + 3]);   \
    unsigned b0 = cvtpk(P[BASE + 4], P[BASE + 5]), b1 = cvtpk(P[BASE + 6], P[BASE + 7]);                              \
    auto r0 = __builtin_amdgcn_permlane32_swap(a0, b0, false, false); auto r1 = __builtin_amdgcn_permlane32_swap(a1, b1, false, false); \
    u32x4 w = {r0[0], r1[0], r0[1], r1[1]}; OUT = *reinterpret_cast<bf16x8*>(&w); } while (0)
  PK4(p0, 0, pa0); PK4(p0, 8, pa1); PK4(p1, 0, pa2); PK4(p1, 8, pa3);
#undef PK4
}
__device__ __forceinline__ void qkt(f32x16& p0, f32x16& p1, const bf16_t* Ks, const bf16x8* qr, int r32, int hi) {
  p0 = f32x16{}; p1 = f32x16{};
#pragma unroll
  for (int d0 = 0; d0 < 6; ++d0) { int cb = (d0 * 16 + hi * 8) * 2;
    bf16x8 b0 = *reinterpret_cast<const bf16x8*>((const char*)Ks + KSWZ(r32, cb));
    bf16x8 b1 = *reinterpret_cast<const bf16x8*>((const char*)Ks + KSWZ(32 + r32, cb));
    p0 = __builtin_amdgcn_mfma_f32_32x32x16_bf16(b0, qr[d0], p0, 0, 0, 0);
    p1 = __builtin_amdgcn_mfma_f32_32x32x16_bf16(b1, qr[d0], p1, 0, 0, 0); }
}
__device__ __forceinline__ int v_st(int k, int c) { const int kk = (k & ~0xC) | ((k & 4) << 1) | ((k & 8) >> 1); return ((kk >> 3) * 4 + (c >> 5)) * 512 + ((kk & 7) * 32 + (c & 31)) * 2; }
__device__ __forceinline__ int v_rd_base(int lane) { return ((lane & 3) << 3) | (((lane >> 2) & 3) << 6) | (((lane >> 4) & 1) << 5) | (((lane >> 5) & 1) << 8); }
constexpr int v_rd_off(int d0, int ks, int half) { return d0 * 512 + ks * 4096 + half * 2048; }
template <int OFF> __device__ __forceinline__ s16x4 tr_read(int vb) {
  s16x4 r; asm volatile("ds_read_b64_tr_b16 %0, %1 offset:%2" : "=&v"(r) : "v"(vb), "i"(OFF) : "memory"); return r;
}
template <int D0> __device__ __forceinline__ void pv_one(f32x16& od, int vb, bf16x8 pa0, bf16x8 pa1, bf16x8 pa2, bf16x8 pa3) {
  const s16x4 l0 = tr_read<v_rd_off(D0, 0, 0)>(vb), h0 = tr_read<v_rd_off(D0, 0, 1)>(vb), l1 = tr_read<v_rd_off(D0, 1, 0)>(vb), h1 = tr_read<v_rd_off(D0, 1, 1)>(vb);
  const s16x4 l2 = tr_read<v_rd_off(D0, 2, 0)>(vb), h2 = tr_read<v_rd_off(D0, 2, 1)>(vb), l3 = tr_read<v_rd_off(D0, 3, 0)>(vb), h3 = tr_read<v_rd_off(D0, 3, 1)>(vb);
  asm volatile("s_waitcnt lgkmcnt(0)" ::: "memory"); SBAR();
#define PK(L, H) (bf16x8){L[0], L[1], L[2], L[3], H[0], H[1], H[2], H[3]}
  od = __builtin_amdgcn_mfma_f32_32x32x16_bf16(pa0, PK(l0, h0), od, 0, 0, 0);
  od = __builtin_amdgcn_mfma_f32_32x32x16_bf16(pa1, PK(l1, h1), od, 0, 0, 0);
  od = __builtin_amdgcn_mfma_f32_32x32x16_bf16(pa2, PK(l2, h2), od, 0, 0, 0);
  od = __builtin_amdgcn_mfma_f32_32x32x16_bf16(pa3, PK(l3, h3), od, 0, 0, 0);
#undef PK
}
__device__ __forceinline__ void pv_d0(f32x16* o, int vb, bf16x8 pa0, bf16x8 pa1, bf16x8 pa2, bf16x8 pa3) {
  pv_one<0>(o[0], vb, pa0, pa1, pa2, pa3); pv_one<1>(o[1], vb, pa0, pa1, pa2, pa3);
}
__device__ __forceinline__ void attn_unit(const bf16_t* __restrict__ Qb, const bf16_t* __restrict__ KNh, const bf16_t* __restrict__ KRb, const bf16_t* __restrict__ Vh,
                                          bf16_t* __restrict__ Ob, int seq, int qrow0, const float* __restrict__ ropec, const float* __restrict__ ropes, char* lds) {
  int tid_ = threadIdx.x; asm volatile("" : "+v"(tid_)); const int tid = tid_, wid = __builtin_amdgcn_readfirstlane(tid >> 6), lane = tid & 63, r32 = lane & 31, hi = lane >> 5;
  bf16_t* V_lds = (bf16_t*)lds; bf16_t* K_lds = (bf16_t*)(lds + 2 * SHM_V);
  float* ws = (float*)(lds + 2 * SHM_V + 2 * SHM_K) + wid * 64; float* li_l = ws; float* al_l = ws + 32;
  float m_reg = -1e30f, l_reg = 0; f32x16 o[2] = {}; bf16x8 qr[6];
  const bf16_t* Qw = Qb + (long)(wid * QBLK + r32) * LDQ + hi * 8;
#pragma unroll
  for (int d0 = 0; d0 < 6; ++d0) qr[d0] = *reinterpret_cast<const bf16x8*>(Qw + d0 * 16);
  {
    const int pos = row_pos(qrow0 + wid * QBLK + r32); const float* cp = ropec + pos * 16 + 8 * hi; const float* sp = ropes + pos * 16 + 8 * hi;
    unsigned w1[4], w2[4];
#pragma unroll
    for (int e = 0; e < 8; e += 2) { float o1[2], o2[2];
#pragma unroll
      for (int f = 0; f < 2; ++f) { const float x1 = __uint_as_float(((unsigned)(unsigned short)qr[4][e + f]) << 16), x2 = __uint_as_float(((unsigned)(unsigned short)qr[5][e + f]) << 16); const float c = cp[e + f], s = sp[e + f];
        o1[f] = x1 * c - x2 * s; o2[f] = x1 * s + x2 * c; }
      w1[e >> 1] = cvtpk(o1[0], o1[1]); w2[e >> 1] = cvtpk(o2[0], o2[1]); }
    u32x4 v1 = {w1[0], w1[1], w1[2], w1[3]}, v2 = {w2[0], w2[1], w2[2], w2[3]}; qr[4] = *reinterpret_cast<bf16x8*>(&v1); qr[5] = *reinterpret_cast<bf16x8*>(&v2); }
  const int sr = tid >> 4, sc = (tid & 15) * 8, vst0 = v_st(sr, sc), vst1 = v_st(32 + sr, sc);
  const bf16_t* kp = (sc < 64) ? (KNh + sc) : (KRb + ((sc - 64) & 31)); const int kld = (sc < 64) ? LDKN : LDKR;
  const bf16_t* vp = Vh + (sc & 63);
  const int vb0 = (int)(uintptr_t)V_lds + v_rd_base(lane);
  struct { bf16x8 vs0, vs1, ks0, ks1; } sr_[2];
#define SLOAD(i, k0) do { sr_[i].vs0 = *reinterpret_cast<const bf16x8*>(&vp[(long)((k0) + sr) * LDV]); sr_[i].vs1 = *reinterpret_cast<const bf16x8*>(&vp[(long)((k0) + 32 + sr) * LDV]); \
    sr_[i].ks0 = *reinterpret_cast<const bf16x8*>(&kp[(long)((k0) + sr) * kld]); sr_[i].ks1 = *reinterpret_cast<const bf16x8*>(&kp[(long)((k0) + 32 + sr) * kld]); } while (0)
#define SWRITE(b, i) do { *(bf16x8*)((char*)V_lds + (b) * SHM_V + vst0) = sr_[i].vs0;          \
    *(bf16x8*)((char*)V_lds + (b) * SHM_V + vst1) = sr_[i].vs1; int kc = sc * 2;               \
    *(bf16x8*)((char*)K_lds + (b) * SHM_K + KSWZ(sr, kc)) = sr_[i].ks0;                       \
    *(bf16x8*)((char*)K_lds + (b) * SHM_K + KSWZ(32 + sr, kc)) = sr_[i].ks1; } while (0)
#define SWAIT() asm volatile("s_waitcnt vmcnt(4)" ::: "memory")
#define RESC(a) do { if (__any((a) < 1.f)) { if (hi == 0) al_l[r32] = (a); asm volatile("s_waitcnt lgkmcnt(0)" ::: "memory"); \
    _Pragma("unroll") for (int d = 0; d < 2; ++d) _Pragma("unroll") for (int r = 0; r < 16; ++r) o[d][r] *= al_l[crow(r, hi)]; } } while (0)
  f32x16 pA0, pA1, pB0, pB1; float mnA, mnB, alA, alB; bf16x8 pa0, pa1, pa2, pa3; const int NT = seq / KVBLK;
  constexpr int SE = 0, SO = 1;
  SLOAD(SE, 0); asm volatile("s_waitcnt vmcnt(0)" ::: "memory"); SWRITE(0, SE); __syncthreads();
  qkt(pA0, pA1, K_lds, qr, r32, hi); partialSM(pA0, pA1, m_reg, mnA, alA);
  SLOAD(SO, KVBLK); if (2 < NT) SLOAD(SE, 2 * KVBLK);
  SWAIT(); SWRITE(1, SO); __syncthreads();
  for (int j = 1; j + 1 < NT; j += 2) {
    SBAR(); qkt(pB0, pB1, (bf16_t*)((char*)K_lds + SHM_K), qr, r32, hi);
    finishSM(pA0, pA1, alA, l_reg, pa0, pa1, pa2, pa3); SBAR();
    SLOAD(SO, (j + 2) * KVBLK); SBAR();
    pv_d0(o, vb0, pa0, pa1, pa2, pa3); partialSM(pB0, pB1, m_reg, mnB, alB);
    __syncthreads(); SWAIT(); SWRITE(0, SE);
    RESC(alB); __syncthreads();
    SBAR(); qkt(pA0, pA1, K_lds, qr, r32, hi);
    finishSM(pB0, pB1, alB, l_reg, pa0, pa1, pa2, pa3); SBAR();
    if (j + 3 < NT) SLOAD(SE, (j + 3) * KVBLK); SBAR();
    pv_d0(o, vb0 + (int)SHM_V, pa0, pa1, pa2, pa3); partialSM(pA0, pA1, m_reg, mnA, alA);
    __syncthreads(); SWAIT(); SWRITE(1, SO);
    RESC(alA); __syncthreads();
  }
  SBAR(); qkt(pB0, pB1, (bf16_t*)((char*)K_lds + SHM_K), qr, r32, hi);
  finishSM(pA0, pA1, alA, l_reg, pa0, pa1, pa2, pa3); SBAR();
  pv_d0(o, vb0, pa0, pa1, pa2, pa3); partialSM(pB0, pB1, m_reg, mnB, alB);
  __syncthreads(); RESC(alB);
  finishSM(pB0, pB1, alB, l_reg, pa0, pa1, pa2, pa3); SBAR();
  pv_d0(o, vb0 + (int)SHM_V, pa0, pa1, pa2, pa3);
  if (hi == 0) li_l[r32] = l_reg; asm volatile("s_waitcnt lgkmcnt(0)" ::: "memory");
  float rli[16];
#pragma unroll
  for (int r = 0; r < 16; ++r) rli[r] = __builtin_amdgcn_rcpf(li_l[crow(r, hi)]);
  bf16_t* Ow = Ob + (long)(wid * QBLK) * LDO;
#pragma unroll
  for (int r = 0; r < 16; ++r) { int orow = crow(r, hi);
#pragma unroll
    for (int d0 = 0; d0 < 2; ++d0) { const unsigned w = cvtpk(o[d0][r] * rli[r], 0.f); Ow[(long)orow * LDO + d0 * 32 + r32] = (bf16_t)(w & 0xffffu); } }
  __syncthreads();
#undef SLOAD
#undef SWRITE
#undef SWAIT
#undef RESC
}
#undef KSWZ
#undef SBAR
}
namespace hg {
typedef unsigned short bf16_t;
using bf16x8 = __attribute__((ext_vector_type(8))) short;
using f32x16 = __attribute__((ext_vector_type(16))) float;
using f32x4  = __attribute__((ext_vector_type(4))) float;
using u32x4  = __attribute__((ext_vector_type(4))) unsigned;
#define SWZ256(row, colB) ((row) * 256 + ((colB) ^ (((row) & 7) << 4)))
#define SWZ128(row, colB) ((row) * 128 + ((colB) ^ (((row) & 7) << 4)))
constexpr int L_ST = 0, L_QH = 32768, L_KH = 49152, L_KT = 65536, L_VT = 81920, L_GB = 98304, L_SEG = 131072, L_DD = 133120, L_LB = 133632;
__device__ __forceinline__ int crow(int r, int hi) { return (r & 3) + 8 * (r >> 2) + 4 * hi; }
__device__ __forceinline__ unsigned cvtpk(float lo, float hi) { unsigned r; asm volatile("v_cvt_pk_bf16_f32 %0, %1, %2" : "=v"(r) : "v"(lo), "v"(hi)); return r; }
__device__ __forceinline__ float bf2f(unsigned short h) { return __uint_as_float(((unsigned)h) << 16); }
template <int MODE> __device__ __forceinline__ void chain(const bf16_t* __restrict__ U, float* __restrict__ OP, const float* __restrict__ hg_lb, int rowbase, int S, int h, int dir, int tau0, int nchunk,
                                                   const float* __restrict__ slot_in, float* __restrict__ slot_out, float* __restrict__ dseg_out, char* lds) {
  int tid_ = threadIdx.x; asm volatile("" : "+v"(tid_)); const int tid = tid_, wid = __builtin_amdgcn_readfirstlane(tid >> 6), lane = tid & 63, r32 = lane & 31, hi = lane >> 5;
  float* GB = (float*)(lds + L_GB); float* SEG = (float*)(lds + L_SEG); float* DD = (float*)(lds + L_DD); float* LB = (float*)(lds + L_LB);
  char* ST = lds + L_ST; char* QH = lds + L_QH; char* KH = lds + L_KH; char* KT = lds + L_KT; char* VT = lds + L_VT; char* AL = lds + L_GB;
  if (tid < 128) { const float a0 = hg_lb[dir * 1024 + h * 128 + tid], a1 = hg_lb[dir * 1024 + 512 + h * 128 + tid]; LB[tid] = 1.0f / (1.0f + __expf(a1 - a0)); }
  f32x16 sacc[2]; sacc[0] = f32x16{}; sacc[1] = f32x16{};
  if (MODE == 3) {
    if (slot_in) {
#pragma unroll
      for (int i = 0; i < 2; ++i)
#pragma unroll
        for (int r = 0; r < 16; ++r) sacc[i][r] = slot_in[(32 * (wid & 3) + crow(r, hi)) * 128 + 32 * (2 * (wid >> 2) + i) + r32];
    }
#pragma unroll
    for (int i = 0; i < 2; ++i)
#pragma unroll
      for (int r = 0; r < 16; ++r) *(bf16_t*)(ST + SWZ256(32 * (wid & 3) + crow(r, hi), 2 * (32 * (2 * (wid >> 2) + i) + r32))) = (bf16_t)(cvtpk(sacc[i][r], 0.f) & 0xffffu);
  }
  float dseg = 1.0f;
  const int tau = tid >> 3, c0 = (tid & 7) * 16, segt = tau >> 4;
  const bf16_t* Ub = U + (size_t)rowbase * 2560 + h * 128 + c0;
  const size_t offq = 0, offv = 512, offf = (size_t)(2 + dir) * 512;
  float* OPd = OP + (size_t)dir * T_ALL * 512;
  bf16x8 nq0, nq1, nv0, nv1, nf0, nf1;
  { const int t1 = tau0 + tau; const int tok = dir ? (S - 1 - t1) : t1; const bf16_t* p = Ub + (size_t)tok * 2560;
    nq0 = *(const bf16x8*)(p + offq); nq1 = *(const bf16x8*)(p + offq + 8); nv0 = *(const bf16x8*)(p + offv); nv1 = *(const bf16x8*)(p + offv + 8); nf0 = *(const bf16x8*)(p + offf); nf1 = *(const bf16x8*)(p + offf + 8); }
  __syncthreads();
  for (int ci = 0; ci < nchunk; ++ci) {
    const bf16x8 qv[2] = {nq0, nq1}, vv[2] = {nv0, nv1}, fv[2] = {nf0, nf1};
    { const int cn = (ci + 1 < nchunk) ? ci + 1 : ci; const int t2 = tau0 + cn * 64 + tau; const int tok = dir ? (S - 1 - t2) : t2; const bf16_t* p = Ub + (size_t)tok * 2560;
      nq0 = *(const bf16x8*)(p + offq); nq1 = *(const bf16x8*)(p + offq + 8); nv0 = *(const bf16x8*)(p + offv); nv1 = *(const bf16x8*)(p + offv + 8); nf0 = *(const bf16x8*)(p + offf); nf1 = *(const bf16x8*)(p + offf + 8); }
    float qq[16], kk[16];
#pragma unroll
    for (int j = 0; j < 16; ++j) {
      const float z = bf2f((unsigned short)fv[j >> 3][j & 7]); const float x = bf2f((unsigned short)qv[j >> 3][j & 7]);
      const float lbv = LB[c0 + j]; const float sg = __builtin_amdgcn_rcpf(1.0f + __expf(-z)); const float f = lbv + (1.0f - lbv) * sg;
      kk[j] = 1.0f - f; qq[j] = x * __builtin_amdgcn_rcpf(1.0f + __expf(-x));
      GB[tau * 128 + c0 + j] = __logf(f);
    }
    __syncthreads();
    { const int k = tid & 127, seg = tid >> 7; float run = 0.f;
#pragma unroll
      for (int j = 0; j < 16; ++j) { run += GB[(16 * seg + j) * 128 + k]; GB[(16 * seg + j) * 128 + k] = run; }
      SEG[seg * 128 + k] = run; }
    __syncthreads();
    { unsigned qh[8], kh[8];
#pragma unroll
      for (int j = 0; j < 16; j += 2) {
        float g2[2], gl2[2];
#pragma unroll
        for (int e = 0; e < 2; ++e) { const int col = c0 + j + e; const float s0 = SEG[col], s1 = SEG[128 + col], s2 = SEG[256 + col];
          const float off = (segt >= 1 ? s0 : 0.f) + (segt >= 2 ? s1 : 0.f) + (segt >= 3 ? s2 : 0.f);
          g2[e] = GB[tau * 128 + col] + off; gl2[e] = GB[63 * 128 + col] + ((s0 + s1) + s2); }
        const float ea = __expf(g2[0]), eb = __expf(g2[1]);
        qh[j >> 1] = cvtpk(qq[j] * ea, qq[j + 1] * eb);
        kh[j >> 1] = cvtpk(kk[j] * __expf(fminf(-g2[0], 80.f)), kk[j + 1] * __expf(fminf(-g2[1], 80.f)));
        const unsigned kt = cvtpk(kk[j] * __expf(gl2[0] - g2[0]), kk[j + 1] * __expf(gl2[1] - g2[1]));
        *(bf16_t*)(KT + SWZ128(c0 + j, 2 * tau)) = (bf16_t)(kt & 0xffffu); *(bf16_t*)(KT + SWZ128(c0 + j + 1, 2 * tau)) = (bf16_t)(kt >> 16);
        *(bf16_t*)(VT + SWZ128(c0 + j, 2 * tau)) = (bf16_t)vv[j >> 3][j & 7]; *(bf16_t*)(VT + SWZ128(c0 + j + 1, 2 * tau)) = (bf16_t)vv[(j + 1) >> 3][(j + 1) & 7];
        if (tau == 63) { DD[c0 + j] = __expf(gl2[0]); DD[c0 + j + 1] = __expf(gl2[1]); }
      }
      *(u32x4*)(QH + SWZ256(tau, 2 * c0)) = (u32x4){qh[0], qh[1], qh[2], qh[3]}; *(u32x4*)(QH + SWZ256(tau, 2 * c0 + 16)) = (u32x4){qh[4], qh[5], qh[6], qh[7]};
      *(u32x4*)(KH + SWZ256(tau, 2 * c0)) = (u32x4){kh[0], kh[1], kh[2], kh[3]}; *(u32x4*)(KH + SWZ256(tau, 2 * c0 + 16)) = (u32x4){kh[4], kh[5], kh[6], kh[7]};
    }
    __syncthreads();
    if (MODE == 3 && wid < 4 && wid != 1) { const int ti = wid >> 1, si = wid & 1; f32x16 a = f32x16{};
#pragma unroll
      for (int k8 = 0; k8 < 8; ++k8) { const int cb = (16 * k8 + 8 * hi) * 2;
        const bf16x8 av = *(const bf16x8*)(QH + SWZ256(32 * ti + r32, cb)); const bf16x8 bv = *(const bf16x8*)(KH + SWZ256(32 * si + r32, cb));
        a = __builtin_amdgcn_mfma_f32_32x32x16_bf16(av, bv, a, 0, 0, 0); }
#pragma unroll
      for (int r = 0; r < 16; ++r) { const int tl = 32 * ti + crow(r, hi), sl = 32 * si + r32; const float val = (sl <= tl) ? a[r] : 0.f;
        *(bf16_t*)(AL + SWZ128(tl, 2 * sl)) = (bf16_t)(cvtpk(val, 0.f) & 0xffffu); } }
    if (MODE == 3) __syncthreads();
    { const int th = wid >> 2, vb = wid & 3;
      if (MODE == 3) { f32x16 o = f32x16{};
      const int nks = th ? 4 : 2;
      for (int ks = 0; ks < nks; ++ks) { const int cb = (16 * ks + 8 * hi) * 2;
        const bf16x8 av = *(const bf16x8*)(AL + SWZ128(32 * th + r32, cb)); const bf16x8 bv = *(const bf16x8*)(VT + SWZ128(32 * vb + r32, cb));
        o = __builtin_amdgcn_mfma_f32_32x32x16_bf16(av, bv, o, 0, 0, 0); }
#pragma unroll
      for (int k8 = 0; k8 < 8; ++k8) { const int cb = (16 * k8 + 8 * hi) * 2;
        const bf16x8 av = *(const bf16x8*)(QH + SWZ256(32 * th + r32, cb)); const bf16x8 bv = *(const bf16x8*)(ST + SWZ256(32 * vb + r32, cb));
        o = __builtin_amdgcn_mfma_f32_32x32x16_bf16(av, bv, o, 0, 0, 0); }
#pragma unroll
      for (int r = 0; r < 16; ++r) { const int t2 = tau0 + ci * 64 + 32 * th + crow(r, hi); const int tok = dir ? (S - 1 - t2) : t2;
        OPd[(size_t)(rowbase + tok) * 512 + h * 128 + 32 * vb + r32] = o[r]; }
      } else { if (tid < 128) dseg *= DD[tid]; }
#pragma unroll
      for (int i = 0; i < 2; ++i) { const int kb = 2 * th + i; const float dk = DD[32 * kb + r32];
#pragma unroll
        for (int r = 0; r < 16; ++r) sacc[i][r] *= dk;
#pragma unroll
        for (int ks = 0; ks < 4; ++ks) { const int cb = (16 * ks + 8 * hi) * 2;
          const bf16x8 av = *(const bf16x8*)(VT + SWZ128(32 * vb + r32, cb)); const bf16x8 bv = *(const bf16x8*)(KT + SWZ128(32 * kb + r32, cb));
          sacc[i] = __builtin_amdgcn_mfma_f32_32x32x16_bf16(av, bv, sacc[i], 0, 0, 0); } }
    }
    __syncthreads();
    if (MODE == 3) { const int th = wid >> 2, vb = wid & 3;
#pragma unroll
      for (int i = 0; i < 2; ++i) { const int kb = 2 * th + i;
#pragma unroll
        for (int r = 0; r < 16; ++r) *(bf16_t*)(ST + SWZ256(32 * vb + crow(r, hi), 2 * (32 * kb + r32))) = (bf16_t)(cvtpk(sacc[i][r], 0.f) & 0xffffu); } }
  }
  if (MODE == 1) {
#pragma unroll
    for (int i = 0; i < 2; ++i)
#pragma unroll
      for (int r = 0; r < 16; ++r) slot_out[(32 * (wid & 3) + crow(r, hi)) * 128 + 32 * (2 * (wid >> 2) + i) + r32] = sacc[i][r];
    if (tid < 128) dseg_out[tid] = dseg;
  }
  __syncthreads();
}
#undef SWZ256
#undef SWZ128
}
typedef unsigned short bf16_t;
typedef float f32x4 __attribute__((ext_vector_type(4)));
typedef unsigned u32x4 __attribute__((ext_vector_type(4)));
typedef unsigned u32x2 __attribute__((ext_vector_type(2)));
typedef short bf16x8 __attribute__((ext_vector_type(8)));
#define LAS __attribute__((address_space(3)))
constexpr size_t MiB = 1u << 20;
constexpr size_t WS_SS = 0;
constexpr size_t WS_ROPEC = 4 * MiB, WS_ROPES = 5 * MiB;
constexpr size_t WS_W1GU = 16 * MiB, WS_W1D = 27 * MiB, WS_WIN = 33 * MiB, WS_WUQ = 40 * MiB, WS_WUKV = 41 * MiB, WS_WO = 42 * MiB, WS_W2GU = 44 * MiB, WS_W2D = 55 * MiB, WS_WPG = 61 * MiB, WS_WPP = 63 * MiB;
constexpr size_t WS_HB = 64 * MiB;
constexpr size_t WS_BIG = 256 * MiB;
constexpr size_t WS_UHG = WS_BIG, WS_UMLA = WS_BIG + 480 * MiB, WS_MIX = WS_BIG + 480 * MiB, WS_ACT = WS_BIG, WS_PROJ = WS_BIG;
constexpr size_t WS_PB = 928 * MiB;
constexpr size_t WS_SLOT = 976 * MiB;
constexpr size_t WS_DSEG = 8 * MiB;
constexpr size_t WS_END = 1024 * MiB;
constexpr size_t DO_Q = 0, DO_KN = 144 * MiB, DO_V = 240 * MiB, DO_KR = 336 * MiB;
constexpr int LDS_BYTES = 147456;

struct Params {
  const float* in[26];
  float* out; unsigned char* ws;
};

__device__ __forceinline__ unsigned f2bf(float f) { unsigned u = __builtin_bit_cast(unsigned, f); return (u + 0x7fffu + ((u >> 16) & 1u)) >> 16; }
__device__ __forceinline__ unsigned pk2(float lo, float hi) { return f2bf(lo) | (f2bf(hi) << 16); }
__device__ __forceinline__ float wave_sum(float v) {
#pragma unroll
  for (int o = 1; o < 64; o <<= 1) v += __shfl_xor(v, o);
  return v;
}
__device__ __forceinline__ void prep_item(const float* W, int ld, int col0, const float* fold, bf16_t* WT, int K, int n0, int k0, float* scr, int lane) {
#pragma unroll 8
  for (int i = 0; i < 32; ++i) { const int kk = 2 * i + (lane >> 5); float v = 0.f; if (W) { v = W[(size_t)(k0 + kk) * ld + col0 + (lane & 31)]; if (fold) v *= fold[k0 + kk]; } scr[kk * 33 + (lane & 31)] = v; }
  asm volatile("s_waitcnt lgkmcnt(0)" ::: "memory");
  const int c = lane & 7;
#pragma unroll
  for (int j = 0; j < 4; ++j) { const int n = (lane >> 3) + 8 * j; const float* s = scr + (8 * c) * 33 + n;
    u32x4 o; o.x = pk2(s[0 * 33], s[1 * 33]); o.y = pk2(s[2 * 33], s[3 * 33]); o.z = pk2(s[4 * 33], s[5 * 33]); o.w = pk2(s[6 * 33], s[7 * 33]);
    *(u32x4*)(WT + (size_t)(n0 + n) * K + k0 + 8 * c) = o; }
  asm volatile("s_waitcnt lgkmcnt(0)" ::: "memory");
}
__device__ __forceinline__ void sincos_d(double x, float& s, float& c) {
  const double TWO_PI = 6.283185307179586476925286766559, INV_2PI = 0.15915494309189533576888376337251;
  double k = __builtin_rint(x * INV_2PI); double r = x - k * TWO_PI;
  const double HALF_PI = 1.5707963267948966192313216916398;
  double q = __builtin_rint(r * 0.63661977236758134308); double y = r - q * HALF_PI; int qi = ((int)q) & 3;
  double y2 = y * y;
  double sp = y * (1.0 + y2 * (-1.0 / 6 + y2 * (1.0 / 120 + y2 * (-1.0 / 5040 + y2 * (1.0 / 362880 + y2 * (-1.0 / 39916800 + y2 * (1.0 / 6227020800.0)))))));
  double cp = 1.0 + y2 * (-0.5 + y2 * (1.0 / 24 + y2 * (-1.0 / 720 + y2 * (1.0 / 40320 + y2 * (-1.0 / 3628800 + y2 * (1.0 / 479001600.0 + y2 * (-1.0 / 87178291200.0)))))));
  double ss, cc;
  if (qi == 0) { ss = sp; cc = cp; } else if (qi == 1) { ss = cp; cc = -sp; } else if (qi == 2) { ss = -sp; cc = -cp; } else { ss = -cp; cc = sp; }
  s = (float)ss; c = (float)cc;
}

__device__ __forceinline__ void p0_prologue(const Params& P, unsigned char* ws, char* lds) {
  int tid_ = threadIdx.x; asm volatile("" : "+v"(tid_)); const int tid = tid_, lane = tid & 63, wave = tid >> 6;
  const int gw = blockIdx.x * 8 + wave, NGW = gridDim.x * 8;
  float* scr = (float*)(lds + wave * 16384);
  constexpr int NJ = 10;
  const int jN[NJ] = {NGU, 1024, NIN, 768, 1024, 1024, NGU, 1024, 1024, 1024};
  const int jK[NJ] = {1024, DFF, 1024, 384, 256, 1024, 1024, DFF, 1024, 256};
  int total = 0;
#pragma unroll
  for (int j = 0; j < NJ; ++j) total += (jN[j] / 32) * (jK[j] / 64);
  for (int it = gw; it < total; it += NGW) {
    int r = it, job = 0;
#pragma unroll
    for (int j = 0; j < NJ; ++j) { const int cnt = (jN[j] / 32) * (jK[j] / 64); if (job == j && r >= cnt) { r -= cnt; job = j + 1; } }
    int N = 0, K = 0;
#pragma unroll
    for (int j = 0; j < NJ; ++j) if (job == j) { N = jN[j]; K = jK[j]; }
    const int nblk = N / 32, kb = r / nblk, nb = r % nblk, k0 = 64 * kb, n0 = 32 * nb;
    const float* W = nullptr; int ld = 0, col0 = 0; const float* fold = nullptr; bf16_t* WT = nullptr;
    if (job == 0 || job == 6) { const int t = n0 >> 8, half = (n0 >> 7) & 1, j0 = n0 & 127; const int b = (job == 0) ? 5 : 19;
      W = P.in[b + half]; ld = DFF; col0 = 128 * t + j0; fold = P.in[(job == 0) ? 4 : 18]; WT = (bf16_t*)(ws + ((job == 0) ? WS_W1GU : WS_W2GU)); }
    else if (job == 1 || job == 7) { W = P.in[(job == 1) ? 7 : 21]; ld = 1024; col0 = n0; WT = (bf16_t*)(ws + ((job == 1) ? WS_W1D : WS_W2D)); }
    else if (job == 2) { ld = 3232; fold = P.in[8]; WT = (bf16_t*)(ws + WS_WIN); W = P.in[9];
      if (n0 < 384) col0 = n0; else if (n0 < 416) col0 = 640 + (n0 - 384); else if (n0 < 512) W = nullptr; else if (n0 < 768) col0 = 384 + (n0 - 512); else col0 = 672 + (n0 - 768); }
    else if (job == 3) { W = P.in[11]; ld = 768; col0 = n0; fold = P.in[10]; WT = (bf16_t*)(ws + WS_WUQ); }
    else if (job == 4) { if (n0 < 512) { W = P.in[13]; col0 = n0; } else { W = P.in[14]; col0 = n0 - 512; } ld = 512; fold = P.in[12]; WT = (bf16_t*)(ws + WS_WUKV); }
    else if (job == 5) { W = P.in[17]; ld = 1024; col0 = n0; WT = (bf16_t*)(ws + WS_WO); }
    else if (job == 8) { W = P.in[23]; ld = 1024; col0 = n0; fold = P.in[22]; WT = (bf16_t*)(ws + WS_WPG); }
    else { W = P.in[24]; ld = 1024; col0 = n0; WT = (bf16_t*)(ws + WS_WPP); }
    prep_item(W, ld, col0, fold, WT, K, n0, k0, scr, lane);
  }
  float* ss = (float*)(ws + WS_SS); bf16_t* HB = (bf16_t*)(ws + WS_HB); bf16_t* PB = (bf16_t*)(ws + WS_PB);
  for (int m = gw; m < T_ALL; m += NGW) {
    const float* xr = (m < T_P) ? P.in[0] + (size_t)m * DM : P.in[1] + (size_t)(m - T_P) * DM;
    const f32x4* x4 = (const f32x4*)xr + lane; float s = 0.f; f32x4 v[4];
#pragma unroll
    for (int j = 0; j < 4; ++j) { v[j] = x4[64 * j]; s += (v[j][0] * v[j][0] + v[j][1] * v[j][1]) + (v[j][2] * v[j][2] + v[j][3] * v[j][3]); }
    s = wave_sum(s);
    u32x2* o8 = (u32x2*)(HB + (size_t)m * DM) + lane;
#pragma unroll
    for (int j = 0; j < 4; ++j) { u32x2 w; w.x = pk2(v[j][0], v[j][1]); w.y = pk2(v[j][2], v[j][3]); o8[64 * j] = w; }
    const float* pr = (m < T_P) ? P.in[2] + (size_t)m * PLE : P.in[3] + (size_t)(m - T_P) * PLE;
    const f32x4 pv = ((const f32x4*)pr)[lane]; u32x2 w; w.x = pk2(pv[0], pv[1]); w.y = pk2(pv[2], pv[3]); ((u32x2*)(PB + (size_t)m * PLE))[lane] = w;
    if (lane < 7) ss[(size_t)lane * T_ALL + m] = (lane == 0) ? s : 0.f;
  }
  float* rc = (float*)(ws + WS_ROPEC); float* rs = (float*)(ws + WS_ROPES);
  for (int e = blockIdx.x * 512 + tid; e < S_P * 16; e += gridDim.x * 512) {
    const int pos = e >> 4, i = e & 15;
    const float cst = (float)(-9.210340371976184 / 32.0); const float arg = (float)(2 * i) * cst;
    const double a = (double)arg; const double nn = __builtin_rint(a * 1.4426950408889634); const double rr = a - nn * 0.69314718055994530942;
    double ex = 1.0 + rr * (1.0 + rr * (0.5 + rr * (1.0 / 6 + rr * (1.0 / 24 + rr * (1.0 / 120 + rr * (1.0 / 720 + rr * (1.0 / 5040 + rr * (1.0 / 40320 + rr * (1.0 / 362880 + rr * (1.0 / 3628800 + rr * (1.0 / 39916800)))))))))));
    ex = ex * __builtin_ldexp(1.0, (int)nn);
    const float invf = (float)ex; const float ang = (float)pos * invf;
    float sv, cv; sincos_d((double)ang, sv, cv); rc[e] = cv; rs[e] = sv;
  }
}
__device__ __forceinline__ void hg_combine(const float* OP, const bf16_t* U, const float* hg_norm, bf16_t* MIX) {
  int tid_ = threadIdx.x; asm volatile("" : "+v"(tid_)); const int lane = tid_ & 63, wave = tid_ >> 6; const int gw = blockIdx.x * 8 + wave, NGW = gridDim.x * 8;
  f32x4 gn0 = *(const f32x4*)(hg_norm + 8 * lane), gn1 = *(const f32x4*)(hg_norm + 8 * lane + 4);
  for (int m = gw; m < T_ALL; m += NGW) {
    const float* a = OP + (size_t)m * 512 + 8 * lane; const float* b = a + (size_t)T_ALL * 512;
    f32x4 o0 = *(const f32x4*)a + *(const f32x4*)b, o1 = *(const f32x4*)(a + 4) + *(const f32x4*)(b + 4);
    float s = (o0[0] * o0[0] + o0[1] * o0[1]) + (o0[2] * o0[2] + o0[3] * o0[3]) + (o1[0] * o1[0] + o1[1] * o1[1]) + (o1[2] * o1[2] + o1[3] * o1[3]);
    s += __shfl_xor(s, 1); s += __shfl_xor(s, 2); s += __shfl_xor(s, 4); s += __shfl_xor(s, 8);
    const float r = rsqrtf(s * (1.0f / 128.0f) + EPS);
    const bf16x8 g = *(const bf16x8*)(U + (size_t)m * 2560 + 2048 + 8 * lane);
    float ov[8] = {o0[0], o0[1], o0[2], o0[3], o1[0], o1[1], o1[2], o1[3]}; float gnv[8] = {gn0[0], gn0[1], gn0[2], gn0[3], gn1[0], gn1[1], gn1[2], gn1[3]};
    unsigned w[4];
#pragma unroll
    for (int j = 0; j < 8; j += 2) { float r2[2];
#pragma unroll
      for (int e = 0; e < 2; ++e) { const float x = __uint_as_float(((unsigned)(unsigned short)g[j + e]) << 16); const float sl = x * __builtin_amdgcn_rcpf(1.0f + __expf(-x)); r2[e] = ov[j + e] * r * gnv[j + e] * sl; }
      w[j >> 1] = pk2(r2[0], r2[1]); }
    *(u32x4*)(MIX + (size_t)m * 1024 + 512 + 8 * lane) = (u32x4){w[0], w[1], w[2], w[3]};
  }
}
__device__ __forceinline__ void final_norm(float* out, const float* ss4, const float* fn) {
  int tid_ = threadIdx.x; asm volatile("" : "+v"(tid_)); const int lane = tid_ & 63, wave = tid_ >> 6; const int gw = blockIdx.x * 8 + wave, NGW = gridDim.x * 8;
  f32x4 g[4];
#pragma unroll
  for (int j = 0; j < 4; ++j) g[j] = ((const f32x4*)fn)[lane + 64 * j];
  for (int m = gw; m < T_ALL; m += NGW) {
    const float r = rsqrtf(ss4[m] * (1.0f / 1024.0f) + EPS);
    f32x4* p = (f32x4*)(out + (size_t)m * DM) + lane;
#pragma unroll
    for (int j = 0; j < 4; ++j) { const f32x4 v = p[64 * j]; p[64 * j] = v * r * g[j]; }
  }
}

#define GSYNC() cg::this_grid().sync()

template <class Epi> __device__ __forceinline__ void run_gemm(LAS unsigned char* lds, const bf16_t* A, int lda, const bf16_t* Bt, int ldb, int N, int K, const Epi& E) {
  pg8::Gemm g{A, Bt, T_ALL, N, K, lda, ldb}; pg8::StaticOrder S; S.init(T_ALL, N, (int)gridDim.x, (int)blockIdx.x);
  pg8::gemm_phase<Epi, pg8::StaticOrder, true, true>(lds, g, S, E);
}

__global__ void __launch_bounds__(512, 2) mk_fwd(Params P) {
  extern __shared__ __attribute__((aligned(16))) unsigned char lds[];
  unsigned char* ws = P.ws; float* out = P.out; unsigned char* dob = (unsigned char*)P.out;
  LAS unsigned char* l3 = (LAS unsigned char*)lds;
  float* ss = (float*)(ws + WS_SS);
  float* ss0 = ss, *ss1 = ss + T_ALL, *ss2 = ss + 2 * (size_t)T_ALL, *ss3 = ss + 3 * (size_t)T_ALL, *ss4 = ss + 4 * (size_t)T_ALL, *ssq = ss + 5 * (size_t)T_ALL, *sskv = ss + 6 * (size_t)T_ALL;
  const float* ropec = (const float*)(ws + WS_ROPEC); const float* ropes = (const float*)(ws + WS_ROPES);
  bf16_t* HB = (bf16_t*)(ws + WS_HB); bf16_t* ACT = (bf16_t*)(ws + WS_ACT); bf16_t* UHG = (bf16_t*)(ws + WS_UHG); bf16_t* UMLA = (bf16_t*)(ws + WS_UMLA);
  bf16_t* MIX = (bf16_t*)(ws + WS_MIX); bf16_t* PROJ = (bf16_t*)(ws + WS_PROJ); bf16_t* PB = (bf16_t*)(ws + WS_PB);
  bf16_t* Qb = (bf16_t*)(dob + DO_Q); bf16_t* KN = (bf16_t*)(dob + DO_KN); bf16_t* Vb = (bf16_t*)(dob + DO_V); bf16_t* KR = (bf16_t*)(dob + DO_KR);

  p0_prologue(P, ws, (char*)lds);
  GSYNC();
  { pg8::EpiSwiGLU E{ACT, ss0}; run_gemm(l3, HB, 1024, (const bf16_t*)(ws + WS_W1GU), 1024, NGU, 1024, E); }
  GSYNC();
  { pg8::EpiRes<0> E{P.in[0], P.in[1], out, HB, ss1, nullptr, nullptr}; run_gemm(l3, ACT, DFF, (const bf16_t*)(ws + WS_W1D), DFF, 1024, DFF, E); }
  GSYNC();
  { pg8::EpiWin E{UMLA, UHG, KR, ss1, ssq, sskv, ropec, ropes}; run_gemm(l3, HB, 1024, (const bf16_t*)(ws + WS_WIN), 1024, NIN, 1024, E); }
  GSYNC();
  { pg8::EpiBf E{Qb, Qb, 768, 1000, ssq, 1.0f / 384.0f}; run_gemm(l3, UMLA, 768, (const bf16_t*)(ws + WS_WUQ), 384, 768, 384, E); }
  { pg8::EpiBf E{KN, Vb, 512, 2, sskv, 1.0f / 256.0f}; run_gemm(l3, UMLA + 512, 768, (const bf16_t*)(ws + WS_WUKV), 256, 1024, 256, E); }
  GSYNC();
  {
    const int G = gridDim.x, bx = blockIdx.x;
    if (G == 256) {
      const int xcd = bx & 7, idx = bx >> 3;
      for (int i = 0; i < 12; ++i) {
        int rowbase, seq, h, qb;
        if (i < 4) { const int pair = 2 * xcd + (i >> 1); const int b = pair >> 3; h = pair & 7; qb = idx * 2 + (i & 1); rowbase = b * S_P; seq = S_P; }
        else { const int j = i - 4; const int pair = 16 * xcd + 2 * j + (idx >> 4); const int b = pair >> 3; h = pair & 7; qb = idx & 15; rowbase = T_P + b * S_S; seq = S_S; }
        att::attn_unit(Qb + (size_t)(rowbase + qb * 256) * 768 + h * 96, KN + (size_t)rowbase * 512 + h * 64, KR + (size_t)rowbase * 32, Vb + (size_t)rowbase * 512 + h * 64,
                       MIX + (size_t)(rowbase + qb * 256) * 1024 + h * 64, seq, rowbase + qb * 256, ropec, ropes, (char*)lds);
      }
    } else {
      for (int u = bx; u < 3072; u += G) {
        int rowbase, seq, h, qb;
        if (u < 1024) { const int pair = u >> 6; const int b = pair >> 3; h = pair & 7; qb = u & 63; rowbase = b * S_P; seq = S_P; }
        else { const int v = u - 1024; const int pair = v >> 4; const int b = pair >> 3; h = pair & 7; qb = v & 15; rowbase = T_P + b * S_S; seq = S_S; }
        att::attn_unit(Qb + (size_t)(rowbase + qb * 256) * 768 + h * 96, KN + (size_t)rowbase * 512 + h * 64, KR + (size_t)rowbase * 32, Vb + (size_t)rowbase * 512 + h * 64,
                       MIX + (size_t)(rowbase + qb * 256) * 1024 + h * 64, seq, rowbase + qb * 256, ropec, ropes, (char*)lds);
      }
    }
  }
  GSYNC();
  {
    float* SLOT = (float*)(ws + WS_SLOT); float* DSEG = (float*)(ws + WS_DSEG);
    for (int u = blockIdx.x; u < 768; u += gridDim.x) {
      int chainid, seg, nseg;
      if (u < 256) { chainid = u >> 4; seg = u & 15; nseg = 16; } else { const int u2 = u - 256; chainid = 16 + (u2 >> 2); seg = u2 & 3; nseg = 4; }
      if (seg == nseg - 1) continue;
      int rowbase, S, h, dir;
      if (chainid < 16) { const int b = chainid >> 3; h = (chainid >> 1) & 3; dir = chainid & 1; rowbase = b * S_P; S = S_P; }
      else { const int c2 = chainid - 16; const int b = c2 >> 3; h = (c2 >> 1) & 3; dir = c2 & 1; rowbase = T_P + b * S_S; S = S_S; }
      hg::chain<1>(UHG, out, P.in[15], rowbase, S, h, dir, seg * 1024, 16, nullptr, SLOT + (size_t)u * 16384, DSEG + (size_t)u * 128, (char*)lds);
    }
  }
  GSYNC();
  {
    float* SLOT = (float*)(ws + WS_SLOT); const float* DSEG = (const float*)(ws + WS_DSEG);
    int tid_ = threadIdx.x; asm volatile("" : "+v"(tid_));
    for (int e = blockIdx.x * 512 + tid_; e < 144 * 16384; e += gridDim.x * 512) {
      const int chainid = e >> 14, el = e & 16383, k = el & 127;
      int u0, nseg; if (chainid < 16) { u0 = chainid * 16; nseg = 16; } else { u0 = 256 + (chainid - 16) * 4; nseg = 4; }
      float Sv = 0.f;
      for (int s = 1; s < nseg; ++s) { float* sl = SLOT + (size_t)(u0 + s - 1) * 16384 + el; Sv = DSEG[(size_t)(u0 + s - 1) * 128 + k] * Sv + *sl; *sl = Sv; }
    }
  }
  GSYNC();
  {
    const float* SLOT = (const float*)(ws + WS_SLOT);
    for (int u = blockIdx.x; u < 768; u += gridDim.x) {
      int chainid, seg;
      if (u < 256) { chainid = u >> 4; seg = u & 15; } else { const int u2 = u - 256; chainid = 16 + (u2 >> 2); seg = u2 & 3; }
      int rowbase, S, h, dir;
      if (chainid < 16) { const int b = chainid >> 3; h = (chainid >> 1) & 3; dir = chainid & 1; rowbase = b * S_P; S = S_P; }
      else { const int c2 = chainid - 16; const int b = c2 >> 3; h = (c2 >> 1) & 3; dir = c2 & 1; rowbase = T_P + b * S_S; S = S_S; }
      hg::chain<3>(UHG, out, P.in[15], rowbase, S, h, dir, seg * 1024, 16, seg ? SLOT + (size_t)(u - 1) * 16384 : nullptr, nullptr, nullptr, (char*)lds);
    }
  }
  GSYNC();
  hg_combine(out, UHG, P.in[16], MIX);
  GSYNC();
  { pg8::EpiRes<1> E{nullptr, nullptr, out, HB, ss2, nullptr, nullptr}; run_gemm(l3, MIX, 1024, (const bf16_t*)(ws + WS_WO), 1024, 1024, 1024, E); }
  GSYNC();
  { pg8::EpiSwiGLU E{ACT, ss2}; run_gemm(l3, HB, 1024, (const bf16_t*)(ws + WS_W2GU), 1024, NGU, 1024, E); }
  GSYNC();
  { pg8::EpiRes<2> E{nullptr, nullptr, out, HB, ss3, nullptr, nullptr}; run_gemm(l3, ACT, DFF, (const bf16_t*)(ws + WS_W2D), DFF, 1024, DFF, E); }
  GSYNC();
  { pg8::EpiBf E{PROJ, PROJ, 1024, 1000, nullptr, 0.f}; run_gemm(l3, PB, 256, (const bf16_t*)(ws + WS_WPP), 256, 1024, 256, E); }
  GSYNC();
  { pg8::EpiRes<3> E{nullptr, nullptr, out, HB, ss4, ss3, PROJ}; run_gemm(l3, HB, 1024, (const bf16_t*)(ws + WS_WPG), 1024, 1024, 1024, E); }
  GSYNC();
  final_norm(out, ss4, P.in[25]);
}

extern "C" void kernel_launch(void* const* d_in, const int* in_sizes, int n_in, void* d_out, int out_size, void* d_ws, size_t ws_size, hipStream_t stream) {
  static int grid = 0;
  if (grid == 0) {
    if (n_in != 26 || out_size != T_ALL * DM || ws_size < WS_END) { fprintf(stderr, "kernel_launch: unexpected shapes n_in %d out %d ws %zu\n", n_in, out_size, ws_size); grid = -1; return; }
    int dev = 0, cus = 0, per_cu = 0;
    if (hipGetDevice(&dev) != hipSuccess || hipDeviceGetAttribute(&cus, hipDeviceAttributeMultiprocessorCount, dev) != hipSuccess) { grid = -1; return; }
    if (hipFuncSetAttribute((const void*)mk_fwd, hipFuncAttributeMaxDynamicSharedMemorySize, LDS_BYTES) != hipSuccess) { fprintf(stderr, "kernel_launch: LDS attribute failed\n"); grid = -1; return; }
    if (hipOccupancyMaxActiveBlocksPerMultiprocessor(&per_cu, (const void*)mk_fwd, 512, LDS_BYTES) != hipSuccess || per_cu < 1) { fprintf(stderr, "kernel_launch: occupancy query says %d\n", per_cu); per_cu = 1; }
    (void)hipGetLastError();
    grid = cus;
  }
  if (grid < 0) return;
  Params p{};
  for (int i = 0; i < 26; ++i) p.in[i] = (const float*)d_in[i];
  p.out = (float*)d_out; p.ws = (unsigned char*)d_ws;
  void* args[] = {&p};
  hipError_t e = hipLaunchCooperativeKernel((void*)mk_fwd, dim3(grid), dim3(512), args, LDS_BYTES, stream);
  if (e != hipSuccess) fprintf(stderr, "cooperative launch failed: %s (grid %d)\n", hipGetErrorString(e), grid);
}
```

```cpp
#include <hip/hip_runtime.h>
#include <hip/hip_cooperative_groups.h>
#include <cstdio>
#include <cstdint>
namespace cg = cooperative_groups;

constexpr int DM = 1024, T_P = 32768, T_ALL = 98304, S_P = 16384, S_S = 4096;
constexpr int DFF = 2816, NGU = 5632, NIN = 3328, NMLA = 768, NHG = 2560, PLE = 256;
constexpr float EPS = 1e-6f;
__device__ __forceinline__ int row_pos(int row) { return row < T_P ? (row & (S_P - 1)) : (row & (S_S - 1)); }

namespace pg8 {
#define PG8_LAS __attribute__((address_space(3)))
typedef unsigned short bf16_t;
typedef short bf16x8 __attribute__((ext_vector_type(8)));
typedef float f32x4 __attribute__((ext_vector_type(4)));
typedef unsigned u32x4 __attribute__((ext_vector_type(4)));
constexpr int BM = 256, BK = 64, HALF = 128, HTB = HALF * BK * 2  , STAGE_BYTES = 8 * HTB, NXCD = 8, WGM = 8;

__host__ __device__ __forceinline__ int lds_byte(int r, int c) { const int st = (r >> 4) * 2 + (c >> 5), rr = r & 15, cc = c & 31, ob = rr * 64 + cc * 2; return st * 1024 + (ob ^ (((ob >> 9) & 1) << 5)); }
__host__ __device__ __forceinline__ void stage_rc(int b, int& R, int& C) { const int st = b / 1024, sb = b % 1024, swz = sb ^ (((sb >> 9) & 1) << 5); R = (st >> 1) * 16 + swz / 64; C = (st & 1) * 32 + (swz % 64) / 2; }
__host__ __device__ __forceinline__ int perm32(int rho) { const int n = rho >> 4, i = rho & 15; return 8 * (i >> 2) + 4 * n + (i & 3); }

struct Unit { int pm, pn; };
struct Gemm { const bf16_t* A; const bf16_t* Bt; int M, N, K, lda, ldb; };

struct StaticOrder {
    int nM, nN, nwg, G, c;
    __host__ __device__ void init(int M, int N, int G_, int c_) { nM = M / BM; nN = N / BM; nwg = nM * nN; G = G_; c = c_; }
    __host__ __device__ bool next(int i, Unit& u) const {
        const long L = (long)i * G + c; if (L >= nwg) return false;
        int wgid = (int)L; { const int q = nwg / NXCD, r = nwg % NXCD, xcd = wgid % NXCD, off = wgid / NXCD; wgid = (xcd < r ? xcd * (q + 1) : r * (q + 1) + (xcd - r) * q) + off; }
        const int nig = WGM * nN, gid = wgid / nig, fm = gid * WGM, gsz = (nM - fm) < WGM ? (nM - fm) : WGM;
        u.pm = fm + ((wgid % nig) % gsz); u.pn = (wgid % nig) / gsz; return true;
    }
    __device__ __forceinline__ void a_ready(const Unit&) const {}
    __device__ __forceinline__ void done(const Unit&) const {}
};
__device__ __forceinline__ unsigned cvt_pk_bf16(float lo, float hi) { unsigned r; asm volatile("v_cvt_pk_bf16_f32 %0, %1, %2" : "=v"(r) : "v"(lo), "v"(hi)); return r; }
typedef unsigned u32x2 __attribute__((ext_vector_type(2)));
__device__ __forceinline__ float bf2f(unsigned short h) { return __uint_as_float(((unsigned)h) << 16); }
__device__ __forceinline__ float fsigmoid(float x) { return __builtin_amdgcn_rcpf(1.0f + __expf(-x)); }
__device__ __forceinline__ float row_sum4(float s) { s += __shfl_xor(s, 16); s += __shfl_xor(s, 32); return s; }

struct EpiSwiGLU {
    static constexpr bool PERM = true, AFTER_DRAIN = false;
    bf16_t* O; const float* ss;
    __device__ __forceinline__ void operator()(const f32x4 (&acc)[2][2][4][2], const Unit& u, int wr, int wc, int fr, int fq) const {
        const int row0 = u.pm * BM + wr * 64 + fr; const int col0 = u.pn * HALF + wc * 32 + 8 * fq;
#pragma unroll
        for (int ai = 0; ai < 2; ++ai)
#pragma unroll
            for (int m = 0; m < 4; ++m) { const int row = row0 + ai * HALF + m * 16; const float r = rsqrtf(ss[row] * (1.0f / 1024.0f) + 1e-6f);
                float v[8];
#pragma unroll
                for (int n = 0; n < 2; ++n)
#pragma unroll
                    for (int j = 0; j < 4; ++j) { const float g = acc[ai][0][m][n][j] * r, uu = acc[ai][1][m][n][j] * r; v[n * 4 + j] = g * fsigmoid(g) * uu; }
                u32x4 w; w.x = cvt_pk_bf16(v[0], v[1]); w.y = cvt_pk_bf16(v[2], v[3]); w.z = cvt_pk_bf16(v[4], v[5]); w.w = cvt_pk_bf16(v[6], v[7]);
                *(u32x4*)(O + (size_t)row * 2816 + col0) = w; }
    }
};
template <int MODE> struct EpiRes {
    static constexpr bool PERM = false, AFTER_DRAIN = false;
    const float* xp; const float* xs; float* out; bf16_t* hb; float* ssout; const float* ssin; const bf16_t* proj;
    __device__ __forceinline__ void operator()(const f32x4 (&acc)[2][2][4][2], const Unit& u, int wr, int wc, int fr, int fq) const {
        const int row0 = u.pm * BM + wr * 64 + fr; const int col0 = u.pn * BM + wc * 32 + 4 * fq;
#pragma unroll
        for (int ai = 0; ai < 2; ++ai)
#pragma unroll
            for (int m = 0; m < 4; ++m) { const int row = row0 + ai * HALF + m * 16; float sq = 0.f; float r3 = 0.f;
                if (MODE == 3) r3 = rsqrtf(ssin[row] * (1.0f / 1024.0f) + 1e-6f);
#pragma unroll
                for (int bj = 0; bj < 2; ++bj)
#pragma unroll
                    for (int n = 0; n < 2; ++n) { const int col = col0 + bj * HALF + n * 16; const size_t off = (size_t)row * 1024 + col; f32x4 b, v;
                        if (MODE == 0) { b = (row < 32768) ? *(const f32x4*)(xp + off) : *(const f32x4*)(xs + (off - (size_t)32768 * 1024)); v = b + acc[ai][bj][m][n] * 0.5f; }
                        else if (MODE == 1) { const u32x2 hb2 = *(const u32x2*)(hb + off); b[0] = __uint_as_float(hb2.x << 16); b[1] = __uint_as_float(hb2.x & 0xffff0000u); b[2] = __uint_as_float(hb2.y << 16); b[3] = __uint_as_float(hb2.y & 0xffff0000u); v = b + acc[ai][bj][m][n]; }
                        else if (MODE == 2) { b = *(const f32x4*)(out + off); v = b + acc[ai][bj][m][n] * 0.5f; }
                        else { b = *(const f32x4*)(out + off); const u32x2 p2 = *(const u32x2*)(proj + off); f32x4 pr; pr[0] = __uint_as_float(p2.x << 16); pr[1] = __uint_as_float(p2.x & 0xffff0000u); pr[2] = __uint_as_float(p2.y << 16); pr[3] = __uint_as_float(p2.y & 0xffff0000u);
                            const f32x4 a = acc[ai][bj][m][n] * r3; f32x4 gt; gt[0] = fsigmoid(a[0]); gt[1] = fsigmoid(a[1]); gt[2] = fsigmoid(a[2]); gt[3] = fsigmoid(a[3]); v = b + gt * pr; }
                        sq += (v[0] * v[0] + v[1] * v[1]) + (v[2] * v[2] + v[3] * v[3]);
                        if (MODE != 0) *(f32x4*)(out + off) = v;
                        if (MODE != 3) { u32x2 w; w.x = cvt_pk_bf16(v[0], v[1]); w.y = cvt_pk_bf16(v[2], v[3]); *(u32x2*)(hb + off) = w; } }
                sq = row_sum4(sq);
                if (fq == 0) atomicAdd(ssout + row, sq); }
    }
};
struct EpiWin {
    static constexpr bool PERM = false, AFTER_DRAIN = false;
    bf16_t* umla; bf16_t* uhg; bf16_t* kr; const float* ss1; float* ssq; float* sskv; const float* ropec; const float* ropes;
    __device__ __forceinline__ void operator()(const f32x4 (&acc)[2][2][4][2], const Unit& u, int wr, int wc, int fr, int fq) const {
        const int row0 = u.pm * BM + wr * 64 + fr; const int pn = u.pn;
        bf16_t* dst; int ld, colt;
        if (pn < 3) { dst = umla; ld = 768; colt = pn * BM; } else { dst = uhg; ld = 2560; colt = (pn - 3) * BM; }
        const int col0 = colt + wc * 32 + 4 * fq;
#pragma unroll
        for (int ai = 0; ai < 2; ++ai)
#pragma unroll
            for (int m = 0; m < 4; ++m) { const int row = row0 + ai * HALF + m * 16; const float r = rsqrtf(ss1[row] * (1.0f / 1024.0f) + 1e-6f);
                float sq0 = 0.f, sq1 = 0.f; f32x4 v[2][2];
#pragma unroll
                for (int bj = 0; bj < 2; ++bj)
#pragma unroll
                    for (int n = 0; n < 2; ++n) { v[bj][n] = acc[ai][bj][m][n] * r; const f32x4 x = v[bj][n]; const float s = (x[0] * x[0] + x[1] * x[1]) + (x[2] * x[2] + x[3] * x[3]); if (bj == 0) sq0 += s; else sq1 += s;
                        u32x2 w; w.x = cvt_pk_bf16(x[0], x[1]); w.y = cvt_pk_bf16(x[2], x[3]); *(u32x2*)(dst + (size_t)row * ld + col0 + bj * HALF + n * 16) = w; }
                if (pn < 3) { float s = (pn == 1) ? sq0 : (sq0 + sq1); s = row_sum4(s); if (fq == 0) atomicAdd((pn == 2 ? sskv : ssq) + row, s); }
                if (pn == 1 && wc == 0) {
                    const int pos = row_pos(row); const f32x4 cs = *(const f32x4*)(ropec + pos * 16 + 4 * fq), sn = *(const f32x4*)(ropes + pos * 16 + 4 * fq);
                    const f32x4 x1 = v[1][0], x2 = v[1][1]; const f32x4 o1 = x1 * cs - x2 * sn, o2 = x1 * sn + x2 * cs;
                    u32x2 w1, w2; w1.x = cvt_pk_bf16(o1[0], o1[1]); w1.y = cvt_pk_bf16(o1[2], o1[3]); w2.x = cvt_pk_bf16(o2[0], o2[1]); w2.y = cvt_pk_bf16(o2[2], o2[3]);
                    *(u32x2*)(kr + (size_t)row * 32 + 4 * fq) = w1; *(u32x2*)(kr + (size_t)row * 32 + 16 + 4 * fq) = w2; } }
    }
};
struct EpiBf {
    static constexpr bool PERM = true, AFTER_DRAIN = false;
    bf16_t* O0; bf16_t* O1; int ld; int split; const float* ss; float inv_n; float mul;
    __device__ __forceinline__ void operator()(const f32x4 (&acc)[2][2][4][2], const Unit& u, int wr, int wc, int fr, int fq) const {
        const int row0 = u.pm * BM + wr * 64 + fr; bf16_t* base = O0; int colt = u.pn * BM; if (u.pn >= split) { base = O1; colt = (u.pn - split) * BM; }
        const int col0 = colt + wc * 32 + 8 * fq;
#pragma unroll
        for (int ai = 0; ai < 2; ++ai)
#pragma unroll
            for (int m = 0; m < 4; ++m) { const int row = row0 + ai * HALF + m * 16; const float r = (ss ? rsqrtf(ss[row] * inv_n + 1e-6f) : 1.0f) * mul;
#pragma unroll
                for (int bj = 0; bj < 2; ++bj) { const f32x4 v0 = acc[ai][bj][m][0] * r, v1 = acc[ai][bj][m][1] * r;
                    u32x4 w; w.x = cvt_pk_bf16(v0[0], v0[1]); w.y = cvt_pk_bf16(v0[2], v0[3]); w.z = cvt_pk_bf16(v1[0], v1[1]); w.w = cvt_pk_bf16(v1[2], v1[3]);
                    *(u32x4*)(base + (size_t)row * ld + col0 + bj * HALF) = w; } }
    }
};
template <class Epi, class Sched, bool ALIGN_EPI = false, bool SP2 = false>
__device__ __forceinline__ void gemm_phase(PG8_LAS unsigned char* lds, const Gemm g, const Sched& S, const Epi& E) {
    int tid_ = threadIdx.x; asm volatile("" : "+v"(tid_)); const int tid = tid_, wid = __builtin_amdgcn_readfirstlane(tid >> 6), lane = tid & 63, wr = wid >> 2, wc = wid & 3, fr = lane & 15, fq = lane >> 4;
    const int K = g.K, nt = K / BK;
    unsigned voffA[2], voffB[2];
#pragma unroll
    for (int i = 0; i < 2; ++i) { int R, C; stage_rc(tid * 16 + i * 8192, R, C); const int Rb = Epi::PERM ? ((R & ~31) + perm32(R & 31)) : R;
        voffA[i] = (unsigned)(R * g.lda + C) * 2u; voffB[i] = (unsigned)(Rb * g.ldb + C) * 2u; }
    const size_t kstep = (size_t)(BK * 2);
    const size_t hstepA = (size_t)HALF * g.lda * 2, hstepB = (size_t)HALF * g.ldb * 2;
    const size_t tstepA = 2 * hstepA, tstepB = 2 * hstepB;
    const unsigned ldsw = (unsigned)wid * 1024u;
    const int aoff = lds_byte(wr * 64 + fr, fq * 8), boff = lds_byte(wc * 32 + fr, fq * 8);
#define PG8_SA(b, h) (((b) * 2 + (h)) * HTB)
#define PG8_SB(b, h) ((4 + (b) * 2 + (h)) * HTB)
#define PG8_STAGE(bufoff, gbase, voff) do { _Pragma("unroll") for (int _i = 0; _i < 2; ++_i) \
        __builtin_amdgcn_global_load_lds((const unsigned*)((const char*)(gbase) + (voff)[_i]), (PG8_LAS unsigned*)(lds + (bufoff) + ldsw + _i * 8192), 16, 0, 0); } while (0)
#define PG8_LDA(dst, b, h) do { _Pragma("unroll") for (int m = 0; m < 4; ++m) _Pragma("unroll") for (int k = 0; k < 2; ++k) dst[m][k] = *(const PG8_LAS bf16x8*)(lds + PG8_SA(b, h) + aoff + m * 2048 + k * 1024); } while (0)
#define PG8_LDB(dst, b, h) do { _Pragma("unroll") for (int n = 0; n < 2; ++n) _Pragma("unroll") for (int k = 0; k < 2; ++k) dst[n][k] = *(const PG8_LAS bf16x8*)(lds + PG8_SB(b, h) + boff + n * 2048 + k * 1024); } while (0)
#define PG8_MMA(ai, bj, At, Bt) do { __builtin_amdgcn_s_setprio(1); _Pragma("unroll") for (int m = 0; m < 4; ++m) _Pragma("unroll") for (int n = 0; n < 2; ++n) _Pragma("unroll") for (int k = 0; k < 2; ++k) \
        acc[ai][bj][m][n] = __builtin_amdgcn_mfma_f32_16x16x32_bf16(Bt[n][k], At[m][k], acc[ai][bj][m][n], 0, 0, 0); __builtin_amdgcn_s_setprio(0); } while (0)
#define PG8_WAIT_V(n) asm volatile("s_waitcnt vmcnt(" #n ")" ::: "memory")
#define PG8_WAIT_L(n) asm volatile("s_waitcnt lgkmcnt(" #n ")" ::: "memory")
#define PG8_BAR __builtin_amdgcn_s_barrier()
#define PG8_SCHED __builtin_amdgcn_sched_barrier(0)
    Unit cur, nxt; int ui = 0;
    if (!S.next(0, cur)) return;
    f32x4 acc[2][2][4][2];
#pragma unroll
    for (int a = 0; a < 2; ++a)
#pragma unroll
        for (int b = 0; b < 2; ++b)
#pragma unroll
            for (int m = 0; m < 4; ++m)
#pragma unroll
                for (int n = 0; n < 2; ++n) acc[a][b][m][n] = (f32x4){0.f, 0.f, 0.f, 0.f};
    bf16x8 At[4][2], B0[2][2], B1[2][2];
    const char* cA = (const char*)g.A + (size_t)cur.pm * tstepA; const char* cB = (const char*)g.Bt + (size_t)cur.pn * tstepB;
    S.a_ready(cur);
    if constexpr (SP2) {
        PG8_STAGE(PG8_SB(0, 0), cB, voffB); PG8_STAGE(PG8_SB(0, 1), cB + hstepB, voffB); PG8_STAGE(PG8_SA(0, 0), cA, voffA); PG8_STAGE(PG8_SA(0, 1), cA + hstepA, voffA);
        if (wr == 1) PG8_BAR;
        PG8_WAIT_V(2); PG8_BAR;
        PG8_STAGE(PG8_SB(1, 0), cB + kstep, voffB); PG8_STAGE(PG8_SA(1, 0), cA + kstep, voffA); PG8_STAGE(PG8_SB(1, 1), cB + hstepB + kstep, voffB);
        PG8_WAIT_V(6); PG8_BAR;
    } else {
        PG8_STAGE(PG8_SB(0, 0), cB, voffB); PG8_STAGE(PG8_SA(0, 0), cA, voffA); PG8_STAGE(PG8_SB(0, 1), cB + hstepB, voffB); PG8_STAGE(PG8_SA(0, 1), cA + hstepA, voffA);
        if (wr == 1) PG8_BAR;
        PG8_WAIT_V(4); PG8_BAR;
        PG8_STAGE(PG8_SB(1, 0), cB + kstep, voffB); PG8_STAGE(PG8_SA(1, 0), cA + kstep, voffA); PG8_STAGE(PG8_SB(1, 1), cB + hstepB + kstep, voffB);
        PG8_WAIT_V(6); PG8_BAR;
    }
    for (;;) {
        const bool has_next = S.next(ui + 1, nxt);
        const char* nA = has_next ? (const char*)g.A + (size_t)nxt.pm * tstepA : cA; const char* nB = has_next ? (const char*)g.Bt + (size_t)nxt.pn * tstepB : cB;
        for (int t = 0; t < nt; t += 2) {
            const bool last = (t == nt - 2);
            const char* a1 = cA + (size_t)(t + 1) * kstep;
            const char* a2 = last ? nA : cA + (size_t)(t + 2) * kstep; const char* b2 = last ? nB : cB + (size_t)(t + 2) * kstep;
            const char* a3 = a2 + kstep; const char* b3 = b2 + kstep;
            if (last && has_next) S.a_ready(nxt);
            if constexpr (SP2) {
            PG8_LDB(B0, 0, 0); PG8_LDB(B1, 0, 1); PG8_SCHED; PG8_LDA(At, 0, 0); PG8_STAGE(PG8_SA(1, 1), a1 + hstepA, voffA);
            PG8_WAIT_V(8); PG8_WAIT_L(0); PG8_BAR; PG8_MMA(0, 0, At, B0); PG8_MMA(0, 1, At, B1); PG8_BAR; PG8_SCHED;
            PG8_LDA(At, 0, 1); PG8_STAGE(PG8_SB(0, 0), b2, voffB); PG8_STAGE(PG8_SB(0, 1), b2 + hstepB, voffB); PG8_STAGE(PG8_SA(0, 0), a2, voffA);
            PG8_WAIT_V(8); PG8_WAIT_L(0); PG8_BAR; PG8_MMA(1, 0, At, B0); PG8_MMA(1, 1, At, B1); PG8_BAR; PG8_SCHED;
            PG8_LDB(B0, 1, 0); PG8_LDB(B1, 1, 1); PG8_SCHED; PG8_LDA(At, 1, 0); PG8_STAGE(PG8_SA(0, 1), a2 + hstepA, voffA);
            PG8_WAIT_V(8); PG8_WAIT_L(0); PG8_BAR; PG8_MMA(0, 0, At, B0); PG8_MMA(0, 1, At, B1); PG8_BAR; PG8_SCHED;
            PG8_LDA(At, 1, 1); PG8_STAGE(PG8_SB(1, 0), b3, voffB); PG8_STAGE(PG8_SB(1, 1), b3 + hstepB, voffB); PG8_STAGE(PG8_SA(1, 0), a3, voffA);
            PG8_WAIT_V(8); PG8_WAIT_L(0); PG8_BAR; PG8_MMA(1, 0, At, B0); PG8_MMA(1, 1, At, B1); PG8_BAR; PG8_SCHED;
            } else {
            PG8_LDB(B0, 0, 0); PG8_SCHED; PG8_LDA(At, 0, 0); PG8_STAGE(PG8_SA(1, 1), a1 + hstepA, voffA);
            PG8_WAIT_L(8); PG8_BAR; PG8_WAIT_L(0); PG8_MMA(0, 0, At, B0); PG8_BAR; PG8_SCHED;
            PG8_LDB(B1, 0, 1); PG8_STAGE(PG8_SB(0, 0), b2, voffB);
            PG8_BAR; PG8_WAIT_L(0); PG8_MMA(0, 1, At, B1); PG8_BAR;
            PG8_LDA(At, 0, 1); PG8_STAGE(PG8_SA(0, 0), a2, voffA);
            PG8_BAR; PG8_WAIT_L(0); PG8_MMA(1, 0, At, B0); PG8_BAR; PG8_SCHED;
            PG8_STAGE(PG8_SB(0, 1), b2 + hstepB, voffB);
            PG8_WAIT_V(6); PG8_BAR; PG8_MMA(1, 1, At, B1); PG8_BAR;
            PG8_LDB(B0, 1, 0); PG8_SCHED; PG8_LDA(At, 1, 0); PG8_STAGE(PG8_SA(0, 1), a2 + hstepA, voffA);
            PG8_WAIT_L(8); PG8_BAR; PG8_WAIT_L(0); PG8_MMA(0, 0, At, B0); PG8_BAR; PG8_SCHED;
            PG8_LDB(B1, 1, 1); PG8_STAGE(PG8_SB(1, 0), b3, voffB);
            PG8_BAR; PG8_WAIT_L(0); PG8_MMA(0, 1, At, B1); PG8_BAR;
            PG8_LDA(At, 1, 1); PG8_STAGE(PG8_SA(1, 0), a3, voffA);
            PG8_BAR; PG8_WAIT_L(0); PG8_MMA(1, 0, At, B0); PG8_BAR; PG8_SCHED;
            PG8_STAGE(PG8_SB(1, 1), b3 + hstepB, voffB);
            PG8_WAIT_V(6); PG8_BAR; PG8_MMA(1, 1, At, B1); PG8_BAR;
            }
        }
        if constexpr (ALIGN_EPI) { if (wr == 0) PG8_BAR; }
        if constexpr (!Epi::AFTER_DRAIN) { E(acc, cur, wr, wc, fr, fq); S.done(cur); }
        if (!has_next) break;
#pragma unroll
        for (int a = 0; a < 2; ++a)
#pragma unroll
            for (int b = 0; b < 2; ++b)
#pragma unroll
                for (int m = 0; m < 4; ++m)
#pragma unroll
                    for (int n = 0; n < 2; ++n) acc[a][b][m][n] = (f32x4){0.f, 0.f, 0.f, 0.f};
        cur = nxt; cA = nA; cB = nB; ++ui;
        if constexpr (ALIGN_EPI) { if (wr == 1) PG8_BAR; }
    }
    PG8_WAIT_V(0);
    if constexpr (!ALIGN_EPI) { if (wr == 0) PG8_BAR; }
    PG8_BAR;
    if constexpr (Epi::AFTER_DRAIN) { E.fused(acc, cur, wr, wc, fr, fq, lds, wid, lane); S.done(cur); }
#undef PG8_SA
#undef PG8_SB
#undef PG8_STAGE
#undef PG8_LDA
#undef PG8_LDB
#undef PG8_MMA
#undef PG8_WAIT_V
#undef PG8_WAIT_L
#undef PG8_BAR
#undef PG8_SCHED
}
}

namespace att {
typedef unsigned short bf16_t;
using bf16x8 = __attribute__((ext_vector_type(8))) short;
using s16x4  = __attribute__((ext_vector_type(4))) short;
using f32x16 = __attribute__((ext_vector_type(16))) float;
using u32x4  = __attribute__((ext_vector_type(4))) unsigned;
constexpr int NW = 8, QBLK = 32, KVBLK = 64;
constexpr float SCALE = 0.10206207261596575f;
constexpr float THR = 8.f;
constexpr int LDQ = 768, LDKN = 512, LDKR = 32, LDV = 512, LDO = 1024;
constexpr int SHM_V = 64 * 128 * 2, SHM_K = 64 * 128 * 2;
#define KSWZ(row, colB) ((row) * 256 + ((colB) ^ (((row) & 7) << 4)))
#define SBAR() __builtin_amdgcn_sched_barrier(0)
__device__ __forceinline__ int crow(int r, int hi) { return (r & 3) + 8 * (r >> 2) + 4 * hi; }
__device__ __forceinline__ unsigned cvtpk(float lo, float hi) { unsigned r; asm volatile("v_cvt_pk_bf16_f32 %0, %1, %2" : "=v"(r) : "v"(lo), "v"(hi)); return r; }
template <bool FIRST> __device__ __forceinline__ void partialSM(f32x16& p0, f32x16& p1, float& m_ref, f32x16& negm, float& alpha) {
  constexpr float THR2 = THR * 1.4426950408889634f;
  float pmax = p0[0];
#pragma unroll
  for (int r = 1; r < 16; ++r) pmax = fmaxf(pmax, p0[r]);
#pragma unroll
  for (int r = 0; r < 16; ++r) pmax = fmaxf(pmax, p1[r]);
  { auto rr = __builtin_amdgcn_permlane32_swap(__float_as_uint(pmax), __float_as_uint(pmax), false, false);
    pmax = fmaxf(__uint_as_float(rr[0]), __uint_as_float(rr[1])); }
  alpha = 1.f;
  if (FIRST || !__builtin_expect(__all(pmax <= THR2), 1)) {
    const float dl = FIRST ? pmax : fmaxf(pmax, 0.f);
    m_ref += dl; alpha = FIRST ? 1.f : __builtin_amdgcn_exp2f(-dl);
#pragma unroll
    for (int r = 0; r < 16; ++r) { p0[r] -= dl; p1[r] -= dl; }
#pragma unroll
    for (int r = 0; r < 16; ++r) negm[r] = -m_ref;
    asm volatile("" : "+v"(negm));
  }
#pragma unroll
  for (int r = 0; r < 16; ++r) p0[r] = __builtin_amdgcn_exp2f(p0[r]);
}
__device__ __forceinline__ void finishSM(f32x16& p0, f32x16& p1, bf16x8& pa0, bf16x8& pa1, bf16x8& pa2, bf16x8& pa3) {
#pragma unroll
  for (int r = 0; r < 16; ++r) p1[r] = __builtin_amdgcn_exp2f(p1[r]);
#define PK4(P, BASE, OUT) do { unsigned a0 = cvtpk(P[BASE + 0], P[BASE + 1]), a1 = cvtpk(P[BASE + 2], P[BASE + 3]);   \
    unsigned b0 = cvtpk(P[BASE + 4], P[BASE + 5]), b1 = cvtpk(P[BASE + 6], P[BASE + 7]);                              \
    auto r0 = __builtin_amdgcn_permlane32_swap(a0, b0, false, false); auto r1 = __builtin_amdgcn_permlane32_swap(a1, b1, false, false); \
    u32x4 w = {r0[0], r1[0], r0[1], r1[1]}; OUT = *reinterpret_cast<bf16x8*>(&w); } while (0)
  PK4(p0, 0, pa0); PK4(p0, 8, pa1); PK4(p1, 0, pa2); PK4(p1, 8, pa3);
#undef PK4
}
__device__ __forceinline__ void qkt(f32x16& p0, f32x16& p1, const bf16_t* Ks, const bf16x8* qr, const f32x16& negm, int r32, int hi) {
#pragma unroll
  for (int d0 = 0; d0 < 6; ++d0) { int cb = (d0 * 16 + hi * 8) * 2;
    bf16x8 b0 = *reinterpret_cast<const bf16x8*>((const char*)Ks + KSWZ(r32, cb));
    bf16x8 b1 = *reinterpret_cast<const bf16x8*>((const char*)Ks + KSWZ(32 + r32, cb));
    if (d0 == 0) { p0 = __builtin_amdgcn_mfma_f32_32x32x16_bf16(b0, qr[0], negm, 0, 0, 0); p1 = __builtin_amdgcn_mfma_f32_32x32x16_bf16(b1, qr[0], negm, 0, 0, 0); }
    else { p0 = __builtin_amdgcn_mfma_f32_32x32x16_bf16(b0, qr[d0], p0, 0, 0, 0); p1 = __builtin_amdgcn_mfma_f32_32x32x16_bf16(b1, qr[d0], p1, 0, 0, 0); } }
}
__device__ __forceinline__ int v_st(int k, int c) { const int kk = (k & ~0xC) | ((k & 4) << 1) | ((k & 8) >> 1); return ((kk >> 3) * 4 + (c >> 5)) * 512 + ((kk & 7) * 32 + (c & 31)) * 2; }
__device__ __forceinline__ int v_rd_base(int lane) { return ((lane & 3) << 3) | (((lane >> 2) & 3) << 6) | (((lane >> 4) & 1) << 5) | (((lane >> 5) & 1) << 8); }
constexpr int v_rd_off(int d0, int ks, int half) { return d0 * 512 + ks * 4096 + half * 2048; }
template <int OFF> __device__ __forceinline__ s16x4 tr_read(int vb) {
  s16x4 r; asm volatile("ds_read_b64_tr_b16 %0, %1 offset:%2" : "=&v"(r) : "v"(vb), "i"(OFF) : "memory"); return r;
}
template <int D0> __device__ __forceinline__ void pv_one(f32x16& od, int vb, bf16x8 pa0, bf16x8 pa1, bf16x8 pa2, bf16x8 pa3) {
  const s16x4 l0 = tr_read<v_rd_off(D0, 0, 0)>(vb), h0 = tr_read<v_rd_off(D0, 0, 1)>(vb), l1 = tr_read<v_rd_off(D0, 1, 0)>(vb), h1 = tr_read<v_rd_off(D0, 1, 1)>(vb);
  const s16x4 l2 = tr_read<v_rd_off(D0, 2, 0)>(vb), h2 = tr_read<v_rd_off(D0, 2, 1)>(vb), l3 = tr_read<v_rd_off(D0, 3, 0)>(vb), h3 = tr_read<v_rd_off(D0, 3, 1)>(vb);
  asm volatile("s_waitcnt lgkmcnt(0)" ::: "memory"); SBAR();
#define PK(L, H) (bf16x8){L[0], L[1], L[2], L[3], H[0], H[1], H[2], H[3]}
  od = __builtin_amdgcn_mfma_f32_32x32x16_bf16(pa0, PK(l0, h0), od, 0, 0, 0);
  od = __builtin_amdgcn_mfma_f32_32x32x16_bf16(pa1, PK(l1, h1), od, 0, 0, 0);
  od = __builtin_amdgcn_mfma_f32_32x32x16_bf16(pa2, PK(l2, h2), od, 0, 0, 0);
  od = __builtin_amdgcn_mfma_f32_32x32x16_bf16(pa3, PK(l3, h3), od, 0, 0, 0);
#undef PK
}
__device__ __forceinline__ void pv_d0(f32x16* o, f32x16& osum, int vb, bf16x8 pa0, bf16x8 pa1, bf16x8 pa2, bf16x8 pa3) {
  pv_one<0>(o[0], vb, pa0, pa1, pa2, pa3); pv_one<1>(o[1], vb, pa0, pa1, pa2, pa3);
  const short one = (short)0x3F80; const bf16x8 ones = {one, one, one, one, one, one, one, one};
  osum = __builtin_amdgcn_mfma_f32_32x32x16_bf16(pa0, ones, osum, 0, 0, 0); osum = __builtin_amdgcn_mfma_f32_32x32x16_bf16(pa1, ones, osum, 0, 0, 0);
  osum = __builtin_amdgcn_mfma_f32_32x32x16_bf16(pa2, ones, osum, 0, 0, 0); osum = __builtin_amdgcn_mfma_f32_32x32x16_bf16(pa3, ones, osum, 0, 0, 0);
}
__device__ __forceinline__ void attn_unit(const bf16_t* __restrict__ Qb, const bf16_t* __restrict__ KNh, const bf16_t* __restrict__ KRb, const bf16_t* __restrict__ Vh,
                                          bf16_t* __restrict__ Ob, int seq, int qrow0, const float* __restrict__ ropec, const float* __restrict__ ropes, char* lds) {
  int tid_ = threadIdx.x; asm volatile("" : "+v"(tid_)); const int tid = tid_, wid = __builtin_amdgcn_readfirstlane(tid >> 6), lane = tid & 63, r32 = lane & 31, hi = lane >> 5;
  bf16_t* V_lds = (bf16_t*)lds; bf16_t* K_lds = (bf16_t*)(lds + 3 * SHM_V);
  float* ws = (float*)(lds + 3 * SHM_V + 3 * SHM_K) + wid * 64; float* al_l = ws + 32;
  float m_ref = 0.f; f32x16 o[2] = {}; f32x16 osum = {}; f32x16 negm = {}; asm volatile("" : "+v"(negm)); bf16x8 qr[6];
  const bf16_t* Qw = Qb + (long)(wid * QBLK + r32) * LDQ + hi * 8;
#pragma unroll
  for (int d0 = 0; d0 < 6; ++d0) qr[d0] = *reinterpret_cast<const bf16x8*>(Qw + d0 * 16);
  {
    const int pos = row_pos(qrow0 + wid * QBLK + r32); const float* cp = ropec + pos * 16 + 8 * hi; const float* sp = ropes + pos * 16 + 8 * hi;
    unsigned w1[4], w2[4];
#pragma unroll
    for (int e = 0; e < 8; e += 2) { float o1[2], o2[2];
#pragma unroll
      for (int f = 0; f < 2; ++f) { const float x1 = __uint_as_float(((unsigned)(unsigned short)qr[4][e + f]) << 16), x2 = __uint_as_float(((unsigned)(unsigned short)qr[5][e + f]) << 16); const float c = cp[e + f], s = sp[e + f];
        o1[f] = x1 * c - x2 * s; o2[f] = x1 * s + x2 * c; }
      w1[e >> 1] = cvtpk(o1[0], o1[1]); w2[e >> 1] = cvtpk(o2[0], o2[1]); }
    u32x4 v1 = {w1[0], w1[1], w1[2], w1[3]}, v2 = {w2[0], w2[1], w2[2], w2[3]}; qr[4] = *reinterpret_cast<bf16x8*>(&v1); qr[5] = *reinterpret_cast<bf16x8*>(&v2); }
  const int srow = tid >> 3, sch = tid & 7, srow2 = tid >> 2, sch2 = tid & 3;
  const bf16_t* kp = KNh + (long)srow * LDKN + 8 * sch; const bf16_t* vp = Vh + (long)srow * LDV + 8 * sch; const bf16_t* rp = KRb + (long)(srow2 & 63) * LDKR + 8 * sch2;
  const int kst = KSWZ(srow, 16 * sch), vst = v_st(srow, 8 * sch), rst = KSWZ(srow2 & 63, 128 + 16 * sch2);
  const bool has_r = wid < 4;
  constexpr int BUF = SHM_V;
  const int vb0 = (int)(uintptr_t)V_lds + v_rd_base(lane);
  struct { bf16x8 v, k, r; } sr_[2];
#define SLOAD(i, k0) do { sr_[i].v = *reinterpret_cast<const bf16x8*>(vp + (long)(k0) * LDV); sr_[i].k = *reinterpret_cast<const bf16x8*>(kp + (long)(k0) * LDKN); \
    if (has_r) sr_[i].r = *reinterpret_cast<const bf16x8*>(rp + (long)(k0) * LDKR); } while (0)
#define SWRITE(off, i) do { *(bf16x8*)((char*)V_lds + (off) + vst) = sr_[i].v; *(bf16x8*)((char*)K_lds + (off) + kst) = sr_[i].k; \
    if (has_r) *(bf16x8*)((char*)K_lds + (off) + rst) = sr_[i].r; } while (0)
#define SWAIT() do { if (has_r) asm volatile("s_waitcnt vmcnt(3)" ::: "memory"); else asm volatile("s_waitcnt vmcnt(2)" ::: "memory"); } while (0)
#define RESC(a) do { if (__any((a) < 1.f)) { if (hi == 0) al_l[r32] = (a); asm volatile("s_waitcnt lgkmcnt(0)" ::: "memory"); \
    _Pragma("unroll") for (int r = 0; r < 16; ++r) { const float f_ = al_l[crow(r, hi)]; o[0][r] *= f_; o[1][r] *= f_; osum[r] *= f_; } } } while (0)
#define ROT() do { const int t_ = o_prev; o_prev = o_cur; o_cur = o_next; o_next = t_; } while (0)
  f32x16 pA0, pA1, pB0, pB1; float alA, alB; bf16x8 pa0, pa1, pa2, pa3; const int NT = seq / KVBLK;
  constexpr int SE = 0, SO = 1;
  int o_prev = 2 * BUF, o_cur = 0, o_next = BUF;
  SLOAD(SE, 0); asm volatile("s_waitcnt vmcnt(0)" ::: "memory"); SWRITE(0, SE); __syncthreads();
  qkt(pA0, pA1, K_lds, qr, negm, r32, hi); partialSM<true>(pA0, pA1, m_ref, negm, alA);
  SLOAD(SO, KVBLK); if (2 < NT) SLOAD(SE, 2 * KVBLK);
  SWAIT(); SWRITE(BUF, SO); __syncthreads();
  ROT();
  for (int j = 1; j + 1 < NT; j += 2) {
    SBAR(); qkt(pB0, pB1, (bf16_t*)((char*)K_lds + o_cur), qr, negm, r32, hi);
    finishSM(pA0, pA1, pa0, pa1, pa2, pa3); SBAR();
    SLOAD(SO, (j + 2) * KVBLK); SBAR();
    pv_d0(o, osum, vb0 + o_prev, pa0, pa1, pa2, pa3); partialSM<false>(pB0, pB1, m_ref, negm, alB);
    SWAIT(); SWRITE(o_next, SE);
    RESC(alB); __syncthreads(); ROT();
    SBAR(); qkt(pA0, pA1, (bf16_t*)((char*)K_lds + o_cur), qr, negm, r32, hi);
    finishSM(pB0, pB1, pa0, pa1, pa2, pa3); SBAR();
    if (j + 3 < NT) SLOAD(SE, (j + 3) * KVBLK); SBAR();
    pv_d0(o, osum, vb0 + o_prev, pa0, pa1, pa2, pa3); partialSM<false>(pA0, pA1, m_ref, negm, alA);
    SWAIT(); SWRITE(o_next, SO);
    RESC(alA); __syncthreads(); ROT();
  }
  SBAR(); qkt(pB0, pB1, (bf16_t*)((char*)K_lds + o_cur), qr, negm, r32, hi);
  finishSM(pA0, pA1, pa0, pa1, pa2, pa3); SBAR();
  pv_d0(o, osum, vb0 + o_prev, pa0, pa1, pa2, pa3); partialSM<false>(pB0, pB1, m_ref, negm, alB);
  RESC(alB);
  finishSM(pB0, pB1, pa0, pa1, pa2, pa3); SBAR();
  pv_d0(o, osum, vb0 + o_cur, pa0, pa1, pa2, pa3);
  float rli[16];
#pragma unroll
  for (int r = 0; r < 16; ++r) rli[r] = __builtin_amdgcn_rcpf(osum[r]);
  bf16_t* Ow = Ob + (long)(wid * QBLK) * LDO;
#pragma unroll
  for (int r = 0; r < 16; ++r) { int orow = crow(r, hi);
#pragma unroll
    for (int d0 = 0; d0 < 2; ++d0) { const unsigned w = cvtpk(o[d0][r] * rli[r], 0.f); Ow[(long)orow * LDO + d0 * 32 + r32] = (bf16_t)(w & 0xffffu); } }
  __syncthreads();
#undef SLOAD
#undef SWRITE
#undef SWAIT
#undef RESC
#undef ROT
}
#undef KSWZ
#undef SBAR
}
namespace hg {
typedef unsigned short bf16_t;
using bf16x8 = __attribute__((ext_vector_type(8))) short;
using f32x16 = __attribute__((ext_vector_type(16))) float;
using f32x4  = __attribute__((ext_vector_type(4))) float;
using u32x4  = __attribute__((ext_vector_type(4))) unsigned;
#define SWZ256(row, colB) ((row) * 256 + ((colB) ^ (((row) & 7) << 4)))
#define SWZ128(row, colB) ((row) * 128 + ((colB) ^ (((((row) >> 4) ^ (row)) & 7) << 4)))
constexpr int GS = 132;
constexpr int L_ST = 0, L_QH = 32768, L_KH = 49152, L_KT = 65536, L_VT = 81920, L_GB = 98304, L_SEG = 98304 + 64 * GS * 4, L_DD = L_SEG + 2048, L_LB = L_DD + 512;
__device__ __forceinline__ int crow(int r, int hi) { return (r & 3) + 8 * (r >> 2) + 4 * hi; }
__device__ __forceinline__ unsigned cvtpk(float lo, float hi) { unsigned r; asm volatile("v_cvt_pk_bf16_f32 %0, %1, %2" : "=v"(r) : "v"(lo), "v"(hi)); return r; }
__device__ __forceinline__ float bf2f(unsigned short h) { return __uint_as_float(((unsigned)h) << 16); }
template <int MODE> __device__ __forceinline__ void chain(const bf16_t* __restrict__ U, float* __restrict__ OP, const float* __restrict__ hg_lb, int rowbase, int S, int h, int dir, int tau0, int nchunk,
                                                   const float* __restrict__ slot_in, float* __restrict__ slot_out, float* __restrict__ dseg_out, char* lds) {
  int tid_ = threadIdx.x; asm volatile("" : "+v"(tid_)); const int tid = tid_, wid = __builtin_amdgcn_readfirstlane(tid >> 6), lane = tid & 63, r32 = lane & 31, hi = lane >> 5;
  float* GB = (float*)(lds + L_GB); float* SEG = (float*)(lds + L_SEG); float* DD = (float*)(lds + L_DD); float* LB = (float*)(lds + L_LB);
  char* ST = lds + L_ST; char* QH = lds + L_QH; char* KH = lds + L_KH; char* KT = lds + L_KT; char* VT = lds + L_VT; char* AL = lds + L_GB;
  if (tid < 128) { const float a0 = hg_lb[dir * 1024 + h * 128 + tid], a1 = hg_lb[dir * 1024 + 512 + h * 128 + tid]; LB[tid] = 1.0f / (1.0f + __expf(a1 - a0)); }
  f32x16 sacc[2]; sacc[0] = f32x16{}; sacc[1] = f32x16{};
  if (MODE == 3) {
    if (slot_in) {
#pragma unroll
      for (int i = 0; i < 2; ++i)
#pragma unroll
        for (int r = 0; r < 16; ++r) sacc[i][r] = slot_in[(32 * (wid & 3) + crow(r, hi)) * 128 + 32 * (2 * (wid >> 2) + i) + r32];
    }
#pragma unroll
    for (int i = 0; i < 2; ++i)
#pragma unroll
      for (int r = 0; r < 16; ++r) *(bf16_t*)(ST + SWZ256(32 * (wid & 3) + crow(r, hi), 2 * (32 * (2 * (wid >> 2) + i) + r32))) = (bf16_t)(cvtpk(sacc[i][r], 0.f) & 0xffffu);
  }
  float dseg = 1.0f;
  const int tau = tid >> 3, c0 = (tid & 7) * 16, segt = tau >> 4;
  const bf16_t* Ub = U + (size_t)rowbase * 2560 + h * 128 + c0;
  const size_t offq = 0, offv = 512, offf = (size_t)(2 + dir) * 512;
  float* OPd = OP + (size_t)dir * T_ALL * 512;
  bf16x8 nq0, nq1, nv0, nv1, nf0, nf1;
  { const int t1 = tau0 + tau; const int tok = dir ? (S - 1 - t1) : t1; const bf16_t* p = Ub + (size_t)tok * 2560;
    nq0 = *(const bf16x8*)(p + offq); nq1 = *(const bf16x8*)(p + offq + 8); nv0 = *(const bf16x8*)(p + offv); nv1 = *(const bf16x8*)(p + offv + 8); nf0 = *(const bf16x8*)(p + offf); nf1 = *(const bf16x8*)(p + offf + 8); }
  __syncthreads();
  for (int ci = 0; ci < nchunk; ++ci) {
    const bf16x8 qv[2] = {nq0, nq1}, vv[2] = {nv0, nv1}, fv[2] = {nf0, nf1};
    { const int cn = (ci + 1 < nchunk) ? ci + 1 : ci; const int t2 = tau0 + cn * 64 + tau; const int tok = dir ? (S - 1 - t2) : t2; const bf16_t* p = Ub + (size_t)tok * 2560;
      nq0 = *(const bf16x8*)(p + offq); nq1 = *(const bf16x8*)(p + offq + 8); nv0 = *(const bf16x8*)(p + offv); nv1 = *(const bf16x8*)(p + offv + 8); nf0 = *(const bf16x8*)(p + offf); nf1 = *(const bf16x8*)(p + offf + 8); }
    float qq[16], kk[16];
#pragma unroll
    for (int j = 0; j < 16; ++j) {
      const float z = bf2f((unsigned short)fv[j >> 3][j & 7]); const float x = bf2f((unsigned short)qv[j >> 3][j & 7]);
      const float lbv = LB[c0 + j]; const float sg = __builtin_amdgcn_rcpf(1.0f + __expf(-z)); const float f = lbv + (1.0f - lbv) * sg;
      kk[j] = 1.0f - f; qq[j] = x * __builtin_amdgcn_rcpf(1.0f + __expf(-x));
      GB[tau * GS + c0 + j] = __logf(f);
    }
    __syncthreads();
    { const int k = tid & 127, seg = tid >> 7; float run = 0.f;
#pragma unroll
      for (int j = 0; j < 16; ++j) { run += GB[(16 * seg + j) * GS + k]; GB[(16 * seg + j) * GS + k] = run; }
      SEG[seg * 128 + k] = run; }
    __syncthreads();
    { unsigned qh[8], kh[8];
#pragma unroll
      for (int j = 0; j < 16; j += 2) {
        float g2[2], gl2[2];
#pragma unroll
        for (int e = 0; e < 2; ++e) { const int col = c0 + j + e; const float s0 = SEG[col], s1 = SEG[128 + col], s2 = SEG[256 + col];
          const float off = (segt >= 1 ? s0 : 0.f) + (segt >= 2 ? s1 : 0.f) + (segt >= 3 ? s2 : 0.f);
          g2[e] = GB[tau * GS + col] + off; gl2[e] = GB[63 * GS + col] + ((s0 + s1) + s2); }
        const float ea = __expf(g2[0]), eb = __expf(g2[1]);
        qh[j >> 1] = cvtpk(qq[j] * ea, qq[j + 1] * eb);
        kh[j >> 1] = cvtpk(kk[j] * __expf(fminf(-g2[0], 80.f)), kk[j + 1] * __expf(fminf(-g2[1], 80.f)));
        const unsigned kt = cvtpk(kk[j] * __expf(gl2[0] - g2[0]), kk[j + 1] * __expf(gl2[1] - g2[1]));
        *(bf16_t*)(KT + SWZ128(c0 + j, 2 * tau)) = (bf16_t)(kt & 0xffffu); *(bf16_t*)(KT + SWZ128(c0 + j + 1, 2 * tau)) = (bf16_t)(kt >> 16);
        *(bf16_t*)(VT + SWZ128(c0 + j, 2 * tau)) = (bf16_t)vv[j >> 3][j & 7]; *(bf16_t*)(VT + SWZ128(c0 + j + 1, 2 * tau)) = (bf16_t)vv[(j + 1) >> 3][(j + 1) & 7];
        if (tau == 63) { DD[c0 + j] = __expf(gl2[0]); DD[c0 + j + 1] = __expf(gl2[1]); }
      }
      *(u32x4*)(QH + SWZ256(tau, 2 * c0)) = (u32x4){qh[0], qh[1], qh[2], qh[3]}; *(u32x4*)(QH + SWZ256(tau, 2 * c0 + 16)) = (u32x4){qh[4], qh[5], qh[6], qh[7]};
      *(u32x4*)(KH + SWZ256(tau, 2 * c0)) = (u32x4){kh[0], kh[1], kh[2], kh[3]}; *(u32x4*)(KH + SWZ256(tau, 2 * c0 + 16)) = (u32x4){kh[4], kh[5], kh[6], kh[7]};
    }
    __syncthreads();
    if (MODE == 3 && wid < 4 && wid != 1) { const int ti = wid >> 1, si = wid & 1; f32x16 a = f32x16{};
#pragma unroll
      for (int k8 = 0; k8 < 8; ++k8) { const int cb = (16 * k8 + 8 * hi) * 2;
        const bf16x8 av = *(const bf16x8*)(QH + SWZ256(32 * ti + r32, cb)); const bf16x8 bv = *(const bf16x8*)(KH + SWZ256(32 * si + r32, cb));
        a = __builtin_amdgcn_mfma_f32_32x32x16_bf16(av, bv, a, 0, 0, 0); }
#pragma unroll
      for (int r = 0; r < 16; ++r) { const int tl = 32 * ti + crow(r, hi), sl = 32 * si + r32; const float val = (sl <= tl) ? a[r] : 0.f;
        *(bf16_t*)(AL + SWZ128(tl, 2 * sl)) = (bf16_t)(cvtpk(val, 0.f) & 0xffffu); } }
    if (MODE == 3) __syncthreads();
    { const int th = wid >> 2, vb = wid & 3;
      if (MODE == 3) { f32x16 o = f32x16{};
      const int nks = th ? 4 : 2;
      for (int ks = 0; ks < nks; ++ks) { const int cb = (16 * ks + 8 * hi) * 2;
        const bf16x8 av = *(const bf16x8*)(AL + SWZ128(32 * th + r32, cb)); const bf16x8 bv = *(const bf16x8*)(VT + SWZ128(32 * vb + r32, cb));
        o = __builtin_amdgcn_mfma_f32_32x32x16_bf16(av, bv, o, 0, 0, 0); }
#pragma unroll
      for (int k8 = 0; k8 < 8; ++k8) { const int cb = (16 * k8 + 8 * hi) * 2;
        const bf16x8 av = *(const bf16x8*)(QH + SWZ256(32 * th + r32, cb)); const bf16x8 bv = *(const bf16x8*)(ST + SWZ256(32 * vb + r32, cb));
        o = __builtin_amdgcn_mfma_f32_32x32x16_bf16(av, bv, o, 0, 0, 0); }
#pragma unroll
      for (int r = 0; r < 16; ++r) { const int t2 = tau0 + ci * 64 + 32 * th + crow(r, hi); const int tok = dir ? (S - 1 - t2) : t2;
        OPd[(size_t)(rowbase + tok) * 512 + h * 128 + 32 * vb + r32] = o[r]; }
      } else { if (tid < 128) dseg *= DD[tid]; }
#pragma unroll
      for (int i = 0; i < 2; ++i) { const int kb = 2 * th + i; const float dk = DD[32 * kb + r32];
#pragma unroll
        for (int r = 0; r < 16; ++r) sacc[i][r] *= dk;
#pragma unroll
        for (int ks = 0; ks < 4; ++ks) { const int cb = (16 * ks + 8 * hi) * 2;
          const bf16x8 av = *(const bf16x8*)(VT + SWZ128(32 * vb + r32, cb)); const bf16x8 bv = *(const bf16x8*)(KT + SWZ128(32 * kb + r32, cb));
          sacc[i] = __builtin_amdgcn_mfma_f32_32x32x16_bf16(av, bv, sacc[i], 0, 0, 0); } }
    }
    __syncthreads();
    if (MODE == 3) { const int th = wid >> 2, vb = wid & 3;
#pragma unroll
      for (int i = 0; i < 2; ++i) { const int kb = 2 * th + i;
#pragma unroll
        for (int r = 0; r < 16; ++r) *(bf16_t*)(ST + SWZ256(32 * vb + crow(r, hi), 2 * (32 * kb + r32))) = (bf16_t)(cvtpk(sacc[i][r], 0.f) & 0xffffu); } }
  }
  if (MODE == 1) {
#pragma unroll
    for (int i = 0; i < 2; ++i)
#pragma unroll
      for (int r = 0; r < 16; ++r) slot_out[(32 * (wid & 3) + crow(r, hi)) * 128 + 32 * (2 * (wid >> 2) + i) + r32] = sacc[i][r];
    if (tid < 128) dseg_out[tid] = dseg;
  }
  __syncthreads();
}
#undef SWZ256
#undef SWZ128
}
typedef unsigned short bf16_t;
typedef float f32x4 __attribute__((ext_vector_type(4)));
typedef unsigned u32x4 __attribute__((ext_vector_type(4)));
typedef unsigned u32x2 __attribute__((ext_vector_type(2)));
typedef short bf16x8 __attribute__((ext_vector_type(8)));
#define LAS __attribute__((address_space(3)))
constexpr size_t MiB = 1u << 20;
constexpr size_t WS_SS = 0;
constexpr size_t WS_ROPEC = 4 * MiB, WS_ROPES = 5 * MiB;
constexpr size_t WS_W1GU = 16 * MiB, WS_W1D = 27 * MiB, WS_WIN = 33 * MiB, WS_WUQ = 40 * MiB, WS_WUKV = 41 * MiB, WS_WO = 42 * MiB, WS_W2GU = 44 * MiB, WS_W2D = 55 * MiB, WS_WPG = 61 * MiB, WS_WPP = 63 * MiB;
constexpr size_t WS_HB = 64 * MiB;
constexpr size_t WS_BIG = 256 * MiB;
constexpr size_t WS_UHG = WS_BIG, WS_UMLA = WS_BIG + 480 * MiB, WS_MIX = WS_BIG + 480 * MiB, WS_ACT = WS_BIG, WS_PROJ = WS_BIG;
constexpr size_t WS_PB = 928 * MiB;
constexpr size_t WS_SLOT = 976 * MiB;
constexpr size_t WS_DSEG = 8 * MiB;
constexpr size_t WS_END = 1024 * MiB;
constexpr size_t DO_Q = 0, DO_KN = 144 * MiB, DO_V = 240 * MiB, DO_KR = 336 * MiB;
constexpr int LDS_BYTES = 147456;

struct Params {
  const float* in[26];
  float* out; unsigned char* ws;
};

__device__ __forceinline__ unsigned f2bf(float f) { unsigned u = __builtin_bit_cast(unsigned, f); return (u + 0x7fffu + ((u >> 16) & 1u)) >> 16; }
__device__ __forceinline__ unsigned pk2(float lo, float hi) { return f2bf(lo) | (f2bf(hi) << 16); }
__device__ __forceinline__ float wave_sum(float v) {
#pragma unroll
  for (int o = 1; o < 64; o <<= 1) v += __shfl_xor(v, o);
  return v;
}
__device__ __forceinline__ void prep_item(const float* W, int ld, int col0, const float* fold, bf16_t* WT, int K, int n0, int k0, float* scr, int lane) {
#pragma unroll 8
  for (int i = 0; i < 32; ++i) { const int kk = 2 * i + (lane >> 5); float v = 0.f; if (W) { v = W[(size_t)(k0 + kk) * ld + col0 + (lane & 31)]; if (fold) v *= fold[k0 + kk]; } scr[kk * 33 + (lane & 31)] = v; }
  asm volatile("s_waitcnt lgkmcnt(0)" ::: "memory");
  const int c = lane & 7;
#pragma unroll
  for (int j = 0; j < 4; ++j) { const int n = (lane >> 3) + 8 * j; const float* s = scr + (8 * c) * 33 + n;
    u32x4 o; o.x = pk2(s[0 * 33], s[1 * 33]); o.y = pk2(s[2 * 33], s[3 * 33]); o.z = pk2(s[4 * 33], s[5 * 33]); o.w = pk2(s[6 * 33], s[7 * 33]);
    *(u32x4*)(WT + (size_t)(n0 + n) * K + k0 + 8 * c) = o; }
  asm volatile("s_waitcnt lgkmcnt(0)" ::: "memory");
}
__device__ __forceinline__ void sincos_d(double x, float& s, float& c) {
  const double TWO_PI = 6.283185307179586476925286766559, INV_2PI = 0.15915494309189533576888376337251;
  double k = __builtin_rint(x * INV_2PI); double r = x - k * TWO_PI;
  const double HALF_PI = 1.5707963267948966192313216916398;
  double q = __builtin_rint(r * 0.63661977236758134308); double y = r - q * HALF_PI; int qi = ((int)q) & 3;
  double y2 = y * y;
  double sp = y * (1.0 + y2 * (-1.0 / 6 + y2 * (1.0 / 120 + y2 * (-1.0 / 5040 + y2 * (1.0 / 362880 + y2 * (-1.0 / 39916800 + y2 * (1.0 / 6227020800.0)))))));
  double cp = 1.0 + y2 * (-0.5 + y2 * (1.0 / 24 + y2 * (-1.0 / 720 + y2 * (1.0 / 40320 + y2 * (-1.0 / 3628800 + y2 * (1.0 / 479001600.0 + y2 * (-1.0 / 87178291200.0)))))));
  double ss, cc;
  if (qi == 0) { ss = sp; cc = cp; } else if (qi == 1) { ss = cp; cc = -sp; } else if (qi == 2) { ss = -sp; cc = -cp; } else { ss = -cp; cc = sp; }
  s = (float)ss; c = (float)cc;
}

__device__ __forceinline__ void p0_prologue(const Params& P, unsigned char* ws, char* lds) {
  int tid_ = threadIdx.x; asm volatile("" : "+v"(tid_)); const int tid = tid_, lane = tid & 63, wave = tid >> 6;
  const int gw = blockIdx.x * 8 + wave, NGW = gridDim.x * 8;
  float* scr = (float*)(lds + wave * 16384);
  constexpr int NJ = 10;
  const int jN[NJ] = {NGU, 1024, NIN, 768, 1024, 1024, NGU, 1024, 1024, 1024};
  const int jK[NJ] = {1024, DFF, 1024, 384, 256, 1024, 1024, DFF, 1024, 256};
  int total = 0;
#pragma unroll
  for (int j = 0; j < NJ; ++j) total += (jN[j] / 32) * (jK[j] / 64);
  for (int it = gw; it < total; it += NGW) {
    int r = it, job = 0;
#pragma unroll
    for (int j = 0; j < NJ; ++j) { const int cnt = (jN[j] / 32) * (jK[j] / 64); if (job == j && r >= cnt) { r -= cnt; job = j + 1; } }
    int N = 0, K = 0;
#pragma unroll
    for (int j = 0; j < NJ; ++j) if (job == j) { N = jN[j]; K = jK[j]; }
    const int nblk = N / 32, kb = r / nblk, nb = r % nblk, k0 = 64 * kb, n0 = 32 * nb;
    const float* W = nullptr; int ld = 0, col0 = 0; const float* fold = nullptr; bf16_t* WT = nullptr;
    if (job == 0 || job == 6) { const int t = n0 >> 8, half = (n0 >> 7) & 1, j0 = n0 & 127; const int b = (job == 0) ? 5 : 19;
      W = P.in[b + half]; ld = DFF; col0 = 128 * t + j0; fold = P.in[(job == 0) ? 4 : 18]; WT = (bf16_t*)(ws + ((job == 0) ? WS_W1GU : WS_W2GU)); }
    else if (job == 1 || job == 7) { W = P.in[(job == 1) ? 7 : 21]; ld = 1024; col0 = n0; WT = (bf16_t*)(ws + ((job == 1) ? WS_W1D : WS_W2D)); }
    else if (job == 2) { ld = 3232; fold = P.in[8]; WT = (bf16_t*)(ws + WS_WIN); W = P.in[9];
      if (n0 < 384) col0 = n0; else if (n0 < 416) col0 = 640 + (n0 - 384); else if (n0 < 512) W = nullptr; else if (n0 < 768) col0 = 384 + (n0 - 512); else col0 = 672 + (n0 - 768); }
    else if (job == 3) { W = P.in[11]; ld = 768; col0 = n0; fold = P.in[10]; WT = (bf16_t*)(ws + WS_WUQ); }
    else if (job == 4) { if (n0 < 512) { W = P.in[13]; col0 = n0; } else { W = P.in[14]; col0 = n0 - 512; } ld = 512; fold = P.in[12]; WT = (bf16_t*)(ws + WS_WUKV); }
    else if (job == 5) { W = P.in[17]; ld = 1024; col0 = n0; WT = (bf16_t*)(ws + WS_WO); }
    else if (job == 8) { W = P.in[23]; ld = 1024; col0 = n0; fold = P.in[22]; WT = (bf16_t*)(ws + WS_WPG); }
    else { W = P.in[24]; ld = 1024; col0 = n0; WT = (bf16_t*)(ws + WS_WPP); }
    prep_item(W, ld, col0, fold, WT, K, n0, k0, scr, lane);
  }
  float* ss = (float*)(ws + WS_SS); bf16_t* HB = (bf16_t*)(ws + WS_HB); bf16_t* PB = (bf16_t*)(ws + WS_PB);
  for (int m = gw; m < T_ALL; m += NGW) {
    const float* xr = (m < T_P) ? P.in[0] + (size_t)m * DM : P.in[1] + (size_t)(m - T_P) * DM;
    const f32x4* x4 = (const f32x4*)xr + lane; float s = 0.f; f32x4 v[4];
#pragma unroll
    for (int j = 0; j < 4; ++j) { v[j] = x4[64 * j]; s += (v[j][0] * v[j][0] + v[j][1] * v[j][1]) + (v[j][2] * v[j][2] + v[j][3] * v[j][3]); }
    s = wave_sum(s);
    u32x2* o8 = (u32x2*)(HB + (size_t)m * DM) + lane;
#pragma unroll
    for (int j = 0; j < 4; ++j) { u32x2 w; w.x = pk2(v[j][0], v[j][1]); w.y = pk2(v[j][2], v[j][3]); o8[64 * j] = w; }
    const float* pr = (m < T_P) ? P.in[2] + (size_t)m * PLE : P.in[3] + (size_t)(m - T_P) * PLE;
    const f32x4 pv = ((const f32x4*)pr)[lane]; u32x2 w; w.x = pk2(pv[0], pv[1]); w.y = pk2(pv[2], pv[3]); ((u32x2*)(PB + (size_t)m * PLE))[lane] = w;
    if (lane < 7) ss[(size_t)lane * T_ALL + m] = (lane == 0) ? s : 0.f;
  }
  float* rc = (float*)(ws + WS_ROPEC); float* rs = (float*)(ws + WS_ROPES);
  for (int e = blockIdx.x * 512 + tid; e < S_P * 16; e += gridDim.x * 512) {
    const int pos = e >> 4, i = e & 15;
    const float cst = (float)(-9.210340371976184 / 32.0); const float arg = (float)(2 * i) * cst;
    const double a = (double)arg; const double nn = __builtin_rint(a * 1.4426950408889634); const double rr = a - nn * 0.69314718055994530942;
    double ex = 1.0 + rr * (1.0 + rr * (0.5 + rr * (1.0 / 6 + rr * (1.0 / 24 + rr * (1.0 / 120 + rr * (1.0 / 720 + rr * (1.0 / 5040 + rr * (1.0 / 40320 + rr * (1.0 / 362880 + rr * (1.0 / 3628800 + rr * (1.0 / 39916800)))))))))));
    ex = ex * __builtin_ldexp(1.0, (int)nn);
    const float invf = (float)ex; const float ang = (float)pos * invf;
    float sv, cv; sincos_d((double)ang, sv, cv); rc[e] = cv; rs[e] = sv;
  }
}
__device__ __forceinline__ void hg_combine(const float* OP, const bf16_t* U, const float* hg_norm, bf16_t* MIX) {
  int tid_ = threadIdx.x; asm volatile("" : "+v"(tid_)); const int lane = tid_ & 63, wave = tid_ >> 6; const int gw = blockIdx.x * 8 + wave, NGW = gridDim.x * 8;
  f32x4 gn0 = *(const f32x4*)(hg_norm + 8 * lane), gn1 = *(const f32x4*)(hg_norm + 8 * lane + 4);
  for (int m = gw; m < T_ALL; m += NGW) {
    const float* a = OP + (size_t)m * 512 + 8 * lane; const float* b = a + (size_t)T_ALL * 512;
    f32x4 o0 = *(const f32x4*)a + *(const f32x4*)b, o1 = *(const f32x4*)(a + 4) + *(const f32x4*)(b + 4);
    float s = (o0[0] * o0[0] + o0[1] * o0[1]) + (o0[2] * o0[2] + o0[3] * o0[3]) + (o1[0] * o1[0] + o1[1] * o1[1]) + (o1[2] * o1[2] + o1[3] * o1[3]);
    s += __shfl_xor(s, 1); s += __shfl_xor(s, 2); s += __shfl_xor(s, 4); s += __shfl_xor(s, 8);
    const float r = rsqrtf(s * (1.0f / 128.0f) + EPS);
    const bf16x8 g = *(const bf16x8*)(U + (size_t)m * 2560 + 2048 + 8 * lane);
    float ov[8] = {o0[0], o0[1], o0[2], o0[3], o1[0], o1[1], o1[2], o1[3]}; float gnv[8] = {gn0[0], gn0[1], gn0[2], gn0[3], gn1[0], gn1[1], gn1[2], gn1[3]};
    unsigned w[4];
#pragma unroll
    for (int j = 0; j < 8; j += 2) { float r2[2];
#pragma unroll
      for (int e = 0; e < 2; ++e) { const float x = __uint_as_float(((unsigned)(unsigned short)g[j + e]) << 16); const float sl = x * __builtin_amdgcn_rcpf(1.0f + __expf(-x)); r2[e] = ov[j + e] * r * gnv[j + e] * sl; }
      w[j >> 1] = pk2(r2[0], r2[1]); }
    *(u32x4*)(MIX + (size_t)m * 1024 + 512 + 8 * lane) = (u32x4){w[0], w[1], w[2], w[3]};
  }
}
__device__ __forceinline__ void final_norm(float* out, const float* ss4, const float* fn) {
  int tid_ = threadIdx.x; asm volatile("" : "+v"(tid_)); const int lane = tid_ & 63, wave = tid_ >> 6; const int gw = blockIdx.x * 8 + wave, NGW = gridDim.x * 8;
  f32x4 g[4];
#pragma unroll
  for (int j = 0; j < 4; ++j) g[j] = ((const f32x4*)fn)[lane + 64 * j];
  for (int m = gw; m < T_ALL; m += NGW) {
    const float r = rsqrtf(ss4[m] * (1.0f / 1024.0f) + EPS);
    f32x4* p = (f32x4*)(out + (size_t)m * DM) + lane;
#pragma unroll
    for (int j = 0; j < 4; ++j) { const f32x4 v = p[64 * j]; p[64 * j] = v * r * g[j]; }
  }
}

#define GSYNC() cg::this_grid().sync()

template <class Epi> __device__ __forceinline__ void run_gemm(LAS unsigned char* lds, const bf16_t* A, int lda, const bf16_t* Bt, int ldb, int N, int K, const Epi& E) {
  pg8::Gemm g{A, Bt, T_ALL, N, K, lda, ldb}; pg8::StaticOrder S; S.init(T_ALL, N, (int)gridDim.x, (int)blockIdx.x);
  pg8::gemm_phase<Epi, pg8::StaticOrder, true, true>(lds, g, S, E);
}

__global__ void __launch_bounds__(512, 2) mk_fwd(Params P) {
  extern __shared__ __attribute__((aligned(16))) unsigned char lds[];
  unsigned char* ws = P.ws; float* out = P.out; unsigned char* dob = (unsigned char*)P.out;
  LAS unsigned char* l3 = (LAS unsigned char*)lds;
  float* ss = (float*)(ws + WS_SS);
  float* ss0 = ss, *ss1 = ss + T_ALL, *ss2 = ss + 2 * (size_t)T_ALL, *ss3 = ss + 3 * (size_t)T_ALL, *ss4 = ss + 4 * (size_t)T_ALL, *ssq = ss + 5 * (size_t)T_ALL, *sskv = ss + 6 * (size_t)T_ALL;
  const float* ropec = (const float*)(ws + WS_ROPEC); const float* ropes = (const float*)(ws + WS_ROPES);
  bf16_t* HB = (bf16_t*)(ws + WS_HB); bf16_t* ACT = (bf16_t*)(ws + WS_ACT); bf16_t* UHG = (bf16_t*)(ws + WS_UHG); bf16_t* UMLA = (bf16_t*)(ws + WS_UMLA);
  bf16_t* MIX = (bf16_t*)(ws + WS_MIX); bf16_t* PROJ = (bf16_t*)(ws + WS_PROJ); bf16_t* PB = (bf16_t*)(ws + WS_PB);
  bf16_t* Qb = (bf16_t*)(dob + DO_Q); bf16_t* KN = (bf16_t*)(dob + DO_KN); bf16_t* Vb = (bf16_t*)(dob + DO_V); bf16_t* KR = (bf16_t*)(dob + DO_KR);

  p0_prologue(P, ws, (char*)lds);
  GSYNC();
  { pg8::EpiSwiGLU E{ACT, ss0}; run_gemm(l3, HB, 1024, (const bf16_t*)(ws + WS_W1GU), 1024, NGU, 1024, E); }
  GSYNC();
  { pg8::EpiRes<0> E{P.in[0], P.in[1], out, HB, ss1, nullptr, nullptr}; run_gemm(l3, ACT, DFF, (const bf16_t*)(ws + WS_W1D), DFF, 1024, DFF, E); }
  GSYNC();
  { pg8::EpiWin E{UMLA, UHG, KR, ss1, ssq, sskv, ropec, ropes}; run_gemm(l3, HB, 1024, (const bf16_t*)(ws + WS_WIN), 1024, NIN, 1024, E); }
  GSYNC();
  { pg8::EpiBf E{Qb, Qb, 768, 1000, ssq, 1.0f / 384.0f, att::SCALE * 1.4426950408889634f}; run_gemm(l3, UMLA, 768, (const bf16_t*)(ws + WS_WUQ), 384, 768, 384, E); }
  { pg8::EpiBf E{KN, Vb, 512, 2, sskv, 1.0f / 256.0f, 1.0f}; run_gemm(l3, UMLA + 512, 768, (const bf16_t*)(ws + WS_WUKV), 256, 1024, 256, E); }
  GSYNC();
  {
    const int G = gridDim.x, bx = blockIdx.x;
    if (G == 256) {
      const int xcd = bx & 7, idx = bx >> 3;
      for (int i = 0; i < 12; ++i) {
        int rowbase, seq, h, qb;
        if (i < 4) { const int pair = 2 * xcd + (i >> 1); const int b = pair >> 3; h = pair & 7; qb = idx * 2 + (i & 1); rowbase = b * S_P; seq = S_P; }
        else { const int j = i - 4; const int pair = 16 * xcd + 2 * j + (idx >> 4); const int b = pair >> 3; h = pair & 7; qb = idx & 15; rowbase = T_P + b * S_S; seq = S_S; }
        att::attn_unit(Qb + (size_t)(rowbase + qb * 256) * 768 + h * 96, KN + (size_t)rowbase * 512 + h * 64, KR + (size_t)rowbase * 32, Vb + (size_t)rowbase * 512 + h * 64,
                       MIX + (size_t)(rowbase + qb * 256) * 1024 + h * 64, seq, rowbase + qb * 256, ropec, ropes, (char*)lds);
      }
    } else {
      for (int u = bx; u < 3072; u += G) {
        int rowbase, seq, h, qb;
        if (u < 1024) { const int pair = u >> 6; const int b = pair >> 3; h = pair & 7; qb = u & 63; rowbase = b * S_P; seq = S_P; }
        else { const int v = u - 1024; const int pair = v >> 4; const int b = pair >> 3; h = pair & 7; qb = v & 15; rowbase = T_P + b * S_S; seq = S_S; }
        att::attn_unit(Qb + (size_t)(rowbase + qb * 256) * 768 + h * 96, KN + (size_t)rowbase * 512 + h * 64, KR + (size_t)rowbase * 32, Vb + (size_t)rowbase * 512 + h * 64,
                       MIX + (size_t)(rowbase + qb * 256) * 1024 + h * 64, seq, rowbase + qb * 256, ropec, ropes, (char*)lds);
      }
    }
  }
  GSYNC();
  {
    float* SLOT = (float*)(ws + WS_SLOT); float* DSEG = (float*)(ws + WS_DSEG);
    for (int u = blockIdx.x; u < 768; u += gridDim.x) {
      int chainid, seg, nseg;
      if (u < 256) { chainid = u >> 4; seg = u & 15; nseg = 16; } else { const int u2 = u - 256; chainid = 16 + (u2 >> 2); seg = u2 & 3; nseg = 4; }
      if (seg == nseg - 1) continue;
      int rowbase, S, h, dir;
      if (chainid < 16) { const int b = chainid >> 3; h = (chainid >> 1) & 3; dir = chainid & 1; rowbase = b * S_P; S = S_P; }
      else { const int c2 = chainid - 16; const int b = c2 >> 3; h = (c2 >> 1) & 3; dir = c2 & 1; rowbase = T_P + b * S_S; S = S_S; }
      hg::chain<1>(UHG, out, P.in[15], rowbase, S, h, dir, seg * 1024, 16, nullptr, SLOT + (size_t)u * 16384, DSEG + (size_t)u * 128, (char*)lds);
    }
  }
  GSYNC();
  {
    float* SLOT = (float*)(ws + WS_SLOT); const float* DSEG = (const float*)(ws + WS_DSEG);
    int tid_ = threadIdx.x; asm volatile("" : "+v"(tid_));
    for (int e = blockIdx.x * 512 + tid_; e < 144 * 16384; e += gridDim.x * 512) {
      const int chainid = e >> 14, el = e & 16383, k = el & 127;
      int u0, nseg; if (chainid < 16) { u0 = chainid * 16; nseg = 16; } else { u0 = 256 + (chainid - 16) * 4; nseg = 4; }
      float Sv = 0.f;
      for (int s = 1; s < nseg; ++s) { float* sl = SLOT + (size_t)(u0 + s - 1) * 16384 + el; Sv = DSEG[(size_t)(u0 + s - 1) * 128 + k] * Sv + *sl; *sl = Sv; }
    }
  }
  GSYNC();
  {
    const float* SLOT = (const float*)(ws + WS_SLOT);
    for (int u = blockIdx.x; u < 768; u += gridDim.x) {
      int chainid, seg;
      if (u < 256) { chainid = u >> 4; seg = u & 15; } else { const int u2 = u - 256; chainid = 16 + (u2 >> 2); seg = u2 & 3; }
      int rowbase, S, h, dir;
      if (chainid < 16) { const int b = chainid >> 3; h = (chainid >> 1) & 3; dir = chainid & 1; rowbase = b * S_P; S = S_P; }
      else { const int c2 = chainid - 16; const int b = c2 >> 3; h = (c2 >> 1) & 3; dir = c2 & 1; rowbase = T_P + b * S_S; S = S_S; }
      hg::chain<3>(UHG, out, P.in[15], rowbase, S, h, dir, seg * 1024, 16, seg ? SLOT + (size_t)(u - 1) * 16384 : nullptr, nullptr, nullptr, (char*)lds);
    }
  }
  GSYNC();
  hg_combine(out, UHG, P.in[16], MIX);
  GSYNC();
  { pg8::EpiRes<1> E{nullptr, nullptr, out, HB, ss2, nullptr, nullptr}; run_gemm(l3, MIX, 1024, (const bf16_t*)(ws + WS_WO), 1024, 1024, 1024, E); }
  GSYNC();
  { pg8::EpiSwiGLU E{ACT, ss2}; run_gemm(l3, HB, 1024, (const bf16_t*)(ws + WS_W2GU), 1024, NGU, 1024, E); }
  GSYNC();
  { pg8::EpiRes<2> E{nullptr, nullptr, out, HB, ss3, nullptr, nullptr}; run_gemm(l3, ACT, DFF, (const bf16_t*)(ws + WS_W2D), DFF, 1024, DFF, E); }
  GSYNC();
  { pg8::EpiBf E{PROJ, PROJ, 1024, 1000, nullptr, 0.f, 1.0f}; run_gemm(l3, PB, 256, (const bf16_t*)(ws + WS_WPP), 256, 1024, 256, E); }
  GSYNC();
  { pg8::EpiRes<3> E{nullptr, nullptr, out, HB, ss4, ss3, PROJ}; run_gemm(l3, HB, 1024, (const bf16_t*)(ws + WS_WPG), 1024, 1024, 1024, E); }
  GSYNC();
  final_norm(out, ss4, P.in[25]);
}

extern "C" void kernel_launch(void* const* d_in, const int* in_sizes, int n_in, void* d_out, int out_size, void* d_ws, size_t ws_size, hipStream_t stream) {
  static int grid = 0;
  if (grid == 0) {
    if (n_in != 26 || out_size != T_ALL * DM || ws_size < WS_END) { fprintf(stderr, "kernel_launch: unexpected shapes n_in %d out %d ws %zu\n", n_in, out_size, ws_size); grid = -1; return; }
    int dev = 0, cus = 0, per_cu = 0;
    if (hipGetDevice(&dev) != hipSuccess || hipDeviceGetAttribute(&cus, hipDeviceAttributeMultiprocessorCount, dev) != hipSuccess) { grid = -1; return; }
    if (hipFuncSetAttribute((const void*)mk_fwd, hipFuncAttributeMaxDynamicSharedMemorySize, LDS_BYTES) != hipSuccess) { fprintf(stderr, "kernel_launch: LDS attribute failed\n"); grid = -1; return; }
    if (hipOccupancyMaxActiveBlocksPerMultiprocessor(&per_cu, (const void*)mk_fwd, 512, LDS_BYTES) != hipSuccess || per_cu < 1) { fprintf(stderr, "kernel_launch: occupancy query says %d\n", per_cu); per_cu = 1; }
    (void)hipGetLastError();
    grid = cus;
  }
  if (grid < 0) return;
  Params p{};
  for (int i = 0; i < 26; ++i) p.in[i] = (const float*)d_in[i];
  p.out = (float*)d_out; p.ws = (unsigned char*)d_ws;
  void* args[] = {&p};
  hipError_t e = hipLaunchCooperativeKernel((void*)mk_fwd, dim3(grid), dim3(512), args, LDS_BYTES, stream);
  if (e != hipSuccess) fprintf(stderr, "cooperative launch failed: %s (grid %d)\n", hipGetErrorString(e), grid);
}
```

```cpp
#include <hip/hip_runtime.h>
#include <hip/hip_cooperative_groups.h>
#include <cstdio>
#include <cstdint>
namespace cg = cooperative_groups;

constexpr int DM = 1024, T_P = 32768, T_ALL = 98304, S_P = 16384, S_S = 4096;
constexpr int DFF = 2816, NGU = 5632, NIN = 3328, NMLA = 768, NHG = 2560, PLE = 256;
constexpr float EPS = 1e-6f;
__device__ __forceinline__ int row_pos(int row) { return row < T_P ? (row & (S_P - 1)) : (row & (S_S - 1)); }

namespace pg8 {
#define PG8_LAS __attribute__((address_space(3)))
typedef unsigned short bf16_t;
typedef short bf16x8 __attribute__((ext_vector_type(8)));
typedef float f32x4 __attribute__((ext_vector_type(4)));
typedef unsigned u32x4 __attribute__((ext_vector_type(4)));
constexpr int BM = 256, BK = 64, HALF = 128, HTB = HALF * BK * 2  , STAGE_BYTES = 8 * HTB, NXCD = 8, WGM = 8;

__host__ __device__ __forceinline__ int lds_byte(int r, int c) { const int st = (r >> 4) * 2 + (c >> 5), rr = r & 15, cc = c & 31, ob = rr * 64 + cc * 2; return st * 1024 + (ob ^ (((ob >> 9) & 1) << 5)); }
__host__ __device__ __forceinline__ void stage_rc(int b, int& R, int& C) { const int st = b / 1024, sb = b % 1024, swz = sb ^ (((sb >> 9) & 1) << 5); R = (st >> 1) * 16 + swz / 64; C = (st & 1) * 32 + (swz % 64) / 2; }
__host__ __device__ __forceinline__ int perm32(int rho) { const int n = rho >> 4, i = rho & 15; return 8 * (i >> 2) + 4 * n + (i & 3); }

struct Unit { int pm, pn; };
struct Gemm { const bf16_t* A; const bf16_t* Bt; int M, N, K, lda, ldb; };

struct StaticOrder {
    int nM, nN, nwg, G, c;
    __host__ __device__ void init(int M, int N, int G_, int c_) { nM = M / BM; nN = N / BM; nwg = nM * nN; G = G_; c = c_; }
    __host__ __device__ bool next(int i, Unit& u) const {
        const long L = (long)i * G + c; if (L >= nwg) return false;
        int wgid = (int)L; { const int q = nwg / NXCD, r = nwg % NXCD, xcd = wgid % NXCD, off = wgid / NXCD; wgid = (xcd < r ? xcd * (q + 1) : r * (q + 1) + (xcd - r) * q) + off; }
        const int nig = WGM * nN, gid = wgid / nig, fm = gid * WGM, gsz = (nM - fm) < WGM ? (nM - fm) : WGM;
        u.pm = fm + ((wgid % nig) % gsz); u.pn = (wgid % nig) / gsz; return true;
    }
    __device__ __forceinline__ void a_ready(const Unit&) const {}
    __device__ __forceinline__ void done(const Unit&) const {}
};
__device__ __forceinline__ unsigned cvt_pk_bf16(float lo, float hi) { unsigned r; asm volatile("v_cvt_pk_bf16_f32 %0, %1, %2" : "=v"(r) : "v"(lo), "v"(hi)); return r; }
typedef unsigned u32x2 __attribute__((ext_vector_type(2)));
__device__ __forceinline__ float bf2f(unsigned short h) { return __uint_as_float(((unsigned)h) << 16); }
__device__ __forceinline__ float fsigmoid(float x) { return __builtin_amdgcn_rcpf(1.0f + __expf(-x)); }
__device__ __forceinline__ float row_sum4(float s) { s += __shfl_xor(s, 16); s += __shfl_xor(s, 32); return s; }

struct EpiSwiGLU {
    static constexpr bool PERM = true, AFTER_DRAIN = false;
    bf16_t* O; const float* ss;
    __device__ __forceinline__ void operator()(const f32x4 (&acc)[2][2][4][2], const Unit& u, int wr, int wc, int fr, int fq) const {
        const int row0 = u.pm * BM + wr * 64 + fr; const int col0 = u.pn * HALF + wc * 32 + 8 * fq;
#pragma unroll
        for (int ai = 0; ai < 2; ++ai)
#pragma unroll
            for (int m = 0; m < 4; ++m) { const int row = row0 + ai * HALF + m * 16; const float r = rsqrtf(ss[row] * (1.0f / 1024.0f) + 1e-6f);
                float v[8];
#pragma unroll
                for (int n = 0; n < 2; ++n)
#pragma unroll
                    for (int j = 0; j < 4; ++j) { const float g = acc[ai][0][m][n][j] * r, uu = acc[ai][1][m][n][j] * r; v[n * 4 + j] = g * fsigmoid(g) * uu; }
                u32x4 w; w.x = cvt_pk_bf16(v[0], v[1]); w.y = cvt_pk_bf16(v[2], v[3]); w.z = cvt_pk_bf16(v[4], v[5]); w.w = cvt_pk_bf16(v[6], v[7]);
                *(u32x4*)(O + (size_t)row * 2816 + col0) = w; }
    }
};
template <int MODE> struct EpiRes {
    static constexpr bool PERM = true, AFTER_DRAIN = false;
    const float* xp; const float* xs; bf16_t* hb; bf16_t* hout; float* ssout; const float* ssin; const bf16_t* proj;
    __device__ __forceinline__ void operator()(const f32x4 (&acc)[2][2][4][2], const Unit& u, int wr, int wc, int fr, int fq) const {
        const int row0 = u.pm * BM + wr * 64 + fr; const int col0 = u.pn * BM + wc * 32 + 8 * fq;
#pragma unroll
        for (int ai = 0; ai < 2; ++ai)
#pragma unroll
            for (int m = 0; m < 4; ++m) { const int row = row0 + ai * HALF + m * 16; float sq = 0.f; float r3 = 0.f;
                if (MODE == 3) r3 = rsqrtf(ssin[row] * (1.0f / 1024.0f) + 1e-6f);
#pragma unroll
                for (int bj = 0; bj < 2; ++bj) { const size_t off = (size_t)row * 1024 + col0 + bj * HALF; float b[8], v[8];
                    if (MODE == 0) { const float* xr = (row < 32768) ? (xp + off) : (xs + (off - (size_t)32768 * 1024)); const f32x4 b0 = *(const f32x4*)xr, b1 = *(const f32x4*)(xr + 4);
                        b[0] = b0[0]; b[1] = b0[1]; b[2] = b0[2]; b[3] = b0[3]; b[4] = b1[0]; b[5] = b1[1]; b[6] = b1[2]; b[7] = b1[3]; }
                    else { const u32x4 h4 = *(const u32x4*)(hb + off);
                        b[0] = __uint_as_float(h4.x << 16); b[1] = __uint_as_float(h4.x & 0xffff0000u); b[2] = __uint_as_float(h4.y << 16); b[3] = __uint_as_float(h4.y & 0xffff0000u);
                        b[4] = __uint_as_float(h4.z << 16); b[5] = __uint_as_float(h4.z & 0xffff0000u); b[6] = __uint_as_float(h4.w << 16); b[7] = __uint_as_float(h4.w & 0xffff0000u); }
                    if (MODE == 3) { const u32x4 p4 = *(const u32x4*)(proj + off); float pr[8];
                        pr[0] = __uint_as_float(p4.x << 16); pr[1] = __uint_as_float(p4.x & 0xffff0000u); pr[2] = __uint_as_float(p4.y << 16); pr[3] = __uint_as_float(p4.y & 0xffff0000u);
                        pr[4] = __uint_as_float(p4.z << 16); pr[5] = __uint_as_float(p4.z & 0xffff0000u); pr[6] = __uint_as_float(p4.w << 16); pr[7] = __uint_as_float(p4.w & 0xffff0000u);
#pragma unroll
                        for (int j = 0; j < 8; ++j) v[j] = b[j] + fsigmoid(acc[ai][bj][m][j >> 2][j & 3] * r3) * pr[j]; }
                    else {
#pragma unroll
                        for (int j = 0; j < 8; ++j) v[j] = b[j] + acc[ai][bj][m][j >> 2][j & 3] * ((MODE == 1) ? 1.0f : 0.5f); }
#pragma unroll
                    for (int j = 0; j < 8; ++j) sq += v[j] * v[j];
                    u32x4 w; w.x = cvt_pk_bf16(v[0], v[1]); w.y = cvt_pk_bf16(v[2], v[3]); w.z = cvt_pk_bf16(v[4], v[5]); w.w = cvt_pk_bf16(v[6], v[7]);
                    *(u32x4*)(((MODE == 3) ? hout : hb) + off) = w; }
                sq = row_sum4(sq);
                if (fq == 0) atomicAdd(ssout + row, sq); }
    }
};
struct EpiWin {
    static constexpr bool PERM = false, AFTER_DRAIN = false;
    bf16_t* umla; bf16_t* uhg; bf16_t* kr; const float* ss1; float* ssq; float* sskv; const float* ropec; const float* ropes;
    __device__ __forceinline__ void operator()(const f32x4 (&acc)[2][2][4][2], const Unit& u, int wr, int wc, int fr, int fq) const {
        const int row0 = u.pm * BM + wr * 64 + fr; const int pn = u.pn;
        bf16_t* dst; int ld, colt;
        if (pn < 3) { dst = umla; ld = 768; colt = pn * BM; } else { dst = uhg; ld = 2560; colt = (pn - 3) * BM; }
        const int col0 = colt + wc * 32 + 4 * fq;
#pragma unroll
        for (int ai = 0; ai < 2; ++ai)
#pragma unroll
            for (int m = 0; m < 4; ++m) { const int row = row0 + ai * HALF + m * 16; const float r = rsqrtf(ss1[row] * (1.0f / 1024.0f) + 1e-6f);
                float sq0 = 0.f, sq1 = 0.f; f32x4 v[2][2];
#pragma unroll
                for (int bj = 0; bj < 2; ++bj)
#pragma unroll
                    for (int n = 0; n < 2; ++n) { v[bj][n] = acc[ai][bj][m][n] * r; const f32x4 x = v[bj][n]; const float s = (x[0] * x[0] + x[1] * x[1]) + (x[2] * x[2] + x[3] * x[3]); if (bj == 0) sq0 += s; else sq1 += s;
                        u32x2 w; w.x = cvt_pk_bf16(x[0], x[1]); w.y = cvt_pk_bf16(x[2], x[3]); *(u32x2*)(dst + (size_t)row * ld + col0 + bj * HALF + n * 16) = w; }
                if (pn < 3) { float s = (pn == 1) ? sq0 : (sq0 + sq1); s = row_sum4(s); if (fq == 0) atomicAdd((pn == 2 ? sskv : ssq) + row, s); }
                if (pn == 1 && wc == 0) {
                    const int pos = row_pos(row); const f32x4 cs = *(const f32x4*)(ropec + pos * 16 + 4 * fq), sn = *(const f32x4*)(ropes + pos * 16 + 4 * fq);
                    const f32x4 x1 = v[1][0], x2 = v[1][1]; const f32x4 o1 = x1 * cs - x2 * sn, o2 = x1 * sn + x2 * cs;
                    u32x2 w1, w2; w1.x = cvt_pk_bf16(o1[0], o1[1]); w1.y = cvt_pk_bf16(o1[2], o1[3]); w2.x = cvt_pk_bf16(o2[0], o2[1]); w2.y = cvt_pk_bf16(o2[2], o2[3]);
                    *(u32x2*)(kr + (size_t)row * 32 + 4 * fq) = w1; *(u32x2*)(kr + (size_t)row * 32 + 16 + 4 * fq) = w2; } }
    }
};
struct EpiBf {
    static constexpr bool PERM = true, AFTER_DRAIN = false;
    bf16_t* O0; bf16_t* O1; int ld; int split; const float* ss; float inv_n; float mul;
    __device__ __forceinline__ void operator()(const f32x4 (&acc)[2][2][4][2], const Unit& u, int wr, int wc, int fr, int fq) const {
        const int row0 = u.pm * BM + wr * 64 + fr; bf16_t* base = O0; int colt = u.pn * BM; if (u.pn >= split) { base = O1; colt = (u.pn - split) * BM; }
        const int col0 = colt + wc * 32 + 8 * fq;
#pragma unroll
        for (int ai = 0; ai < 2; ++ai)
#pragma unroll
            for (int m = 0; m < 4; ++m) { const int row = row0 + ai * HALF + m * 16; const float r = (ss ? rsqrtf(ss[row] * inv_n + 1e-6f) : 1.0f) * mul;
#pragma unroll
                for (int bj = 0; bj < 2; ++bj) { const f32x4 v0 = acc[ai][bj][m][0] * r, v1 = acc[ai][bj][m][1] * r;
                    u32x4 w; w.x = cvt_pk_bf16(v0[0], v0[1]); w.y = cvt_pk_bf16(v0[2], v0[3]); w.z = cvt_pk_bf16(v1[0], v1[1]); w.w = cvt_pk_bf16(v1[2], v1[3]);
                    *(u32x4*)(base + (size_t)row * ld + col0 + bj * HALF) = w; } }
    }
};
template <class Epi, class Sched, bool ALIGN_EPI = false, bool SP2 = false>
__device__ __forceinline__ void gemm_phase(PG8_LAS unsigned char* lds, const Gemm g, const Sched& S, const Epi& E) {
    int tid_ = threadIdx.x; asm volatile("" : "+v"(tid_)); const int tid = tid_, wid = __builtin_amdgcn_readfirstlane(tid >> 6), lane = tid & 63, wr = wid >> 2, wc = wid & 3, fr = lane & 15, fq = lane >> 4;
    const int K = g.K, nt = K / BK;
    unsigned voffA[2], voffB[2];
#pragma unroll
    for (int i = 0; i < 2; ++i) { int R, C; stage_rc(tid * 16 + i * 8192, R, C); const int Rb = Epi::PERM ? ((R & ~31) + perm32(R & 31)) : R;
        voffA[i] = (unsigned)(R * g.lda + C) * 2u; voffB[i] = (unsigned)(Rb * g.ldb + C) * 2u; }
    const size_t kstep = (size_t)(BK * 2);
    const size_t hstepA = (size_t)HALF * g.lda * 2, hstepB = (size_t)HALF * g.ldb * 2;
    const size_t tstepA = 2 * hstepA, tstepB = 2 * hstepB;
    const unsigned ldsw = (unsigned)wid * 1024u;
    const int aoff = lds_byte(wr * 64 + fr, fq * 8), boff = lds_byte(wc * 32 + fr, fq * 8);
#define PG8_SA(b, h) (((b) * 2 + (h)) * HTB)
#define PG8_SB(b, h) ((4 + (b) * 2 + (h)) * HTB)
#define PG8_STAGE(bufoff, gbase, voff) do { _Pragma("unroll") for (int _i = 0; _i < 2; ++_i) \
        __builtin_amdgcn_global_load_lds((const unsigned*)((const char*)(gbase) + (voff)[_i]), (PG8_LAS unsigned*)(lds + (bufoff) + ldsw + _i * 8192), 16, 0, 0); } while (0)
#define PG8_LDA(dst, b, h) do { _Pragma("unroll") for (int m = 0; m < 4; ++m) _Pragma("unroll") for (int k = 0; k < 2; ++k) dst[m][k] = *(const PG8_LAS bf16x8*)(lds + PG8_SA(b, h) + aoff + m * 2048 + k * 1024); } while (0)
#define PG8_LDB(dst, b, h) do { _Pragma("unroll") for (int n = 0; n < 2; ++n) _Pragma("unroll") for (int k = 0; k < 2; ++k) dst[n][k] = *(const PG8_LAS bf16x8*)(lds + PG8_SB(b, h) + boff + n * 2048 + k * 1024); } while (0)
#define PG8_MMA(ai, bj, At, Bt) do { __builtin_amdgcn_s_setprio(1); _Pragma("unroll") for (int m = 0; m < 4; ++m) _Pragma("unroll") for (int n = 0; n < 2; ++n) _Pragma("unroll") for (int k = 0; k < 2; ++k) \
        acc[ai][bj][m][n] = __builtin_amdgcn_mfma_f32_16x16x32_bf16(Bt[n][k], At[m][k], acc[ai][bj][m][n], 0, 0, 0); __builtin_amdgcn_s_setprio(0); } while (0)
#define PG8_WAIT_V(n) asm volatile("s_waitcnt vmcnt(" #n ")" ::: "memory")
#define PG8_WAIT_L(n) asm volatile("s_waitcnt lgkmcnt(" #n ")" ::: "memory")
#define PG8_BAR __builtin_amdgcn_s_barrier()
#define PG8_SCHED __builtin_amdgcn_sched_barrier(0)
    Unit cur, nxt; int ui = 0;
    if (!S.next(0, cur)) return;
    f32x4 acc[2][2][4][2];
#pragma unroll
    for (int a = 0; a < 2; ++a)
#pragma unroll
        for (int b = 0; b < 2; ++b)
#pragma unroll
            for (int m = 0; m < 4; ++m)
#pragma unroll
                for (int n = 0; n < 2; ++n) acc[a][b][m][n] = (f32x4){0.f, 0.f, 0.f, 0.f};
    bf16x8 At[4][2], B0[2][2], B1[2][2];
    const char* cA = (const char*)g.A + (size_t)cur.pm * tstepA; const char* cB = (const char*)g.Bt + (size_t)cur.pn * tstepB;
    S.a_ready(cur);
    if constexpr (SP2) {
        PG8_STAGE(PG8_SB(0, 0), cB, voffB); PG8_STAGE(PG8_SB(0, 1), cB + hstepB, voffB); PG8_STAGE(PG8_SA(0, 0), cA, voffA); PG8_STAGE(PG8_SA(0, 1), cA + hstepA, voffA);
        if (wr == 1) PG8_BAR;
        PG8_WAIT_V(2); PG8_BAR;
        PG8_STAGE(PG8_SB(1, 0), cB + kstep, voffB); PG8_STAGE(PG8_SA(1, 0), cA + kstep, voffA); PG8_STAGE(PG8_SB(1, 1), cB + hstepB + kstep, voffB);
        PG8_WAIT_V(6); PG8_BAR;
    } else {
        PG8_STAGE(PG8_SB(0, 0), cB, voffB); PG8_STAGE(PG8_SA(0, 0), cA, voffA); PG8_STAGE(PG8_SB(0, 1), cB + hstepB, voffB); PG8_STAGE(PG8_SA(0, 1), cA + hstepA, voffA);
        if (wr == 1) PG8_BAR;
        PG8_WAIT_V(4); PG8_BAR;
        PG8_STAGE(PG8_SB(1, 0), cB + kstep, voffB); PG8_STAGE(PG8_SA(1, 0), cA + kstep, voffA); PG8_STAGE(PG8_SB(1, 1), cB + hstepB + kstep, voffB);
        PG8_WAIT_V(6); PG8_BAR;
    }
    for (;;) {
        const bool has_next = S.next(ui + 1, nxt);
        const char* nA = has_next ? (const char*)g.A + (size_t)nxt.pm * tstepA : cA; const char* nB = has_next ? (const char*)g.Bt + (size_t)nxt.pn * tstepB : cB;
        for (int t = 0; t < nt; t += 2) {
            const bool last = (t == nt - 2);
            const char* a1 = cA + (size_t)(t + 1) * kstep;
            const char* a2 = last ? nA : cA + (size_t)(t + 2) * kstep; const char* b2 = last ? nB : cB + (size_t)(t + 2) * kstep;
            const char* a3 = a2 + kstep; const char* b3 = b2 + kstep;
            if (last && has_next) S.a_ready(nxt);
            if constexpr (SP2) {
            PG8_LDB(B0, 0, 0); PG8_LDB(B1, 0, 1); PG8_SCHED; PG8_LDA(At, 0, 0); PG8_STAGE(PG8_SA(1, 1), a1 + hstepA, voffA);
            PG8_WAIT_V(8); PG8_WAIT_L(0); PG8_BAR; PG8_MMA(0, 0, At, B0); PG8_MMA(0, 1, At, B1); PG8_BAR; PG8_SCHED;
            PG8_LDA(At, 0, 1); PG8_STAGE(PG8_SB(0, 0), b2, voffB); PG8_STAGE(PG8_SB(0, 1), b2 + hstepB, voffB); PG8_STAGE(PG8_SA(0, 0), a2, voffA);
            PG8_WAIT_V(8); PG8_WAIT_L(0); PG8_BAR; PG8_MMA(1, 0, At, B0); PG8_MMA(1, 1, At, B1); PG8_BAR; PG8_SCHED;
            PG8_LDB(B0, 1, 0); PG8_LDB(B1, 1, 1); PG8_SCHED; PG8_LDA(At, 1, 0); PG8_STAGE(PG8_SA(0, 1), a2 + hstepA, voffA);
            PG8_WAIT_V(8); PG8_WAIT_L(0); PG8_BAR; PG8_MMA(0, 0, At, B0); PG8_MMA(0, 1, At, B1); PG8_BAR; PG8_SCHED;
            PG8_LDA(At, 1, 1); PG8_STAGE(PG8_SB(1, 0), b3, voffB); PG8_STAGE(PG8_SB(1, 1), b3 + hstepB, voffB); PG8_STAGE(PG8_SA(1, 0), a3, voffA);
            PG8_WAIT_V(8); PG8_WAIT_L(0); PG8_BAR; PG8_MMA(1, 0, At, B0); PG8_MMA(1, 1, At, B1); PG8_BAR; PG8_SCHED;
            } else {
            PG8_LDB(B0, 0, 0); PG8_SCHED; PG8_LDA(At, 0, 0); PG8_STAGE(PG8_SA(1, 1), a1 + hstepA, voffA);
            PG8_WAIT_L(8); PG8_BAR; PG8_WAIT_L(0); PG8_MMA(0, 0, At, B0); PG8_BAR; PG8_SCHED;
            PG8_LDB(B1, 0, 1); PG8_STAGE(PG8_SB(0, 0), b2, voffB);
            PG8_BAR; PG8_WAIT_L(0); PG8_MMA(0, 1, At, B1); PG8_BAR;
            PG8_LDA(At, 0, 1); PG8_STAGE(PG8_SA(0, 0), a2, voffA);
            PG8_BAR; PG8_WAIT_L(0); PG8_MMA(1, 0, At, B0); PG8_BAR; PG8_SCHED;
            PG8_STAGE(PG8_SB(0, 1), b2 + hstepB, voffB);
            PG8_WAIT_V(6); PG8_BAR; PG8_MMA(1, 1, At, B1); PG8_BAR;
            PG8_LDB(B0, 1, 0); PG8_SCHED; PG8_LDA(At, 1, 0); PG8_STAGE(PG8_SA(0, 1), a2 + hstepA, voffA);
            PG8_WAIT_L(8); PG8_BAR; PG8_WAIT_L(0); PG8_MMA(0, 0, At, B0); PG8_BAR; PG8_SCHED;
            PG8_LDB(B1, 1, 1); PG8_STAGE(PG8_SB(1, 0), b3, voffB);
            PG8_BAR; PG8_WAIT_L(0); PG8_MMA(0, 1, At, B1); PG8_BAR;
            PG8_LDA(At, 1, 1); PG8_STAGE(PG8_SA(1, 0), a3, voffA);
            PG8_BAR; PG8_WAIT_L(0); PG8_MMA(1, 0, At, B0); PG8_BAR; PG8_SCHED;
            PG8_STAGE(PG8_SB(1, 1), b3 + hstepB, voffB);
            PG8_WAIT_V(6); PG8_BAR; PG8_MMA(1, 1, At, B1); PG8_BAR;
            }
        }
        if constexpr (ALIGN_EPI) { if (wr == 0) PG8_BAR; }
        if constexpr (!Epi::AFTER_DRAIN) { E(acc, cur, wr, wc, fr, fq); S.done(cur); }
        if (!has_next) break;
#pragma unroll
        for (int a = 0; a < 2; ++a)
#pragma unroll
            for (int b = 0; b < 2; ++b)
#pragma unroll
                for (int m = 0; m < 4; ++m)
#pragma unroll
                    for (int n = 0; n < 2; ++n) acc[a][b][m][n] = (f32x4){0.f, 0.f, 0.f, 0.f};
        cur = nxt; cA = nA; cB = nB; ++ui;
        if constexpr (ALIGN_EPI) { if (wr == 1) PG8_BAR; }
    }
    PG8_WAIT_V(0);
    if constexpr (!ALIGN_EPI) { if (wr == 0) PG8_BAR; }
    PG8_BAR;
    if constexpr (Epi::AFTER_DRAIN) { E.fused(acc, cur, wr, wc, fr, fq, lds, wid, lane); S.done(cur); }
#undef PG8_SA
#undef PG8_SB
#undef PG8_STAGE
#undef PG8_LDA
#undef PG8_LDB
#undef PG8_MMA
#undef PG8_WAIT_V
#undef PG8_WAIT_L
#undef PG8_BAR
#undef PG8_SCHED
}
}

namespace att {
typedef unsigned short bf16_t;
using bf16x8 = __attribute__((ext_vector_type(8))) short;
using s16x4  = __attribute__((ext_vector_type(4))) short;
using f32x16 = __attribute__((ext_vector_type(16))) float;
using u32x4  = __attribute__((ext_vector_type(4))) unsigned;
constexpr int NW = 8, QBLK = 32, KVBLK = 64;
constexpr float SCALE = 0.10206207261596575f;
constexpr float THR = 8.f;
constexpr int LDQ = 768, LDKN = 512, LDKR = 32, LDV = 512, LDO = 1024;
constexpr int SHM_V = 64 * 128 * 2, SHM_K = 64 * 128 * 2;
#define KSWZ(row, colB) ((row) * 256 + ((colB) ^ (((row) & 7) << 4)))
#define SBAR() __builtin_amdgcn_sched_barrier(0)
__device__ __forceinline__ int crow(int r, int hi) { return (r & 3) + 8 * (r >> 2) + 4 * hi; }
__device__ __forceinline__ unsigned cvtpk(float lo, float hi) { unsigned r; asm volatile("v_cvt_pk_bf16_f32 %0, %1, %2" : "=v"(r) : "v"(lo), "v"(hi)); return r; }
template <bool FIRST> __device__ __forceinline__ void partialSM(f32x16& p0, f32x16& p1, float& m_ref, f32x16& negm, float& alpha) {
  constexpr float THR2 = THR * 1.4426950408889634f;
  float pmax = p0[0];
#pragma unroll
  for (int r = 1; r < 16; ++r) pmax = fmaxf(pmax, p0[r]);
#pragma unroll
  for (int r = 0; r < 16; ++r) pmax = fmaxf(pmax, p1[r]);
  { auto rr = __builtin_amdgcn_permlane32_swap(__float_as_uint(pmax), __float_as_uint(pmax), false, false);
    pmax = fmaxf(__uint_as_float(rr[0]), __uint_as_float(rr[1])); }
  alpha = 1.f;
  if (FIRST || !__builtin_expect(__all(pmax <= THR2), 1)) {
    const float dl = FIRST ? pmax : fmaxf(pmax, 0.f);
    m_ref += dl; alpha = FIRST ? 1.f : __builtin_amdgcn_exp2f(-dl);
#pragma unroll
    for (int r = 0; r < 16; ++r) { p0[r] -= dl; p1[r] -= dl; }
#pragma unroll
    for (int r = 0; r < 16; ++r) negm[r] = -m_ref;
    asm volatile("" : "+v"(negm));
  }
#pragma unroll
  for (int r = 0; r < 16; ++r) p0[r] = __builtin_amdgcn_exp2f(p0[r]);
}
__device__ __forceinline__ void finishSM(f32x16& p0, f32x16& p1, bf16x8& pa0, bf16x8& pa1, bf16x8& pa2, bf16x8& pa3) {
#pragma unroll
  for (int r = 0; r < 16; ++r) p1[r] = __builtin_amdgcn_exp2f(p1[r]);
#define PK4(P, BASE, OUT) do { unsigned a0 = cvtpk(P[BASE + 0], P[BASE + 1]), a1 = cvtpk(P[BASE + 2], P[BASE + 3]);   \
    unsigned b0 = cvtpk(P[BASE + 4], P[BASE + 5]), b1 = cvtpk(P[BASE + 6], P[BASE + 7]);                              \
    auto r0 = __builtin_amdgcn_permlane32_swap(a0, b0, false, false); auto r1 = __builtin_amdgcn_permlane32_swap(a1, b1, false, false); \
    u32x4 w = {r0[0], r1[0], r0[1], r1[1]}; OUT = *reinterpret_cast<bf16x8*>(&w); } while (0)
  PK4(p0, 0, pa0); PK4(p0, 8, pa1); PK4(p1, 0, pa2); PK4(p1, 8, pa3);
#undef PK4
}
__device__ __forceinline__ void qkt(f32x16& p0, f32x16& p1, const bf16_t* Ks, const bf16x8* qr, const f32x16& negm, int r32, int hi) {
#pragma unroll
  for (int d0 = 0; d0 < 6; ++d0) { int cb = (d0 * 16 + hi * 8) * 2;
    bf16x8 b0 = *reinterpret_cast<const bf16x8*>((const char*)Ks + KSWZ(r32, cb));
    bf16x8 b1 = *reinterpret_cast<const bf16x8*>((const char*)Ks + KSWZ(32 + r32, cb));
    if (d0 == 0) { p0 = __builtin_amdgcn_mfma_f32_32x32x16_bf16(b0, qr[0], negm, 0, 0, 0); p1 = __builtin_amdgcn_mfma_f32_32x32x16_bf16(b1, qr[0], negm, 0, 0, 0); }
    else { p0 = __builtin_amdgcn_mfma_f32_32x32x16_bf16(b0, qr[d0], p0, 0, 0, 0); p1 = __builtin_amdgcn_mfma_f32_32x32x16_bf16(b1, qr[d0], p1, 0, 0, 0); } }
}
__device__ __forceinline__ int v_st(int k, int c) { const int kk = (k & ~0xC) | ((k & 4) << 1) | ((k & 8) >> 1); return ((kk >> 3) * 4 + (c >> 5)) * 512 + ((kk & 7) * 32 + (c & 31)) * 2; }
__device__ __forceinline__ int v_rd_base(int lane) { return ((lane & 3) << 3) | (((lane >> 2) & 3) << 6) | (((lane >> 4) & 1) << 5) | (((lane >> 5) & 1) << 8); }
constexpr int v_rd_off(int d0, int ks, int half) { return d0 * 512 + ks * 4096 + half * 2048; }
template <int OFF> __device__ __forceinline__ s16x4 tr_read(int vb) {
  s16x4 r; asm volatile("ds_read_b64_tr_b16 %0, %1 offset:%2" : "=&v"(r) : "v"(vb), "i"(OFF) : "memory"); return r;
}
template <int D0> __device__ __forceinline__ void pv_one(f32x16& od, int vb, bf16x8 pa0, bf16x8 pa1, bf16x8 pa2, bf16x8 pa3) {
  const s16x4 l0 = tr_read<v_rd_off(D0, 0, 0)>(vb), h0 = tr_read<v_rd_off(D0, 0, 1)>(vb), l1 = tr_read<v_rd_off(D0, 1, 0)>(vb), h1 = tr_read<v_rd_off(D0, 1, 1)>(vb);
  const s16x4 l2 = tr_read<v_rd_off(D0, 2, 0)>(vb), h2 = tr_read<v_rd_off(D0, 2, 1)>(vb), l3 = tr_read<v_rd_off(D0, 3, 0)>(vb), h3 = tr_read<v_rd_off(D0, 3, 1)>(vb);
  asm volatile("s_waitcnt lgkmcnt(0)" ::: "memory"); SBAR();
#define PK(L, H) (bf16x8){L[0], L[1], L[2], L[3], H[0], H[1], H[2], H[3]}
  od = __builtin_amdgcn_mfma_f32_32x32x16_bf16(pa0, PK(l0, h0), od, 0, 0, 0);
  od = __builtin_amdgcn_mfma_f32_32x32x16_bf16(pa1, PK(l1, h1), od, 0, 0, 0);
  od = __builtin_amdgcn_mfma_f32_32x32x16_bf16(pa2, PK(l2, h2), od, 0, 0, 0);
  od = __builtin_amdgcn_mfma_f32_32x32x16_bf16(pa3, PK(l3, h3), od, 0, 0, 0);
#undef PK
}
__device__ __forceinline__ void pv_d0(f32x16* o, f32x16& osum, int vb, bf16x8 pa0, bf16x8 pa1, bf16x8 pa2, bf16x8 pa3) {
  pv_one<0>(o[0], vb, pa0, pa1, pa2, pa3); pv_one<1>(o[1], vb, pa0, pa1, pa2, pa3);
  const short one = (short)0x3F80; const bf16x8 ones = {one, one, one, one, one, one, one, one};
  osum = __builtin_amdgcn_mfma_f32_32x32x16_bf16(pa0, ones, osum, 0, 0, 0); osum = __builtin_amdgcn_mfma_f32_32x32x16_bf16(pa1, ones, osum, 0, 0, 0);
  osum = __builtin_amdgcn_mfma_f32_32x32x16_bf16(pa2, ones, osum, 0, 0, 0); osum = __builtin_amdgcn_mfma_f32_32x32x16_bf16(pa3, ones, osum, 0, 0, 0);
}
__device__ __forceinline__ void attn_unit(const bf16_t* __restrict__ Qb, const bf16_t* __restrict__ KNh, const bf16_t* __restrict__ KRb, const bf16_t* __restrict__ Vh,
                                          bf16_t* __restrict__ Ob, int seq, int qrow0, const float* __restrict__ ropec, const float* __restrict__ ropes, char* lds) {
  int tid_ = threadIdx.x; asm volatile("" : "+v"(tid_)); const int tid = tid_, wid = __builtin_amdgcn_readfirstlane(tid >> 6), lane = tid & 63, r32 = lane & 31, hi = lane >> 5;
  bf16_t* V_lds = (bf16_t*)lds; bf16_t* K_lds = (bf16_t*)(lds + 3 * SHM_V);
  float* ws = (float*)(lds + 3 * SHM_V + 3 * SHM_K) + wid * 64; float* al_l = ws + 32;
  float m_ref = 0.f; f32x16 o[2] = {}; f32x16 osum = {}; f32x16 negm = {}; asm volatile("" : "+v"(negm)); bf16x8 qr[6];
  const bf16_t* Qw = Qb + (long)(wid * QBLK + r32) * LDQ + hi * 8;
#pragma unroll
  for (int d0 = 0; d0 < 6; ++d0) qr[d0] = *reinterpret_cast<const bf16x8*>(Qw + d0 * 16);
  {
    const int pos = row_pos(qrow0 + wid * QBLK + r32); const float* cp = ropec + pos * 16 + 8 * hi; const float* sp = ropes + pos * 16 + 8 * hi;
    unsigned w1[4], w2[4];
#pragma unroll
    for (int e = 0; e < 8; e += 2) { float o1[2], o2[2];
#pragma unroll
      for (int f = 0; f < 2; ++f) { const float x1 = __uint_as_float(((unsigned)(unsigned short)qr[4][e + f]) << 16), x2 = __uint_as_float(((unsigned)(unsigned short)qr[5][e + f]) << 16); const float c = cp[e + f], s = sp[e + f];
        o1[f] = x1 * c - x2 * s; o2[f] = x1 * s + x2 * c; }
      w1[e >> 1] = cvtpk(o1[0], o1[1]); w2[e >> 1] = cvtpk(o2[0], o2[1]); }
    u32x4 v1 = {w1[0], w1[1], w1[2], w1[3]}, v2 = {w2[0], w2[1], w2[2], w2[3]}; qr[4] = *reinterpret_cast<bf16x8*>(&v1); qr[5] = *reinterpret_cast<bf16x8*>(&v2); }
  const int srow = tid >> 3, sch = tid & 7, srow2 = tid >> 2, sch2 = tid & 3;
  const bf16_t* kp = KNh + (long)srow * LDKN + 8 * sch; const bf16_t* vp = Vh + (long)srow * LDV + 8 * sch; const bf16_t* rp = KRb + (long)(srow2 & 63) * LDKR + 8 * sch2;
  const int kst = KSWZ(srow, 16 * sch), vst = v_st(srow, 8 * sch), rst = KSWZ(srow2 & 63, 128 + 16 * sch2);
  const bool has_r = wid < 4;
  constexpr int BUF = SHM_V;
  const int vb0 = (int)(uintptr_t)V_lds + v_rd_base(lane);
  struct { bf16x8 v, k, r; } sr_[2];
#define SLOAD(i, k0) do { sr_[i].v = *reinterpret_cast<const bf16x8*>(vp + (long)(k0) * LDV); sr_[i].k = *reinterpret_cast<const bf16x8*>(kp + (long)(k0) * LDKN); \
    if (has_r) sr_[i].r = *reinterpret_cast<const bf16x8*>(rp + (long)(k0) * LDKR); } while (0)
#define SWRITE(off, i) do { *(bf16x8*)((char*)V_lds + (off) + vst) = sr_[i].v; *(bf16x8*)((char*)K_lds + (off) + kst) = sr_[i].k; \
    if (has_r) *(bf16x8*)((char*)K_lds + (off) + rst) = sr_[i].r; } while (0)
#define SWAIT() do { if (has_r) asm volatile("s_waitcnt vmcnt(3)" ::: "memory"); else asm volatile("s_waitcnt vmcnt(2)" ::: "memory"); } while (0)
#define RESC(a) do { if (__any((a) < 1.f)) { if (hi == 0) al_l[r32] = (a); asm volatile("s_waitcnt lgkmcnt(0)" ::: "memory"); \
    _Pragma("unroll") for (int r = 0; r < 16; ++r) { const float f_ = al_l[crow(r, hi)]; o[0][r] *= f_; o[1][r] *= f_; osum[r] *= f_; } } } while (0)
#define ROT() do { const int t_ = o_prev; o_prev = o_cur; o_cur = o_next; o_next = t_; } while (0)
  f32x16 pA0, pA1, pB0, pB1; float alA, alB; bf16x8 pa0, pa1, pa2, pa3; const int NT = seq / KVBLK;
  constexpr int SE = 0, SO = 1;
  int o_prev = 2 * BUF, o_cur = 0, o_next = BUF;
  SLOAD(SE, 0); asm volatile("s_waitcnt vmcnt(0)" ::: "memory"); SWRITE(0, SE); __syncthreads();
  qkt(pA0, pA1, K_lds, qr, negm, r32, hi); partialSM<true>(pA0, pA1, m_ref, negm, alA);
  SLOAD(SO, KVBLK); if (2 < NT) SLOAD(SE, 2 * KVBLK);
  SWAIT(); SWRITE(BUF, SO); __syncthreads();
  ROT();
  for (int j = 1; j + 1 < NT; j += 2) {
    SBAR(); qkt(pB0, pB1, (bf16_t*)((char*)K_lds + o_cur), qr, negm, r32, hi);
    finishSM(pA0, pA1, pa0, pa1, pa2, pa3); SBAR();
    SLOAD(SO, (j + 2) * KVBLK); SBAR();
    pv_d0(o, osum, vb0 + o_prev, pa0, pa1, pa2, pa3); partialSM<false>(pB0, pB1, m_ref, negm, alB);
    SWAIT(); SWRITE(o_next, SE);
    RESC(alB); __syncthreads(); ROT();
    SBAR(); qkt(pA0, pA1, (bf16_t*)((char*)K_lds + o_cur), qr, negm, r32, hi);
    finishSM(pB0, pB1, pa0, pa1, pa2, pa3); SBAR();
    if (j + 3 < NT) SLOAD(SE, (j + 3) * KVBLK); SBAR();
    pv_d0(o, osum, vb0 + o_prev, pa0, pa1, pa2, pa3); partialSM<false>(pA0, pA1, m_ref, negm, alA);
    SWAIT(); SWRITE(o_next, SO);
    RESC(alA); __syncthreads(); ROT();
  }
  SBAR(); qkt(pB0, pB1, (bf16_t*)((char*)K_lds + o_cur), qr, negm, r32, hi);
  finishSM(pA0, pA1, pa0, pa1, pa2, pa3); SBAR();
  pv_d0(o, osum, vb0 + o_prev, pa0, pa1, pa2, pa3); partialSM<false>(pB0, pB1, m_ref, negm, alB);
  RESC(alB);
  finishSM(pB0, pB1, pa0, pa1, pa2, pa3); SBAR();
  pv_d0(o, osum, vb0 + o_cur, pa0, pa1, pa2, pa3);
  float rli[16];
#pragma unroll
  for (int r = 0; r < 16; ++r) rli[r] = __builtin_amdgcn_rcpf(osum[r]);
  bf16_t* Ow = Ob + (long)(wid * QBLK) * LDO;
#pragma unroll
  for (int r = 0; r < 16; ++r) { int orow = crow(r, hi);
#pragma unroll
    for (int d0 = 0; d0 < 2; ++d0) { const unsigned w = cvtpk(o[d0][r] * rli[r], 0.f); Ow[(long)orow * LDO + d0 * 32 + r32] = (bf16_t)(w & 0xffffu); } }
  __syncthreads();
#undef SLOAD
#undef SWRITE
#undef SWAIT
#undef RESC
#undef ROT
}
#undef KSWZ
#undef SBAR
}
namespace hg {
typedef unsigned short bf16_t;
using bf16x8 = __attribute__((ext_vector_type(8))) short;
using f32x16 = __attribute__((ext_vector_type(16))) float;
using f32x4  = __attribute__((ext_vector_type(4))) float;
using u32x4  = __attribute__((ext_vector_type(4))) unsigned;
#define SWZ256(row, colB) ((row) * 256 + ((colB) ^ (((row) & 7) << 4)))
#define SWZ128(row, colB) ((row) * 128 + ((colB) ^ (((((row) >> 4) ^ (row)) & 7) << 4)))
constexpr int GS = 132;
constexpr int L_ST = 0, L_QH = 32768, L_KH = 49152, L_KT = 65536, L_VT = 81920, L_GB = 98304, L_SEG = 98304 + 64 * GS * 4, L_DD = L_SEG + 2048, L_LB = L_DD + 512;
__device__ __forceinline__ int crow(int r, int hi) { return (r & 3) + 8 * (r >> 2) + 4 * hi; }
__device__ __forceinline__ unsigned cvtpk(float lo, float hi) { unsigned r; asm volatile("v_cvt_pk_bf16_f32 %0, %1, %2" : "=v"(r) : "v"(lo), "v"(hi)); return r; }
__device__ __forceinline__ float bf2f(unsigned short h) { return __uint_as_float(((unsigned)h) << 16); }
template <int MODE> __device__ __forceinline__ void chain(const bf16_t* __restrict__ U, float* __restrict__ OP, const float* __restrict__ hg_lb, int rowbase, int S, int h, int dir, int tau0, int nchunk,
                                                   const float* __restrict__ slot_in, float* __restrict__ slot_out, float* __restrict__ dseg_out, char* lds) {
  int tid_ = threadIdx.x; asm volatile("" : "+v"(tid_)); const int tid = tid_, wid = __builtin_amdgcn_readfirstlane(tid >> 6), lane = tid & 63, r32 = lane & 31, hi = lane >> 5;
  float* GB = (float*)(lds + L_GB); float* SEG = (float*)(lds + L_SEG); float* DD = (float*)(lds + L_DD); float* LB = (float*)(lds + L_LB);
  char* ST = lds + L_ST; char* QH = lds + L_QH; char* KH = lds + L_KH; char* KT = lds + L_KT; char* VT = lds + L_VT; char* AL = lds + L_GB;
  if (tid < 128) { const float a0 = hg_lb[dir * 1024 + h * 128 + tid], a1 = hg_lb[dir * 1024 + 512 + h * 128 + tid]; LB[tid] = 1.0f / (1.0f + __expf(a1 - a0)); }
  f32x16 sacc[2]; sacc[0] = f32x16{}; sacc[1] = f32x16{};
  if (MODE == 3) {
    if (slot_in) {
#pragma unroll
      for (int i = 0; i < 2; ++i)
#pragma unroll
        for (int r = 0; r < 16; ++r) sacc[i][r] = slot_in[(32 * (wid & 3) + crow(r, hi)) * 128 + 32 * (2 * (wid >> 2) + i) + r32];
    }
#pragma unroll
    for (int i = 0; i < 2; ++i)
#pragma unroll
      for (int r = 0; r < 16; ++r) *(bf16_t*)(ST + SWZ256(32 * (wid & 3) + crow(r, hi), 2 * (32 * (2 * (wid >> 2) + i) + r32))) = (bf16_t)(cvtpk(sacc[i][r], 0.f) & 0xffffu);
  }
  float dseg = 1.0f;
  const int tau = tid >> 3, c0 = (tid & 7) * 16, segt = tau >> 4;
  const bf16_t* Ub = U + (size_t)rowbase * 2560 + h * 128 + c0;
  const size_t offq = 0, offv = 512, offf = (size_t)(2 + dir) * 512;
  float* OPd = OP + (size_t)dir * T_ALL * 512;
  bf16x8 nq0, nq1, nv0, nv1, nf0, nf1;
  { const int t1 = tau0 + tau; const int tok = dir ? (S - 1 - t1) : t1; const bf16_t* p = Ub + (size_t)tok * 2560;
    nq0 = *(const bf16x8*)(p + offq); nq1 = *(const bf16x8*)(p + offq + 8); nv0 = *(const bf16x8*)(p + offv); nv1 = *(const bf16x8*)(p + offv + 8); nf0 = *(const bf16x8*)(p + offf); nf1 = *(const bf16x8*)(p + offf + 8); }
  __syncthreads();
  for (int ci = 0; ci < nchunk; ++ci) {
    const bf16x8 qv[2] = {nq0, nq1}, vv[2] = {nv0, nv1}, fv[2] = {nf0, nf1};
    { const int cn = (ci + 1 < nchunk) ? ci + 1 : ci; const int t2 = tau0 + cn * 64 + tau; const int tok = dir ? (S - 1 - t2) : t2; const bf16_t* p = Ub + (size_t)tok * 2560;
      nq0 = *(const bf16x8*)(p + offq); nq1 = *(const bf16x8*)(p + offq + 8); nv0 = *(const bf16x8*)(p + offv); nv1 = *(const bf16x8*)(p + offv + 8); nf0 = *(const bf16x8*)(p + offf); nf1 = *(const bf16x8*)(p + offf + 8); }
    float qq[16], kk[16];
#pragma unroll
    for (int j = 0; j < 16; ++j) {
      const float z = bf2f((unsigned short)fv[j >> 3][j & 7]); const float x = bf2f((unsigned short)qv[j >> 3][j & 7]);
      const float lbv = LB[c0 + j]; const float sg = __builtin_amdgcn_rcpf(1.0f + __expf(-z)); const float f = lbv + (1.0f - lbv) * sg;
      kk[j] = 1.0f - f; qq[j] = x * __builtin_amdgcn_rcpf(1.0f + __expf(-x));
      GB[tau * GS + c0 + j] = __logf(f);
    }
    __syncthreads();
    { const int k = tid & 127, seg = tid >> 7; float run = 0.f;
#pragma unroll
      for (int j = 0; j < 16; ++j) { run += GB[(16 * seg + j) * GS + k]; GB[(16 * seg + j) * GS + k] = run; }
      SEG[seg * 128 + k] = run; }
    __syncthreads();
    { unsigned qh[8], kh[8];
#pragma unroll
      for (int j = 0; j < 16; j += 2) {
        float g2[2], gl2[2];
#pragma unroll
        for (int e = 0; e < 2; ++e) { const int col = c0 + j + e; const float s0 = SEG[col], s1 = SEG[128 + col], s2 = SEG[256 + col];
          const float off = (segt >= 1 ? s0 : 0.f) + (segt >= 2 ? s1 : 0.f) + (segt >= 3 ? s2 : 0.f);
          g2[e] = GB[tau * GS + col] + off; gl2[e] = GB[63 * GS + col] + ((s0 + s1) + s2); }
        const float ea = __expf(g2[0]), eb = __expf(g2[1]);
        qh[j >> 1] = cvtpk(qq[j] * ea, qq[j + 1] * eb);
        kh[j >> 1] = cvtpk(kk[j] * __expf(fminf(-g2[0], 80.f)), kk[j + 1] * __expf(fminf(-g2[1], 80.f)));
        const unsigned kt = cvtpk(kk[j] * __expf(gl2[0] - g2[0]), kk[j + 1] * __expf(gl2[1] - g2[1]));
        *(bf16_t*)(KT + SWZ128(c0 + j, 2 * tau)) = (bf16_t)(kt & 0xffffu); *(bf16_t*)(KT + SWZ128(c0 + j + 1, 2 * tau)) = (bf16_t)(kt >> 16);
        *(bf16_t*)(VT + SWZ128(c0 + j, 2 * tau)) = (bf16_t)vv[j >> 3][j & 7]; *(bf16_t*)(VT + SWZ128(c0 + j + 1, 2 * tau)) = (bf16_t)vv[(j + 1) >> 3][(j + 1) & 7];
        if (tau == 63) { DD[c0 + j] = __expf(gl2[0]); DD[c0 + j + 1] = __expf(gl2[1]); }
      }
      *(u32x4*)(QH + SWZ256(tau, 2 * c0)) = (u32x4){qh[0], qh[1], qh[2], qh[3]}; *(u32x4*)(QH + SWZ256(tau, 2 * c0 + 16)) = (u32x4){qh[4], qh[5], qh[6], qh[7]};
      *(u32x4*)(KH + SWZ256(tau, 2 * c0)) = (u32x4){kh[0], kh[1], kh[2], kh[3]}; *(u32x4*)(KH + SWZ256(tau, 2 * c0 + 16)) = (u32x4){kh[4], kh[5], kh[6], kh[7]};
    }
    __syncthreads();
    if (MODE == 3 && wid < 4 && wid != 1) { const int ti = wid >> 1, si = wid & 1; f32x16 a = f32x16{};
#pragma unroll
      for (int k8 = 0; k8 < 8; ++k8) { const int cb = (16 * k8 + 8 * hi) * 2;
        const bf16x8 av = *(const bf16x8*)(QH + SWZ256(32 * ti + r32, cb)); const bf16x8 bv = *(const bf16x8*)(KH + SWZ256(32 * si + r32, cb));
        a = __builtin_amdgcn_mfma_f32_32x32x16_bf16(av, bv, a, 0, 0, 0); }
#pragma unroll
      for (int r = 0; r < 16; ++r) { const int tl = 32 * ti + crow(r, hi), sl = 32 * si + r32; const float val = (sl <= tl) ? a[r] : 0.f;
        *(bf16_t*)(AL + SWZ128(tl, 2 * sl)) = (bf16_t)(cvtpk(val, 0.f) & 0xffffu); } }
    if (MODE == 3) __syncthreads();
    { const int th = wid >> 2, vb = wid & 3;
      if (MODE == 3) { f32x16 o = f32x16{};
      const int nks = th ? 4 : 2;
      for (int ks = 0; ks < nks; ++ks) { const int cb = (16 * ks + 8 * hi) * 2;
        const bf16x8 av = *(const bf16x8*)(AL + SWZ128(32 * th + r32, cb)); const bf16x8 bv = *(const bf16x8*)(VT + SWZ128(32 * vb + r32, cb));
        o = __builtin_amdgcn_mfma_f32_32x32x16_bf16(av, bv, o, 0, 0, 0); }
#pragma unroll
      for (int k8 = 0; k8 < 8; ++k8) { const int cb = (16 * k8 + 8 * hi) * 2;
        const bf16x8 av = *(const bf16x8*)(QH + SWZ256(32 * th + r32, cb)); const bf16x8 bv = *(const bf16x8*)(ST + SWZ256(32 * vb + r32, cb));
        o = __builtin_amdgcn_mfma_f32_32x32x16_bf16(av, bv, o, 0, 0, 0); }
#pragma unroll
      for (int r = 0; r < 16; ++r) { const int t2 = tau0 + ci * 64 + 32 * th + crow(r, hi); const int tok = dir ? (S - 1 - t2) : t2;
        OPd[(size_t)(rowbase + tok) * 512 + h * 128 + 32 * vb + r32] = o[r]; }
      } else { if (tid < 128) dseg *= DD[tid]; }
#pragma unroll
      for (int i = 0; i < 2; ++i) { const int kb = 2 * th + i; const float dk = DD[32 * kb + r32];
#pragma unroll
        for (int r = 0; r < 16; ++r) sacc[i][r] *= dk;
#pragma unroll
        for (int ks = 0; ks < 4; ++ks) { const int cb = (16 * ks + 8 * hi) * 2;
          const bf16x8 av = *(const bf16x8*)(VT + SWZ128(32 * vb + r32, cb)); const bf16x8 bv = *(const bf16x8*)(KT + SWZ128(32 * kb + r32, cb));
          sacc[i] = __builtin_amdgcn_mfma_f32_32x32x16_bf16(av, bv, sacc[i], 0, 0, 0); } }
    }
    __syncthreads();
    if (MODE == 3) { const int th = wid >> 2, vb = wid & 3;
#pragma unroll
      for (int i = 0; i < 2; ++i) { const int kb = 2 * th + i;
#pragma unroll
        for (int r = 0; r < 16; ++r) *(bf16_t*)(ST + SWZ256(32 * vb + crow(r, hi), 2 * (32 * kb + r32))) = (bf16_t)(cvtpk(sacc[i][r], 0.f) & 0xffffu); } }
  }
  if (MODE == 1) {
#pragma unroll
    for (int i = 0; i < 2; ++i)
#pragma unroll
      for (int r = 0; r < 16; ++r) slot_out[(32 * (wid & 3) + crow(r, hi)) * 128 + 32 * (2 * (wid >> 2) + i) + r32] = sacc[i][r];
    if (tid < 128) dseg_out[tid] = dseg;
  }
  __syncthreads();
}
#undef SWZ256
#undef SWZ128
}
typedef unsigned short bf16_t;
typedef float f32x4 __attribute__((ext_vector_type(4)));
typedef unsigned u32x4 __attribute__((ext_vector_type(4)));
typedef unsigned u32x2 __attribute__((ext_vector_type(2)));
typedef short bf16x8 __attribute__((ext_vector_type(8)));
#define LAS __attribute__((address_space(3)))
constexpr size_t MiB = 1u << 20;
constexpr size_t WS_SS = 0;
constexpr size_t WS_ROPEC = 4 * MiB, WS_ROPES = 5 * MiB;
constexpr size_t WS_W1GU = 16 * MiB, WS_W1D = 27 * MiB, WS_WIN = 33 * MiB, WS_WUQ = 40 * MiB, WS_WUKV = 41 * MiB, WS_WO = 42 * MiB, WS_W2GU = 44 * MiB, WS_W2D = 55 * MiB, WS_WPG = 61 * MiB, WS_WPP = 63 * MiB;
constexpr size_t WS_HB = 64 * MiB;
constexpr size_t WS_BIG = 256 * MiB;
constexpr size_t WS_UHG = WS_BIG, WS_UMLA = WS_BIG + 480 * MiB, WS_MIX = WS_BIG + 480 * MiB, WS_ACT = WS_BIG, WS_PROJ = WS_BIG;
constexpr size_t WS_PB = 928 * MiB;
constexpr size_t WS_SLOT = 976 * MiB;
constexpr size_t WS_DSEG = 8 * MiB;
constexpr size_t WS_END = 1024 * MiB;
constexpr size_t DO_Q = 0, DO_KN = 144 * MiB, DO_V = 240 * MiB, DO_KR = 336 * MiB;
constexpr int LDS_BYTES = 147456;
constexpr int LDS_BARST = 147392;
constexpr size_t WS_BAR = 12 * MiB;
#define XB_TMO      128
#define XB_XCNT(j)  (256  + 64 * (j))
#define XB_XSUB(j)  (1280 + 64 * (j))
#define XB_XGEN(j)  (2304 + 64 * (j))
#define XB_TOP      3328
#define XB_TOPGEN   3392
#define XCD_BAR_WORDS 3456
#define XB_SPIN_CAP (1u << 18)

__device__ __forceinline__ unsigned xb_ld(unsigned* p)              { return __hip_atomic_load(p, __ATOMIC_RELAXED, __HIP_MEMORY_SCOPE_AGENT); }
__device__ __forceinline__ unsigned xb_add(unsigned* p, unsigned v) { return __hip_atomic_fetch_add(p, v, __ATOMIC_RELAXED, __HIP_MEMORY_SCOPE_AGENT); }
__device__ __forceinline__ unsigned xb_xcc_id() { return (unsigned)__builtin_amdgcn_s_getreg((3 << 11) | 20) & 0xFu; }
#define XB_SPIN(cond, bar) do { unsigned _sp = 0; while (cond) { __builtin_amdgcn_s_sleep(1); \
    if ((++_sp & 255u) == 0u) { if (xb_ld(&(bar)[XB_TMO])) break; if (_sp > XB_SPIN_CAP) { atomicAdd(&(bar)[XB_TMO], 1u); break; } } } } while (0)

struct XcdBarrier {
    unsigned* bar; unsigned x;
    volatile LAS unsigned* st;
};

__device__ __forceinline__ XcdBarrier xcd_barrier_post(unsigned* bar, volatile LAS unsigned* st) {
    XcdBarrier b; b.bar = bar; b.x = xb_xcc_id(); b.st = st;
    if (threadIdx.x == 0) (void)xb_add(&bar[XB_XCNT(b.x)], 1u);
    return b;
}
__device__ __forceinline__ void xcd_barrier_complete(unsigned* bar, unsigned x, unsigned& nloc, unsigned& nx) {
    const unsigned G = gridDim.x * gridDim.y * gridDim.z;
    unsigned sum, cnt, mine, sp = 0u;
    for (;;) {
        sum = 0u; cnt = 0u; mine = 0u;
#pragma unroll
        for (unsigned j = 0; j < 16; ++j) { const unsigned c = xb_ld(&bar[XB_XCNT(j)]); sum += c; cnt += (c > 0u) ? 1u : 0u; mine = (j == x) ? c : mine; }
        if (sum == G) break;
        __builtin_amdgcn_s_sleep(1);
        if ((++sp & 255u) == 0u) { if (xb_ld(&bar[XB_TMO])) break; if (sp > XB_SPIN_CAP) { atomicAdd(&bar[XB_TMO], 1u); break; } }
    }
    nloc = mine > 0u ? mine : 1u; nx = cnt > 0u ? cnt : 1u;
}

__device__ __forceinline__ void xcd_barrier(const XcdBarrier& b) {
    asm volatile("s_waitcnt vmcnt(0)" ::: "memory");
    __syncthreads();
    if (threadIdx.x == 0) {
        unsigned* bar = b.bar;
        __builtin_amdgcn_s_waitcnt(0);
        unsigned nloc = b.st[0], nx = b.st[1];
        if (nloc == 0u) { xcd_barrier_complete(bar, b.x, nloc, nx); b.st[0] = nloc; b.st[1] = nx; }
        const unsigned old = xb_add(&bar[XB_XSUB(b.x)], 1u);
        const unsigned gen = old / nloc;
        if (old + 1u == (gen + 1u) * nloc) {
            __builtin_amdgcn_fence(__ATOMIC_RELEASE, "agent");
            asm volatile("s_waitcnt vmcnt(0)" ::: "memory");
            const unsigned og = xb_add(&bar[XB_TOP], 1u);
            const unsigned tg = og / nx;
            if (og + 1u == (tg + 1u) * nx) xb_add(&bar[XB_TOPGEN], 1u);
            else XB_SPIN(xb_ld(&bar[XB_TOPGEN]) == tg, bar);
            __builtin_amdgcn_fence(__ATOMIC_ACQUIRE, "agent");
            xb_add(&bar[XB_XGEN(b.x)], 1u);
            asm volatile("s_waitcnt vmcnt(0)" ::: "memory");
        } else {
            XB_SPIN(xb_ld(&bar[XB_XGEN(b.x)]) == gen, bar);
            __builtin_amdgcn_fence(__ATOMIC_ACQUIRE, "agent");
            asm volatile("s_waitcnt vmcnt(0)" ::: "memory");
        }
    }
    __syncthreads();
}


struct Params {
  const float* in[26];
  float* out; unsigned char* ws;
};

__device__ __forceinline__ unsigned f2bf(float f) { unsigned u = __builtin_bit_cast(unsigned, f); return (u + 0x7fffu + ((u >> 16) & 1u)) >> 16; }
__device__ __forceinline__ unsigned pk2(float lo, float hi) { return f2bf(lo) | (f2bf(hi) << 16); }
__device__ __forceinline__ float wave_sum(float v) {
#pragma unroll
  for (int o = 1; o < 64; o <<= 1) v += __shfl_xor(v, o);
  return v;
}
__device__ __forceinline__ void prep_item(const float* W, int ld, int col0, const float* fold, bf16_t* WT, int K, int n0, int k0, float* scr, int lane) {
#pragma unroll 8
  for (int i = 0; i < 32; ++i) { const int kk = 2 * i + (lane >> 5); float v = 0.f; if (W) { v = W[(size_t)(k0 + kk) * ld + col0 + (lane & 31)]; if (fold) v *= fold[k0 + kk]; } scr[kk * 33 + (lane & 31)] = v; }
  asm volatile("s_waitcnt lgkmcnt(0)" ::: "memory");
  const int c = lane & 7;
#pragma unroll
  for (int j = 0; j < 4; ++j) { const int n = (lane >> 3) + 8 * j; const float* s = scr + (8 * c) * 33 + n;
    u32x4 o; o.x = pk2(s[0 * 33], s[1 * 33]); o.y = pk2(s[2 * 33], s[3 * 33]); o.z = pk2(s[4 * 33], s[5 * 33]); o.w = pk2(s[6 * 33], s[7 * 33]);
    *(u32x4*)(WT + (size_t)(n0 + n) * K + k0 + 8 * c) = o; }
  asm volatile("s_waitcnt lgkmcnt(0)" ::: "memory");
}
__device__ __forceinline__ void sincos_d(double x, float& s, float& c) {
  const double TWO_PI = 6.283185307179586476925286766559, INV_2PI = 0.15915494309189533576888376337251;
  double k = __builtin_rint(x * INV_2PI); double r = x - k * TWO_PI;
  const double HALF_PI = 1.5707963267948966192313216916398;
  double q = __builtin_rint(r * 0.63661977236758134308); double y = r - q * HALF_PI; int qi = ((int)q) & 3;
  double y2 = y * y;
  double sp = y * (1.0 + y2 * (-1.0 / 6 + y2 * (1.0 / 120 + y2 * (-1.0 / 5040 + y2 * (1.0 / 362880 + y2 * (-1.0 / 39916800 + y2 * (1.0 / 6227020800.0)))))));
  double cp = 1.0 + y2 * (-0.5 + y2 * (1.0 / 24 + y2 * (-1.0 / 720 + y2 * (1.0 / 40320 + y2 * (-1.0 / 3628800 + y2 * (1.0 / 479001600.0 + y2 * (-1.0 / 87178291200.0)))))));
  double ss, cc;
  if (qi == 0) { ss = sp; cc = cp; } else if (qi == 1) { ss = cp; cc = -sp; } else if (qi == 2) { ss = -sp; cc = -cp; } else { ss = -cp; cc = sp; }
  s = (float)ss; c = (float)cc;
}

__device__ __forceinline__ void p0_prologue(const Params& P, unsigned char* ws, char* lds) {
  int tid_ = threadIdx.x; asm volatile("" : "+v"(tid_)); const int tid = tid_, lane = tid & 63, wave = tid >> 6;
  const int gw = blockIdx.x * 8 + wave, NGW = gridDim.x * 8;
  float* scr = (float*)(lds + wave * 16384);
  constexpr int NJ = 10;
  const int jN[NJ] = {NGU, 1024, NIN, 768, 1024, 1024, NGU, 1024, 1024, 1024};
  const int jK[NJ] = {1024, DFF, 1024, 384, 256, 1024, 1024, DFF, 1024, 256};
  int total = 0;
#pragma unroll
  for (int j = 0; j < NJ; ++j) total += (jN[j] / 32) * (jK[j] / 64);
  for (int it = gw; it < total; it += NGW) {
    int r = it, job = 0;
#pragma unroll
    for (int j = 0; j < NJ; ++j) { const int cnt = (jN[j] / 32) * (jK[j] / 64); if (job == j && r >= cnt) { r -= cnt; job = j + 1; } }
    int N = 0, K = 0;
#pragma unroll
    for (int j = 0; j < NJ; ++j) if (job == j) { N = jN[j]; K = jK[j]; }
    const int nblk = N / 32, kb = r / nblk, nb = r % nblk, k0 = 64 * kb, n0 = 32 * nb;
    const float* W = nullptr; int ld = 0, col0 = 0; const float* fold = nullptr; bf16_t* WT = nullptr;
    if (job == 0 || job == 6) { const int t = n0 >> 8, half = (n0 >> 7) & 1, j0 = n0 & 127; const int b = (job == 0) ? 5 : 19;
      W = P.in[b + half]; ld = DFF; col0 = 128 * t + j0; fold = P.in[(job == 0) ? 4 : 18]; WT = (bf16_t*)(ws + ((job == 0) ? WS_W1GU : WS_W2GU)); }
    else if (job == 1 || job == 7) { W = P.in[(job == 1) ? 7 : 21]; ld = 1024; col0 = n0; WT = (bf16_t*)(ws + ((job == 1) ? WS_W1D : WS_W2D)); }
    else if (job == 2) { ld = 3232; fold = P.in[8]; WT = (bf16_t*)(ws + WS_WIN); W = P.in[9];
      if (n0 < 384) col0 = n0; else if (n0 < 416) col0 = 640 + (n0 - 384); else if (n0 < 512) W = nullptr; else if (n0 < 768) col0 = 384 + (n0 - 512); else col0 = 672 + (n0 - 768); }
    else if (job == 3) { W = P.in[11]; ld = 768; col0 = n0; fold = P.in[10]; WT = (bf16_t*)(ws + WS_WUQ); }
    else if (job == 4) { if (n0 < 512) { W = P.in[13]; col0 = n0; } else { W = P.in[14]; col0 = n0 - 512; } ld = 512; fold = P.in[12]; WT = (bf16_t*)(ws + WS_WUKV); }
    else if (job == 5) { W = P.in[17]; ld = 1024; col0 = n0; WT = (bf16_t*)(ws + WS_WO); }
    else if (job == 8) { W = P.in[23]; ld = 1024; col0 = n0; fold = P.in[22]; WT = (bf16_t*)(ws + WS_WPG); }
    else { W = P.in[24]; ld = 1024; col0 = n0; WT = (bf16_t*)(ws + WS_WPP); }
    prep_item(W, ld, col0, fold, WT, K, n0, k0, scr, lane);
  }
  float* ss = (float*)(ws + WS_SS); bf16_t* HB = (bf16_t*)(ws + WS_HB); bf16_t* PB = (bf16_t*)(ws + WS_PB);
  for (int m = gw; m < T_ALL; m += NGW) {
    const float* xr = (m < T_P) ? P.in[0] + (size_t)m * DM : P.in[1] + (size_t)(m - T_P) * DM;
    const f32x4* x4 = (const f32x4*)xr + lane; float s = 0.f; f32x4 v[4];
#pragma unroll
    for (int j = 0; j < 4; ++j) { v[j] = x4[64 * j]; s += (v[j][0] * v[j][0] + v[j][1] * v[j][1]) + (v[j][2] * v[j][2] + v[j][3] * v[j][3]); }
    s = wave_sum(s);
    u32x2* o8 = (u32x2*)(HB + (size_t)m * DM) + lane;
#pragma unroll
    for (int j = 0; j < 4; ++j) { u32x2 w; w.x = pk2(v[j][0], v[j][1]); w.y = pk2(v[j][2], v[j][3]); o8[64 * j] = w; }
    const float* pr = (m < T_P) ? P.in[2] + (size_t)m * PLE : P.in[3] + (size_t)(m - T_P) * PLE;
    const f32x4 pv = ((const f32x4*)pr)[lane]; u32x2 w; w.x = pk2(pv[0], pv[1]); w.y = pk2(pv[2], pv[3]); ((u32x2*)(PB + (size_t)m * PLE))[lane] = w;
    if (lane < 7) ss[(size_t)lane * T_ALL + m] = (lane == 0) ? s : 0.f;
  }
  float* rc = (float*)(ws + WS_ROPEC); float* rs = (float*)(ws + WS_ROPES);
  for (int e = blockIdx.x * 512 + tid; e < S_P * 16; e += gridDim.x * 512) {
    const int pos = e >> 4, i = e & 15;
    const float cst = (float)(-9.210340371976184 / 32.0); const float arg = (float)(2 * i) * cst;
    const double a = (double)arg; const double nn = __builtin_rint(a * 1.4426950408889634); const double rr = a - nn * 0.69314718055994530942;
    double ex = 1.0 + rr * (1.0 + rr * (0.5 + rr * (1.0 / 6 + rr * (1.0 / 24 + rr * (1.0 / 120 + rr * (1.0 / 720 + rr * (1.0 / 5040 + rr * (1.0 / 40320 + rr * (1.0 / 362880 + rr * (1.0 / 3628800 + rr * (1.0 / 39916800)))))))))));
    ex = ex * __builtin_ldexp(1.0, (int)nn);
    const float invf = (float)ex; const float ang = (float)pos * invf;
    float sv, cv; sincos_d((double)ang, sv, cv); rc[e] = cv; rs[e] = sv;
  }
}
__device__ __forceinline__ void hg_combine(const float* OP, const bf16_t* U, const float* hg_norm, bf16_t* MIX) {
  int tid_ = threadIdx.x; asm volatile("" : "+v"(tid_)); const int lane = tid_ & 63, wave = tid_ >> 6; const int gw = blockIdx.x * 8 + wave, NGW = gridDim.x * 8;
  f32x4 gn0 = *(const f32x4*)(hg_norm + 8 * lane), gn1 = *(const f32x4*)(hg_norm + 8 * lane + 4);
  for (int m = gw; m < T_ALL; m += NGW) {
    const float* a = OP + (size_t)m * 512 + 8 * lane; const float* b = a + (size_t)T_ALL * 512;
    f32x4 o0 = *(const f32x4*)a + *(const f32x4*)b, o1 = *(const f32x4*)(a + 4) + *(const f32x4*)(b + 4);
    float s = (o0[0] * o0[0] + o0[1] * o0[1]) + (o0[2] * o0[2] + o0[3] * o0[3]) + (o1[0] * o1[0] + o1[1] * o1[1]) + (o1[2] * o1[2] + o1[3] * o1[3]);
    s += __shfl_xor(s, 1); s += __shfl_xor(s, 2); s += __shfl_xor(s, 4); s += __shfl_xor(s, 8);
    const float r = rsqrtf(s * (1.0f / 128.0f) + EPS);
    const bf16x8 g = *(const bf16x8*)(U + (size_t)m * 2560 + 2048 + 8 * lane);
    float ov[8] = {o0[0], o0[1], o0[2], o0[3], o1[0], o1[1], o1[2], o1[3]}; float gnv[8] = {gn0[0], gn0[1], gn0[2], gn0[3], gn1[0], gn1[1], gn1[2], gn1[3]};
    unsigned w[4];
#pragma unroll
    for (int j = 0; j < 8; j += 2) { float r2[2];
#pragma unroll
      for (int e = 0; e < 2; ++e) { const float x = __uint_as_float(((unsigned)(unsigned short)g[j + e]) << 16); const float sl = x * __builtin_amdgcn_rcpf(1.0f + __expf(-x)); r2[e] = ov[j + e] * r * gnv[j + e] * sl; }
      w[j >> 1] = pk2(r2[0], r2[1]); }
    *(u32x4*)(MIX + (size_t)m * 1024 + 512 + 8 * lane) = (u32x4){w[0], w[1], w[2], w[3]};
  }
}
__device__ __forceinline__ void final_norm(float* out, const bf16_t* h4, const float* ss4, const float* fn) {
  int tid_ = threadIdx.x; asm volatile("" : "+v"(tid_)); const int lane = tid_ & 63, wave = tid_ >> 6; const int gw = blockIdx.x * 8 + wave, NGW = gridDim.x * 8;
  f32x4 g[2][2];
#pragma unroll
  for (int j = 0; j < 2; ++j) { g[j][0] = *(const f32x4*)(fn + 512 * j + 8 * lane); g[j][1] = *(const f32x4*)(fn + 512 * j + 8 * lane + 4); }
  for (int m = gw; m < T_ALL; m += NGW) {
    const float r = rsqrtf(ss4[m] * (1.0f / 1024.0f) + EPS);
#pragma unroll
    for (int j = 0; j < 2; ++j) { const u32x4 h = *(const u32x4*)(h4 + (size_t)m * DM + 512 * j + 8 * lane);
      f32x4 a, b; a[0] = __uint_as_float(h.x << 16); a[1] = __uint_as_float(h.x & 0xffff0000u); a[2] = __uint_as_float(h.y << 16); a[3] = __uint_as_float(h.y & 0xffff0000u);
      b[0] = __uint_as_float(h.z << 16); b[1] = __uint_as_float(h.z & 0xffff0000u); b[2] = __uint_as_float(h.w << 16); b[3] = __uint_as_float(h.w & 0xffff0000u);
      float* o = out + (size_t)m * DM + 512 * j + 8 * lane; *(f32x4*)o = a * r * g[j][0]; *(f32x4*)(o + 4) = b * r * g[j][1]; }
  }
}

#define GSYNC() xcd_barrier(xbar)

template <class Epi> __device__ __forceinline__ void run_gemm(LAS unsigned char* lds, const bf16_t* A, int lda, const bf16_t* Bt, int ldb, int N, int K, const Epi& E) {
  pg8::Gemm g{A, Bt, T_ALL, N, K, lda, ldb}; pg8::StaticOrder S; S.init(T_ALL, N, (int)gridDim.x, (int)blockIdx.x);
  pg8::gemm_phase<Epi, pg8::StaticOrder, true, true>(lds, g, S, E);
}

__global__ void __launch_bounds__(512, 2) mk_fwd(Params P) {
  extern __shared__ __attribute__((aligned(16))) unsigned char lds[];
  unsigned char* ws = P.ws; float* out = P.out; unsigned char* dob = (unsigned char*)P.out;
  LAS unsigned char* l3 = (LAS unsigned char*)lds;
  float* ss = (float*)(ws + WS_SS);
  float* ss0 = ss, *ss1 = ss + T_ALL, *ss2 = ss + 2 * (size_t)T_ALL, *ss3 = ss + 3 * (size_t)T_ALL, *ss4 = ss + 4 * (size_t)T_ALL, *ssq = ss + 5 * (size_t)T_ALL, *sskv = ss + 6 * (size_t)T_ALL;
  const float* ropec = (const float*)(ws + WS_ROPEC); const float* ropes = (const float*)(ws + WS_ROPES);
  bf16_t* HB = (bf16_t*)(ws + WS_HB); bf16_t* ACT = (bf16_t*)(ws + WS_ACT); bf16_t* UHG = (bf16_t*)(ws + WS_UHG); bf16_t* UMLA = (bf16_t*)(ws + WS_UMLA);
  bf16_t* MIX = (bf16_t*)(ws + WS_MIX); bf16_t* H4B = (bf16_t*)(ws + WS_MIX);     bf16_t* PROJ = (bf16_t*)(ws + WS_PROJ); bf16_t* PB = (bf16_t*)(ws + WS_PB);
  bf16_t* Qb = (bf16_t*)(dob + DO_Q); bf16_t* KN = (bf16_t*)(dob + DO_KN); bf16_t* Vb = (bf16_t*)(dob + DO_V); bf16_t* KR = (bf16_t*)(dob + DO_KR);

  if (threadIdx.x < 16) ((LAS unsigned*)(l3 + LDS_BARST))[threadIdx.x] = 0u;
  if (blockIdx.x == 0) { for (int i = threadIdx.x; i < XCD_BAR_WORDS; i += 512) __hip_atomic_store((unsigned*)(ws + WS_BAR) + i, 0u, __ATOMIC_RELAXED, __HIP_MEMORY_SCOPE_AGENT); }
  p0_prologue(P, ws, (char*)lds);
  cg::this_grid().sync();
  const XcdBarrier xbar = xcd_barrier_post((unsigned*)(ws + WS_BAR), (volatile LAS unsigned*)(l3 + LDS_BARST));
  { pg8::EpiSwiGLU E{ACT, ss0}; run_gemm(l3, HB, 1024, (const bf16_t*)(ws + WS_W1GU), 1024, NGU, 1024, E); }
  GSYNC();
  { pg8::EpiRes<0> E{P.in[0], P.in[1], HB, nullptr, ss1, nullptr, nullptr}; run_gemm(l3, ACT, DFF, (const bf16_t*)(ws + WS_W1D), DFF, 1024, DFF, E); }
  GSYNC();
  { pg8::EpiWin E{UMLA, UHG, KR, ss1, ssq, sskv, ropec, ropes}; run_gemm(l3, HB, 1024, (const bf16_t*)(ws + WS_WIN), 1024, NIN, 1024, E); }
  GSYNC();
  { pg8::EpiBf E{Qb, Qb, 768, 1000, ssq, 1.0f / 384.0f, att::SCALE * 1.4426950408889634f}; run_gemm(l3, UMLA, 768, (const bf16_t*)(ws + WS_WUQ), 384, 768, 384, E); }
  { pg8::EpiBf E{KN, Vb, 512, 2, sskv, 1.0f / 256.0f, 1.0f}; run_gemm(l3, UMLA + 512, 768, (const bf16_t*)(ws + WS_WUKV), 256, 1024, 256, E); }
  GSYNC();
  {
    const int G = gridDim.x, bx = blockIdx.x;
    if (G == 256) {
      const int xcd = bx & 7, idx = bx >> 3;
      for (int i = 0; i < 12; ++i) {
        int rowbase, seq, h, qb;
        if (i < 4) { const int pair = 2 * xcd + (i >> 1); const int b = pair >> 3; h = pair & 7; qb = idx * 2 + (i & 1); rowbase = b * S_P; seq = S_P; }
        else { const int j = i - 4; const int pair = 16 * xcd + 2 * j + (idx >> 4); const int b = pair >> 3; h = pair & 7; qb = idx & 15; rowbase = T_P + b * S_S; seq = S_S; }
        att::attn_unit(Qb + (size_t)(rowbase + qb * 256) * 768 + h * 96, KN + (size_t)rowbase * 512 + h * 64, KR + (size_t)rowbase * 32, Vb + (size_t)rowbase * 512 + h * 64,
                       MIX + (size_t)(rowbase + qb * 256) * 1024 + h * 64, seq, rowbase + qb * 256, ropec, ropes, (char*)lds);
      }
    } else {
      for (int u = bx; u < 3072; u += G) {
        int rowbase, seq, h, qb;
        if (u < 1024) { const int pair = u >> 6; const int b = pair >> 3; h = pair & 7; qb = u & 63; rowbase = b * S_P; seq = S_P; }
        else { const int v = u - 1024; const int pair = v >> 4; const int b = pair >> 3; h = pair & 7; qb = v & 15; rowbase = T_P + b * S_S; seq = S_S; }
        att::attn_unit(Qb + (size_t)(rowbase + qb * 256) * 768 + h * 96, KN + (size_t)rowbase * 512 + h * 64, KR + (size_t)rowbase * 32, Vb + (size_t)rowbase * 512 + h * 64,
                       MIX + (size_t)(rowbase + qb * 256) * 1024 + h * 64, seq, rowbase + qb * 256, ropec, ropes, (char*)lds);
      }
    }
  }
  GSYNC();
  {
    float* SLOT = (float*)(ws + WS_SLOT); float* DSEG = (float*)(ws + WS_DSEG);
    for (int u = blockIdx.x; u < 768; u += gridDim.x) {
      int chainid, seg, nseg;
      if (u < 256) { chainid = u >> 4; seg = u & 15; nseg = 16; } else { const int u2 = u - 256; chainid = 16 + (u2 >> 2); seg = u2 & 3; nseg = 4; }
      if (seg == nseg - 1) continue;
      int rowbase, S, h, dir;
      if (chainid < 16) { const int b = chainid >> 3; h = (chainid >> 1) & 3; dir = chainid & 1; rowbase = b * S_P; S = S_P; }
      else { const int c2 = chainid - 16; const int b = c2 >> 3; h = (c2 >> 1) & 3; dir = c2 & 1; rowbase = T_P + b * S_S; S = S_S; }
      hg::chain<1>(UHG, out, P.in[15], rowbase, S, h, dir, seg * 1024, 16, nullptr, SLOT + (size_t)u * 16384, DSEG + (size_t)u * 128, (char*)lds);
    }
  }
  GSYNC();
  {
    float* SLOT = (float*)(ws + WS_SLOT); const float* DSEG = (const float*)(ws + WS_DSEG);
    int tid_ = threadIdx.x; asm volatile("" : "+v"(tid_));
    for (int e = blockIdx.x * 512 + tid_; e < 144 * 16384; e += gridDim.x * 512) {
      const int chainid = e >> 14, el = e & 16383, k = el & 127;
      int u0, nseg; if (chainid < 16) { u0 = chainid * 16; nseg = 16; } else { u0 = 256 + (chainid - 16) * 4; nseg = 4; }
      float Sv = 0.f;
      for (int s = 1; s < nseg; ++s) { float* sl = SLOT + (size_t)(u0 + s - 1) * 16384 + el; Sv = DSEG[(size_t)(u0 + s - 1) * 128 + k] * Sv + *sl; *sl = Sv; }
    }
  }
  GSYNC();
  {
    const float* SLOT = (const float*)(ws + WS_SLOT);
    for (int u = blockIdx.x; u < 768; u += gridDim.x) {
      int chainid, seg;
      if (u < 256) { chainid = u >> 4; seg = u & 15; } else { const int u2 = u - 256; chainid = 16 + (u2 >> 2); seg = u2 & 3; }
      int rowbase, S, h, dir;
      if (chainid < 16) { const int b = chainid >> 3; h = (chainid >> 1) & 3; dir = chainid & 1; rowbase = b * S_P; S = S_P; }
      else { const int c2 = chainid - 16; const int b = c2 >> 3; h = (c2 >> 1) & 3; dir = c2 & 1; rowbase = T_P + b * S_S; S = S_S; }
      hg::chain<3>(UHG, out, P.in[15], rowbase, S, h, dir, seg * 1024, 16, seg ? SLOT + (size_t)(u - 1) * 16384 : nullptr, nullptr, nullptr, (char*)lds);
    }
  }
  GSYNC();
  hg_combine(out, UHG, P.in[16], MIX);
  GSYNC();
  { pg8::EpiRes<1> E{nullptr, nullptr, HB, nullptr, ss2, nullptr, nullptr}; run_gemm(l3, MIX, 1024, (const bf16_t*)(ws + WS_WO), 1024, 1024, 1024, E); }
  GSYNC();
  { pg8::EpiSwiGLU E{ACT, ss2}; run_gemm(l3, HB, 1024, (const bf16_t*)(ws + WS_W2GU), 1024, NGU, 1024, E); }
  GSYNC();
  { pg8::EpiRes<2> E{nullptr, nullptr, HB, nullptr, ss3, nullptr, nullptr}; run_gemm(l3, ACT, DFF, (const bf16_t*)(ws + WS_W2D), DFF, 1024, DFF, E); }
  GSYNC();
  { pg8::EpiBf E{PROJ, PROJ, 1024, 1000, nullptr, 0.f, 1.0f}; run_gemm(l3, PB, 256, (const bf16_t*)(ws + WS_WPP), 256, 1024, 256, E); }
  GSYNC();
  { pg8::EpiRes<3> E{nullptr, nullptr, HB, H4B, ss4, ss3, PROJ}; run_gemm(l3, HB, 1024, (const bf16_t*)(ws + WS_WPG), 1024, 1024, 1024, E); }
  GSYNC();
  final_norm(out, H4B, ss4, P.in[25]);
}

extern "C" void kernel_launch(void* const* d_in, const int* in_sizes, int n_in, void* d_out, int out_size, void* d_ws, size_t ws_size, hipStream_t stream) {
  static int grid = 0;
  if (grid == 0) {
    if (n_in != 26 || out_size != T_ALL * DM || ws_size < WS_END) { fprintf(stderr, "kernel_launch: unexpected shapes n_in %d out %d ws %zu\n", n_in, out_size, ws_size); grid = -1; return; }
    int dev = 0, cus = 0, per_cu = 0;
    if (hipGetDevice(&dev) != hipSuccess || hipDeviceGetAttribute(&cus, hipDeviceAttributeMultiprocessorCount, dev) != hipSuccess) { grid = -1; return; }
    if (hipFuncSetAttribute((const void*)mk_fwd, hipFuncAttributeMaxDynamicSharedMemorySize, LDS_BYTES) != hipSuccess) { fprintf(stderr, "kernel_launch: LDS attribute failed\n"); grid = -1; return; }
    if (hipOccupancyMaxActiveBlocksPerMultiprocessor(&per_cu, (const void*)mk_fwd, 512, LDS_BYTES) != hipSuccess || per_cu < 1) { fprintf(stderr, "kernel_launch: occupancy query says %d\n", per_cu); per_cu = 1; }
    (void)hipGetLastError();
    grid = cus;
  }
  if (grid < 0) return;
  Params p{};
  for (int i = 0; i < 26; ++i) p.in[i] = (const float*)d_in[i];
  p.out = (float*)d_out; p.ws = (unsigned char*)d_ws;
  void* args[] = {&p};
  hipError_t e = hipLaunchCooperativeKernel((void*)mk_fwd, dim3(grid), dim3(512), args, LDS_BYTES, stream);
  if (e != hipSuccess) fprintf(stderr, "cooperative launch failed: %s (grid %d)\n", hipGetErrorString(e), grid);
}
```

```cpp
#include <hip/hip_runtime.h>
#include <hip/hip_cooperative_groups.h>
#include <cstdio>
#include <cstdint>
namespace cg = cooperative_groups;

constexpr int DM = 1024, T_P = 32768, T_ALL = 98304, S_P = 16384, S_S = 4096;
constexpr int DFF = 2816, NGU = 5632, NIN = 3328, NMLA = 768, NHG = 2560, PLE = 256;
constexpr float EPS = 1e-6f;
__device__ __forceinline__ int row_pos(int row) { return row < T_P ? (row & (S_P - 1)) : (row & (S_S - 1)); }

namespace pg8 {
#define PG8_LAS __attribute__((address_space(3)))
typedef unsigned short bf16_t;
typedef short bf16x8 __attribute__((ext_vector_type(8)));
typedef float f32x4 __attribute__((ext_vector_type(4)));
typedef unsigned u32x4 __attribute__((ext_vector_type(4)));
constexpr int BM = 256, BK = 64, HALF = 128, HTB = HALF * BK * 2  , STAGE_BYTES = 8 * HTB, NXCD = 8, WGM = 8;

__host__ __device__ __forceinline__ int lds_byte(int r, int c) { const int st = (r >> 4) * 2 + (c >> 5), rr = r & 15, cc = c & 31, ob = rr * 64 + cc * 2; return st * 1024 + (ob ^ (((ob >> 9) & 1) << 5)); }
__host__ __device__ __forceinline__ void stage_rc(int b, int& R, int& C) { const int st = b / 1024, sb = b % 1024, swz = sb ^ (((sb >> 9) & 1) << 5); R = (st >> 1) * 16 + swz / 64; C = (st & 1) * 32 + (swz % 64) / 2; }
__host__ __device__ __forceinline__ int perm32(int rho) { const int n = rho >> 4, i = rho & 15; return 8 * (i >> 2) + 4 * n + (i & 3); }

struct Unit { int pm, pn; };
struct Gemm { const bf16_t* A; const bf16_t* Bt; int M, N, K, lda, ldb; };

struct StaticOrder {
    int nM, nN, nwg, G, c;
    __host__ __device__ void init(int M, int N, int G_, int c_) { nM = M / BM; nN = N / BM; nwg = nM * nN; G = G_; c = c_; }
    __host__ __device__ bool next(int i, Unit& u) const {
        const long L = (long)i * G + c; if (L >= nwg) return false;
        int wgid = (int)L; { const int q = nwg / NXCD, r = nwg % NXCD, xcd = wgid % NXCD, off = wgid / NXCD; wgid = (xcd < r ? xcd * (q + 1) : r * (q + 1) + (xcd - r) * q) + off; }
        const int nig = WGM * nN, gid = wgid / nig, fm = gid * WGM, gsz = (nM - fm) < WGM ? (nM - fm) : WGM;
        u.pm = fm + ((wgid % nig) % gsz); u.pn = (wgid % nig) / gsz; return true;
    }
    __device__ __forceinline__ void a_ready(const Unit&) const {}
    __device__ __forceinline__ void done(const Unit&) const {}
};
__device__ __forceinline__ unsigned cvt_pk_bf16(float lo, float hi) { unsigned r; asm volatile("v_cvt_pk_bf16_f32 %0, %1, %2" : "=v"(r) : "v"(lo), "v"(hi)); return r; }
typedef unsigned u32x2 __attribute__((ext_vector_type(2)));
__device__ __forceinline__ float bf2f(unsigned short h) { return __uint_as_float(((unsigned)h) << 16); }
__device__ __forceinline__ float fsigmoid(float x) { return __builtin_amdgcn_rcpf(1.0f + __expf(-x)); }
__device__ __forceinline__ float row_sum4(float s) { s += __shfl_xor(s, 16); s += __shfl_xor(s, 32); return s; }

struct EpiSwiGLU {
    static constexpr bool PERM = true, AFTER_DRAIN = false;
    bf16_t* O; const float* ss;
    __device__ __forceinline__ void operator()(const f32x4 (&acc)[2][2][4][2], const Unit& u, int wr, int wc, int fr, int fq) const {
        const int row0 = u.pm * BM + wr * 64 + fr; const int col0 = u.pn * HALF + wc * 32 + 8 * fq;
#pragma unroll
        for (int ai = 0; ai < 2; ++ai)
#pragma unroll
            for (int m = 0; m < 4; ++m) { const int row = row0 + ai * HALF + m * 16; const float r = rsqrtf(ss[row] * (1.0f / 1024.0f) + 1e-6f);
                float v[8];
#pragma unroll
                for (int n = 0; n < 2; ++n)
#pragma unroll
                    for (int j = 0; j < 4; ++j) { const float g = acc[ai][0][m][n][j] * r, uu = acc[ai][1][m][n][j] * r; v[n * 4 + j] = g * fsigmoid(g) * uu; }
                u32x4 w; w.x = cvt_pk_bf16(v[0], v[1]); w.y = cvt_pk_bf16(v[2], v[3]); w.z = cvt_pk_bf16(v[4], v[5]); w.w = cvt_pk_bf16(v[6], v[7]);
                *(u32x4*)(O + (size_t)row * 2816 + col0) = w; }
    }
};
template <int MODE> struct EpiRes {
    static constexpr bool PERM = true, AFTER_DRAIN = false;
    const float* xp; const float* xs; bf16_t* hb; bf16_t* hout; float* ssout; const float* ssin; const bf16_t* proj;
    __device__ __forceinline__ void operator()(const f32x4 (&acc)[2][2][4][2], const Unit& u, int wr, int wc, int fr, int fq) const {
        const int row0 = u.pm * BM + wr * 64 + fr; const int col0 = u.pn * BM + wc * 32 + 8 * fq;
#pragma unroll
        for (int ai = 0; ai < 2; ++ai)
#pragma unroll
            for (int m = 0; m < 4; ++m) { const int row = row0 + ai * HALF + m * 16; float sq = 0.f; float r3 = 0.f;
                if (MODE == 3) r3 = rsqrtf(ssin[row] * (1.0f / 1024.0f) + 1e-6f);
#pragma unroll
                for (int bj = 0; bj < 2; ++bj) { const size_t off = (size_t)row * 1024 + col0 + bj * HALF; float b[8], v[8];
                    if (MODE == 0) { const float* xr = (row < 32768) ? (xp + off) : (xs + (off - (size_t)32768 * 1024)); const f32x4 b0 = *(const f32x4*)xr, b1 = *(const f32x4*)(xr + 4);
                        b[0] = b0[0]; b[1] = b0[1]; b[2] = b0[2]; b[3] = b0[3]; b[4] = b1[0]; b[5] = b1[1]; b[6] = b1[2]; b[7] = b1[3]; }
                    else { const u32x4 h4 = *(const u32x4*)(hb + off);
                        b[0] = __uint_as_float(h4.x << 16); b[1] = __uint_as_float(h4.x & 0xffff0000u); b[2] = __uint_as_float(h4.y << 16); b[3] = __uint_as_float(h4.y & 0xffff0000u);
                        b[4] = __uint_as_float(h4.z << 16); b[5] = __uint_as_float(h4.z & 0xffff0000u); b[6] = __uint_as_float(h4.w << 16); b[7] = __uint_as_float(h4.w & 0xffff0000u); }
                    if (MODE == 3) { const u32x4 p4 = *(const u32x4*)(proj + off); float pr[8];
                        pr[0] = __uint_as_float(p4.x << 16); pr[1] = __uint_as_float(p4.x & 0xffff0000u); pr[2] = __uint_as_float(p4.y << 16); pr[3] = __uint_as_float(p4.y & 0xffff0000u);
                        pr[4] = __uint_as_float(p4.z << 16); pr[5] = __uint_as_float(p4.z & 0xffff0000u); pr[6] = __uint_as_float(p4.w << 16); pr[7] = __uint_as_float(p4.w & 0xffff0000u);
#pragma unroll
                        for (int j = 0; j < 8; ++j) v[j] = b[j] + fsigmoid(acc[ai][bj][m][j >> 2][j & 3] * r3) * pr[j]; }
                    else {
#pragma unroll
                        for (int j = 0; j < 8; ++j) v[j] = b[j] + acc[ai][bj][m][j >> 2][j & 3] * ((MODE == 1) ? 1.0f : 0.5f); }
#pragma unroll
                    for (int j = 0; j < 8; ++j) sq += v[j] * v[j];
                    u32x4 w; w.x = cvt_pk_bf16(v[0], v[1]); w.y = cvt_pk_bf16(v[2], v[3]); w.z = cvt_pk_bf16(v[4], v[5]); w.w = cvt_pk_bf16(v[6], v[7]);
                    *(u32x4*)(((MODE == 3) ? hout : hb) + off) = w; }
                sq = row_sum4(sq);
                if (fq == 0) atomicAdd(ssout + row, sq); }
    }
};
struct EpiWin {
    static constexpr bool PERM = false, AFTER_DRAIN = false;
    bf16_t* umla; bf16_t* uhg; bf16_t* kr; const float* ss1; float* ssq; float* sskv; const float* ropec; const float* ropes;
    __device__ __forceinline__ void operator()(const f32x4 (&acc)[2][2][4][2], const Unit& u, int wr, int wc, int fr, int fq) const {
        const int row0 = u.pm * BM + wr * 64 + fr; const int pn = u.pn;
        bf16_t* dst; int ld, colt;
        if (pn < 3) { dst = umla; ld = 768; colt = pn * BM; } else { dst = uhg; ld = 2560; colt = (pn - 3) * BM; }
        const int col0 = colt + wc * 32 + 4 * fq;
#pragma unroll
        for (int ai = 0; ai < 2; ++ai)
#pragma unroll
            for (int m = 0; m < 4; ++m) { const int row = row0 + ai * HALF + m * 16; const float r = rsqrtf(ss1[row] * (1.0f / 1024.0f) + 1e-6f);
                float sq0 = 0.f, sq1 = 0.f; f32x4 v[2][2];
#pragma unroll
                for (int bj = 0; bj < 2; ++bj)
#pragma unroll
                    for (int n = 0; n < 2; ++n) { v[bj][n] = acc[ai][bj][m][n] * r; const f32x4 x = v[bj][n]; const float s = (x[0] * x[0] + x[1] * x[1]) + (x[2] * x[2] + x[3] * x[3]); if (bj == 0) sq0 += s; else sq1 += s;
                        u32x2 w; w.x = cvt_pk_bf16(x[0], x[1]); w.y = cvt_pk_bf16(x[2], x[3]); *(u32x2*)(dst + (size_t)row * ld + col0 + bj * HALF + n * 16) = w; }
                if (pn < 3) { float s = (pn == 1) ? sq0 : (sq0 + sq1); s = row_sum4(s); if (fq == 0) atomicAdd((pn == 2 ? sskv : ssq) + row, s); }
                if (pn == 1 && wc == 0) {
                    const int pos = row_pos(row); const f32x4 cs = *(const f32x4*)(ropec + pos * 16 + 4 * fq), sn = *(const f32x4*)(ropes + pos * 16 + 4 * fq);
                    const f32x4 x1 = v[1][0], x2 = v[1][1]; const f32x4 o1 = x1 * cs - x2 * sn, o2 = x1 * sn + x2 * cs;
                    u32x2 w1, w2; w1.x = cvt_pk_bf16(o1[0], o1[1]); w1.y = cvt_pk_bf16(o1[2], o1[3]); w2.x = cvt_pk_bf16(o2[0], o2[1]); w2.y = cvt_pk_bf16(o2[2], o2[3]);
                    *(u32x2*)(kr + (size_t)row * 32 + 4 * fq) = w1; *(u32x2*)(kr + (size_t)row * 32 + 16 + 4 * fq) = w2; } }
    }
};
struct EpiBf {
    static constexpr bool PERM = true, AFTER_DRAIN = false;
    bf16_t* O0; bf16_t* O1; int ld; int split; const float* ss; float inv_n; float mul;
    __device__ __forceinline__ void operator()(const f32x4 (&acc)[2][2][4][2], const Unit& u, int wr, int wc, int fr, int fq) const {
        const int row0 = u.pm * BM + wr * 64 + fr; bf16_t* base = O0; int colt = u.pn * BM; if (u.pn >= split) { base = O1; colt = (u.pn - split) * BM; }
        const int col0 = colt + wc * 32 + 8 * fq;
#pragma unroll
        for (int ai = 0; ai < 2; ++ai)
#pragma unroll
            for (int m = 0; m < 4; ++m) { const int row = row0 + ai * HALF + m * 16; const float r = (ss ? rsqrtf(ss[row] * inv_n + 1e-6f) : 1.0f) * mul;
#pragma unroll
                for (int bj = 0; bj < 2; ++bj) { const f32x4 v0 = acc[ai][bj][m][0] * r, v1 = acc[ai][bj][m][1] * r;
                    u32x4 w; w.x = cvt_pk_bf16(v0[0], v0[1]); w.y = cvt_pk_bf16(v0[2], v0[3]); w.z = cvt_pk_bf16(v1[0], v1[1]); w.w = cvt_pk_bf16(v1[2], v1[3]);
                    *(u32x4*)(base + (size_t)row * ld + col0 + bj * HALF) = w; } }
    }
};
template <class Epi, class Sched, bool ALIGN_EPI = false, bool SP2 = false>
__device__ __forceinline__ void gemm_phase(PG8_LAS unsigned char* lds, const Gemm g, const Sched& S, const Epi& E) {
    int tid_ = threadIdx.x; asm volatile("" : "+v"(tid_)); const int tid = tid_, wid = __builtin_amdgcn_readfirstlane(tid >> 6), lane = tid & 63, wr = wid >> 2, wc = wid & 3, fr = lane & 15, fq = lane >> 4;
    const int K = g.K, nt = K / BK;
    unsigned voffA[2], voffB[2];
#pragma unroll
    for (int i = 0; i < 2; ++i) { int R, C; stage_rc(tid * 16 + i * 8192, R, C); const int Rb = Epi::PERM ? ((R & ~31) + perm32(R & 31)) : R;
        voffA[i] = (unsigned)(R * g.lda + C) * 2u; voffB[i] = (unsigned)(Rb * g.ldb + C) * 2u; }
    const size_t kstep = (size_t)(BK * 2);
    const size_t hstepA = (size_t)HALF * g.lda * 2, hstepB = (size_t)HALF * g.ldb * 2;
    const size_t tstepA = 2 * hstepA, tstepB = 2 * hstepB;
    const unsigned ldsw = (unsigned)wid * 1024u;
    const int aoff = lds_byte(wr * 64 + fr, fq * 8), boff = lds_byte(wc * 32 + fr, fq * 8);
#define PG8_SA(b, h) (((b) * 2 + (h)) * HTB)
#define PG8_SB(b, h) ((4 + (b) * 2 + (h)) * HTB)
#define PG8_STAGE(bufoff, gbase, voff) do { _Pragma("unroll") for (int _i = 0; _i < 2; ++_i) \
        __builtin_amdgcn_global_load_lds((const unsigned*)((const char*)(gbase) + (voff)[_i]), (PG8_LAS unsigned*)(lds + (bufoff) + ldsw + _i * 8192), 16, 0, 0); } while (0)
#define PG8_LDA(dst, b, h) do { _Pragma("unroll") for (int m = 0; m < 4; ++m) _Pragma("unroll") for (int k = 0; k < 2; ++k) dst[m][k] = *(const PG8_LAS bf16x8*)(lds + PG8_SA(b, h) + aoff + m * 2048 + k * 1024); } while (0)
#define PG8_LDB(dst, b, h) do { _Pragma("unroll") for (int n = 0; n < 2; ++n) _Pragma("unroll") for (int k = 0; k < 2; ++k) dst[n][k] = *(const PG8_LAS bf16x8*)(lds + PG8_SB(b, h) + boff + n * 2048 + k * 1024); } while (0)
#define PG8_MMA(ai, bj, At, Bt) do { __builtin_amdgcn_s_setprio(1); _Pragma("unroll") for (int m = 0; m < 4; ++m) _Pragma("unroll") for (int n = 0; n < 2; ++n) _Pragma("unroll") for (int k = 0; k < 2; ++k) \
        acc[ai][bj][m][n] = __builtin_amdgcn_mfma_f32_16x16x32_bf16(Bt[n][k], At[m][k], acc[ai][bj][m][n], 0, 0, 0); __builtin_amdgcn_s_setprio(0); } while (0)
#define PG8_WAIT_V(n) asm volatile("s_waitcnt vmcnt(" #n ")" ::: "memory")
#define PG8_WAIT_L(n) asm volatile("s_waitcnt lgkmcnt(" #n ")" ::: "memory")
#define PG8_BAR __builtin_amdgcn_s_barrier()
#define PG8_SCHED __builtin_amdgcn_sched_barrier(0)
    Unit cur, nxt; int ui = 0;
    if (!S.next(0, cur)) return;
    f32x4 acc[2][2][4][2];
#pragma unroll
    for (int a = 0; a < 2; ++a)
#pragma unroll
        for (int b = 0; b < 2; ++b)
#pragma unroll
            for (int m = 0; m < 4; ++m)
#pragma unroll
                for (int n = 0; n < 2; ++n) acc[a][b][m][n] = (f32x4){0.f, 0.f, 0.f, 0.f};
    bf16x8 At[4][2], B0[2][2], B1[2][2];
    const char* cA = (const char*)g.A + (size_t)cur.pm * tstepA; const char* cB = (const char*)g.Bt + (size_t)cur.pn * tstepB;
    S.a_ready(cur);
    if constexpr (SP2) {
        PG8_STAGE(PG8_SB(0, 0), cB, voffB); PG8_STAGE(PG8_SB(0, 1), cB + hstepB, voffB); PG8_STAGE(PG8_SA(0, 0), cA, voffA); PG8_STAGE(PG8_SA(0, 1), cA + hstepA, voffA);
        if (wr == 1) PG8_BAR;
        PG8_WAIT_V(2); PG8_BAR;
        PG8_STAGE(PG8_SB(1, 0), cB + kstep, voffB); PG8_STAGE(PG8_SA(1, 0), cA + kstep, voffA); PG8_STAGE(PG8_SB(1, 1), cB + hstepB + kstep, voffB);
        PG8_WAIT_V(6); PG8_BAR;
    } else {
        PG8_STAGE(PG8_SB(0, 0), cB, voffB); PG8_STAGE(PG8_SA(0, 0), cA, voffA); PG8_STAGE(PG8_SB(0, 1), cB + hstepB, voffB); PG8_STAGE(PG8_SA(0, 1), cA + hstepA, voffA);
        if (wr == 1) PG8_BAR;
        PG8_WAIT_V(4); PG8_BAR;
        PG8_STAGE(PG8_SB(1, 0), cB + kstep, voffB); PG8_STAGE(PG8_SA(1, 0), cA + kstep, voffA); PG8_STAGE(PG8_SB(1, 1), cB + hstepB + kstep, voffB);
        PG8_WAIT_V(6); PG8_BAR;
    }
    for (;;) {
        const bool has_next = S.next(ui + 1, nxt);
        const char* nA = has_next ? (const char*)g.A + (size_t)nxt.pm * tstepA : cA; const char* nB = has_next ? (const char*)g.Bt + (size_t)nxt.pn * tstepB : cB;
        for (int t = 0; t < nt; t += 2) {
            const bool last = (t == nt - 2);
            const char* a1 = cA + (size_t)(t + 1) * kstep;
            const char* a2 = last ? nA : cA + (size_t)(t + 2) * kstep; const char* b2 = last ? nB : cB + (size_t)(t + 2) * kstep;
            const char* a3 = a2 + kstep; const char* b3 = b2 + kstep;
            if (last && has_next) S.a_ready(nxt);
            if constexpr (SP2) {
            PG8_LDB(B0, 0, 0); PG8_LDB(B1, 0, 1); PG8_SCHED; PG8_LDA(At, 0, 0); PG8_STAGE(PG8_SA(1, 1), a1 + hstepA, voffA);
            PG8_WAIT_V(8); PG8_WAIT_L(0); PG8_BAR; PG8_MMA(0, 0, At, B0); PG8_MMA(0, 1, At, B1); PG8_BAR; PG8_SCHED;
            PG8_LDA(At, 0, 1); PG8_STAGE(PG8_SB(0, 0), b2, voffB); PG8_STAGE(PG8_SB(0, 1), b2 + hstepB, voffB); PG8_STAGE(PG8_SA(0, 0), a2, voffA);
            PG8_WAIT_V(8); PG8_WAIT_L(0); PG8_BAR; PG8_MMA(1, 0, At, B0); PG8_MMA(1, 1, At, B1); PG8_BAR; PG8_SCHED;
            PG8_LDB(B0, 1, 0); PG8_LDB(B1, 1, 1); PG8_SCHED; PG8_LDA(At, 1, 0); PG8_STAGE(PG8_SA(0, 1), a2 + hstepA, voffA);
            PG8_WAIT_V(8); PG8_WAIT_L(0); PG8_BAR; PG8_MMA(0, 0, At, B0); PG8_MMA(0, 1, At, B1); PG8_BAR; PG8_SCHED;
            PG8_LDA(At, 1, 1); PG8_STAGE(PG8_SB(1, 0), b3, voffB); PG8_STAGE(PG8_SB(1, 1), b3 + hstepB, voffB); PG8_STAGE(PG8_SA(1, 0), a3, voffA);
            PG8_WAIT_V(8); PG8_WAIT_L(0); PG8_BAR; PG8_MMA(1, 0, At, B0); PG8_MMA(1, 1, At, B1); PG8_BAR; PG8_SCHED;
            } else {
            PG8_LDB(B0, 0, 0); PG8_SCHED; PG8_LDA(At, 0, 0); PG8_STAGE(PG8_SA(1, 1), a1 + hstepA, voffA);
            PG8_WAIT_L(8); PG8_BAR; PG8_WAIT_L(0); PG8_MMA(0, 0, At, B0); PG8_BAR; PG8_SCHED;
            PG8_LDB(B1, 0, 1); PG8_STAGE(PG8_SB(0, 0), b2, voffB);
            PG8_BAR; PG8_WAIT_L(0); PG8_MMA(0, 1, At, B1); PG8_BAR;
            PG8_LDA(At, 0, 1); PG8_STAGE(PG8_SA(0, 0), a2, voffA);
            PG8_BAR; PG8_WAIT_L(0); PG8_MMA(1, 0, At, B0); PG8_BAR; PG8_SCHED;
            PG8_STAGE(PG8_SB(0, 1), b2 + hstepB, voffB);
            PG8_WAIT_V(6); PG8_BAR; PG8_MMA(1, 1, At, B1); PG8_BAR;
            PG8_LDB(B0, 1, 0); PG8_SCHED; PG8_LDA(At, 1, 0); PG8_STAGE(PG8_SA(0, 1), a2 + hstepA, voffA);
            PG8_WAIT_L(8); PG8_BAR; PG8_WAIT_L(0); PG8_MMA(0, 0, At, B0); PG8_BAR; PG8_SCHED;
            PG8_LDB(B1, 1, 1); PG8_STAGE(PG8_SB(1, 0), b3, voffB);
            PG8_BAR; PG8_WAIT_L(0); PG8_MMA(0, 1, At, B1); PG8_BAR;
            PG8_LDA(At, 1, 1); PG8_STAGE(PG8_SA(1, 0), a3, voffA);
            PG8_BAR; PG8_WAIT_L(0); PG8_MMA(1, 0, At, B0); PG8_BAR; PG8_SCHED;
            PG8_STAGE(PG8_SB(1, 1), b3 + hstepB, voffB);
            PG8_WAIT_V(6); PG8_BAR; PG8_MMA(1, 1, At, B1); PG8_BAR;
            }
        }
        if constexpr (ALIGN_EPI) { if (wr == 0) PG8_BAR; }
        if constexpr (!Epi::AFTER_DRAIN) { E(acc, cur, wr, wc, fr, fq); S.done(cur); }
        if (!has_next) break;
#pragma unroll
        for (int a = 0; a < 2; ++a)
#pragma unroll
            for (int b = 0; b < 2; ++b)
#pragma unroll
                for (int m = 0; m < 4; ++m)
#pragma unroll
                    for (int n = 0; n < 2; ++n) acc[a][b][m][n] = (f32x4){0.f, 0.f, 0.f, 0.f};
        cur = nxt; cA = nA; cB = nB; ++ui;
        if constexpr (ALIGN_EPI) { if (wr == 1) PG8_BAR; }
    }
    PG8_WAIT_V(0);
    if constexpr (!ALIGN_EPI) { if (wr == 0) PG8_BAR; }
    PG8_BAR;
    if constexpr (Epi::AFTER_DRAIN) { E.fused(acc, cur, wr, wc, fr, fq, lds, wid, lane); S.done(cur); }
#undef PG8_SA
#undef PG8_SB
#undef PG8_STAGE
#undef PG8_LDA
#undef PG8_LDB
#undef PG8_MMA
#undef PG8_WAIT_V
#undef PG8_WAIT_L
#undef PG8_BAR
#undef PG8_SCHED
}
}

namespace att {
typedef unsigned short bf16_t;
using bf16x8 = __attribute__((ext_vector_type(8))) short;
using s16x4  = __attribute__((ext_vector_type(4))) short;
using f32x16 = __attribute__((ext_vector_type(16))) float;
using u32x4  = __attribute__((ext_vector_type(4))) unsigned;
constexpr int NW = 8, QBLK = 32, KVBLK = 64;
constexpr float SCALE = 0.10206207261596575f;
constexpr float THR = 8.f;
constexpr int LDQ = 768, LDKN = 512, LDKR = 32, LDV = 512, LDO = 1024;
constexpr int SHM_V = 64 * 128 * 2, SHM_K = 64 * 128 * 2;
#define KSWZ(row, colB) ((row) * 256 + ((colB) ^ (((row) & 7) << 4)))
#define SBAR() __builtin_amdgcn_sched_barrier(0)
__device__ __forceinline__ int crow(int r, int hi) { return (r & 3) + 8 * (r >> 2) + 4 * hi; }
__device__ __forceinline__ unsigned cvtpk(float lo, float hi) { unsigned r; asm volatile("v_cvt_pk_bf16_f32 %0, %1, %2" : "=v"(r) : "v"(lo), "v"(hi)); return r; }
template <bool FIRST> __device__ __forceinline__ void partialSM(f32x16& p0, f32x16& p1, float& m_ref, f32x16& negm, float& alpha) {
  constexpr float THR2 = THR * 1.4426950408889634f;
  float pmax = p0[0];
#pragma unroll
  for (int r = 1; r < 16; ++r) pmax = fmaxf(pmax, p0[r]);
#pragma unroll
  for (int r = 0; r < 16; ++r) pmax = fmaxf(pmax, p1[r]);
  { auto rr = __builtin_amdgcn_permlane32_swap(__float_as_uint(pmax), __float_as_uint(pmax), false, false);
    pmax = fmaxf(__uint_as_float(rr[0]), __uint_as_float(rr[1])); }
  alpha = 1.f;
  if (FIRST || !__builtin_expect(__all(pmax <= THR2), 1)) {
    const float dl = FIRST ? pmax : fmaxf(pmax, 0.f);
    m_ref += dl; alpha = FIRST ? 1.f : __builtin_amdgcn_exp2f(-dl);
#pragma unroll
    for (int r = 0; r < 16; ++r) { p0[r] -= dl; p1[r] -= dl; }
#pragma unroll
    for (int r = 0; r < 16; ++r) negm[r] = -m_ref;
    asm volatile("" : "+v"(negm));
  }
#pragma unroll
  for (int r = 0; r < 16; ++r) p0[r] = __builtin_amdgcn_exp2f(p0[r]);
}
__device__ __forceinline__ void finishSM(f32x16& p0, f32x16& p1, bf16x8& pa0, bf16x8& pa1, bf16x8& pa2, bf16x8& pa3) {
#pragma unroll
  for (int r = 0; r < 16; ++r) p1[r] = __builtin_amdgcn_exp2f(p1[r]);
#define PK4(P, BASE, OUT) do { unsigned a0 = cvtpk(P[BASE + 0], P[BASE + 1]), a1 = cvtpk(P[BASE + 2], P[BASE + 3]);   \
    unsigned b0 = cvtpk(P[BASE + 4], P[BASE + 5]), b1 = cvtpk(P[BASE + 6], P[BASE + 7]);                              \
    auto r0 = __builtin_amdgcn_permlane32_swap(a0, b0, false, false); auto r1 = __builtin_amdgcn_permlane32_swap(a1, b1, false, false); \
    u32x4 w = {r0[0], r1[0], r0[1], r1[1]}; OUT = *reinterpret_cast<bf16x8*>(&w); } while (0)
  PK4(p0, 0, pa0); PK4(p0, 8, pa1); PK4(p1, 0, pa2); PK4(p1, 8, pa3);
#undef PK4
}
__device__ __forceinline__ void qkt(f32x16& p0, f32x16& p1, const bf16_t* Ks, const bf16x8* qr, const f32x16& negm, int r32, int hi) {
#pragma unroll
  for (int d0 = 0; d0 < 6; ++d0) { int cb = (d0 * 16 + hi * 8) * 2;
    bf16x8 b0 = *reinterpret_cast<const bf16x8*>((const char*)Ks + KSWZ(r32, cb));
    bf16x8 b1 = *reinterpret_cast<const bf16x8*>((const char*)Ks + KSWZ(32 + r32, cb));
    if (d0 == 0) { p0 = __builtin_amdgcn_mfma_f32_32x32x16_bf16(b0, qr[0], negm, 0, 0, 0); p1 = __builtin_amdgcn_mfma_f32_32x32x16_bf16(b1, qr[0], negm, 0, 0, 0); }
    else { p0 = __builtin_amdgcn_mfma_f32_32x32x16_bf16(b0, qr[d0], p0, 0, 0, 0); p1 = __builtin_amdgcn_mfma_f32_32x32x16_bf16(b1, qr[d0], p1, 0, 0, 0); } }
}
__device__ __forceinline__ int v_st(int k, int c) { const int kk = (k & ~0xC) | ((k & 4) << 1) | ((k & 8) >> 1); return ((kk >> 3) * 4 + (c >> 5)) * 512 + ((kk & 7) * 32 + (c & 31)) * 2; }
__device__ __forceinline__ int v_rd_base(int lane) { return ((lane & 3) << 3) | (((lane >> 2) & 3) << 6) | (((lane >> 4) & 1) << 5) | (((lane >> 5) & 1) << 8); }
constexpr int v_rd_off(int d0, int ks, int half) { return d0 * 512 + ks * 4096 + half * 2048; }
template <int OFF> __device__ __forceinline__ s16x4 tr_read(int vb) {
  s16x4 r; asm volatile("ds_read_b64_tr_b16 %0, %1 offset:%2" : "=&v"(r) : "v"(vb), "i"(OFF) : "memory"); return r;
}
template <int D0> __device__ __forceinline__ void pv_one(f32x16& od, int vb, bf16x8 pa0, bf16x8 pa1, bf16x8 pa2, bf16x8 pa3) {
  const s16x4 l0 = tr_read<v_rd_off(D0, 0, 0)>(vb), h0 = tr_read<v_rd_off(D0, 0, 1)>(vb), l1 = tr_read<v_rd_off(D0, 1, 0)>(vb), h1 = tr_read<v_rd_off(D0, 1, 1)>(vb);
  const s16x4 l2 = tr_read<v_rd_off(D0, 2, 0)>(vb), h2 = tr_read<v_rd_off(D0, 2, 1)>(vb), l3 = tr_read<v_rd_off(D0, 3, 0)>(vb), h3 = tr_read<v_rd_off(D0, 3, 1)>(vb);
  asm volatile("s_waitcnt lgkmcnt(0)" ::: "memory"); SBAR();
#define PK(L, H) (bf16x8){L[0], L[1], L[2], L[3], H[0], H[1], H[2], H[3]}
  od = __builtin_amdgcn_mfma_f32_32x32x16_bf16(pa0, PK(l0, h0), od, 0, 0, 0);
  od = __builtin_amdgcn_mfma_f32_32x32x16_bf16(pa1, PK(l1, h1), od, 0, 0, 0);
  od = __builtin_amdgcn_mfma_f32_32x32x16_bf16(pa2, PK(l2, h2), od, 0, 0, 0);
  od = __builtin_amdgcn_mfma_f32_32x32x16_bf16(pa3, PK(l3, h3), od, 0, 0, 0);
#undef PK
}
__device__ __forceinline__ void pv_d0(f32x16* o, f32x16& osum, int vb, bf16x8 pa0, bf16x8 pa1, bf16x8 pa2, bf16x8 pa3) {
  pv_one<0>(o[0], vb, pa0, pa1, pa2, pa3); pv_one<1>(o[1], vb, pa0, pa1, pa2, pa3);
  const short one = (short)0x3F80; const bf16x8 ones = {one, one, one, one, one, one, one, one};
  osum = __builtin_amdgcn_mfma_f32_32x32x16_bf16(pa0, ones, osum, 0, 0, 0); osum = __builtin_amdgcn_mfma_f32_32x32x16_bf16(pa1, ones, osum, 0, 0, 0);
  osum = __builtin_amdgcn_mfma_f32_32x32x16_bf16(pa2, ones, osum, 0, 0, 0); osum = __builtin_amdgcn_mfma_f32_32x32x16_bf16(pa3, ones, osum, 0, 0, 0);
}
__device__ __forceinline__ void attn_unit(const bf16_t* __restrict__ Qb, const bf16_t* __restrict__ KNh, const bf16_t* __restrict__ KRb, const bf16_t* __restrict__ Vh,
                                          bf16_t* __restrict__ Ob, int seq, int qrow0, const float* __restrict__ ropec, const float* __restrict__ ropes, char* lds) {
  int tid_ = threadIdx.x; asm volatile("" : "+v"(tid_)); const int tid = tid_, wid = __builtin_amdgcn_readfirstlane(tid >> 6), lane = tid & 63, r32 = lane & 31, hi = lane >> 5;
  bf16_t* V_lds = (bf16_t*)lds; bf16_t* K_lds = (bf16_t*)(lds + 3 * SHM_V);
  float* ws = (float*)(lds + 3 * SHM_V + 3 * SHM_K) + wid * 64; float* al_l = ws + 32;
  float m_ref = 0.f; f32x16 o[2] = {}; f32x16 osum = {}; f32x16 negm = {}; asm volatile("" : "+v"(negm)); bf16x8 qr[6];
  const bf16_t* Qw = Qb + (long)(wid * QBLK + r32) * LDQ + hi * 8;
#pragma unroll
  for (int d0 = 0; d0 < 6; ++d0) qr[d0] = *reinterpret_cast<const bf16x8*>(Qw + d0 * 16);
  {
    const int pos = row_pos(qrow0 + wid * QBLK + r32); const float* cp = ropec + pos * 16 + 8 * hi; const float* sp = ropes + pos * 16 + 8 * hi;
    unsigned w1[4], w2[4];
#pragma unroll
    for (int e = 0; e < 8; e += 2) { float o1[2], o2[2];
#pragma unroll
      for (int f = 0; f < 2; ++f) { const float x1 = __uint_as_float(((unsigned)(unsigned short)qr[4][e + f]) << 16), x2 = __uint_as_float(((unsigned)(unsigned short)qr[5][e + f]) << 16); const float c = cp[e + f], s = sp[e + f];
        o1[f] = x1 * c - x2 * s; o2[f] = x1 * s + x2 * c; }
      w1[e >> 1] = cvtpk(o1[0], o1[1]); w2[e >> 1] = cvtpk(o2[0], o2[1]); }
    u32x4 v1 = {w1[0], w1[1], w1[2], w1[3]}, v2 = {w2[0], w2[1], w2[2], w2[3]}; qr[4] = *reinterpret_cast<bf16x8*>(&v1); qr[5] = *reinterpret_cast<bf16x8*>(&v2); }
  const int srow = tid >> 3, sch = tid & 7, srow2 = tid >> 2, sch2 = tid & 3;
  const bf16_t* kp = KNh + (long)srow * LDKN + 8 * sch; const bf16_t* vp = Vh + (long)srow * LDV + 8 * sch; const bf16_t* rp = KRb + (long)(srow2 & 63) * LDKR + 8 * sch2;
  const int kst = KSWZ(srow, 16 * sch), vst = v_st(srow, 8 * sch), rst = KSWZ(srow2 & 63, 128 + 16 * sch2);
  const bool has_r = wid < 4;
  constexpr int BUF = SHM_V;
  const int vb0 = (int)(uintptr_t)V_lds + v_rd_base(lane);
  struct { bf16x8 v, k, r; } sr_[2];
#define SLOAD(i, k0) do { sr_[i].v = *reinterpret_cast<const bf16x8*>(vp + (long)(k0) * LDV); sr_[i].k = *reinterpret_cast<const bf16x8*>(kp + (long)(k0) * LDKN); \
    if (has_r) sr_[i].r = *reinterpret_cast<const bf16x8*>(rp + (long)(k0) * LDKR); } while (0)
#define SWRITE(off, i) do { *(bf16x8*)((char*)V_lds + (off) + vst) = sr_[i].v; *(bf16x8*)((char*)K_lds + (off) + kst) = sr_[i].k; \
    if (has_r) *(bf16x8*)((char*)K_lds + (off) + rst) = sr_[i].r; } while (0)
#define SWAIT() do { if (has_r) asm volatile("s_waitcnt vmcnt(3)" ::: "memory"); else asm volatile("s_waitcnt vmcnt(2)" ::: "memory"); } while (0)
#define RESC(a) do { if (__any((a) < 1.f)) { if (hi == 0) al_l[r32] = (a); asm volatile("s_waitcnt lgkmcnt(0)" ::: "memory"); \
    _Pragma("unroll") for (int r = 0; r < 16; ++r) { const float f_ = al_l[crow(r, hi)]; o[0][r] *= f_; o[1][r] *= f_; osum[r] *= f_; } } } while (0)
#define ROT() do { const int t_ = o_prev; o_prev = o_cur; o_cur = o_next; o_next = t_; } while (0)
  f32x16 pA0, pA1, pB0, pB1; float alA, alB; bf16x8 pa0, pa1, pa2, pa3; const int NT = seq / KVBLK;
  constexpr int SE = 0, SO = 1;
  int o_prev = 2 * BUF, o_cur = 0, o_next = BUF;
  SLOAD(SE, 0); asm volatile("s_waitcnt vmcnt(0)" ::: "memory"); SWRITE(0, SE); __syncthreads();
  qkt(pA0, pA1, K_lds, qr, negm, r32, hi); partialSM<true>(pA0, pA1, m_ref, negm, alA);
  SLOAD(SO, KVBLK); if (2 < NT) SLOAD(SE, 2 * KVBLK);
  SWAIT(); SWRITE(BUF, SO); __syncthreads();
  ROT();
  for (int j = 1; j + 1 < NT; j += 2) {
    SBAR(); qkt(pB0, pB1, (bf16_t*)((char*)K_lds + o_cur), qr, negm, r32, hi);
    finishSM(pA0, pA1, pa0, pa1, pa2, pa3); SBAR();
    SLOAD(SO, (j + 2) * KVBLK); SBAR();
    pv_d0(o, osum, vb0 + o_prev, pa0, pa1, pa2, pa3); partialSM<false>(pB0, pB1, m_ref, negm, alB);
    SWAIT(); SWRITE(o_next, SE);
    RESC(alB); __syncthreads(); ROT();
    SBAR(); qkt(pA0, pA1, (bf16_t*)((char*)K_lds + o_cur), qr, negm, r32, hi);
    finishSM(pB0, pB1, pa0, pa1, pa2, pa3); SBAR();
    if (j + 3 < NT) SLOAD(SE, (j + 3) * KVBLK); SBAR();
    pv_d0(o, osum, vb0 + o_prev, pa0, pa1, pa2, pa3); partialSM<false>(pA0, pA1, m_ref, negm, alA);
    SWAIT(); SWRITE(o_next, SO);
    RESC(alA); __syncthreads(); ROT();
  }
  SBAR(); qkt(pB0, pB1, (bf16_t*)((char*)K_lds + o_cur), qr, negm, r32, hi);
  finishSM(pA0, pA1, pa0, pa1, pa2, pa3); SBAR();
  pv_d0(o, osum, vb0 + o_prev, pa0, pa1, pa2, pa3); partialSM<false>(pB0, pB1, m_ref, negm, alB);
  RESC(alB);
  finishSM(pB0, pB1, pa0, pa1, pa2, pa3); SBAR();
  pv_d0(o, osum, vb0 + o_cur, pa0, pa1, pa2, pa3);
  float rli[16];
#pragma unroll
  for (int r = 0; r < 16; ++r) rli[r] = __builtin_amdgcn_rcpf(osum[r]);
  bf16_t* Ow = Ob + (long)(wid * QBLK) * LDO;
#pragma unroll
  for (int r = 0; r < 16; ++r) { int orow = crow(r, hi);
#pragma unroll
    for (int d0 = 0; d0 < 2; ++d0) { const unsigned w = cvtpk(o[d0][r] * rli[r], 0.f); Ow[(long)orow * LDO + d0 * 32 + r32] = (bf16_t)(w & 0xffffu); } }
  __syncthreads();
#undef SLOAD
#undef SWRITE
#undef SWAIT
#undef RESC
#undef ROT
}
#undef KSWZ
#undef SBAR
}
namespace hg {
typedef unsigned short bf16_t;
using bf16x8 = __attribute__((ext_vector_type(8))) short;
using f32x16 = __attribute__((ext_vector_type(16))) float;
using f32x4  = __attribute__((ext_vector_type(4))) float;
using u32x4  = __attribute__((ext_vector_type(4))) unsigned;
#define SWZ256(row, colB) ((row) * 256 + ((colB) ^ (((row) & 7) << 4)))
#define SWZ128(row, colB) ((row) * 128 + ((colB) ^ (((((row) >> 4) ^ (row)) & 7) << 4)))
constexpr int GS = 132;
constexpr int L_ST = 0, L_QH = 32768, L_KH = 49152, L_KT = 65536, L_VT = 81920, L_GB = 98304, L_SEG = 98304 + 64 * GS * 4, L_DD = L_SEG + 2048, L_LB = L_DD + 512;
__device__ __forceinline__ int crow(int r, int hi) { return (r & 3) + 8 * (r >> 2) + 4 * hi; }
__device__ __forceinline__ unsigned cvtpk(float lo, float hi) { unsigned r; asm volatile("v_cvt_pk_bf16_f32 %0, %1, %2" : "=v"(r) : "v"(lo), "v"(hi)); return r; }
__device__ __forceinline__ float bf2f(unsigned short h) { return __uint_as_float(((unsigned)h) << 16); }
template <int MODE> __device__ __forceinline__ void chain(const bf16_t* __restrict__ U, float* __restrict__ OP, const float* __restrict__ hg_lb, int rowbase, int S, int h, int dir, int tau0, int nchunk,
                                                   const float* __restrict__ slot_in, float* __restrict__ slot_out, float* __restrict__ dseg_out, char* lds) {
  int tid_ = threadIdx.x; asm volatile("" : "+v"(tid_)); const int tid = tid_, wid = __builtin_amdgcn_readfirstlane(tid >> 6), lane = tid & 63, r32 = lane & 31, hi = lane >> 5;
  float* GB = (float*)(lds + L_GB); float* SEG = (float*)(lds + L_SEG); float* DD = (float*)(lds + L_DD); float* LB = (float*)(lds + L_LB);
  char* ST = lds + L_ST; char* QH = lds + L_QH; char* KH = lds + L_KH; char* KT = lds + L_KT; char* VT = lds + L_VT; char* AL = lds + L_GB;
  if (tid < 128) { const float a0 = hg_lb[dir * 1024 + h * 128 + tid], a1 = hg_lb[dir * 1024 + 512 + h * 128 + tid]; LB[tid] = 1.0f / (1.0f + __expf(a1 - a0)); }
  f32x16 sacc[2]; sacc[0] = f32x16{}; sacc[1] = f32x16{};
  if (MODE == 3) {
    if (slot_in) {
#pragma unroll
      for (int i = 0; i < 2; ++i)
#pragma unroll
        for (int r = 0; r < 16; ++r) sacc[i][r] = slot_in[(32 * (wid & 3) + crow(r, hi)) * 128 + 32 * (2 * (wid >> 2) + i) + r32];
    }
#pragma unroll
    for (int i = 0; i < 2; ++i)
#pragma unroll
      for (int r = 0; r < 16; ++r) *(bf16_t*)(ST + SWZ256(32 * (wid & 3) + crow(r, hi), 2 * (32 * (2 * (wid >> 2) + i) + r32))) = (bf16_t)(cvtpk(sacc[i][r], 0.f) & 0xffffu);
  }
  float dseg = 1.0f;
  const int tau = tid >> 3, c0 = (tid & 7) * 16, segt = tau >> 4;
  const bf16_t* Ub = U + (size_t)rowbase * 2560 + h * 128 + c0;
  const size_t offq = 0, offv = 512, offf = (size_t)(2 + dir) * 512;
  float* OPd = OP + (size_t)dir * T_ALL * 512;
  bf16x8 nq0 = {}, nq1 = {}, nv0, nv1, nf0, nf1;
  { const int t1 = tau0 + tau; const int tok = dir ? (S - 1 - t1) : t1; const bf16_t* p = Ub + (size_t)tok * 2560;
    if (MODE == 3) { nq0 = *(const bf16x8*)(p + offq); nq1 = *(const bf16x8*)(p + offq + 8); } nv0 = *(const bf16x8*)(p + offv); nv1 = *(const bf16x8*)(p + offv + 8); nf0 = *(const bf16x8*)(p + offf); nf1 = *(const bf16x8*)(p + offf + 8); }
  __syncthreads();
  for (int ci = 0; ci < nchunk; ++ci) {
    const bf16x8 qv[2] = {nq0, nq1}, vv[2] = {nv0, nv1}, fv[2] = {nf0, nf1};
    { const int cn = (ci + 1 < nchunk) ? ci + 1 : ci; const int t2 = tau0 + cn * 64 + tau; const int tok = dir ? (S - 1 - t2) : t2; const bf16_t* p = Ub + (size_t)tok * 2560;
      if (MODE == 3) { nq0 = *(const bf16x8*)(p + offq); nq1 = *(const bf16x8*)(p + offq + 8); } nv0 = *(const bf16x8*)(p + offv); nv1 = *(const bf16x8*)(p + offv + 8); nf0 = *(const bf16x8*)(p + offf); nf1 = *(const bf16x8*)(p + offf + 8); }
    float qq[16], kk[16];
#pragma unroll
    for (int j = 0; j < 16; ++j) {
      const float z = bf2f((unsigned short)fv[j >> 3][j & 7]); const float x = bf2f((unsigned short)qv[j >> 3][j & 7]);
      const float lbv = LB[c0 + j]; const float sg = __builtin_amdgcn_rcpf(1.0f + __expf(-z)); const float f = lbv + (1.0f - lbv) * sg;
      kk[j] = 1.0f - f; qq[j] = (MODE == 3) ? x * __builtin_amdgcn_rcpf(1.0f + __expf(-x)) : 0.f;
      GB[tau * GS + c0 + j] = __logf(f);
    }
    __syncthreads();
    { const int k = tid & 127, seg = tid >> 7; float run = 0.f;
#pragma unroll
      for (int j = 0; j < 16; ++j) { run += GB[(16 * seg + j) * GS + k]; GB[(16 * seg + j) * GS + k] = run; }
      SEG[seg * 128 + k] = run; }
    __syncthreads();
    { unsigned qh[8] = {}, kh[8] = {};
#pragma unroll
      for (int j = 0; j < 16; j += 2) {
        float g2[2], gl2[2];
#pragma unroll
        for (int e = 0; e < 2; ++e) { const int col = c0 + j + e; const float s0 = SEG[col], s1 = SEG[128 + col], s2 = SEG[256 + col];
          const float off = (segt >= 1 ? s0 : 0.f) + (segt >= 2 ? s1 : 0.f) + (segt >= 3 ? s2 : 0.f);
          g2[e] = GB[tau * GS + col] + off; gl2[e] = GB[63 * GS + col] + ((s0 + s1) + s2); }
        if (MODE == 3) { const float ea = __expf(g2[0]), eb = __expf(g2[1]);
          qh[j >> 1] = cvtpk(qq[j] * ea, qq[j + 1] * eb);
          kh[j >> 1] = cvtpk(kk[j] * __expf(fminf(-g2[0], 80.f)), kk[j + 1] * __expf(fminf(-g2[1], 80.f))); }
        const unsigned kt = cvtpk(kk[j] * __expf(gl2[0] - g2[0]), kk[j + 1] * __expf(gl2[1] - g2[1]));
        *(bf16_t*)(KT + SWZ128(c0 + j, 2 * tau)) = (bf16_t)(kt & 0xffffu); *(bf16_t*)(KT + SWZ128(c0 + j + 1, 2 * tau)) = (bf16_t)(kt >> 16);
        *(bf16_t*)(VT + SWZ128(c0 + j, 2 * tau)) = (bf16_t)vv[j >> 3][j & 7]; *(bf16_t*)(VT + SWZ128(c0 + j + 1, 2 * tau)) = (bf16_t)vv[(j + 1) >> 3][(j + 1) & 7];
        if (tau == 63) { DD[c0 + j] = __expf(gl2[0]); DD[c0 + j + 1] = __expf(gl2[1]); }
      }
      if (MODE == 3) {
      *(u32x4*)(QH + SWZ256(tau, 2 * c0)) = (u32x4){qh[0], qh[1], qh[2], qh[3]}; *(u32x4*)(QH + SWZ256(tau, 2 * c0 + 16)) = (u32x4){qh[4], qh[5], qh[6], qh[7]};
      *(u32x4*)(KH + SWZ256(tau, 2 * c0)) = (u32x4){kh[0], kh[1], kh[2], kh[3]}; *(u32x4*)(KH + SWZ256(tau, 2 * c0 + 16)) = (u32x4){kh[4], kh[5], kh[6], kh[7]}; }
    }
    __syncthreads();
    if (MODE == 3 && wid < 4 && wid != 1) { const int ti = wid >> 1, si = wid & 1; f32x16 a = f32x16{};
#pragma unroll
      for (int k8 = 0; k8 < 8; ++k8) { const int cb = (16 * k8 + 8 * hi) * 2;
        const bf16x8 av = *(const bf16x8*)(QH + SWZ256(32 * ti + r32, cb)); const bf16x8 bv = *(const bf16x8*)(KH + SWZ256(32 * si + r32, cb));
        a = __builtin_amdgcn_mfma_f32_32x32x16_bf16(av, bv, a, 0, 0, 0); }
#pragma unroll
      for (int r = 0; r < 16; ++r) { const int tl = 32 * ti + crow(r, hi), sl = 32 * si + r32; const float val = (sl <= tl) ? a[r] : 0.f;
        *(bf16_t*)(AL + SWZ128(tl, 2 * sl)) = (bf16_t)(cvtpk(val, 0.f) & 0xffffu); } }
    if (MODE == 3) __syncthreads();
    { const int th = wid >> 2, vb = wid & 3;
      if (MODE == 3) { f32x16 o = f32x16{};
      const int nks = th ? 4 : 2;
      for (int ks = 0; ks < nks; ++ks) { const int cb = (16 * ks + 8 * hi) * 2;
        const bf16x8 av = *(const bf16x8*)(AL + SWZ128(32 * th + r32, cb)); const bf16x8 bv = *(const bf16x8*)(VT + SWZ128(32 * vb + r32, cb));
        o = __builtin_amdgcn_mfma_f32_32x32x16_bf16(av, bv, o, 0, 0, 0); }
#pragma unroll
      for (int k8 = 0; k8 < 8; ++k8) { const int cb = (16 * k8 + 8 * hi) * 2;
        const bf16x8 av = *(const bf16x8*)(QH + SWZ256(32 * th + r32, cb)); const bf16x8 bv = *(const bf16x8*)(ST + SWZ256(32 * vb + r32, cb));
        o = __builtin_amdgcn_mfma_f32_32x32x16_bf16(av, bv, o, 0, 0, 0); }
#pragma unroll
      for (int r = 0; r < 16; ++r) { const int t2 = tau0 + ci * 64 + 32 * th + crow(r, hi); const int tok = dir ? (S - 1 - t2) : t2;
        OPd[(size_t)(rowbase + tok) * 512 + h * 128 + 32 * vb + r32] = o[r]; }
      } else { if (tid < 128) dseg *= DD[tid]; }
#pragma unroll
      for (int i = 0; i < 2; ++i) { const int kb = 2 * th + i; const float dk = DD[32 * kb + r32];
#pragma unroll
        for (int r = 0; r < 16; ++r) sacc[i][r] *= dk;
#pragma unroll
        for (int ks = 0; ks < 4; ++ks) { const int cb = (16 * ks + 8 * hi) * 2;
          const bf16x8 av = *(const bf16x8*)(VT + SWZ128(32 * vb + r32, cb)); const bf16x8 bv = *(const bf16x8*)(KT + SWZ128(32 * kb + r32, cb));
          sacc[i] = __builtin_amdgcn_mfma_f32_32x32x16_bf16(av, bv, sacc[i], 0, 0, 0); } }
    }
    __syncthreads();
    if (MODE == 3) { const int th = wid >> 2, vb = wid & 3;
#pragma unroll
      for (int i = 0; i < 2; ++i) { const int kb = 2 * th + i;
#pragma unroll
        for (int r = 0; r < 16; ++r) *(bf16_t*)(ST + SWZ256(32 * vb + crow(r, hi), 2 * (32 * kb + r32))) = (bf16_t)(cvtpk(sacc[i][r], 0.f) & 0xffffu); } }
  }
  if (MODE == 1) {
#pragma unroll
    for (int i = 0; i < 2; ++i)
#pragma unroll
      for (int r = 0; r < 16; ++r) slot_out[(32 * (wid & 3) + crow(r, hi)) * 128 + 32 * (2 * (wid >> 2) + i) + r32] = sacc[i][r];
    if (tid < 128) dseg_out[tid] = dseg;
  }
  __syncthreads();
}
#undef SWZ256
#undef SWZ128
}
typedef unsigned short bf16_t;
typedef float f32x4 __attribute__((ext_vector_type(4)));
typedef unsigned u32x4 __attribute__((ext_vector_type(4)));
typedef unsigned u32x2 __attribute__((ext_vector_type(2)));
typedef short bf16x8 __attribute__((ext_vector_type(8)));
#define LAS __attribute__((address_space(3)))
constexpr size_t MiB = 1u << 20;
constexpr size_t WS_SS = 0;
constexpr size_t WS_ROPEC = 4 * MiB, WS_ROPES = 5 * MiB;
constexpr size_t WS_W1GU = 16 * MiB, WS_W1D = 27 * MiB, WS_WIN = 33 * MiB, WS_WUQ = 40 * MiB, WS_WUKV = 41 * MiB, WS_WO = 42 * MiB, WS_W2GU = 44 * MiB, WS_W2D = 55 * MiB, WS_WPG = 61 * MiB, WS_WPP = 63 * MiB;
constexpr size_t WS_HB = 64 * MiB;
constexpr size_t WS_BIG = 256 * MiB;
constexpr size_t WS_UHG = WS_BIG, WS_UMLA = WS_BIG + 480 * MiB, WS_MIX = WS_BIG + 480 * MiB, WS_ACT = WS_BIG, WS_PROJ = WS_BIG;
constexpr size_t WS_PB = 928 * MiB;
constexpr size_t WS_SLOT = 976 * MiB;
constexpr size_t WS_DSEG = 8 * MiB;
constexpr size_t WS_END = 1024 * MiB;
constexpr size_t DO_Q = 0, DO_KN = 144 * MiB, DO_V = 240 * MiB, DO_KR = 336 * MiB;
constexpr int LDS_BYTES = 147456;
constexpr int LDS_BARST = 147392;
constexpr size_t WS_BAR = 12 * MiB;
#define XB_TMO      128
#define XB_XCNT(j)  (256  + 64 * (j))
#define XB_XSUB(j)  (1280 + 64 * (j))
#define XB_XGEN(j)  (2304 + 64 * (j))
#define XB_TOP      3328
#define XB_TOPGEN   3392
#define XCD_BAR_WORDS 3456
#define XB_SPIN_CAP (1u << 18)

__device__ __forceinline__ unsigned xb_ld(unsigned* p)              { return __hip_atomic_load(p, __ATOMIC_RELAXED, __HIP_MEMORY_SCOPE_AGENT); }
__device__ __forceinline__ unsigned xb_add(unsigned* p, unsigned v) { return __hip_atomic_fetch_add(p, v, __ATOMIC_RELAXED, __HIP_MEMORY_SCOPE_AGENT); }
__device__ __forceinline__ unsigned xb_xcc_id() { return (unsigned)__builtin_amdgcn_s_getreg((3 << 11) | 20) & 0xFu; }
#define XB_SPIN(cond, bar) do { unsigned _sp = 0; while (cond) { __builtin_amdgcn_s_sleep(1); \
    if ((++_sp & 255u) == 0u) { if (xb_ld(&(bar)[XB_TMO])) break; if (_sp > XB_SPIN_CAP) { atomicAdd(&(bar)[XB_TMO], 1u); break; } } } } while (0)

struct XcdBarrier {
    unsigned* bar; unsigned x;
    volatile LAS unsigned* st;
};

__device__ __forceinline__ XcdBarrier xcd_barrier_post(unsigned* bar, volatile LAS unsigned* st) {
    XcdBarrier b; b.bar = bar; b.x = xb_xcc_id(); b.st = st;
    if (threadIdx.x == 0) (void)xb_add(&bar[XB_XCNT(b.x)], 1u);
    return b;
}
__device__ __forceinline__ void xcd_barrier_complete(unsigned* bar, unsigned x, unsigned& nloc, unsigned& nx) {
    const unsigned G = gridDim.x * gridDim.y * gridDim.z;
    unsigned sum, cnt, mine, sp = 0u;
    for (;;) {
        sum = 0u; cnt = 0u; mine = 0u;
#pragma unroll
        for (unsigned j = 0; j < 16; ++j) { const unsigned c = xb_ld(&bar[XB_XCNT(j)]); sum += c; cnt += (c > 0u) ? 1u : 0u; mine = (j == x) ? c : mine; }
        if (sum == G) break;
        __builtin_amdgcn_s_sleep(1);
        if ((++sp & 255u) == 0u) { if (xb_ld(&bar[XB_TMO])) break; if (sp > XB_SPIN_CAP) { atomicAdd(&bar[XB_TMO], 1u); break; } }
    }
    nloc = mine > 0u ? mine : 1u; nx = cnt > 0u ? cnt : 1u;
}

__device__ __forceinline__ void xcd_barrier(const XcdBarrier& b) {
    asm volatile("s_waitcnt vmcnt(0)" ::: "memory");
    __syncthreads();
    if (threadIdx.x == 0) {
        unsigned* bar = b.bar;
        __builtin_amdgcn_s_waitcnt(0);
        unsigned nloc = b.st[0], nx = b.st[1];
        if (nloc == 0u) { xcd_barrier_complete(bar, b.x, nloc, nx); b.st[0] = nloc; b.st[1] = nx; }
        const unsigned old = xb_add(&bar[XB_XSUB(b.x)], 1u);
        const unsigned gen = old / nloc;
        if (old + 1u == (gen + 1u) * nloc) {
            __builtin_amdgcn_fence(__ATOMIC_RELEASE, "agent");
            asm volatile("s_waitcnt vmcnt(0)" ::: "memory");
            const unsigned og = xb_add(&bar[XB_TOP], 1u);
            const unsigned tg = og / nx;
            if (og + 1u == (tg + 1u) * nx) xb_add(&bar[XB_TOPGEN], 1u);
            else XB_SPIN(xb_ld(&bar[XB_TOPGEN]) == tg, bar);
            __builtin_amdgcn_fence(__ATOMIC_ACQUIRE, "agent");
            xb_add(&bar[XB_XGEN(b.x)], 1u);
            asm volatile("s_waitcnt vmcnt(0)" ::: "memory");
        } else {
            XB_SPIN(xb_ld(&bar[XB_XGEN(b.x)]) == gen, bar);
            __builtin_amdgcn_fence(__ATOMIC_ACQUIRE, "agent");
            asm volatile("s_waitcnt vmcnt(0)" ::: "memory");
        }
    }
    __syncthreads();
}


struct Params {
  const float* in[26];
  float* out; unsigned char* ws;
};

__device__ __forceinline__ unsigned f2bf(float f) { unsigned u = __builtin_bit_cast(unsigned, f); return (u + 0x7fffu + ((u >> 16) & 1u)) >> 16; }
__device__ __forceinline__ unsigned pk2(float lo, float hi) { return f2bf(lo) | (f2bf(hi) << 16); }
__device__ __forceinline__ float wave_sum(float v) {
#pragma unroll
  for (int o = 1; o < 64; o <<= 1) v += __shfl_xor(v, o);
  return v;
}
__device__ __forceinline__ void prep_item(const float* W, int ld, int col0, const float* fold, bf16_t* WT, int K, int n0, int k0, float* scr, int lane) {
#pragma unroll 8
  for (int i = 0; i < 32; ++i) { const int kk = 2 * i + (lane >> 5); float v = 0.f; if (W) { v = W[(size_t)(k0 + kk) * ld + col0 + (lane & 31)]; if (fold) v *= fold[k0 + kk]; } scr[kk * 33 + (lane & 31)] = v; }
  asm volatile("s_waitcnt lgkmcnt(0)" ::: "memory");
  const int c = lane & 7;
#pragma unroll
  for (int j = 0; j < 4; ++j) { const int n = (lane >> 3) + 8 * j; const float* s = scr + (8 * c) * 33 + n;
    u32x4 o; o.x = pk2(s[0 * 33], s[1 * 33]); o.y = pk2(s[2 * 33], s[3 * 33]); o.z = pk2(s[4 * 33], s[5 * 33]); o.w = pk2(s[6 * 33], s[7 * 33]);
    *(u32x4*)(WT + (size_t)(n0 + n) * K + k0 + 8 * c) = o; }
  asm volatile("s_waitcnt lgkmcnt(0)" ::: "memory");
}
__device__ __forceinline__ void sincos_d(double x, float& s, float& c) {
  const double TWO_PI = 6.283185307179586476925286766559, INV_2PI = 0.15915494309189533576888376337251;
  double k = __builtin_rint(x * INV_2PI); double r = x - k * TWO_PI;
  const double HALF_PI = 1.5707963267948966192313216916398;
  double q = __builtin_rint(r * 0.63661977236758134308); double y = r - q * HALF_PI; int qi = ((int)q) & 3;
  double y2 = y * y;
  double sp = y * (1.0 + y2 * (-1.0 / 6 + y2 * (1.0 / 120 + y2 * (-1.0 / 5040 + y2 * (1.0 / 362880 + y2 * (-1.0 / 39916800 + y2 * (1.0 / 6227020800.0)))))));
  double cp = 1.0 + y2 * (-0.5 + y2 * (1.0 / 24 + y2 * (-1.0 / 720 + y2 * (1.0 / 40320 + y2 * (-1.0 / 3628800 + y2 * (1.0 / 479001600.0 + y2 * (-1.0 / 87178291200.0)))))));
  double ss, cc;
  if (qi == 0) { ss = sp; cc = cp; } else if (qi == 1) { ss = cp; cc = -sp; } else if (qi == 2) { ss = -sp; cc = -cp; } else { ss = -cp; cc = sp; }
  s = (float)ss; c = (float)cc;
}

__device__ __forceinline__ void p0_prologue(const Params& P, unsigned char* ws, char* lds) {
  int tid_ = threadIdx.x; asm volatile("" : "+v"(tid_)); const int tid = tid_, lane = tid & 63, wave = tid >> 6;
  const int gw = blockIdx.x * 8 + wave, NGW = gridDim.x * 8;
  float* scr = (float*)(lds + wave * 16384);
  constexpr int NJ = 10;
  const int jN[NJ] = {NGU, 1024, NIN, 768, 1024, 1024, NGU, 1024, 1024, 1024};
  const int jK[NJ] = {1024, DFF, 1024, 384, 256, 1024, 1024, DFF, 1024, 256};
  int total = 0;
#pragma unroll
  for (int j = 0; j < NJ; ++j) total += (jN[j] / 32) * (jK[j] / 64);
  for (int it = gw; it < total; it += NGW) {
    int r = it, job = 0;
#pragma unroll
    for (int j = 0; j < NJ; ++j) { const int cnt = (jN[j] / 32) * (jK[j] / 64); if (job == j && r >= cnt) { r -= cnt; job = j + 1; } }
    int N = 0, K = 0;
#pragma unroll
    for (int j = 0; j < NJ; ++j) if (job == j) { N = jN[j]; K = jK[j]; }
    const int nblk = N / 32, kb = r / nblk, nb = r % nblk, k0 = 64 * kb, n0 = 32 * nb;
    const float* W = nullptr; int ld = 0, col0 = 0; const float* fold = nullptr; bf16_t* WT = nullptr;
    if (job == 0 || job == 6) { const int t = n0 >> 8, half = (n0 >> 7) & 1, j0 = n0 & 127; const int b = (job == 0) ? 5 : 19;
      W = P.in[b + half]; ld = DFF; col0 = 128 * t + j0; fold = P.in[(job == 0) ? 4 : 18]; WT = (bf16_t*)(ws + ((job == 0) ? WS_W1GU : WS_W2GU)); }
    else if (job == 1 || job == 7) { W = P.in[(job == 1) ? 7 : 21]; ld = 1024; col0 = n0; WT = (bf16_t*)(ws + ((job == 1) ? WS_W1D : WS_W2D)); }
    else if (job == 2) { ld = 3232; fold = P.in[8]; WT = (bf16_t*)(ws + WS_WIN); W = P.in[9];
      if (n0 < 384) col0 = n0; else if (n0 < 416) col0 = 640 + (n0 - 384); else if (n0 < 512) W = nullptr; else if (n0 < 768) col0 = 384 + (n0 - 512); else col0 = 672 + (n0 - 768); }
    else if (job == 3) { W = P.in[11]; ld = 768; col0 = n0; fold = P.in[10]; WT = (bf16_t*)(ws + WS_WUQ); }
    else if (job == 4) { if (n0 < 512) { W = P.in[13]; col0 = n0; } else { W = P.in[14]; col0 = n0 - 512; } ld = 512; fold = P.in[12]; WT = (bf16_t*)(ws + WS_WUKV); }
    else if (job == 5) { W = P.in[17]; ld = 1024; col0 = n0; WT = (bf16_t*)(ws + WS_WO); }
    else if (job == 8) { W = P.in[23]; ld = 1024; col0 = n0; fold = P.in[22]; WT = (bf16_t*)(ws + WS_WPG); }
    else { W = P.in[24]; ld = 1024; col0 = n0; WT = (bf16_t*)(ws + WS_WPP); }
    prep_item(W, ld, col0, fold, WT, K, n0, k0, scr, lane);
  }
  float* ss = (float*)(ws + WS_SS); bf16_t* HB = (bf16_t*)(ws + WS_HB); bf16_t* PB = (bf16_t*)(ws + WS_PB);
  for (int m = gw; m < T_ALL; m += NGW) {
    const float* xr = (m < T_P) ? P.in[0] + (size_t)m * DM : P.in[1] + (size_t)(m - T_P) * DM;
    const f32x4* x4 = (const f32x4*)xr + lane; float s = 0.f; f32x4 v[4];
#pragma unroll
    for (int j = 0; j < 4; ++j) { v[j] = x4[64 * j]; s += (v[j][0] * v[j][0] + v[j][1] * v[j][1]) + (v[j][2] * v[j][2] + v[j][3] * v[j][3]); }
    s = wave_sum(s);
    u32x2* o8 = (u32x2*)(HB + (size_t)m * DM) + lane;
#pragma unroll
    for (int j = 0; j < 4; ++j) { u32x2 w; w.x = pk2(v[j][0], v[j][1]); w.y = pk2(v[j][2], v[j][3]); o8[64 * j] = w; }
    const float* pr = (m < T_P) ? P.in[2] + (size_t)m * PLE : P.in[3] + (size_t)(m - T_P) * PLE;
    const f32x4 pv = ((const f32x4*)pr)[lane]; u32x2 w; w.x = pk2(pv[0], pv[1]); w.y = pk2(pv[2], pv[3]); ((u32x2*)(PB + (size_t)m * PLE))[lane] = w;
    if (lane < 7) ss[(size_t)lane * T_ALL + m] = (lane == 0) ? s : 0.f;
  }
  float* rc = (float*)(ws + WS_ROPEC); float* rs = (float*)(ws + WS_ROPES);
  for (int e = blockIdx.x * 512 + tid; e < S_P * 16; e += gridDim.x * 512) {
    const int pos = e >> 4, i = e & 15;
    const float cst = (float)(-9.210340371976184 / 32.0); const float arg = (float)(2 * i) * cst;
    const double a = (double)arg; const double nn = __builtin_rint(a * 1.4426950408889634); const double rr = a - nn * 0.69314718055994530942;
    double ex = 1.0 + rr * (1.0 + rr * (0.5 + rr * (1.0 / 6 + rr * (1.0 / 24 + rr * (1.0 / 120 + rr * (1.0 / 720 + rr * (1.0 / 5040 + rr * (1.0 / 40320 + rr * (1.0 / 362880 + rr * (1.0 / 3628800 + rr * (1.0 / 39916800)))))))))));
    ex = ex * __builtin_ldexp(1.0, (int)nn);
    const float invf = (float)ex; const float ang = (float)pos * invf;
    float sv, cv; sincos_d((double)ang, sv, cv); rc[e] = cv; rs[e] = sv;
  }
}
__device__ __forceinline__ void hg_combine(const float* OP, const bf16_t* U, const float* hg_norm, bf16_t* MIX) {
  int tid_ = threadIdx.x; asm volatile("" : "+v"(tid_)); const int lane = tid_ & 63, wave = tid_ >> 6; const int gw = blockIdx.x * 8 + wave, NGW = gridDim.x * 8;
  f32x4 gn0 = *(const f32x4*)(hg_norm + 8 * lane), gn1 = *(const f32x4*)(hg_norm + 8 * lane + 4);
  for (int m = gw; m < T_ALL; m += NGW) {
    const float* a = OP + (size_t)m * 512 + 8 * lane; const float* b = a + (size_t)T_ALL * 512;
    f32x4 o0 = *(const f32x4*)a + *(const f32x4*)b, o1 = *(const f32x4*)(a + 4) + *(const f32x4*)(b + 4);
    float s = (o0[0] * o0[0] + o0[1] * o0[1]) + (o0[2] * o0[2] + o0[3] * o0[3]) + (o1[0] * o1[0] + o1[1] * o1[1]) + (o1[2] * o1[2] + o1[3] * o1[3]);
    s += __shfl_xor(s, 1); s += __shfl_xor(s, 2); s += __shfl_xor(s, 4); s += __shfl_xor(s, 8);
    const float r = rsqrtf(s * (1.0f / 128.0f) + EPS);
    const bf16x8 g = *(const bf16x8*)(U + (size_t)m * 2560 + 2048 + 8 * lane);
    float ov[8] = {o0[0], o0[1], o0[2], o0[3], o1[0], o1[1], o1[2], o1[3]}; float gnv[8] = {gn0[0], gn0[1], gn0[2], gn0[3], gn1[0], gn1[1], gn1[2], gn1[3]};
    unsigned w[4];
#pragma unroll
    for (int j = 0; j < 8; j += 2) { float r2[2];
#pragma unroll
      for (int e = 0; e < 2; ++e) { const float x = __uint_as_float(((unsigned)(unsigned short)g[j + e]) << 16); const float sl = x * __builtin_amdgcn_rcpf(1.0f + __expf(-x)); r2[e] = ov[j + e] * r * gnv[j + e] * sl; }
      w[j >> 1] = pk2(r2[0], r2[1]); }
    *(u32x4*)(MIX + (size_t)m * 1024 + 512 + 8 * lane) = (u32x4){w[0], w[1], w[2], w[3]};
  }
}
__device__ __forceinline__ void final_norm(float* out, const bf16_t* h4, const float* ss4, const float* fn) {
  int tid_ = threadIdx.x; asm volatile("" : "+v"(tid_)); const int lane = tid_ & 63, wave = tid_ >> 6; const int gw = blockIdx.x * 8 + wave, NGW = gridDim.x * 8;
  f32x4 g[2][2];
#pragma unroll
  for (int j = 0; j < 2; ++j) { g[j][0] = *(const f32x4*)(fn + 512 * j + 8 * lane); g[j][1] = *(const f32x4*)(fn + 512 * j + 8 * lane + 4); }
  for (int m = gw; m < T_ALL; m += NGW) {
    const float r = rsqrtf(ss4[m] * (1.0f / 1024.0f) + EPS);
#pragma unroll
    for (int j = 0; j < 2; ++j) { const u32x4 h = *(const u32x4*)(h4 + (size_t)m * DM + 512 * j + 8 * lane);
      f32x4 a, b; a[0] = __uint_as_float(h.x << 16); a[1] = __uint_as_float(h.x & 0xffff0000u); a[2] = __uint_as_float(h.y << 16); a[3] = __uint_as_float(h.y & 0xffff0000u);
      b[0] = __uint_as_float(h.z << 16); b[1] = __uint_as_float(h.z & 0xffff0000u); b[2] = __uint_as_float(h.w << 16); b[3] = __uint_as_float(h.w & 0xffff0000u);
      float* o = out + (size_t)m * DM + 512 * j + 8 * lane; *(f32x4*)o = a * r * g[j][0]; *(f32x4*)(o + 4) = b * r * g[j][1]; }
  }
}

#define GSYNC() xcd_barrier(xbar)

template <class Epi> __device__ __forceinline__ void run_gemm(LAS unsigned char* lds, const bf16_t* A, int lda, const bf16_t* Bt, int ldb, int N, int K, const Epi& E) {
  pg8::Gemm g{A, Bt, T_ALL, N, K, lda, ldb}; pg8::StaticOrder S; S.init(T_ALL, N, (int)gridDim.x, (int)blockIdx.x);
  pg8::gemm_phase<Epi, pg8::StaticOrder, true, true>(lds, g, S, E);
}

__global__ void __launch_bounds__(512, 2) mk_fwd(Params P) {
  extern __shared__ __attribute__((aligned(16))) unsigned char lds[];
  unsigned char* ws = P.ws; float* out = P.out; unsigned char* dob = (unsigned char*)P.out;
  LAS unsigned char* l3 = (LAS unsigned char*)lds;
  float* ss = (float*)(ws + WS_SS);
  float* ss0 = ss, *ss1 = ss + T_ALL, *ss2 = ss + 2 * (size_t)T_ALL, *ss3 = ss + 3 * (size_t)T_ALL, *ss4 = ss + 4 * (size_t)T_ALL, *ssq = ss + 5 * (size_t)T_ALL, *sskv = ss + 6 * (size_t)T_ALL;
  const float* ropec = (const float*)(ws + WS_ROPEC); const float* ropes = (const float*)(ws + WS_ROPES);
  bf16_t* HB = (bf16_t*)(ws + WS_HB); bf16_t* ACT = (bf16_t*)(ws + WS_ACT); bf16_t* UHG = (bf16_t*)(ws + WS_UHG); bf16_t* UMLA = (bf16_t*)(ws + WS_UMLA);
  bf16_t* MIX = (bf16_t*)(ws + WS_MIX); bf16_t* H4B = (bf16_t*)(ws + WS_MIX);     bf16_t* PROJ = (bf16_t*)(ws + WS_PROJ); bf16_t* PB = (bf16_t*)(ws + WS_PB);
  bf16_t* Qb = (bf16_t*)(dob + DO_Q); bf16_t* KN = (bf16_t*)(dob + DO_KN); bf16_t* Vb = (bf16_t*)(dob + DO_V); bf16_t* KR = (bf16_t*)(dob + DO_KR);

  if (threadIdx.x < 16) ((LAS unsigned*)(l3 + LDS_BARST))[threadIdx.x] = 0u;
  if (blockIdx.x == 0) { for (int i = threadIdx.x; i < XCD_BAR_WORDS; i += 512) __hip_atomic_store((unsigned*)(ws + WS_BAR) + i, 0u, __ATOMIC_RELAXED, __HIP_MEMORY_SCOPE_AGENT); }
  p0_prologue(P, ws, (char*)lds);
  cg::this_grid().sync();
  const XcdBarrier xbar = xcd_barrier_post((unsigned*)(ws + WS_BAR), (volatile LAS unsigned*)(l3 + LDS_BARST));
  { pg8::EpiSwiGLU E{ACT, ss0}; run_gemm(l3, HB, 1024, (const bf16_t*)(ws + WS_W1GU), 1024, NGU, 1024, E); }
  GSYNC();
  { pg8::EpiRes<2> E{nullptr, nullptr, HB, nullptr, ss1, nullptr, nullptr}; run_gemm(l3, ACT, DFF, (const bf16_t*)(ws + WS_W1D), DFF, 1024, DFF, E); }
  GSYNC();
  { pg8::EpiWin E{UMLA, UHG, KR, ss1, ssq, sskv, ropec, ropes}; run_gemm(l3, HB, 1024, (const bf16_t*)(ws + WS_WIN), 1024, NIN, 1024, E); }
  GSYNC();
  { pg8::EpiBf E{Qb, Qb, 768, 1000, ssq, 1.0f / 384.0f, att::SCALE * 1.4426950408889634f}; run_gemm(l3, UMLA, 768, (const bf16_t*)(ws + WS_WUQ), 384, 768, 384, E); }
  { pg8::EpiBf E{KN, Vb, 512, 2, sskv, 1.0f / 256.0f, 1.0f}; run_gemm(l3, UMLA + 512, 768, (const bf16_t*)(ws + WS_WUKV), 256, 1024, 256, E); }
  GSYNC();
  {
    const int G = gridDim.x, bx = blockIdx.x;
    if (G == 256) {
      const int xcd = bx & 7, idx = bx >> 3;
      for (int i = 0; i < 12; ++i) {
        int rowbase, seq, h, qb;
        if (i < 4) { const int pair = 2 * xcd + (i >> 1); const int b = pair >> 3; h = pair & 7; qb = idx * 2 + (i & 1); rowbase = b * S_P; seq = S_P; }
        else { const int j = i - 4; const int pair = 16 * xcd + 2 * j + (idx >> 4); const int b = pair >> 3; h = pair & 7; qb = idx & 15; rowbase = T_P + b * S_S; seq = S_S; }
        att::attn_unit(Qb + (size_t)(rowbase + qb * 256) * 768 + h * 96, KN + (size_t)rowbase * 512 + h * 64, KR + (size_t)rowbase * 32, Vb + (size_t)rowbase * 512 + h * 64,
                       MIX + (size_t)(rowbase + qb * 256) * 1024 + h * 64, seq, rowbase + qb * 256, ropec, ropes, (char*)lds);
      }
    } else {
      for (int u = bx; u < 3072; u += G) {
        int rowbase, seq, h, qb;
        if (u < 1024) { const int pair = u >> 6; const int b = pair >> 3; h = pair & 7; qb = u & 63; rowbase = b * S_P; seq = S_P; }
        else { const int v = u - 1024; const int pair = v >> 4; const int b = pair >> 3; h = pair & 7; qb = v & 15; rowbase = T_P + b * S_S; seq = S_S; }
        att::attn_unit(Qb + (size_t)(rowbase + qb * 256) * 768 + h * 96, KN + (size_t)rowbase * 512 + h * 64, KR + (size_t)rowbase * 32, Vb + (size_t)rowbase * 512 + h * 64,
                       MIX + (size_t)(rowbase + qb * 256) * 1024 + h * 64, seq, rowbase + qb * 256, ropec, ropes, (char*)lds);
      }
    }
  }
  GSYNC();
  {
    float* SLOT = (float*)(ws + WS_SLOT); float* DSEG = (float*)(ws + WS_DSEG);
    for (int u = blockIdx.x; u < 768; u += gridDim.x) {
      int chainid, seg, nseg;
      if (u < 256) { chainid = u >> 4; seg = u & 15; nseg = 16; } else { const int u2 = u - 256; chainid = 16 + (u2 >> 2); seg = u2 & 3; nseg = 4; }
      if (seg == nseg - 1) continue;
      int rowbase, S, h, dir;
      if (chainid < 16) { const int b = chainid >> 3; h = (chainid >> 1) & 3; dir = chainid & 1; rowbase = b * S_P; S = S_P; }
      else { const int c2 = chainid - 16; const int b = c2 >> 3; h = (c2 >> 1) & 3; dir = c2 & 1; rowbase = T_P + b * S_S; S = S_S; }
      hg::chain<1>(UHG, out, P.in[15], rowbase, S, h, dir, seg * 1024, 16, nullptr, SLOT + (size_t)u * 16384, DSEG + (size_t)u * 128, (char*)lds);
    }
  }
  GSYNC();
  {
    float* SLOT = (float*)(ws + WS_SLOT); const float* DSEG = (const float*)(ws + WS_DSEG);
    int tid_ = threadIdx.x; asm volatile("" : "+v"(tid_));
    for (int e = blockIdx.x * 512 + tid_; e < 144 * 16384; e += gridDim.x * 512) {
      const int chainid = e >> 14, el = e & 16383, k = el & 127;
      int u0, nseg; if (chainid < 16) { u0 = chainid * 16; nseg = 16; } else { u0 = 256 + (chainid - 16) * 4; nseg = 4; }
      float Sv = 0.f;
      for (int s = 1; s < nseg; ++s) { float* sl = SLOT + (size_t)(u0 + s - 1) * 16384 + el; Sv = DSEG[(size_t)(u0 + s - 1) * 128 + k] * Sv + *sl; *sl = Sv; }
    }
  }
  GSYNC();
  {
    const float* SLOT = (const float*)(ws + WS_SLOT);
    for (int u = blockIdx.x; u < 768; u += gridDim.x) {
      int chainid, seg;
      if (u < 256) { chainid = u >> 4; seg = u & 15; } else { const int u2 = u - 256; chainid = 16 + (u2 >> 2); seg = u2 & 3; }
      int rowbase, S, h, dir;
      if (chainid < 16) { const int b = chainid >> 3; h = (chainid >> 1) & 3; dir = chainid & 1; rowbase = b * S_P; S = S_P; }
      else { const int c2 = chainid - 16; const int b = c2 >> 3; h = (c2 >> 1) & 3; dir = c2 & 1; rowbase = T_P + b * S_S; S = S_S; }
      hg::chain<3>(UHG, out, P.in[15], rowbase, S, h, dir, seg * 1024, 16, seg ? SLOT + (size_t)(u - 1) * 16384 : nullptr, nullptr, nullptr, (char*)lds);
    }
  }
  GSYNC();
  hg_combine(out, UHG, P.in[16], MIX);
  GSYNC();
  { pg8::EpiRes<1> E{nullptr, nullptr, HB, nullptr, ss2, nullptr, nullptr}; run_gemm(l3, MIX, 1024, (const bf16_t*)(ws + WS_WO), 1024, 1024, 1024, E); }
  GSYNC();
  { pg8::EpiSwiGLU E{ACT, ss2}; run_gemm(l3, HB, 1024, (const bf16_t*)(ws + WS_W2GU), 1024, NGU, 1024, E); }
  GSYNC();
  { pg8::EpiRes<2> E{nullptr, nullptr, HB, nullptr, ss3, nullptr, nullptr}; run_gemm(l3, ACT, DFF, (const bf16_t*)(ws + WS_W2D), DFF, 1024, DFF, E); }
  GSYNC();
  { pg8::EpiBf E{PROJ, PROJ, 1024, 1000, nullptr, 0.f, 1.0f}; run_gemm(l3, PB, 256, (const bf16_t*)(ws + WS_WPP), 256, 1024, 256, E); }
  GSYNC();
  { pg8::EpiRes<3> E{nullptr, nullptr, HB, H4B, ss4, ss3, PROJ}; run_gemm(l3, HB, 1024, (const bf16_t*)(ws + WS_WPG), 1024, 1024, 1024, E); }
  GSYNC();
  final_norm(out, H4B, ss4, P.in[25]);
}

extern "C" void kernel_launch(void* const* d_in, const int* in_sizes, int n_in, void* d_out, int out_size, void* d_ws, size_t ws_size, hipStream_t stream) {
  static int grid = 0;
  if (grid == 0) {
    if (n_in != 26 || out_size != T_ALL * DM || ws_size < WS_END) { fprintf(stderr, "kernel_launch: unexpected shapes n_in %d out %d ws %zu\n", n_in, out_size, ws_size); grid = -1; return; }
    int dev = 0, cus = 0, per_cu = 0;
    if (hipGetDevice(&dev) != hipSuccess || hipDeviceGetAttribute(&cus, hipDeviceAttributeMultiprocessorCount, dev) != hipSuccess) { grid = -1; return; }
    if (hipFuncSetAttribute((const void*)mk_fwd, hipFuncAttributeMaxDynamicSharedMemorySize, LDS_BYTES) != hipSuccess) { fprintf(stderr, "kernel_launch: LDS attribute failed\n"); grid = -1; return; }
    if (hipOccupancyMaxActiveBlocksPerMultiprocessor(&per_cu, (const void*)mk_fwd, 512, LDS_BYTES) != hipSuccess || per_cu < 1) { fprintf(stderr, "kernel_launch: occupancy query says %d\n", per_cu); per_cu = 1; }
    (void)hipGetLastError();
    grid = cus;
  }
  if (grid < 0) return;
  Params p{};
  for (int i = 0; i < 26; ++i) p.in[i] = (const float*)d_in[i];
  p.out = (float*)d_out; p.ws = (unsigned char*)d_ws;
  void* args[] = {&p};
  hipError_t e = hipLaunchCooperativeKernel((void*)mk_fwd, dim3(grid), dim3(512), args, LDS_BYTES, stream);
  if (e != hipSuccess) fprintf(stderr, "cooperative launch failed: %s (grid %d)\n", hipGetErrorString(e), grid);
}
```

```cpp
#include <hip/hip_runtime.h>
#include <hip/hip_cooperative_groups.h>
#include <cstdio>
#include <cstdint>
namespace cg = cooperative_groups;

constexpr int DM = 1024, T_P = 32768, T_ALL = 98304, S_P = 16384, S_S = 4096;
constexpr int DFF = 2816, NGU = 5632, NIN = 3328, NMLA = 768, NHG = 2560, PLE = 256;
constexpr float EPS = 1e-6f;
__device__ __forceinline__ int row_pos(int row) { return row < T_P ? (row & (S_P - 1)) : (row & (S_S - 1)); }

namespace pg8 {
#define PG8_LAS __attribute__((address_space(3)))
typedef unsigned short bf16_t;
typedef short bf16x8 __attribute__((ext_vector_type(8)));
typedef float f32x4 __attribute__((ext_vector_type(4)));
typedef unsigned u32x4 __attribute__((ext_vector_type(4)));
constexpr int BM = 256, BK = 64, HALF = 128, HTB = HALF * BK * 2  , STAGE_BYTES = 8 * HTB, NXCD = 8, WGM = 8;

__host__ __device__ __forceinline__ int lds_byte(int r, int c) { const int st = (r >> 4) * 2 + (c >> 5), rr = r & 15, cc = c & 31, ob = rr * 64 + cc * 2; return st * 1024 + (ob ^ (((ob >> 9) & 1) << 5)); }
__host__ __device__ __forceinline__ void stage_rc(int b, int& R, int& C) { const int st = b / 1024, sb = b % 1024, swz = sb ^ (((sb >> 9) & 1) << 5); R = (st >> 1) * 16 + swz / 64; C = (st & 1) * 32 + (swz % 64) / 2; }
__host__ __device__ __forceinline__ int perm32(int rho) { const int n = rho >> 4, i = rho & 15; return 8 * (i >> 2) + 4 * n + (i & 3); }

struct Unit { int pm, pn; };
struct Gemm { const bf16_t* A; const bf16_t* Bt; int M, N, K, lda, ldb; };

struct StaticOrder {
    int nM, nN, nwg, G, c;
    __host__ __device__ void init(int M, int N, int G_, int c_) { nM = M / BM; nN = N / BM; nwg = nM * nN; G = G_; c = c_; }
    __host__ __device__ bool next(int i, Unit& u) const {
        const long L = (long)i * G + c; if (L >= nwg) return false;
        int wgid = (int)L; { const int q = nwg / NXCD, r = nwg % NXCD, xcd = wgid % NXCD, off = wgid / NXCD; wgid = (xcd < r ? xcd * (q + 1) : r * (q + 1) + (xcd - r) * q) + off; }
        const int nig = WGM * nN, gid = wgid / nig, fm = gid * WGM, gsz = (nM - fm) < WGM ? (nM - fm) : WGM;
        u.pm = fm + ((wgid % nig) % gsz); u.pn = (wgid % nig) / gsz; return true;
    }
    __device__ __forceinline__ void a_ready(const Unit&) const {}
    __device__ __forceinline__ void done(const Unit&) const {}
};
__device__ __forceinline__ unsigned cvt_pk_bf16(float lo, float hi) { unsigned r; asm volatile("v_cvt_pk_bf16_f32 %0, %1, %2" : "=v"(r) : "v"(lo), "v"(hi)); return r; }
typedef unsigned u32x2 __attribute__((ext_vector_type(2)));
__device__ __forceinline__ float bf2f(unsigned short h) { return __uint_as_float(((unsigned)h) << 16); }
__device__ __forceinline__ float fsigmoid(float x) { return __builtin_amdgcn_rcpf(1.0f + __builtin_amdgcn_exp2f(-1.4426950408889634f * x)); }
__device__ __forceinline__ float row_sum4(float s) { s += __shfl_xor(s, 16); s += __shfl_xor(s, 32); return s; }

struct EpiSwiGLU {
    static constexpr bool PERM = true, AFTER_DRAIN = false;
    bf16_t* O; const float* ss;
    __device__ __forceinline__ void operator()(const f32x4 (&acc)[2][2][4][2], const Unit& u, int wr, int wc, int fr, int fq) const {
        const int row0 = u.pm * BM + wr * 64 + fr; const int col0 = u.pn * HALF + wc * 32 + 8 * fq;
#pragma unroll
        for (int ai = 0; ai < 2; ++ai)
#pragma unroll
            for (int m = 0; m < 4; ++m) { const int row = row0 + ai * HALF + m * 16; const float r = rsqrtf(ss[row] * (1.0f / 1024.0f) + 1e-6f);
                const float c1 = -1.4426950408889634f * r, r2 = r * r;
                f32x4 vv[2];
#pragma unroll
                for (int n = 0; n < 2; ++n) { const f32x4 a = acc[ai][0][m][n], b = acc[ai][1][m][n]; const f32x4 m1 = a * c1; f32x4 d;
                    d[0] = __builtin_amdgcn_exp2f(m1[0]); d[1] = __builtin_amdgcn_exp2f(m1[1]); d[2] = __builtin_amdgcn_exp2f(m1[2]); d[3] = __builtin_amdgcn_exp2f(m1[3]);
                    d = d + 1.0f; f32x4 inv; inv[0] = __builtin_amdgcn_rcpf(d[0]); inv[1] = __builtin_amdgcn_rcpf(d[1]); inv[2] = __builtin_amdgcn_rcpf(d[2]); inv[3] = __builtin_amdgcn_rcpf(d[3]);
                    vv[n] = (a * b) * (inv * r2); }
                u32x4 w; w.x = cvt_pk_bf16(vv[0][0], vv[0][1]); w.y = cvt_pk_bf16(vv[0][2], vv[0][3]); w.z = cvt_pk_bf16(vv[1][0], vv[1][1]); w.w = cvt_pk_bf16(vv[1][2], vv[1][3]);
                __builtin_nontemporal_store(w, (u32x4*)(O + (size_t)row * 2816 + col0)); }
    }
};
template <int MODE> struct EpiRes {
    static constexpr bool PERM = true, AFTER_DRAIN = false;
    const float* xp; const float* xs; bf16_t* hb; bf16_t* hout; float* ssout; const float* ssin; const bf16_t* proj;
    __device__ __forceinline__ void operator()(const f32x4 (&acc)[2][2][4][2], const Unit& u, int wr, int wc, int fr, int fq) const {
        const int row0 = u.pm * BM + wr * 64 + fr; const int col0 = u.pn * BM + wc * 32 + 8 * fq;
#pragma unroll
        for (int ai = 0; ai < 2; ++ai)
#pragma unroll
            for (int m = 0; m < 4; ++m) { const int row = row0 + ai * HALF + m * 16; float sq = 0.f; float r3 = 0.f;
                if (MODE == 3) r3 = rsqrtf(ssin[row] * (1.0f / 1024.0f) + 1e-6f);
#pragma unroll
                for (int bj = 0; bj < 2; ++bj) { const size_t off = (size_t)row * 1024 + col0 + bj * HALF; float b[8], v[8];
                    if (MODE == 0) { const float* xr = (row < 32768) ? (xp + off) : (xs + (off - (size_t)32768 * 1024)); const f32x4 b0 = *(const f32x4*)xr, b1 = *(const f32x4*)(xr + 4);
                        b[0] = b0[0]; b[1] = b0[1]; b[2] = b0[2]; b[3] = b0[3]; b[4] = b1[0]; b[5] = b1[1]; b[6] = b1[2]; b[7] = b1[3]; }
                    else { const u32x4 h4 = *(const u32x4*)(hb + off);
                        b[0] = __uint_as_float(h4.x << 16); b[1] = __uint_as_float(h4.x & 0xffff0000u); b[2] = __uint_as_float(h4.y << 16); b[3] = __uint_as_float(h4.y & 0xffff0000u);
                        b[4] = __uint_as_float(h4.z << 16); b[5] = __uint_as_float(h4.z & 0xffff0000u); b[6] = __uint_as_float(h4.w << 16); b[7] = __uint_as_float(h4.w & 0xffff0000u); }
                    if (MODE == 3) { const u32x4 p4 = *(const u32x4*)(proj + off); float pr[8];
                        pr[0] = __uint_as_float(p4.x << 16); pr[1] = __uint_as_float(p4.x & 0xffff0000u); pr[2] = __uint_as_float(p4.y << 16); pr[3] = __uint_as_float(p4.y & 0xffff0000u);
                        pr[4] = __uint_as_float(p4.z << 16); pr[5] = __uint_as_float(p4.z & 0xffff0000u); pr[6] = __uint_as_float(p4.w << 16); pr[7] = __uint_as_float(p4.w & 0xffff0000u);
#pragma unroll
                        for (int j = 0; j < 8; ++j) v[j] = b[j] + fsigmoid(acc[ai][bj][m][j >> 2][j & 3] * r3) * pr[j]; }
                    else {
#pragma unroll
                        for (int j = 0; j < 8; ++j) v[j] = b[j] + acc[ai][bj][m][j >> 2][j & 3] * ((MODE == 1) ? 1.0f : 0.5f); }
#pragma unroll
                    for (int j = 0; j < 8; ++j) sq += v[j] * v[j];
                    u32x4 w; w.x = cvt_pk_bf16(v[0], v[1]); w.y = cvt_pk_bf16(v[2], v[3]); w.z = cvt_pk_bf16(v[4], v[5]); w.w = cvt_pk_bf16(v[6], v[7]);
                    *(u32x4*)(((MODE == 3) ? hout : hb) + off) = w; }
                sq = row_sum4(sq);
                if (fq == 0) atomicAdd(ssout + row, sq); }
    }
};
struct EpiWin {
    static constexpr bool PERM = true, AFTER_DRAIN = false;
    bf16_t* umla; bf16_t* uhg; bf16_t* kr; const float* ss1; float* ssq; float* sskv; const float* ropec; const float* ropes;
    __device__ __forceinline__ void operator()(const f32x4 (&acc)[2][2][4][2], const Unit& u, int wr, int wc, int fr, int fq) const {
        const int row0 = u.pm * BM + wr * 64 + fr; const int pn = u.pn;
        bf16_t* dst; int ld, colt;
        if (pn < 3) { dst = umla; ld = 768; colt = pn * BM; } else { dst = uhg; ld = 2560; colt = (pn - 3) * BM; }
        const int col0 = colt + wc * 32 + 8 * fq;
#pragma unroll
        for (int ai = 0; ai < 2; ++ai)
#pragma unroll
            for (int m = 0; m < 4; ++m) { const int row = row0 + ai * HALF + m * 16; const float r = rsqrtf(ss1[row] * (1.0f / 1024.0f) + 1e-6f);
                float sq0 = 0.f, sq1 = 0.f; f32x4 v[2][2];
#pragma unroll
                for (int bj = 0; bj < 2; ++bj) {
#pragma unroll
                    for (int n = 0; n < 2; ++n) { v[bj][n] = acc[ai][bj][m][n] * r; const f32x4 x = v[bj][n]; const float s = (x[0] * x[0] + x[1] * x[1]) + (x[2] * x[2] + x[3] * x[3]); if (bj == 0) sq0 += s; else sq1 += s; }
                    u32x4 w; w.x = cvt_pk_bf16(v[bj][0][0], v[bj][0][1]); w.y = cvt_pk_bf16(v[bj][0][2], v[bj][0][3]); w.z = cvt_pk_bf16(v[bj][1][0], v[bj][1][1]); w.w = cvt_pk_bf16(v[bj][1][2], v[bj][1][3]);
                    __builtin_nontemporal_store(w, (u32x4*)(dst + (size_t)row * ld + col0 + bj * HALF)); }
                if (pn < 3) { float s = (pn == 1) ? sq0 : (sq0 + sq1); s = row_sum4(s); if (fq == 0) atomicAdd((pn == 2 ? sskv : ssq) + row, s); }
                if (pn == 1 && wc == 0) {
                    const int pos = row_pos(row); const f32x4 cs = *(const f32x4*)(ropec + pos * 16 + 4 * fq), sn = *(const f32x4*)(ropes + pos * 16 + 4 * fq);
                    const f32x4 x1 = v[1][0], x2 = v[1][1]; const f32x4 o1 = x1 * cs - x2 * sn, o2 = x1 * sn + x2 * cs;
                    u32x2 w1, w2; w1.x = cvt_pk_bf16(o1[0], o1[1]); w1.y = cvt_pk_bf16(o1[2], o1[3]); w2.x = cvt_pk_bf16(o2[0], o2[1]); w2.y = cvt_pk_bf16(o2[2], o2[3]);
                    *(u32x2*)(kr + (size_t)row * 32 + 4 * fq) = w1; *(u32x2*)(kr + (size_t)row * 32 + 16 + 4 * fq) = w2; } }
    }
};
struct EpiBf {
    static constexpr bool PERM = true, AFTER_DRAIN = false;
    bf16_t* O0; bf16_t* O1; int ld; int split; const float* ss; float inv_n; float mul;
    __device__ __forceinline__ void operator()(const f32x4 (&acc)[2][2][4][2], const Unit& u, int wr, int wc, int fr, int fq) const {
        const int row0 = u.pm * BM + wr * 64 + fr; bf16_t* base = O0; int colt = u.pn * BM; if (u.pn >= split) { base = O1; colt = (u.pn - split) * BM; }
        const int col0 = colt + wc * 32 + 8 * fq;
#pragma unroll
        for (int ai = 0; ai < 2; ++ai)
#pragma unroll
            for (int m = 0; m < 4; ++m) { const int row = row0 + ai * HALF + m * 16; const float r = (ss ? rsqrtf(ss[row] * inv_n + 1e-6f) : 1.0f) * mul;
#pragma unroll
                for (int bj = 0; bj < 2; ++bj) { const f32x4 v0 = acc[ai][bj][m][0] * r, v1 = acc[ai][bj][m][1] * r;
                    u32x4 w; w.x = cvt_pk_bf16(v0[0], v0[1]); w.y = cvt_pk_bf16(v0[2], v0[3]); w.z = cvt_pk_bf16(v1[0], v1[1]); w.w = cvt_pk_bf16(v1[2], v1[3]);
                    *(u32x4*)(base + (size_t)row * ld + col0 + bj * HALF) = w; } }
    }
};
template <class Epi, class Sched, bool ALIGN_EPI = false, bool SP2 = false>
__device__ __forceinline__ void gemm_phase(PG8_LAS unsigned char* lds, const Gemm g, const Sched& S, const Epi& E) {
    int tid_ = threadIdx.x; asm volatile("" : "+v"(tid_)); const int tid = tid_, wid = __builtin_amdgcn_readfirstlane(tid >> 6), lane = tid & 63, wr = wid >> 2, wc = wid & 3, fr = lane & 15, fq = lane >> 4;
    const int K = g.K, nt = K / BK;
    unsigned voffA[2], voffB[2];
#pragma unroll
    for (int i = 0; i < 2; ++i) { int R, C; stage_rc(tid * 16 + i * 8192, R, C); const int Rb = Epi::PERM ? ((R & ~31) + perm32(R & 31)) : R;
        voffA[i] = (unsigned)(R * g.lda + C) * 2u; voffB[i] = (unsigned)(Rb * g.ldb + C) * 2u; }
    const size_t kstep = (size_t)(BK * 2);
    const size_t hstepA = (size_t)HALF * g.lda * 2, hstepB = (size_t)HALF * g.ldb * 2;
    const size_t tstepA = 2 * hstepA, tstepB = 2 * hstepB;
    const unsigned ldsw = (unsigned)wid * 1024u;
    const int aoff = lds_byte(wr * 64 + fr, fq * 8), boff = lds_byte(wc * 32 + fr, fq * 8);
#define PG8_SA(b, h) (((b) * 2 + (h)) * HTB)
#define PG8_SB(b, h) ((4 + (b) * 2 + (h)) * HTB)
#define PG8_STAGE(bufoff, gbase, voff) do { _Pragma("unroll") for (int _i = 0; _i < 2; ++_i) \
        __builtin_amdgcn_global_load_lds((const unsigned*)((const char*)(gbase) + (voff)[_i]), (PG8_LAS unsigned*)(lds + (bufoff) + ldsw + _i * 8192), 16, 0, 0); } while (0)
#define PG8_LDA(dst, b, h) do { _Pragma("unroll") for (int m = 0; m < 4; ++m) _Pragma("unroll") for (int k = 0; k < 2; ++k) dst[m][k] = *(const PG8_LAS bf16x8*)(lds + PG8_SA(b, h) + aoff + m * 2048 + k * 1024); } while (0)
#define PG8_LDB(dst, b, h) do { _Pragma("unroll") for (int n = 0; n < 2; ++n) _Pragma("unroll") for (int k = 0; k < 2; ++k) dst[n][k] = *(const PG8_LAS bf16x8*)(lds + PG8_SB(b, h) + boff + n * 2048 + k * 1024); } while (0)
#define PG8_MMA(ai, bj, At, Bt) do { __builtin_amdgcn_s_setprio(1); _Pragma("unroll") for (int m = 0; m < 4; ++m) _Pragma("unroll") for (int n = 0; n < 2; ++n) _Pragma("unroll") for (int k = 0; k < 2; ++k) \
        acc[ai][bj][m][n] = __builtin_amdgcn_mfma_f32_16x16x32_bf16(Bt[n][k], At[m][k], acc[ai][bj][m][n], 0, 0, 0); __builtin_amdgcn_s_setprio(0); } while (0)
#define PG8_WAIT_V(n) asm volatile("s_waitcnt vmcnt(" #n ")" ::: "memory")
#define PG8_WAIT_L(n) asm volatile("s_waitcnt lgkmcnt(" #n ")" ::: "memory")
#define PG8_BAR __builtin_amdgcn_s_barrier()
#define PG8_SCHED __builtin_amdgcn_sched_barrier(0)
    Unit cur, nxt; int ui = 0;
    if (!S.next(0, cur)) return;
    f32x4 acc[2][2][4][2];
#pragma unroll
    for (int a = 0; a < 2; ++a)
#pragma unroll
        for (int b = 0; b < 2; ++b)
#pragma unroll
            for (int m = 0; m < 4; ++m)
#pragma unroll
                for (int n = 0; n < 2; ++n) acc[a][b][m][n] = (f32x4){0.f, 0.f, 0.f, 0.f};
    bf16x8 At[4][2], B0[2][2], B1[2][2];
    const char* cA = (const char*)g.A + (size_t)cur.pm * tstepA; const char* cB = (const char*)g.Bt + (size_t)cur.pn * tstepB;
    S.a_ready(cur);
    if constexpr (SP2) {
        PG8_STAGE(PG8_SB(0, 0), cB, voffB); PG8_STAGE(PG8_SB(0, 1), cB + hstepB, voffB); PG8_STAGE(PG8_SA(0, 0), cA, voffA); PG8_STAGE(PG8_SA(0, 1), cA + hstepA, voffA);
        if (wr == 1) PG8_BAR;
        PG8_WAIT_V(2); PG8_BAR;
        PG8_STAGE(PG8_SB(1, 0), cB + kstep, voffB); PG8_STAGE(PG8_SA(1, 0), cA + kstep, voffA); PG8_STAGE(PG8_SB(1, 1), cB + hstepB + kstep, voffB);
        PG8_WAIT_V(6); PG8_BAR;
    } else {
        PG8_STAGE(PG8_SB(0, 0), cB, voffB); PG8_STAGE(PG8_SA(0, 0), cA, voffA); PG8_STAGE(PG8_SB(0, 1), cB + hstepB, voffB); PG8_STAGE(PG8_SA(0, 1), cA + hstepA, voffA);
        if (wr == 1) PG8_BAR;
        PG8_WAIT_V(4); PG8_BAR;
        PG8_STAGE(PG8_SB(1, 0), cB + kstep, voffB); PG8_STAGE(PG8_SA(1, 0), cA + kstep, voffA); PG8_STAGE(PG8_SB(1, 1), cB + hstepB + kstep, voffB);
        PG8_WAIT_V(6); PG8_BAR;
    }
    for (;;) {
        const bool has_next = S.next(ui + 1, nxt);
        const char* nA = has_next ? (const char*)g.A + (size_t)nxt.pm * tstepA : cA; const char* nB = has_next ? (const char*)g.Bt + (size_t)nxt.pn * tstepB : cB;
        for (int t = 0; t < nt; t += 2) {
            const bool last = (t == nt - 2);
            const char* a1 = cA + (size_t)(t + 1) * kstep;
            const char* a2 = last ? nA : cA + (size_t)(t + 2) * kstep; const char* b2 = last ? nB : cB + (size_t)(t + 2) * kstep;
            const char* a3 = a2 + kstep; const char* b3 = b2 + kstep;
            if (last && has_next) S.a_ready(nxt);
            if constexpr (SP2) {
            PG8_LDB(B0, 0, 0); PG8_LDB(B1, 0, 1); PG8_SCHED; PG8_LDA(At, 0, 0); PG8_STAGE(PG8_SA(1, 1), a1 + hstepA, voffA);
            PG8_WAIT_V(8); PG8_WAIT_L(0); PG8_BAR; PG8_MMA(0, 0, At, B0); PG8_MMA(0, 1, At, B1); PG8_BAR; PG8_SCHED;
            PG8_LDA(At, 0, 1); PG8_STAGE(PG8_SB(0, 0), b2, voffB); PG8_STAGE(PG8_SB(0, 1), b2 + hstepB, voffB); PG8_STAGE(PG8_SA(0, 0), a2, voffA);
            PG8_WAIT_V(8); PG8_WAIT_L(0); PG8_BAR; PG8_MMA(1, 0, At, B0); PG8_MMA(1, 1, At, B1); PG8_BAR; PG8_SCHED;
            PG8_LDB(B0, 1, 0); PG8_LDB(B1, 1, 1); PG8_SCHED; PG8_LDA(At, 1, 0); PG8_STAGE(PG8_SA(0, 1), a2 + hstepA, voffA);
            PG8_WAIT_V(8); PG8_WAIT_L(0); PG8_BAR; PG8_MMA(0, 0, At, B0); PG8_MMA(0, 1, At, B1); PG8_BAR; PG8_SCHED;
            PG8_LDA(At, 1, 1); PG8_STAGE(PG8_SB(1, 0), b3, voffB); PG8_STAGE(PG8_SB(1, 1), b3 + hstepB, voffB); PG8_STAGE(PG8_SA(1, 0), a3, voffA);
            PG8_WAIT_V(8); PG8_WAIT_L(0); PG8_BAR; PG8_MMA(1, 0, At, B0); PG8_MMA(1, 1, At, B1); PG8_BAR; PG8_SCHED;
            } else {
            PG8_LDB(B0, 0, 0); PG8_SCHED; PG8_LDA(At, 0, 0); PG8_STAGE(PG8_SA(1, 1), a1 + hstepA, voffA);
            PG8_WAIT_L(8); PG8_BAR; PG8_WAIT_L(0); PG8_MMA(0, 0, At, B0); PG8_BAR; PG8_SCHED;
            PG8_LDB(B1, 0, 1); PG8_STAGE(PG8_SB(0, 0), b2, voffB);
            PG8_BAR; PG8_WAIT_L(0); PG8_MMA(0, 1, At, B1); PG8_BAR;
            PG8_LDA(At, 0, 1); PG8_STAGE(PG8_SA(0, 0), a2, voffA);
            PG8_BAR; PG8_WAIT_L(0); PG8_MMA(1, 0, At, B0); PG8_BAR; PG8_SCHED;
            PG8_STAGE(PG8_SB(0, 1), b2 + hstepB, voffB);
            PG8_WAIT_V(6); PG8_BAR; PG8_MMA(1, 1, At, B1); PG8_BAR;
            PG8_LDB(B0, 1, 0); PG8_SCHED; PG8_LDA(At, 1, 0); PG8_STAGE(PG8_SA(0, 1), a2 + hstepA, voffA);
            PG8_WAIT_L(8); PG8_BAR; PG8_WAIT_L(0); PG8_MMA(0, 0, At, B0); PG8_BAR; PG8_SCHED;
            PG8_LDB(B1, 1, 1); PG8_STAGE(PG8_SB(1, 0), b3, voffB);
            PG8_BAR; PG8_WAIT_L(0); PG8_MMA(0, 1, At, B1); PG8_BAR;
            PG8_LDA(At, 1, 1); PG8_STAGE(PG8_SA(1, 0), a3, voffA);
            PG8_BAR; PG8_WAIT_L(0); PG8_MMA(1, 0, At, B0); PG8_BAR; PG8_SCHED;
            PG8_STAGE(PG8_SB(1, 1), b3 + hstepB, voffB);
            PG8_WAIT_V(6); PG8_BAR; PG8_MMA(1, 1, At, B1); PG8_BAR;
            }
        }
        if constexpr (ALIGN_EPI) { if (wr == 0) PG8_BAR; }
        if constexpr (!Epi::AFTER_DRAIN) { E(acc, cur, wr, wc, fr, fq); S.done(cur); }
        if (!has_next) break;
#pragma unroll
        for (int a = 0; a < 2; ++a)
#pragma unroll
            for (int b = 0; b < 2; ++b)
#pragma unroll
                for (int m = 0; m < 4; ++m)
#pragma unroll
                    for (int n = 0; n < 2; ++n) acc[a][b][m][n] = (f32x4){0.f, 0.f, 0.f, 0.f};
        cur = nxt; cA = nA; cB = nB; ++ui;
        if constexpr (ALIGN_EPI) { if (wr == 1) PG8_BAR; }
    }
    PG8_WAIT_V(0);
    if constexpr (!ALIGN_EPI) { if (wr == 0) PG8_BAR; }
    PG8_BAR;
    if constexpr (Epi::AFTER_DRAIN) { E.fused(acc, cur, wr, wc, fr, fq, lds, wid, lane); S.done(cur); }
#undef PG8_SA
#undef PG8_SB
#undef PG8_STAGE
#undef PG8_LDA
#undef PG8_LDB
#undef PG8_MMA
#undef PG8_WAIT_V
#undef PG8_WAIT_L
#undef PG8_BAR
#undef PG8_SCHED
}
}

namespace att {
typedef unsigned short bf16_t;
using bf16x8 = __attribute__((ext_vector_type(8))) short;
using s16x4  = __attribute__((ext_vector_type(4))) short;
using f32x16 = __attribute__((ext_vector_type(16))) float;
using u32x4  = __attribute__((ext_vector_type(4))) unsigned;
constexpr int NW = 8, QBLK = 32, KVBLK = 64;
constexpr float SCALE = 0.10206207261596575f;
constexpr float THR = 8.f;
constexpr int LDQ = 768, LDKN = 512, LDKR = 32, LDV = 512, LDO = 1024;
constexpr int SHM_V = 64 * 128 * 2, SHM_K = 64 * 128 * 2;
#define KSWZ(row, colB) ((row) * 256 + ((colB) ^ (((row) & 7) << 4)))
#define SBAR() __builtin_amdgcn_sched_barrier(0)
__device__ __forceinline__ int crow(int r, int hi) { return (r & 3) + 8 * (r >> 2) + 4 * hi; }
__device__ __forceinline__ unsigned cvtpk(float lo, float hi) { unsigned r; asm volatile("v_cvt_pk_bf16_f32 %0, %1, %2" : "=v"(r) : "v"(lo), "v"(hi)); return r; }
template <bool FIRST> __device__ __forceinline__ void partialSM(f32x16& p0, f32x16& p1, float& m_ref, f32x16& negm, float& alpha) {
  constexpr float THR2 = THR * 1.4426950408889634f;
  float pmax = p0[0];
#pragma unroll
  for (int r = 1; r < 16; ++r) pmax = fmaxf(pmax, p0[r]);
#pragma unroll
  for (int r = 0; r < 16; ++r) pmax = fmaxf(pmax, p1[r]);
  { auto rr = __builtin_amdgcn_permlane32_swap(__float_as_uint(pmax), __float_as_uint(pmax), false, false);
    pmax = fmaxf(__uint_as_float(rr[0]), __uint_as_float(rr[1])); }
  alpha = 1.f;
  if (FIRST || !__builtin_expect(__all(pmax <= THR2), 1)) {
    const float dl = FIRST ? pmax : fmaxf(pmax, 0.f);
    m_ref += dl; alpha = FIRST ? 1.f : __builtin_amdgcn_exp2f(-dl);
#pragma unroll
    for (int r = 0; r < 16; ++r) { p0[r] -= dl; p1[r] -= dl; }
#pragma unroll
    for (int r = 0; r < 16; ++r) negm[r] = -m_ref;
    asm volatile("" : "+v"(negm));
  }
#pragma unroll
  for (int r = 0; r < 16; ++r) p0[r] = __builtin_amdgcn_exp2f(p0[r]);
}
__device__ __forceinline__ void finishSM(f32x16& p0, f32x16& p1, bf16x8& pa0, bf16x8& pa1, bf16x8& pa2, bf16x8& pa3) {
#pragma unroll
  for (int r = 0; r < 16; ++r) p1[r] = __builtin_amdgcn_exp2f(p1[r]);
#define PK4(P, BASE, OUT) do { unsigned a0 = cvtpk(P[BASE + 0], P[BASE + 1]), a1 = cvtpk(P[BASE + 2], P[BASE + 3]);   \
    unsigned b0 = cvtpk(P[BASE + 4], P[BASE + 5]), b1 = cvtpk(P[BASE + 6], P[BASE + 7]);                              \
    auto r0 = __builtin_amdgcn_permlane32_swap(a0, b0, false, false); auto r1 = __builtin_amdgcn_permlane32_swap(a1, b1, false, false); \
    u32x4 w = {r0[0], r1[0], r0[1], r1[1]}; OUT = *reinterpret_cast<bf16x8*>(&w); } while (0)
  PK4(p0, 0, pa0); PK4(p0, 8, pa1); PK4(p1, 0, pa2); PK4(p1, 8, pa3);
#undef PK4
}
__device__ __forceinline__ void qkt(f32x16& p0, f32x16& p1, const bf16_t* Ks, const bf16x8* qr, const f32x16& negm, int r32, int hi) {
#pragma unroll
  for (int d0 = 0; d0 < 6; ++d0) { int cb = (d0 * 16 + hi * 8) * 2;
    bf16x8 b0 = *reinterpret_cast<const bf16x8*>((const char*)Ks + KSWZ(r32, cb));
    bf16x8 b1 = *reinterpret_cast<const bf16x8*>((const char*)Ks + KSWZ(32 + r32, cb));
    if (d0 == 0) { p0 = __builtin_amdgcn_mfma_f32_32x32x16_bf16(b0, qr[0], negm, 0, 0, 0); p1 = __builtin_amdgcn_mfma_f32_32x32x16_bf16(b1, qr[0], negm, 0, 0, 0); }
    else { p0 = __builtin_amdgcn_mfma_f32_32x32x16_bf16(b0, qr[d0], p0, 0, 0, 0); p1 = __builtin_amdgcn_mfma_f32_32x32x16_bf16(b1, qr[d0], p1, 0, 0, 0); } }
}
__device__ __forceinline__ int v_st(int k, int c) { const int kk = (k & ~0xC) | ((k & 4) << 1) | ((k & 8) >> 1); return ((kk >> 3) * 4 + (c >> 5)) * 512 + ((kk & 7) * 32 + (c & 31)) * 2; }
__device__ __forceinline__ int v_rd_base(int lane) { return ((lane & 3) << 3) | (((lane >> 2) & 3) << 6) | (((lane >> 4) & 1) << 5) | (((lane >> 5) & 1) << 8); }
constexpr int v_rd_off(int d0, int ks, int half) { return d0 * 512 + ks * 4096 + half * 2048; }
template <int OFF> __device__ __forceinline__ s16x4 tr_read(int vb) {
  s16x4 r; asm volatile("ds_read_b64_tr_b16 %0, %1 offset:%2" : "=&v"(r) : "v"(vb), "i"(OFF) : "memory"); return r;
}
template <int D0> __device__ __forceinline__ void pv_one(f32x16& od, int vb, bf16x8 pa0, bf16x8 pa1, bf16x8 pa2, bf16x8 pa3) {
  const s16x4 l0 = tr_read<v_rd_off(D0, 0, 0)>(vb), h0 = tr_read<v_rd_off(D0, 0, 1)>(vb), l1 = tr_read<v_rd_off(D0, 1, 0)>(vb), h1 = tr_read<v_rd_off(D0, 1, 1)>(vb);
  const s16x4 l2 = tr_read<v_rd_off(D0, 2, 0)>(vb), h2 = tr_read<v_rd_off(D0, 2, 1)>(vb), l3 = tr_read<v_rd_off(D0, 3, 0)>(vb), h3 = tr_read<v_rd_off(D0, 3, 1)>(vb);
  asm volatile("s_waitcnt lgkmcnt(0)" ::: "memory"); SBAR();
#define PK(L, H) (bf16x8){L[0], L[1], L[2], L[3], H[0], H[1], H[2], H[3]}
  od = __builtin_amdgcn_mfma_f32_32x32x16_bf16(pa0, PK(l0, h0), od, 0, 0, 0);
  od = __builtin_amdgcn_mfma_f32_32x32x16_bf16(pa1, PK(l1, h1), od, 0, 0, 0);
  od = __builtin_amdgcn_mfma_f32_32x32x16_bf16(pa2, PK(l2, h2), od, 0, 0, 0);
  od = __builtin_amdgcn_mfma_f32_32x32x16_bf16(pa3, PK(l3, h3), od, 0, 0, 0);
#undef PK
}
__device__ __forceinline__ void pv_d0(f32x16* o, f32x16& osum, int vb, bf16x8 pa0, bf16x8 pa1, bf16x8 pa2, bf16x8 pa3) {
  pv_one<0>(o[0], vb, pa0, pa1, pa2, pa3); pv_one<1>(o[1], vb, pa0, pa1, pa2, pa3);
  const short one = (short)0x3F80; const bf16x8 ones = {one, one, one, one, one, one, one, one};
  osum = __builtin_amdgcn_mfma_f32_32x32x16_bf16(pa0, ones, osum, 0, 0, 0); osum = __builtin_amdgcn_mfma_f32_32x32x16_bf16(pa1, ones, osum, 0, 0, 0);
  osum = __builtin_amdgcn_mfma_f32_32x32x16_bf16(pa2, ones, osum, 0, 0, 0); osum = __builtin_amdgcn_mfma_f32_32x32x16_bf16(pa3, ones, osum, 0, 0, 0);
}
__device__ __forceinline__ void attn_unit(const bf16_t* __restrict__ Qb, const bf16_t* __restrict__ KNh, const bf16_t* __restrict__ KRb, const bf16_t* __restrict__ Vh,
                                          bf16_t* __restrict__ Ob, int seq, int qrow0, const float* __restrict__ ropec, const float* __restrict__ ropes, char* lds) {
  int tid_ = threadIdx.x; asm volatile("" : "+v"(tid_)); const int tid = tid_, wid = __builtin_amdgcn_readfirstlane(tid >> 6), lane = tid & 63, r32 = lane & 31, hi = lane >> 5;
  bf16_t* V_lds = (bf16_t*)lds; bf16_t* K_lds = (bf16_t*)(lds + 3 * SHM_V);
  float* ws = (float*)(lds + 3 * SHM_V + 3 * SHM_K) + wid * 64; float* al_l = ws + 32;
  float m_ref = 0.f; f32x16 o[2] = {}; f32x16 osum = {}; f32x16 negm = {}; asm volatile("" : "+v"(negm)); bf16x8 qr[6];
  const bf16_t* Qw = Qb + (long)(wid * QBLK + r32) * LDQ + hi * 8;
#pragma unroll
  for (int d0 = 0; d0 < 6; ++d0) qr[d0] = *reinterpret_cast<const bf16x8*>(Qw + d0 * 16);
  {
    const int pos = row_pos(qrow0 + wid * QBLK + r32); const float* cp = ropec + pos * 16 + 8 * hi; const float* sp = ropes + pos * 16 + 8 * hi;
    unsigned w1[4], w2[4];
#pragma unroll
    for (int e = 0; e < 8; e += 2) { float o1[2], o2[2];
#pragma unroll
      for (int f = 0; f < 2; ++f) { const float x1 = __uint_as_float(((unsigned)(unsigned short)qr[4][e + f]) << 16), x2 = __uint_as_float(((unsigned)(unsigned short)qr[5][e + f]) << 16); const float c = cp[e + f], s = sp[e + f];
        o1[f] = x1 * c - x2 * s; o2[f] = x1 * s + x2 * c; }
      w1[e >> 1] = cvtpk(o1[0], o1[1]); w2[e >> 1] = cvtpk(o2[0], o2[1]); }
    u32x4 v1 = {w1[0], w1[1], w1[2], w1[3]}, v2 = {w2[0], w2[1], w2[2], w2[3]}; qr[4] = *reinterpret_cast<bf16x8*>(&v1); qr[5] = *reinterpret_cast<bf16x8*>(&v2); }
  const int srow = tid >> 3, sch = tid & 7, srow2 = tid >> 2, sch2 = tid & 3;
  const bf16_t* kp = KNh + (long)srow * LDKN + 8 * sch; const bf16_t* vp = Vh + (long)srow * LDV + 8 * sch; const bf16_t* rp = KRb + (long)(srow2 & 63) * LDKR + 8 * sch2;
  const int kst = KSWZ(srow, 16 * sch), vst = v_st(srow, 8 * sch), rst = KSWZ(srow2 & 63, 128 + 16 * sch2);
  const bool has_r = wid < 4;
  constexpr int BUF = SHM_V;
  const int vb0 = (int)(uintptr_t)V_lds + v_rd_base(lane);
  struct { bf16x8 v, k, r; } sr_[2];
#define SLOAD(i, k0) do { sr_[i].v = *reinterpret_cast<const bf16x8*>(vp + (long)(k0) * LDV); sr_[i].k = *reinterpret_cast<const bf16x8*>(kp + (long)(k0) * LDKN); \
    if (has_r) sr_[i].r = *reinterpret_cast<const bf16x8*>(rp + (long)(k0) * LDKR); } while (0)
#define SWRITE(off, i) do { *(bf16x8*)((char*)V_lds + (off) + vst) = sr_[i].v; *(bf16x8*)((char*)K_lds + (off) + kst) = sr_[i].k; \
    if (has_r) *(bf16x8*)((char*)K_lds + (off) + rst) = sr_[i].r; } while (0)
#define SWAIT() do { if (has_r) asm volatile("s_waitcnt vmcnt(3)" ::: "memory"); else asm volatile("s_waitcnt vmcnt(2)" ::: "memory"); } while (0)
#define RESC(a) do { if (__any((a) < 1.f)) { if (hi == 0) al_l[r32] = (a); asm volatile("s_waitcnt lgkmcnt(0)" ::: "memory"); \
    _Pragma("unroll") for (int r = 0; r < 16; ++r) { const float f_ = al_l[crow(r, hi)]; o[0][r] *= f_; o[1][r] *= f_; osum[r] *= f_; } } } while (0)
#define ROT() do { const int t_ = o_prev; o_prev = o_cur; o_cur = o_next; o_next = t_; } while (0)
  f32x16 pA0, pA1, pB0, pB1; float alA, alB; bf16x8 pa0, pa1, pa2, pa3; const int NT = seq / KVBLK;
  constexpr int SE = 0, SO = 1;
  int o_prev = 2 * BUF, o_cur = 0, o_next = BUF;
  SLOAD(SE, 0); asm volatile("s_waitcnt vmcnt(0)" ::: "memory"); SWRITE(0, SE); __syncthreads();
  qkt(pA0, pA1, K_lds, qr, negm, r32, hi); partialSM<true>(pA0, pA1, m_ref, negm, alA);
  SLOAD(SO, KVBLK); if (2 < NT) SLOAD(SE, 2 * KVBLK);
  SWAIT(); SWRITE(BUF, SO); __syncthreads();
  ROT();
  for (int j = 1; j + 1 < NT; j += 2) {
    SBAR(); qkt(pB0, pB1, (bf16_t*)((char*)K_lds + o_cur), qr, negm, r32, hi);
    finishSM(pA0, pA1, pa0, pa1, pa2, pa3); SBAR();
    SLOAD(SO, (j + 2) * KVBLK); SBAR();
    pv_d0(o, osum, vb0 + o_prev, pa0, pa1, pa2, pa3); partialSM<false>(pB0, pB1, m_ref, negm, alB);
    SWAIT(); SWRITE(o_next, SE);
    RESC(alB); __syncthreads(); ROT();
    SBAR(); qkt(pA0, pA1, (bf16_t*)((char*)K_lds + o_cur), qr, negm, r32, hi);
    finishSM(pB0, pB1, pa0, pa1, pa2, pa3); SBAR();
    if (j + 3 < NT) SLOAD(SE, (j + 3) * KVBLK); SBAR();
    pv_d0(o, osum, vb0 + o_prev, pa0, pa1, pa2, pa3); partialSM<false>(pA0, pA1, m_ref, negm, alA);
    SWAIT(); SWRITE(o_next, SO);
    RESC(alA); __syncthreads(); ROT();
  }
  SBAR(); qkt(pB0, pB1, (bf16_t*)((char*)K_lds + o_cur), qr, negm, r32, hi);
  finishSM(pA0, pA1, pa0, pa1, pa2, pa3); SBAR();
  pv_d0(o, osum, vb0 + o_prev, pa0, pa1, pa2, pa3); partialSM<false>(pB0, pB1, m_ref, negm, alB);
  RESC(alB);
  finishSM(pB0, pB1, pa0, pa1, pa2, pa3); SBAR();
  pv_d0(o, osum, vb0 + o_cur, pa0, pa1, pa2, pa3);
  float rli[16];
#pragma unroll
  for (int r = 0; r < 16; ++r) rli[r] = __builtin_amdgcn_rcpf(osum[r]);
  bf16_t* Ow = Ob + (long)(wid * QBLK) * LDO;
#pragma unroll
  for (int r = 0; r < 16; ++r) { int orow = crow(r, hi);
#pragma unroll
    for (int d0 = 0; d0 < 2; ++d0) { const unsigned w = cvtpk(o[d0][r] * rli[r], 0.f); Ow[(long)orow * LDO + d0 * 32 + r32] = (bf16_t)(w & 0xffffu); } }
  __syncthreads();
#undef SLOAD
#undef SWRITE
#undef SWAIT
#undef RESC
#undef ROT
}
#undef KSWZ
#undef SBAR
}
namespace hg {
typedef unsigned short bf16_t;
using bf16x8 = __attribute__((ext_vector_type(8))) short;
using f32x16 = __attribute__((ext_vector_type(16))) float;
using f32x4  = __attribute__((ext_vector_type(4))) float;
using u32x4  = __attribute__((ext_vector_type(4))) unsigned;
#define SWZ256(row, colB) ((row) * 256 + ((colB) ^ (((row) & 7) << 4)))
#define SWZ128(row, colB) ((row) * 128 + ((colB) ^ (((((row) >> 4) ^ (row)) & 7) << 4)))
constexpr int GS = 132;
constexpr int L_ST = 0, L_QH = 32768, L_KH = 49152, L_KT = 65536, L_VT = 81920, L_GB = 98304, L_SEG = 98304 + 64 * GS * 4, L_DD = L_SEG + 2048, L_LB = L_DD + 512;
__device__ __forceinline__ int crow(int r, int hi) { return (r & 3) + 8 * (r >> 2) + 4 * hi; }
__device__ __forceinline__ unsigned cvtpk(float lo, float hi) { unsigned r; asm volatile("v_cvt_pk_bf16_f32 %0, %1, %2" : "=v"(r) : "v"(lo), "v"(hi)); return r; }
__device__ __forceinline__ float bf2f(unsigned short h) { return __uint_as_float(((unsigned)h) << 16); }
template <int MODE> __device__ __forceinline__ void chain(const bf16_t* __restrict__ U, float* __restrict__ OP, const float* __restrict__ hg_lb, int rowbase, int S, int h, int dir, int tau0, int nchunk,
                                                   const float* __restrict__ slot_in, float* __restrict__ slot_out, float* __restrict__ dseg_out, char* lds) {
  int tid_ = threadIdx.x; asm volatile("" : "+v"(tid_)); const int tid = tid_, wid = __builtin_amdgcn_readfirstlane(tid >> 6), lane = tid & 63, r32 = lane & 31, hi = lane >> 5;
  float* GB = (float*)(lds + L_GB); float* SEG = (float*)(lds + L_SEG); float* DD = (float*)(lds + L_DD); float* LB = (float*)(lds + L_LB);
  char* ST = lds + L_ST; char* QH = lds + L_QH; char* KH = lds + L_KH; char* KT = lds + L_KT; char* VT = lds + L_VT; char* AL = lds + L_GB;
  if (tid < 128) { const float a0 = hg_lb[dir * 1024 + h * 128 + tid], a1 = hg_lb[dir * 1024 + 512 + h * 128 + tid]; LB[tid] = 1.0f / (1.0f + __expf(a1 - a0)); }
  f32x16 sacc[2]; sacc[0] = f32x16{}; sacc[1] = f32x16{};
  if (MODE == 3) {
    if (slot_in) {
#pragma unroll
      for (int i = 0; i < 2; ++i)
#pragma unroll
        for (int r = 0; r < 16; ++r) sacc[i][r] = slot_in[(32 * (wid & 3) + crow(r, hi)) * 128 + 32 * (2 * (wid >> 2) + i) + r32];
    }
#pragma unroll
    for (int i = 0; i < 2; ++i)
#pragma unroll
      for (int r = 0; r < 16; ++r) *(bf16_t*)(ST + SWZ256(32 * (wid & 3) + crow(r, hi), 2 * (32 * (2 * (wid >> 2) + i) + r32))) = (bf16_t)(cvtpk(sacc[i][r], 0.f) & 0xffffu);
  }
  float dseg = 1.0f;
  const int tau = tid >> 3, c0 = (tid & 7) * 16, segt = tau >> 4;
  const bf16_t* Ub = U + (size_t)rowbase * 2560 + h * 128 + c0;
  const size_t offq = 0, offv = 512, offf = (size_t)(2 + dir) * 512;
  float* OPd = OP + (size_t)dir * T_ALL * 512;
  bf16x8 nq0 = {}, nq1 = {}, nv0, nv1, nf0, nf1;
  { const int t1 = tau0 + tau; const int tok = dir ? (S - 1 - t1) : t1; const bf16_t* p = Ub + (size_t)tok * 2560;
    if (MODE == 3) { nq0 = *(const bf16x8*)(p + offq); nq1 = *(const bf16x8*)(p + offq + 8); } nv0 = *(const bf16x8*)(p + offv); nv1 = *(const bf16x8*)(p + offv + 8); nf0 = *(const bf16x8*)(p + offf); nf1 = *(const bf16x8*)(p + offf + 8); }
  __syncthreads();
  for (int ci = 0; ci < nchunk; ++ci) {
    const bf16x8 qv[2] = {nq0, nq1}, vv[2] = {nv0, nv1}, fv[2] = {nf0, nf1};
    { const int cn = (ci + 1 < nchunk) ? ci + 1 : ci; const int t2 = tau0 + cn * 64 + tau; const int tok = dir ? (S - 1 - t2) : t2; const bf16_t* p = Ub + (size_t)tok * 2560;
      if (MODE == 3) { nq0 = *(const bf16x8*)(p + offq); nq1 = *(const bf16x8*)(p + offq + 8); } nv0 = *(const bf16x8*)(p + offv); nv1 = *(const bf16x8*)(p + offv + 8); nf0 = *(const bf16x8*)(p + offf); nf1 = *(const bf16x8*)(p + offf + 8); }
    float qq[16], kk[16];
#pragma unroll
    for (int j = 0; j < 16; ++j) {
      const float z = bf2f((unsigned short)fv[j >> 3][j & 7]); const float x = bf2f((unsigned short)qv[j >> 3][j & 7]);
      const float lbv = LB[c0 + j]; const float sg = __builtin_amdgcn_rcpf(1.0f + __builtin_amdgcn_exp2f(-1.4426950408889634f * z)); const float f = lbv + (1.0f - lbv) * sg;
      kk[j] = 1.0f - f; qq[j] = (MODE == 3) ? x * __builtin_amdgcn_rcpf(1.0f + __builtin_amdgcn_exp2f(-1.4426950408889634f * x)) : 0.f;
      GB[tau * GS + c0 + j] = __builtin_amdgcn_logf(f);
    }
    __syncthreads();
    { const int k = tid & 127, seg = tid >> 7; float run = 0.f;
#pragma unroll
      for (int j = 0; j < 16; ++j) { run += GB[(16 * seg + j) * GS + k]; GB[(16 * seg + j) * GS + k] = run; }
      SEG[seg * 128 + k] = run; }
    __syncthreads();
    { unsigned qh[8] = {}, kh[8] = {};
#pragma unroll
      for (int j = 0; j < 16; j += 2) {
        float g2[2], gl2[2];
#pragma unroll
        for (int e = 0; e < 2; ++e) { const int col = c0 + j + e; const float s0 = SEG[col], s1 = SEG[128 + col], s2 = SEG[256 + col];
          const float off = (segt >= 1 ? s0 : 0.f) + (segt >= 2 ? s1 : 0.f) + (segt >= 3 ? s2 : 0.f);
          g2[e] = GB[tau * GS + col] + off; gl2[e] = GB[63 * GS + col] + ((s0 + s1) + s2); }
        if (MODE == 3) { const float ea = __builtin_amdgcn_exp2f(g2[0]), eb = __builtin_amdgcn_exp2f(g2[1]);
          qh[j >> 1] = cvtpk(qq[j] * ea, qq[j + 1] * eb);
          kh[j >> 1] = cvtpk(kk[j] * __builtin_amdgcn_exp2f(fminf(-g2[0], 115.f)), kk[j + 1] * __builtin_amdgcn_exp2f(fminf(-g2[1], 115.f))); }
        const unsigned kt = cvtpk(kk[j] * __builtin_amdgcn_exp2f(gl2[0] - g2[0]), kk[j + 1] * __builtin_amdgcn_exp2f(gl2[1] - g2[1]));
        *(bf16_t*)(KT + SWZ128(c0 + j, 2 * tau)) = (bf16_t)(kt & 0xffffu); *(bf16_t*)(KT + SWZ128(c0 + j + 1, 2 * tau)) = (bf16_t)(kt >> 16);
        *(bf16_t*)(VT + SWZ128(c0 + j, 2 * tau)) = (bf16_t)vv[j >> 3][j & 7]; *(bf16_t*)(VT + SWZ128(c0 + j + 1, 2 * tau)) = (bf16_t)vv[(j + 1) >> 3][(j + 1) & 7];
        if (tau == 63) { DD[c0 + j] = __builtin_amdgcn_exp2f(gl2[0]); DD[c0 + j + 1] = __builtin_amdgcn_exp2f(gl2[1]); }
      }
      if (MODE == 3) {
      *(u32x4*)(QH + SWZ256(tau, 2 * c0)) = (u32x4){qh[0], qh[1], qh[2], qh[3]}; *(u32x4*)(QH + SWZ256(tau, 2 * c0 + 16)) = (u32x4){qh[4], qh[5], qh[6], qh[7]};
      *(u32x4*)(KH + SWZ256(tau, 2 * c0)) = (u32x4){kh[0], kh[1], kh[2], kh[3]}; *(u32x4*)(KH + SWZ256(tau, 2 * c0 + 16)) = (u32x4){kh[4], kh[5], kh[6], kh[7]}; }
    }
    __syncthreads();
    if (MODE == 3 && wid < 4 && wid != 1) { const int ti = wid >> 1, si = wid & 1; f32x16 a = f32x16{};
#pragma unroll
      for (int k8 = 0; k8 < 8; ++k8) { const int cb = (16 * k8 + 8 * hi) * 2;
        const bf16x8 av = *(const bf16x8*)(QH + SWZ256(32 * ti + r32, cb)); const bf16x8 bv = *(const bf16x8*)(KH + SWZ256(32 * si + r32, cb));
        a = __builtin_amdgcn_mfma_f32_32x32x16_bf16(av, bv, a, 0, 0, 0); }
#pragma unroll
      for (int r = 0; r < 16; ++r) { const int tl = 32 * ti + crow(r, hi), sl = 32 * si + r32; const float val = (sl <= tl) ? a[r] : 0.f;
        *(bf16_t*)(AL + SWZ128(tl, 2 * sl)) = (bf16_t)(cvtpk(val, 0.f) & 0xffffu); } }
    if (MODE == 3) __syncthreads();
    { const int th = wid >> 2, vb = wid & 3;
      if (MODE == 3) { f32x16 o = f32x16{};
      const int nks = th ? 4 : 2;
      for (int ks = 0; ks < nks; ++ks) { const int cb = (16 * ks + 8 * hi) * 2;
        const bf16x8 av = *(const bf16x8*)(AL + SWZ128(32 * th + r32, cb)); const bf16x8 bv = *(const bf16x8*)(VT + SWZ128(32 * vb + r32, cb));
        o = __builtin_amdgcn_mfma_f32_32x32x16_bf16(av, bv, o, 0, 0, 0); }
#pragma unroll
      for (int k8 = 0; k8 < 8; ++k8) { const int cb = (16 * k8 + 8 * hi) * 2;
        const bf16x8 av = *(const bf16x8*)(QH + SWZ256(32 * th + r32, cb)); const bf16x8 bv = *(const bf16x8*)(ST + SWZ256(32 * vb + r32, cb));
        o = __builtin_amdgcn_mfma_f32_32x32x16_bf16(av, bv, o, 0, 0, 0); }
#pragma unroll
      for (int r = 0; r < 16; ++r) { const int t2 = tau0 + ci * 64 + 32 * th + crow(r, hi); const int tok = dir ? (S - 1 - t2) : t2;
        OPd[(size_t)(rowbase + tok) * 512 + h * 128 + 32 * vb + r32] = o[r]; }
      } else { if (tid < 128) dseg *= DD[tid]; }
#pragma unroll
      for (int i = 0; i < 2; ++i) { const int kb = 2 * th + i; const float dk = DD[32 * kb + r32];
#pragma unroll
        for (int r = 0; r < 16; ++r) sacc[i][r] *= dk;
#pragma unroll
        for (int ks = 0; ks < 4; ++ks) { const int cb = (16 * ks + 8 * hi) * 2;
          const bf16x8 av = *(const bf16x8*)(VT + SWZ128(32 * vb + r32, cb)); const bf16x8 bv = *(const bf16x8*)(KT + SWZ128(32 * kb + r32, cb));
          sacc[i] = __builtin_amdgcn_mfma_f32_32x32x16_bf16(av, bv, sacc[i], 0, 0, 0); } }
    }
    __syncthreads();
    if (MODE == 3) { const int th = wid >> 2, vb = wid & 3;
#pragma unroll
      for (int i = 0; i < 2; ++i) { const int kb = 2 * th + i;
#pragma unroll
        for (int r = 0; r < 16; ++r) *(bf16_t*)(ST + SWZ256(32 * vb + crow(r, hi), 2 * (32 * kb + r32))) = (bf16_t)(cvtpk(sacc[i][r], 0.f) & 0xffffu); } }
  }
  if (MODE == 1) {
#pragma unroll
    for (int i = 0; i < 2; ++i)
#pragma unroll
      for (int r = 0; r < 16; ++r) slot_out[(32 * (wid & 3) + crow(r, hi)) * 128 + 32 * (2 * (wid >> 2) + i) + r32] = sacc[i][r];
    if (tid < 128) dseg_out[tid] = dseg;
  }
  __syncthreads();
}
#undef SWZ256
#undef SWZ128
}
typedef unsigned short bf16_t;
typedef float f32x4 __attribute__((ext_vector_type(4)));
typedef unsigned u32x4 __attribute__((ext_vector_type(4)));
typedef unsigned u32x2 __attribute__((ext_vector_type(2)));
typedef short bf16x8 __attribute__((ext_vector_type(8)));
#define LAS __attribute__((address_space(3)))
constexpr size_t MiB = 1u << 20;
constexpr size_t WS_SS = 0;
constexpr size_t WS_ROPEC = 4 * MiB, WS_ROPES = 5 * MiB;
constexpr size_t WS_W1GU = 16 * MiB, WS_W1D = 27 * MiB, WS_WIN = 33 * MiB, WS_WUQ = 40 * MiB, WS_WUKV = 41 * MiB, WS_WO = 42 * MiB, WS_W2GU = 44 * MiB, WS_W2D = 55 * MiB, WS_WPG = 61 * MiB, WS_WPP = 63 * MiB;
constexpr size_t WS_HB = 64 * MiB;
constexpr size_t WS_BIG = 256 * MiB;
constexpr size_t WS_UHG = WS_BIG, WS_UMLA = WS_BIG + 480 * MiB, WS_MIX = WS_BIG + 480 * MiB, WS_ACT = WS_BIG, WS_PROJ = WS_BIG;
constexpr size_t WS_PB = 928 * MiB;
constexpr size_t WS_SLOT = 976 * MiB;
constexpr size_t WS_DSEG = 8 * MiB;
constexpr size_t WS_END = 1024 * MiB;
constexpr size_t DO_Q = 0, DO_KN = 144 * MiB, DO_V = 240 * MiB, DO_KR = 336 * MiB;
constexpr int LDS_BYTES = 147456;
constexpr int LDS_BARST = 147392;
constexpr size_t WS_BAR = 12 * MiB;
#define XB_TMO      128
#define XB_XCNT(j)  (256  + 64 * (j))
#define XB_XSUB(j)  (1280 + 64 * (j))
#define XB_XGEN(j)  (2304 + 64 * (j))
#define XB_TOP      3328
#define XB_TOPGEN   3392
#define XCD_BAR_WORDS 3456
#define XB_SPIN_CAP (1u << 18)

__device__ __forceinline__ unsigned xb_ld(unsigned* p)              { return __hip_atomic_load(p, __ATOMIC_RELAXED, __HIP_MEMORY_SCOPE_AGENT); }
__device__ __forceinline__ unsigned xb_add(unsigned* p, unsigned v) { return __hip_atomic_fetch_add(p, v, __ATOMIC_RELAXED, __HIP_MEMORY_SCOPE_AGENT); }
__device__ __forceinline__ unsigned xb_xcc_id() { return (unsigned)__builtin_amdgcn_s_getreg((3 << 11) | 20) & 0xFu; }
#define XB_SPIN(cond, bar) do { unsigned _sp = 0; while (cond) { __builtin_amdgcn_s_sleep(1); \
    if ((++_sp & 255u) == 0u) { if (xb_ld(&(bar)[XB_TMO])) break; if (_sp > XB_SPIN_CAP) { atomicAdd(&(bar)[XB_TMO], 1u); break; } } } } while (0)

struct XcdBarrier {
    unsigned* bar; unsigned x;
    volatile LAS unsigned* st;
};

__device__ __forceinline__ XcdBarrier xcd_barrier_post(unsigned* bar, volatile LAS unsigned* st) {
    XcdBarrier b; b.bar = bar; b.x = xb_xcc_id(); b.st = st;
    if (threadIdx.x == 0) (void)xb_add(&bar[XB_XCNT(b.x)], 1u);
    return b;
}
__device__ __forceinline__ void xcd_barrier_complete(unsigned* bar, unsigned x, unsigned& nloc, unsigned& nx) {
    const unsigned G = gridDim.x * gridDim.y * gridDim.z;
    unsigned sum, cnt, mine, sp = 0u;
    for (;;) {
        sum = 0u; cnt = 0u; mine = 0u;
#pragma unroll
        for (unsigned j = 0; j < 16; ++j) { const unsigned c = xb_ld(&bar[XB_XCNT(j)]); sum += c; cnt += (c > 0u) ? 1u : 0u; mine = (j == x) ? c : mine; }
        if (sum == G) break;
        __builtin_amdgcn_s_sleep(1);
        if ((++sp & 255u) == 0u) { if (xb_ld(&bar[XB_TMO])) break; if (sp > XB_SPIN_CAP) { atomicAdd(&bar[XB_TMO], 1u); break; } }
    }
    nloc = mine > 0u ? mine : 1u; nx = cnt > 0u ? cnt : 1u;
}

__device__ __forceinline__ void xcd_barrier(const XcdBarrier& b) {
    asm volatile("s_waitcnt vmcnt(0)" ::: "memory");
    __syncthreads();
    if (threadIdx.x == 0) {
        unsigned* bar = b.bar;
        __builtin_amdgcn_s_waitcnt(0);
        unsigned nloc = b.st[0], nx = b.st[1];
        if (nloc == 0u) { xcd_barrier_complete(bar, b.x, nloc, nx); b.st[0] = nloc; b.st[1] = nx; }
        const unsigned old = xb_add(&bar[XB_XSUB(b.x)], 1u);
        const unsigned gen = old / nloc;
        if (old + 1u == (gen + 1u) * nloc) {
            __builtin_amdgcn_fence(__ATOMIC_RELEASE, "agent");
            asm volatile("s_waitcnt vmcnt(0)" ::: "memory");
            const unsigned og = xb_add(&bar[XB_TOP], 1u);
            const unsigned tg = og / nx;
            if (og + 1u == (tg + 1u) * nx) xb_add(&bar[XB_TOPGEN], 1u);
            else XB_SPIN(xb_ld(&bar[XB_TOPGEN]) == tg, bar);
            __builtin_amdgcn_fence(__ATOMIC_ACQUIRE, "agent");
            xb_add(&bar[XB_XGEN(b.x)], 1u);
            asm volatile("s_waitcnt vmcnt(0)" ::: "memory");
        } else {
            XB_SPIN(xb_ld(&bar[XB_XGEN(b.x)]) == gen, bar);
            __builtin_amdgcn_fence(__ATOMIC_ACQUIRE, "agent");
            asm volatile("s_waitcnt vmcnt(0)" ::: "memory");
        }
    }
    __syncthreads();
}


struct Params {
  const float* in[26];
  float* out; unsigned char* ws;
};

__device__ __forceinline__ unsigned f2bf(float f) { unsigned u = __builtin_bit_cast(unsigned, f); return (u + 0x7fffu + ((u >> 16) & 1u)) >> 16; }
__device__ __forceinline__ unsigned pk2(float lo, float hi) { return f2bf(lo) | (f2bf(hi) << 16); }
__device__ __forceinline__ float wave_sum(float v) {
#pragma unroll
  for (int o = 1; o < 64; o <<= 1) v += __shfl_xor(v, o);
  return v;
}
__device__ __forceinline__ void prep_item(const float* W, int ld, int col0, const float* fold, bf16_t* WT, int K, int n0, int k0, float* scr, int lane, bool perm) {
#pragma unroll 16
  for (int i = 0; i < 32; ++i) { const int kk = 2 * i + (lane >> 5); float v = 0.f; if (W) { const int p_ = lane & 31; const int cc = perm ? (16 * ((p_ >> 2) & 1) + 4 * (p_ >> 3) + (p_ & 3)) : p_; v = W[(size_t)(k0 + kk) * ld + col0 + cc]; if (fold) v *= fold[k0 + kk]; } scr[kk * 33 + (lane & 31)] = v; }
  asm volatile("s_waitcnt lgkmcnt(0)" ::: "memory");
  const int c = lane & 7;
#pragma unroll
  for (int j = 0; j < 4; ++j) { const int n = (lane >> 3) + 8 * j; const float* s = scr + (8 * c) * 33 + n;
    u32x4 o; o.x = pk2(s[0 * 33], s[1 * 33]); o.y = pk2(s[2 * 33], s[3 * 33]); o.z = pk2(s[4 * 33], s[5 * 33]); o.w = pk2(s[6 * 33], s[7 * 33]);
    *(u32x4*)(WT + (size_t)(n0 + n) * K + k0 + 8 * c) = o; }
  asm volatile("s_waitcnt lgkmcnt(0)" ::: "memory");
}
__device__ __forceinline__ void sincos_d(double x, float& s, float& c) {
  const double TWO_PI = 6.283185307179586476925286766559, INV_2PI = 0.15915494309189533576888376337251;
  double k = __builtin_rint(x * INV_2PI); double r = x - k * TWO_PI;
  const double HALF_PI = 1.5707963267948966192313216916398;
  double q = __builtin_rint(r * 0.63661977236758134308); double y = r - q * HALF_PI; int qi = ((int)q) & 3;
  double y2 = y * y;
  double sp = y * (1.0 + y2 * (-1.0 / 6 + y2 * (1.0 / 120 + y2 * (-1.0 / 5040 + y2 * (1.0 / 362880 + y2 * (-1.0 / 39916800 + y2 * (1.0 / 6227020800.0)))))));
  double cp = 1.0 + y2 * (-0.5 + y2 * (1.0 / 24 + y2 * (-1.0 / 720 + y2 * (1.0 / 40320 + y2 * (-1.0 / 3628800 + y2 * (1.0 / 479001600.0 + y2 * (-1.0 / 87178291200.0)))))));
  double ss, cc;
  if (qi == 0) { ss = sp; cc = cp; } else if (qi == 1) { ss = cp; cc = -sp; } else if (qi == 2) { ss = -sp; cc = -cp; } else { ss = -cp; cc = sp; }
  s = (float)ss; c = (float)cc;
}

__device__ __forceinline__ void p0_prologue(const Params& P, unsigned char* ws, char* lds) {
  int tid_ = threadIdx.x; asm volatile("" : "+v"(tid_)); const int tid = tid_, lane = tid & 63, wave = tid >> 6;
  const int gw = blockIdx.x * 8 + wave, NGW = gridDim.x * 8;
  float* scr = (float*)(lds + wave * 16384);
  constexpr int NJ = 10;
  const int jN[NJ] = {NGU, 1024, NIN, 768, 1024, 1024, NGU, 1024, 1024, 1024};
  const int jK[NJ] = {1024, DFF, 1024, 384, 256, 1024, 1024, DFF, 1024, 256};
  int total = 0;
#pragma unroll
  for (int j = 0; j < NJ; ++j) total += (jN[j] / 32) * (jK[j] / 64);
  const int gwp = blockIdx.x * 4 + (wave & 3), NGWP = gridDim.x * 4;
  if (wave < 4)
  for (int it = gwp; it < total; it += NGWP) {
    int r = it, job = 0;
#pragma unroll
    for (int j = 0; j < NJ; ++j) { const int cnt = (jN[j] / 32) * (jK[j] / 64); if (job == j && r >= cnt) { r -= cnt; job = j + 1; } }
    int N = 0, K = 0;
#pragma unroll
    for (int j = 0; j < NJ; ++j) if (job == j) { N = jN[j]; K = jK[j]; }
    const int nblk = N / 32, kb = r / nblk, nb = r % nblk, k0 = 64 * kb, n0 = 32 * nb;
    const float* W = nullptr; int ld = 0, col0 = 0; const float* fold = nullptr; bf16_t* WT = nullptr;
    if (job == 0 || job == 6) { const int t = n0 >> 8, half = (n0 >> 7) & 1, j0 = n0 & 127; const int b = (job == 0) ? 5 : 19;
      W = P.in[b + half]; ld = DFF; col0 = 128 * t + j0; fold = P.in[(job == 0) ? 4 : 18]; WT = (bf16_t*)(ws + ((job == 0) ? WS_W1GU : WS_W2GU)); }
    else if (job == 1 || job == 7) { W = P.in[(job == 1) ? 7 : 21]; ld = 1024; col0 = n0; WT = (bf16_t*)(ws + ((job == 1) ? WS_W1D : WS_W2D)); }
    else if (job == 2) { ld = 3232; fold = P.in[8]; WT = (bf16_t*)(ws + WS_WIN); W = P.in[9];
      if (n0 < 384) col0 = n0; else if (n0 < 416) col0 = 640 + (n0 - 384); else if (n0 < 512) W = nullptr; else if (n0 < 768) col0 = 384 + (n0 - 512); else col0 = 672 + (n0 - 768); }
    else if (job == 3) { W = P.in[11]; ld = 768; col0 = n0; fold = P.in[10]; WT = (bf16_t*)(ws + WS_WUQ); }
    else if (job == 4) { if (n0 < 512) { W = P.in[13]; col0 = n0; } else { W = P.in[14]; col0 = n0 - 512; } ld = 512; fold = P.in[12]; WT = (bf16_t*)(ws + WS_WUKV); }
    else if (job == 5) { W = P.in[17]; ld = 1024; col0 = n0; WT = (bf16_t*)(ws + WS_WO); }
    else if (job == 8) { W = P.in[23]; ld = 1024; col0 = n0; fold = P.in[22]; WT = (bf16_t*)(ws + WS_WPG); }
    else { W = P.in[24]; ld = 1024; col0 = n0; WT = (bf16_t*)(ws + WS_WPP); }
    prep_item(W, ld, col0, fold, WT, K, n0, k0, scr, lane, job == 2 && n0 == 384);
  }
  float* ss = (float*)(ws + WS_SS); bf16_t* HB = (bf16_t*)(ws + WS_HB); bf16_t* PB = (bf16_t*)(ws + WS_PB);
  if (wave >= 4)
  for (int m0 = gwp; m0 < T_ALL; m0 += 2 * NGWP) {
    f32x4 v[2][4], pv[2]; bool ok[2];
#pragma unroll
    for (int q = 0; q < 2; ++q) { const int m = m0 + q * NGWP; ok[q] = m < T_ALL; const int mm = ok[q] ? m : m0;
      const float* xr = (mm < T_P) ? P.in[0] + (size_t)mm * DM : P.in[1] + (size_t)(mm - T_P) * DM; const f32x4* x4 = (const f32x4*)xr + lane;
#pragma unroll
      for (int j = 0; j < 4; ++j) v[q][j] = x4[64 * j];
      const float* pr = (mm < T_P) ? P.in[2] + (size_t)mm * PLE : P.in[3] + (size_t)(mm - T_P) * PLE; pv[q] = ((const f32x4*)pr)[lane]; }
#pragma unroll
    for (int q = 0; q < 2; ++q) { const int m = m0 + q * NGWP; if (!ok[q]) continue; float s = 0.f;
#pragma unroll
      for (int j = 0; j < 4; ++j) s += (v[q][j][0] * v[q][j][0] + v[q][j][1] * v[q][j][1]) + (v[q][j][2] * v[q][j][2] + v[q][j][3] * v[q][j][3]);
      s = wave_sum(s);
      u32x2* o8 = (u32x2*)(HB + (size_t)m * DM) + lane;
#pragma unroll
      for (int j = 0; j < 4; ++j) { u32x2 w; w.x = pk2(v[q][j][0], v[q][j][1]); w.y = pk2(v[q][j][2], v[q][j][3]); o8[64 * j] = w; }
      u32x2 w; w.x = pk2(pv[q][0], pv[q][1]); w.y = pk2(pv[q][2], pv[q][3]); ((u32x2*)(PB + (size_t)m * PLE))[lane] = w;
      if (lane < 7) ss[(size_t)lane * T_ALL + m] = (lane == 0) ? s : 0.f; }
  }
  float* rc = (float*)(ws + WS_ROPEC); float* rs = (float*)(ws + WS_ROPES);
  for (int e = blockIdx.x * 512 + tid; e < S_P * 16; e += gridDim.x * 512) {
    const int pos = e >> 4, i = e & 15;
    const float cst = (float)(-9.210340371976184 / 32.0); const float arg = (float)(2 * i) * cst;
    const double a = (double)arg; const double nn = __builtin_rint(a * 1.4426950408889634); const double rr = a - nn * 0.69314718055994530942;
    double ex = 1.0 + rr * (1.0 + rr * (0.5 + rr * (1.0 / 6 + rr * (1.0 / 24 + rr * (1.0 / 120 + rr * (1.0 / 720 + rr * (1.0 / 5040 + rr * (1.0 / 40320 + rr * (1.0 / 362880 + rr * (1.0 / 3628800 + rr * (1.0 / 39916800)))))))))));
    ex = ex * __builtin_ldexp(1.0, (int)nn);
    const float invf = (float)ex; const float ang = (float)pos * invf;
    float sv, cv; sincos_d((double)ang, sv, cv); rc[e] = cv; rs[e] = sv;
  }
}
__device__ __forceinline__ void hg_combine(const float* OP, const bf16_t* U, const float* hg_norm, bf16_t* MIX) {
  int tid_ = threadIdx.x; asm volatile("" : "+v"(tid_)); const int lane = tid_ & 63, wave = tid_ >> 6; const int gw = blockIdx.x * 8 + wave, NGW = gridDim.x * 8;
  f32x4 gn0 = *(const f32x4*)(hg_norm + 8 * lane), gn1 = *(const f32x4*)(hg_norm + 8 * lane + 4);
  for (int m = gw; m < T_ALL; m += NGW) {
    const float* a = OP + (size_t)m * 512 + 8 * lane; const float* b = a + (size_t)T_ALL * 512;
    f32x4 o0 = *(const f32x4*)a + *(const f32x4*)b, o1 = *(const f32x4*)(a + 4) + *(const f32x4*)(b + 4);
    float s = (o0[0] * o0[0] + o0[1] * o0[1]) + (o0[2] * o0[2] + o0[3] * o0[3]) + (o1[0] * o1[0] + o1[1] * o1[1]) + (o1[2] * o1[2] + o1[3] * o1[3]);
    s += __shfl_xor(s, 1); s += __shfl_xor(s, 2); s += __shfl_xor(s, 4); s += __shfl_xor(s, 8);
    const float r = rsqrtf(s * (1.0f / 128.0f) + EPS);
    const bf16x8 g = *(const bf16x8*)(U + (size_t)m * 2560 + 2048 + 8 * lane);
    float ov[8] = {o0[0], o0[1], o0[2], o0[3], o1[0], o1[1], o1[2], o1[3]}; float gnv[8] = {gn0[0], gn0[1], gn0[2], gn0[3], gn1[0], gn1[1], gn1[2], gn1[3]};
    unsigned w[4];
#pragma unroll
    for (int j = 0; j < 8; j += 2) { float r2[2];
#pragma unroll
      for (int e = 0; e < 2; ++e) { const float x = __uint_as_float(((unsigned)(unsigned short)g[j + e]) << 16); const float sl = x * __builtin_amdgcn_rcpf(1.0f + __builtin_amdgcn_exp2f(-1.4426950408889634f * x)); r2[e] = ov[j + e] * r * gnv[j + e] * sl; }
      w[j >> 1] = pk2(r2[0], r2[1]); }
    *(u32x4*)(MIX + (size_t)m * 1024 + 512 + 8 * lane) = (u32x4){w[0], w[1], w[2], w[3]};
  }
}
__device__ __forceinline__ void final_norm(float* out, const bf16_t* h4, const float* ss4, const float* fn) {
  int tid_ = threadIdx.x; asm volatile("" : "+v"(tid_)); const int lane = tid_ & 63, wave = tid_ >> 6; const int gw = blockIdx.x * 8 + wave, NGW = gridDim.x * 8;
  f32x4 g[2][2];
#pragma unroll
  for (int j = 0; j < 2; ++j) { g[j][0] = *(const f32x4*)(fn + 512 * j + 8 * lane); g[j][1] = *(const f32x4*)(fn + 512 * j + 8 * lane + 4); }
  for (int m0 = gw; m0 < T_ALL; m0 += 2 * NGW) {
    u32x4 h[2][2]; float r[2]; bool ok[2];
#pragma unroll
    for (int q = 0; q < 2; ++q) { const int m = m0 + q * NGW; ok[q] = m < T_ALL; const int mm = ok[q] ? m : m0; r[q] = ss4[mm];
#pragma unroll
      for (int j = 0; j < 2; ++j) h[q][j] = *(const u32x4*)(h4 + (size_t)mm * DM + 512 * j + 8 * lane); }
#pragma unroll
    for (int q = 0; q < 2; ++q) { const int m = m0 + q * NGW; if (!ok[q]) continue; const float rr = rsqrtf(r[q] * (1.0f / 1024.0f) + EPS);
#pragma unroll
      for (int j = 0; j < 2; ++j) { const u32x4 hh = h[q][j];
        f32x4 a, b; a[0] = __uint_as_float(hh.x << 16); a[1] = __uint_as_float(hh.x & 0xffff0000u); a[2] = __uint_as_float(hh.y << 16); a[3] = __uint_as_float(hh.y & 0xffff0000u);
        b[0] = __uint_as_float(hh.z << 16); b[1] = __uint_as_float(hh.z & 0xffff0000u); b[2] = __uint_as_float(hh.w << 16); b[3] = __uint_as_float(hh.w & 0xffff0000u);
        float* o = out + (size_t)m * DM + 512 * j + 8 * lane; *(f32x4*)o = a * rr * g[j][0]; *(f32x4*)(o + 4) = b * rr * g[j][1]; } }
  }
}

#define GSYNC() xcd_barrier(xbar)

template <class Epi> __device__ __forceinline__ void run_gemm(LAS unsigned char* lds, const bf16_t* A, int lda, const bf16_t* Bt, int ldb, int N, int K, const Epi& E) {
  pg8::Gemm g{A, Bt, T_ALL, N, K, lda, ldb}; pg8::StaticOrder S; S.init(T_ALL, N, (int)gridDim.x, (int)blockIdx.x);
  pg8::gemm_phase<Epi, pg8::StaticOrder, true, true>(lds, g, S, E);
}

__global__ void __launch_bounds__(512, 2) mk_fwd(Params P) {
  extern __shared__ __attribute__((aligned(16))) unsigned char lds[];
  unsigned char* ws = P.ws; float* out = P.out; unsigned char* dob = (unsigned char*)P.out;
  LAS unsigned char* l3 = (LAS unsigned char*)lds;
  float* ss = (float*)(ws + WS_SS);
  float* ss0 = ss, *ss1 = ss + T_ALL, *ss2 = ss + 2 * (size_t)T_ALL, *ss3 = ss + 3 * (size_t)T_ALL, *ss4 = ss + 4 * (size_t)T_ALL, *ssq = ss + 5 * (size_t)T_ALL, *sskv = ss + 6 * (size_t)T_ALL;
  const float* ropec = (const float*)(ws + WS_ROPEC); const float* ropes = (const float*)(ws + WS_ROPES);
  bf16_t* HB = (bf16_t*)(ws + WS_HB); bf16_t* ACT = (bf16_t*)(ws + WS_ACT); bf16_t* UHG = (bf16_t*)(ws + WS_UHG); bf16_t* UMLA = (bf16_t*)(ws + WS_UMLA);
  bf16_t* MIX = (bf16_t*)(ws + WS_MIX); bf16_t* H4B = (bf16_t*)(ws + WS_MIX);     bf16_t* PROJ = (bf16_t*)(ws + WS_PROJ); bf16_t* PB = (bf16_t*)(ws + WS_PB);
  bf16_t* Qb = (bf16_t*)(dob + DO_Q); bf16_t* KN = (bf16_t*)(dob + DO_KN); bf16_t* Vb = (bf16_t*)(dob + DO_V); bf16_t* KR = (bf16_t*)(dob + DO_KR);

  if (threadIdx.x < 16) ((LAS unsigned*)(l3 + LDS_BARST))[threadIdx.x] = 0u;
  if (blockIdx.x == 0) { for (int i = threadIdx.x; i < XCD_BAR_WORDS; i += 512) __hip_atomic_store((unsigned*)(ws + WS_BAR) + i, 0u, __ATOMIC_RELAXED, __HIP_MEMORY_SCOPE_AGENT); }
  p0_prologue(P, ws, (char*)lds);
  cg::this_grid().sync();
  const XcdBarrier xbar = xcd_barrier_post((unsigned*)(ws + WS_BAR), (volatile LAS unsigned*)(l3 + LDS_BARST));
  { pg8::EpiSwiGLU E{ACT, ss0}; run_gemm(l3, HB, 1024, (const bf16_t*)(ws + WS_W1GU), 1024, NGU, 1024, E); }
  GSYNC();
  { pg8::EpiRes<2> E{nullptr, nullptr, HB, nullptr, ss1, nullptr, nullptr}; run_gemm(l3, ACT, DFF, (const bf16_t*)(ws + WS_W1D), DFF, 1024, DFF, E); }
  GSYNC();
  { pg8::EpiWin E{UMLA, UHG, KR, ss1, ssq, sskv, ropec, ropes}; run_gemm(l3, HB, 1024, (const bf16_t*)(ws + WS_WIN), 1024, NIN, 1024, E); }
  GSYNC();
  { pg8::EpiBf E{Qb, Qb, 768, 1000, ssq, 1.0f / 384.0f, att::SCALE * 1.4426950408889634f}; run_gemm(l3, UMLA, 768, (const bf16_t*)(ws + WS_WUQ), 384, 768, 384, E); }
  { pg8::EpiBf E{KN, Vb, 512, 2, sskv, 1.0f / 256.0f, 1.0f}; run_gemm(l3, UMLA + 512, 768, (const bf16_t*)(ws + WS_WUKV), 256, 1024, 256, E); }
  {
    float* SLOT = (float*)(ws + WS_SLOT); float* DSEG = (float*)(ws + WS_DSEG);
    for (int u = blockIdx.x; u < 768; u += gridDim.x) {
      int chainid, seg, nseg;
      if (u < 256) { chainid = u >> 4; seg = u & 15; nseg = 16; } else { const int u2 = u - 256; chainid = 16 + (u2 >> 2); seg = u2 & 3; nseg = 4; }
      if (seg == nseg - 1) continue;
      int rowbase, S, h, dir;
      if (chainid < 16) { const int b = chainid >> 3; h = (chainid >> 1) & 3; dir = chainid & 1; rowbase = b * S_P; S = S_P; }
      else { const int c2 = chainid - 16; const int b = c2 >> 3; h = (c2 >> 1) & 3; dir = c2 & 1; rowbase = T_P + b * S_S; S = S_S; }
      hg::chain<1>(UHG, out, P.in[15], rowbase, S, h, dir, seg * 1024, 16, nullptr, SLOT + (size_t)u * 16384, DSEG + (size_t)u * 128, (char*)lds);
    }
  }
  GSYNC();
  {
    float* SLOT = (float*)(ws + WS_SLOT); const float* DSEG = (const float*)(ws + WS_DSEG);
    int tid_ = threadIdx.x; asm volatile("" : "+v"(tid_));
    for (int e = blockIdx.x * 512 + tid_; e < 144 * 16384; e += gridDim.x * 512) {
      const int chainid = e >> 14, el = e & 16383, k = el & 127;
      int u0, nseg; if (chainid < 16) { u0 = chainid * 16; nseg = 16; } else { u0 = 256 + (chainid - 16) * 4; nseg = 4; }
      float Sv = 0.f;
      if (nseg == 16) { float slv[15], dv[15];
#pragma unroll
        for (int s = 0; s < 15; ++s) { slv[s] = SLOT[(size_t)(u0 + s) * 16384 + el]; dv[s] = DSEG[(size_t)(u0 + s) * 128 + k]; }
#pragma unroll
        for (int s = 0; s < 15; ++s) { Sv = dv[s] * Sv + slv[s]; SLOT[(size_t)(u0 + s) * 16384 + el] = Sv; } }
      else { float slv[3], dv[3];
#pragma unroll
        for (int s = 0; s < 3; ++s) { slv[s] = SLOT[(size_t)(u0 + s) * 16384 + el]; dv[s] = DSEG[(size_t)(u0 + s) * 128 + k]; }
#pragma unroll
        for (int s = 0; s < 3; ++s) { Sv = dv[s] * Sv + slv[s]; SLOT[(size_t)(u0 + s) * 16384 + el] = Sv; } }
    }
  }
  {
    const int G = gridDim.x, bx = blockIdx.x;
    if (G == 256) {
      const int xcd = bx & 7, idx = bx >> 3;
      for (int i = 0; i < 12; ++i) {
        int rowbase, seq, h, qb;
        if (i < 4) { const int pair = 2 * xcd + (i >> 1); const int b = pair >> 3; h = pair & 7; qb = idx * 2 + (i & 1); rowbase = b * S_P; seq = S_P; }
        else { const int j = i - 4; const int pair = 16 * xcd + 2 * j + (idx >> 4); const int b = pair >> 3; h = pair & 7; qb = idx & 15; rowbase = T_P + b * S_S; seq = S_S; }
        att::attn_unit(Qb + (size_t)(rowbase + qb * 256) * 768 + h * 96, KN + (size_t)rowbase * 512 + h * 64, KR + (size_t)rowbase * 32, Vb + (size_t)rowbase * 512 + h * 64,
                       MIX + (size_t)(rowbase + qb * 256) * 1024 + h * 64, seq, rowbase + qb * 256, ropec, ropes, (char*)lds);
      }
    } else {
      for (int u = bx; u < 3072; u += G) {
        int rowbase, seq, h, qb;
        if (u < 1024) { const int pair = u >> 6; const int b = pair >> 3; h = pair & 7; qb = u & 63; rowbase = b * S_P; seq = S_P; }
        else { const int v = u - 1024; const int pair = v >> 4; const int b = pair >> 3; h = pair & 7; qb = v & 15; rowbase = T_P + b * S_S; seq = S_S; }
        att::attn_unit(Qb + (size_t)(rowbase + qb * 256) * 768 + h * 96, KN + (size_t)rowbase * 512 + h * 64, KR + (size_t)rowbase * 32, Vb + (size_t)rowbase * 512 + h * 64,
                       MIX + (size_t)(rowbase + qb * 256) * 1024 + h * 64, seq, rowbase + qb * 256, ropec, ropes, (char*)lds);
      }
    }
  }
  GSYNC();
  {
    const float* SLOT = (const float*)(ws + WS_SLOT);
    for (int u = blockIdx.x; u < 768; u += gridDim.x) {
      int chainid, seg;
      if (u < 256) { chainid = u >> 4; seg = u & 15; } else { const int u2 = u - 256; chainid = 16 + (u2 >> 2); seg = u2 & 3; }
      int rowbase, S, h, dir;
      if (chainid < 16) { const int b = chainid >> 3; h = (chainid >> 1) & 3; dir = chainid & 1; rowbase = b * S_P; S = S_P; }
      else { const int c2 = chainid - 16; const int b = c2 >> 3; h = (c2 >> 1) & 3; dir = c2 & 1; rowbase = T_P + b * S_S; S = S_S; }
      hg::chain<3>(UHG, out, P.in[15], rowbase, S, h, dir, seg * 1024, 16, seg ? SLOT + (size_t)(u - 1) * 16384 : nullptr, nullptr, nullptr, (char*)lds);
    }
  }
  GSYNC();
  hg_combine(out, UHG, P.in[16], MIX);
  GSYNC();
  { pg8::EpiRes<1> E{nullptr, nullptr, HB, nullptr, ss2, nullptr, nullptr}; run_gemm(l3, MIX, 1024, (const bf16_t*)(ws + WS_WO), 1024, 1024, 1024, E); }
  GSYNC();
  { pg8::EpiSwiGLU E{ACT, ss2}; run_gemm(l3, HB, 1024, (const bf16_t*)(ws + WS_W2GU), 1024, NGU, 1024, E); }
  GSYNC();
  { pg8::EpiRes<2> E{nullptr, nullptr, HB, nullptr, ss3, nullptr, nullptr}; run_gemm(l3, ACT, DFF, (const bf16_t*)(ws + WS_W2D), DFF, 1024, DFF, E); }
  GSYNC();
  { pg8::EpiBf E{PROJ, PROJ, 1024, 1000, nullptr, 0.f, 1.0f}; run_gemm(l3, PB, 256, (const bf16_t*)(ws + WS_WPP), 256, 1024, 256, E); }
  GSYNC();
  { pg8::EpiRes<3> E{nullptr, nullptr, HB, H4B, ss4, ss3, PROJ}; run_gemm(l3, HB, 1024, (const bf16_t*)(ws + WS_WPG), 1024, 1024, 1024, E); }
  GSYNC();
  final_norm(out, H4B, ss4, P.in[25]);
}

extern "C" void kernel_launch(void* const* d_in, const int* in_sizes, int n_in, void* d_out, int out_size, void* d_ws, size_t ws_size, hipStream_t stream) {
  static int grid = 0;
  if (grid == 0) {
    if (n_in != 26 || out_size != T_ALL * DM || ws_size < WS_END) { fprintf(stderr, "kernel_launch: unexpected shapes n_in %d out %d ws %zu\n", n_in, out_size, ws_size); grid = -1; return; }
    int dev = 0, cus = 0, per_cu = 0;
    if (hipGetDevice(&dev) != hipSuccess || hipDeviceGetAttribute(&cus, hipDeviceAttributeMultiprocessorCount, dev) != hipSuccess) { grid = -1; return; }
    if (hipFuncSetAttribute((const void*)mk_fwd, hipFuncAttributeMaxDynamicSharedMemorySize, LDS_BYTES) != hipSuccess) { fprintf(stderr, "kernel_launch: LDS attribute failed\n"); grid = -1; return; }
    if (hipOccupancyMaxActiveBlocksPerMultiprocessor(&per_cu, (const void*)mk_fwd, 512, LDS_BYTES) != hipSuccess || per_cu < 1) { fprintf(stderr, "kernel_launch: occupancy query says %d\n", per_cu); per_cu = 1; }
    (void)hipGetLastError();
    grid = cus;
  }
  if (grid < 0) return;
  Params p{};
  for (int i = 0; i < 26; ++i) p.in[i] = (const float*)d_in[i];
  p.out = (float*)d_out; p.ws = (unsigned char*)d_ws;
  void* args[] = {&p};
  hipError_t e = hipLaunchCooperativeKernel((void*)mk_fwd, dim3(grid), dim3(512), args, LDS_BYTES, stream);
  if (e != hipSuccess) fprintf(stderr, "cooperative launch failed: %s (grid %d)\n", hipGetErrorString(e), grid);
}
```

```cpp
#include <hip/hip_runtime.h>
#include <hip/hip_cooperative_groups.h>
#include <cstdio>
#include <cstdint>
namespace cg = cooperative_groups;

constexpr int DM = 1024, T_P = 32768, T_ALL = 98304, S_P = 16384, S_S = 4096;
constexpr int DFF = 2816, NGU = 5632, NIN = 3328, NMLA = 768, NHG = 2560, PLE = 256;
constexpr float EPS = 1e-6f;
__device__ __forceinline__ int row_pos(int row) { return row < T_P ? (row & (S_P - 1)) : (row & (S_S - 1)); }

namespace pg8 {
#define PG8_LAS __attribute__((address_space(3)))
typedef unsigned short bf16_t;
typedef short bf16x8 __attribute__((ext_vector_type(8)));
typedef float f32x4 __attribute__((ext_vector_type(4)));
typedef unsigned u32x4 __attribute__((ext_vector_type(4)));
constexpr int BM = 256, BK = 64, HALF = 128, HTB = HALF * BK * 2  , STAGE_BYTES = 8 * HTB, NXCD = 8, WGM = 8;

__host__ __device__ __forceinline__ int lds_byte(int r, int c) { const int st = (r >> 4) * 2 + (c >> 5), rr = r & 15, cc = c & 31, ob = rr * 64 + cc * 2; return st * 1024 + (ob ^ (((ob >> 9) & 1) << 5)); }
__host__ __device__ __forceinline__ void stage_rc(int b, int& R, int& C) { const int st = b / 1024, sb = b % 1024, swz = sb ^ (((sb >> 9) & 1) << 5); R = (st >> 1) * 16 + swz / 64; C = (st & 1) * 32 + (swz % 64) / 2; }
__host__ __device__ __forceinline__ int perm32(int rho) { const int n = rho >> 4, i = rho & 15; return 8 * (i >> 2) + 4 * n + (i & 3); }

struct Unit { int pm, pn; };
struct Gemm { const bf16_t* A; const bf16_t* Bt; int M, N, K, lda, ldb; };

struct StaticOrder {
    int nM, nN, nwg, G, c;
    __host__ __device__ void init(int M, int N, int G_, int c_) { nM = M / BM; nN = N / BM; nwg = nM * nN; G = G_; c = c_; }
    __host__ __device__ bool next(int i, Unit& u) const {
        const long L = (long)i * G + c; if (L >= nwg) return false;
        int wgid = (int)L; { const int q = nwg / NXCD, r = nwg % NXCD, xcd = wgid % NXCD, off = wgid / NXCD; wgid = (xcd < r ? xcd * (q + 1) : r * (q + 1) + (xcd - r) * q) + off; }
        const int nig = WGM * nN, gid = wgid / nig, fm = gid * WGM, gsz = (nM - fm) < WGM ? (nM - fm) : WGM;
        u.pm = fm + ((wgid % nig) % gsz); u.pn = (wgid % nig) / gsz; return true;
    }
    __device__ __forceinline__ void a_ready(const Unit&) const {}
    __device__ __forceinline__ void done(const Unit&) const {}
};
__device__ __forceinline__ unsigned cvt_pk_bf16(float lo, float hi) { unsigned r; asm volatile("v_cvt_pk_bf16_f32 %0, %1, %2" : "=v"(r) : "v"(lo), "v"(hi)); return r; }
typedef unsigned u32x2 __attribute__((ext_vector_type(2)));
__device__ __forceinline__ float bf2f(unsigned short h) { return __uint_as_float(((unsigned)h) << 16); }
__device__ __forceinline__ float fsigmoid(float x) { return __builtin_amdgcn_rcpf(1.0f + __builtin_amdgcn_exp2f(-1.4426950408889634f * x)); }
__device__ __forceinline__ float row_sum4(float s) { s += __shfl_xor(s, 16); s += __shfl_xor(s, 32); return s; }

struct EpiSwiGLU {
    static constexpr bool PERM = true, AFTER_DRAIN = false;
    bf16_t* O; const float* ss;
    __device__ __forceinline__ void operator()(const f32x4 (&acc)[2][2][4][2], const Unit& u, int wr, int wc, int fr, int fq) const {
        const int row0 = u.pm * BM + wr * 64 + fr; const int col0 = u.pn * HALF + wc * 32 + 8 * fq;
        float ssv[2][4];
#pragma unroll
        for (int ai = 0; ai < 2; ++ai)
#pragma unroll
            for (int m = 0; m < 4; ++m) ssv[ai][m] = ss[row0 + ai * HALF + m * 16];
#pragma unroll
        for (int ai = 0; ai < 2; ++ai)
#pragma unroll
            for (int m = 0; m < 4; ++m) { const int row = row0 + ai * HALF + m * 16; const float r = __builtin_amdgcn_rsqf(ssv[ai][m] * (1.0f / 1024.0f) + 1e-6f);
                const float c1 = -1.4426950408889634f * r, r2 = r * r;
                f32x4 vv[2];
#pragma unroll
                for (int n = 0; n < 2; ++n) { const f32x4 a = acc[ai][0][m][n], b = acc[ai][1][m][n]; const f32x4 m1 = a * c1; f32x4 d;
                    d[0] = __builtin_amdgcn_exp2f(m1[0]); d[1] = __builtin_amdgcn_exp2f(m1[1]); d[2] = __builtin_amdgcn_exp2f(m1[2]); d[3] = __builtin_amdgcn_exp2f(m1[3]);
                    d = d + 1.0f; f32x4 inv; inv[0] = __builtin_amdgcn_rcpf(d[0]); inv[1] = __builtin_amdgcn_rcpf(d[1]); inv[2] = __builtin_amdgcn_rcpf(d[2]); inv[3] = __builtin_amdgcn_rcpf(d[3]);
                    vv[n] = (a * b) * (inv * r2); }
                u32x4 w; w.x = cvt_pk_bf16(vv[0][0], vv[0][1]); w.y = cvt_pk_bf16(vv[0][2], vv[0][3]); w.z = cvt_pk_bf16(vv[1][0], vv[1][1]); w.w = cvt_pk_bf16(vv[1][2], vv[1][3]);
                __builtin_nontemporal_store(w, (u32x4*)(O + (size_t)row * 2816 + col0)); }
    }
};
template <int MODE> struct EpiRes {
    static constexpr bool PERM = true, AFTER_DRAIN = false;
    const float* xp; const float* xs; bf16_t* hb; bf16_t* hout; float* ssout; const float* ssin; const bf16_t* proj;
    __device__ __forceinline__ void operator()(const f32x4 (&acc)[2][2][4][2], const Unit& u, int wr, int wc, int fr, int fq) const {
        const int row0 = u.pm * BM + wr * 64 + fr; const int col0 = u.pn * BM + wc * 32 + 8 * fq;
        float s3v[2][4];
        if (MODE == 3) {
#pragma unroll
            for (int ai = 0; ai < 2; ++ai)
#pragma unroll
                for (int m = 0; m < 4; ++m) s3v[ai][m] = ssin[row0 + ai * HALF + m * 16]; }
#pragma unroll
        for (int ai = 0; ai < 2; ++ai) {
            u32x4 hpre[4][2];
            if (MODE != 0) {
#pragma unroll
                for (int m = 0; m < 4; ++m)
#pragma unroll
                    for (int bj = 0; bj < 2; ++bj) hpre[m][bj] = *(const u32x4*)(hb + (size_t)(row0 + ai * HALF + m * 16) * 1024 + col0 + bj * HALF); }
#pragma unroll
            for (int m = 0; m < 4; ++m) { const int row = row0 + ai * HALF + m * 16; float sq = 0.f; float r3 = 0.f;
                if (MODE == 3) r3 = __builtin_amdgcn_rsqf(s3v[ai][m] * (1.0f / 1024.0f) + 1e-6f);
#pragma unroll
                for (int bj = 0; bj < 2; ++bj) { const size_t off = (size_t)row * 1024 + col0 + bj * HALF; float b[8], v[8];
                    if (MODE == 0) { const float* xr = (row < 32768) ? (xp + off) : (xs + (off - (size_t)32768 * 1024)); const f32x4 b0 = *(const f32x4*)xr, b1 = *(const f32x4*)(xr + 4);
                        b[0] = b0[0]; b[1] = b0[1]; b[2] = b0[2]; b[3] = b0[3]; b[4] = b1[0]; b[5] = b1[1]; b[6] = b1[2]; b[7] = b1[3]; }
                    else { const u32x4 h4 = hpre[m][bj];
                        b[0] = __uint_as_float(h4.x << 16); b[1] = __uint_as_float(h4.x & 0xffff0000u); b[2] = __uint_as_float(h4.y << 16); b[3] = __uint_as_float(h4.y & 0xffff0000u);
                        b[4] = __uint_as_float(h4.z << 16); b[5] = __uint_as_float(h4.z & 0xffff0000u); b[6] = __uint_as_float(h4.w << 16); b[7] = __uint_as_float(h4.w & 0xffff0000u); }
                    if (MODE == 3) { const u32x4 p4 = *(const u32x4*)(proj + off); float pr[8];
                        pr[0] = __uint_as_float(p4.x << 16); pr[1] = __uint_as_float(p4.x & 0xffff0000u); pr[2] = __uint_as_float(p4.y << 16); pr[3] = __uint_as_float(p4.y & 0xffff0000u);
                        pr[4] = __uint_as_float(p4.z << 16); pr[5] = __uint_as_float(p4.z & 0xffff0000u); pr[6] = __uint_as_float(p4.w << 16); pr[7] = __uint_as_float(p4.w & 0xffff0000u);
#pragma unroll
                        for (int j = 0; j < 8; ++j) v[j] = b[j] + fsigmoid(acc[ai][bj][m][j >> 2][j & 3] * r3) * pr[j]; }
                    else {
#pragma unroll
                        for (int j = 0; j < 8; ++j) v[j] = b[j] + acc[ai][bj][m][j >> 2][j & 3] * ((MODE == 1) ? 1.0f : 0.5f); }
#pragma unroll
                    for (int j = 0; j < 8; ++j) sq += v[j] * v[j];
                    u32x4 w; w.x = cvt_pk_bf16(v[0], v[1]); w.y = cvt_pk_bf16(v[2], v[3]); w.z = cvt_pk_bf16(v[4], v[5]); w.w = cvt_pk_bf16(v[6], v[7]);
                    *(u32x4*)(((MODE == 3) ? hout : hb) + off) = w; }
                sq = row_sum4(sq);
                if (fq == 0) atomicAdd(ssout + row, sq); }
        }
    }
};
struct EpiWin {
    static constexpr bool PERM = true, AFTER_DRAIN = false;
    bf16_t* umla; bf16_t* uhg; bf16_t* kr; const float* ss1; float* ssq; float* sskv; const float* ropec; const float* ropes;
    __device__ __forceinline__ void operator()(const f32x4 (&acc)[2][2][4][2], const Unit& u, int wr, int wc, int fr, int fq) const {
        const int row0 = u.pm * BM + wr * 64 + fr; const int pn = u.pn;
        bf16_t* dst; int ld, colt;
        if (pn < 3) { dst = umla; ld = 768; colt = pn * BM; } else { dst = uhg; ld = 2560; colt = (pn - 3) * BM; }
        const int col0 = colt + wc * 32 + 8 * fq;
        float ssv[2][4];
#pragma unroll
        for (int ai = 0; ai < 2; ++ai)
#pragma unroll
            for (int m = 0; m < 4; ++m) ssv[ai][m] = ss1[row0 + ai * HALF + m * 16];
#pragma unroll
        for (int ai = 0; ai < 2; ++ai)
#pragma unroll
            for (int m = 0; m < 4; ++m) { const int row = row0 + ai * HALF + m * 16; const float r = __builtin_amdgcn_rsqf(ssv[ai][m] * (1.0f / 1024.0f) + 1e-6f);
                float sq0 = 0.f, sq1 = 0.f; f32x4 v[2][2];
#pragma unroll
                for (int bj = 0; bj < 2; ++bj) {
#pragma unroll
                    for (int n = 0; n < 2; ++n) { v[bj][n] = acc[ai][bj][m][n] * r; const f32x4 x = v[bj][n]; const float s = (x[0] * x[0] + x[1] * x[1]) + (x[2] * x[2] + x[3] * x[3]); if (bj == 0) sq0 += s; else sq1 += s; }
                    u32x4 w; w.x = cvt_pk_bf16(v[bj][0][0], v[bj][0][1]); w.y = cvt_pk_bf16(v[bj][0][2], v[bj][0][3]); w.z = cvt_pk_bf16(v[bj][1][0], v[bj][1][1]); w.w = cvt_pk_bf16(v[bj][1][2], v[bj][1][3]);
                    __builtin_nontemporal_store(w, (u32x4*)(dst + (size_t)row * ld + col0 + bj * HALF)); }
                if (pn < 3) { float s = (pn == 1) ? sq0 : (sq0 + sq1); s = row_sum4(s); if (fq == 0) atomicAdd((pn == 2 ? sskv : ssq) + row, s); }
                if (pn == 1 && wc == 0) {
                    const int pos = row_pos(row); const f32x4 cs = *(const f32x4*)(ropec + pos * 16 + 4 * fq), sn = *(const f32x4*)(ropes + pos * 16 + 4 * fq);
                    const f32x4 x1 = v[1][0], x2 = v[1][1]; const f32x4 o1 = x1 * cs - x2 * sn, o2 = x1 * sn + x2 * cs;
                    u32x2 w1, w2; w1.x = cvt_pk_bf16(o1[0], o1[1]); w1.y = cvt_pk_bf16(o1[2], o1[3]); w2.x = cvt_pk_bf16(o2[0], o2[1]); w2.y = cvt_pk_bf16(o2[2], o2[3]);
                    *(u32x2*)(kr + (size_t)row * 32 + 4 * fq) = w1; *(u32x2*)(kr + (size_t)row * 32 + 16 + 4 * fq) = w2; } }
    }
};
struct EpiBf {
    static constexpr bool PERM = true, AFTER_DRAIN = false;
    bf16_t* O0; bf16_t* O1; int ld; int split; const float* ss; float inv_n; float mul;
    __device__ __forceinline__ void operator()(const f32x4 (&acc)[2][2][4][2], const Unit& u, int wr, int wc, int fr, int fq) const {
        const int row0 = u.pm * BM + wr * 64 + fr; bf16_t* base = O0; int colt = u.pn * BM; if (u.pn >= split) { base = O1; colt = (u.pn - split) * BM; }
        const int col0 = colt + wc * 32 + 8 * fq;
#pragma unroll
        for (int ai = 0; ai < 2; ++ai)
#pragma unroll
            for (int m = 0; m < 4; ++m) { const int row = row0 + ai * HALF + m * 16; const float r = (ss ? rsqrtf(ss[row] * inv_n + 1e-6f) : 1.0f) * mul;
#pragma unroll
                for (int bj = 0; bj < 2; ++bj) { const f32x4 v0 = acc[ai][bj][m][0] * r, v1 = acc[ai][bj][m][1] * r;
                    u32x4 w; w.x = cvt_pk_bf16(v0[0], v0[1]); w.y = cvt_pk_bf16(v0[2], v0[3]); w.z = cvt_pk_bf16(v1[0], v1[1]); w.w = cvt_pk_bf16(v1[2], v1[3]);
                    *(u32x4*)(base + (size_t)row * ld + col0 + bj * HALF) = w; } }
    }
};
template <class Epi, class Sched, bool ALIGN_EPI = false, bool SP2 = false>
__device__ __forceinline__ void gemm_phase(PG8_LAS unsigned char* lds, const Gemm g, const Sched& S, const Epi& E) {
    int tid_ = threadIdx.x; asm volatile("" : "+v"(tid_)); const int tid = tid_, wid = __builtin_amdgcn_readfirstlane(tid >> 6), lane = tid & 63, wr = wid >> 2, wc = wid & 3, fr = lane & 15, fq = lane >> 4;
    const int K = g.K, nt = K / BK;
    unsigned voffA[2], voffB[2];
#pragma unroll
    for (int i = 0; i < 2; ++i) { int R, C; stage_rc(tid * 16 + i * 8192, R, C); const int Rb = Epi::PERM ? ((R & ~31) + perm32(R & 31)) : R;
        voffA[i] = (unsigned)(R * g.lda + C) * 2u; voffB[i] = (unsigned)(Rb * g.ldb + C) * 2u; }
    const size_t kstep = (size_t)(BK * 2);
    const size_t hstepA = (size_t)HALF * g.lda * 2, hstepB = (size_t)HALF * g.ldb * 2;
    const size_t tstepA = 2 * hstepA, tstepB = 2 * hstepB;
    const unsigned ldsw = (unsigned)wid * 1024u;
    const int aoff = lds_byte(wr * 64 + fr, fq * 8), boff = lds_byte(wc * 32 + fr, fq * 8);
#define PG8_SA(b, h) (((b) * 2 + (h)) * HTB)
#define PG8_SB(b, h) ((4 + (b) * 2 + (h)) * HTB)
#define PG8_STAGE(bufoff, gbase, voff) do { _Pragma("unroll") for (int _i = 0; _i < 2; ++_i) \
        __builtin_amdgcn_global_load_lds((const unsigned*)((const char*)(gbase) + (voff)[_i]), (PG8_LAS unsigned*)(lds + (bufoff) + ldsw + _i * 8192), 16, 0, 0); } while (0)
#define PG8_LDA(dst, b, h) do { _Pragma("unroll") for (int m = 0; m < 4; ++m) _Pragma("unroll") for (int k = 0; k < 2; ++k) dst[m][k] = *(const PG8_LAS bf16x8*)(lds + PG8_SA(b, h) + aoff + m * 2048 + k * 1024); } while (0)
#define PG8_LDB(dst, b, h) do { _Pragma("unroll") for (int n = 0; n < 2; ++n) _Pragma("unroll") for (int k = 0; k < 2; ++k) dst[n][k] = *(const PG8_LAS bf16x8*)(lds + PG8_SB(b, h) + boff + n * 2048 + k * 1024); } while (0)
#define PG8_MMA(ai, bj, At, Bt) do { __builtin_amdgcn_s_setprio(1); _Pragma("unroll") for (int m = 0; m < 4; ++m) _Pragma("unroll") for (int n = 0; n < 2; ++n) _Pragma("unroll") for (int k = 0; k < 2; ++k) \
        acc[ai][bj][m][n] = __builtin_amdgcn_mfma_f32_16x16x32_bf16(Bt[n][k], At[m][k], acc[ai][bj][m][n], 0, 0, 0); __builtin_amdgcn_s_setprio(0); } while (0)
#define PG8_WAIT_V(n) asm volatile("s_waitcnt vmcnt(" #n ")" ::: "memory")
#define PG8_WAIT_L(n) asm volatile("s_waitcnt lgkmcnt(" #n ")" ::: "memory")
#define PG8_BAR __builtin_amdgcn_s_barrier()
#define PG8_SCHED __builtin_amdgcn_sched_barrier(0)
    Unit cur, nxt; int ui = 0;
    if (!S.next(0, cur)) return;
    f32x4 acc[2][2][4][2];
#pragma unroll
    for (int a = 0; a < 2; ++a)
#pragma unroll
        for (int b = 0; b < 2; ++b)
#pragma unroll
            for (int m = 0; m < 4; ++m)
#pragma unroll
                for (int n = 0; n < 2; ++n) acc[a][b][m][n] = (f32x4){0.f, 0.f, 0.f, 0.f};
    bf16x8 At[4][2], B0[2][2], B1[2][2];
    const char* cA = (const char*)g.A + (size_t)cur.pm * tstepA; const char* cB = (const char*)g.Bt + (size_t)cur.pn * tstepB;
    S.a_ready(cur);
    if constexpr (SP2) {
        PG8_STAGE(PG8_SB(0, 0), cB, voffB); PG8_STAGE(PG8_SB(0, 1), cB + hstepB, voffB); PG8_STAGE(PG8_SA(0, 0), cA, voffA); PG8_STAGE(PG8_SA(0, 1), cA + hstepA, voffA);
        if (wr == 1) PG8_BAR;
        PG8_WAIT_V(2); PG8_BAR;
        PG8_STAGE(PG8_SB(1, 0), cB + kstep, voffB); PG8_STAGE(PG8_SA(1, 0), cA + kstep, voffA); PG8_STAGE(PG8_SB(1, 1), cB + hstepB + kstep, voffB);
        PG8_WAIT_V(6); PG8_BAR;
    } else {
        PG8_STAGE(PG8_SB(0, 0), cB, voffB); PG8_STAGE(PG8_SA(0, 0), cA, voffA); PG8_STAGE(PG8_SB(0, 1), cB + hstepB, voffB); PG8_STAGE(PG8_SA(0, 1), cA + hstepA, voffA);
        if (wr == 1) PG8_BAR;
        PG8_WAIT_V(4); PG8_BAR;
        PG8_STAGE(PG8_SB(1, 0), cB + kstep, voffB); PG8_STAGE(PG8_SA(1, 0), cA + kstep, voffA); PG8_STAGE(PG8_SB(1, 1), cB + hstepB + kstep, voffB);
        PG8_WAIT_V(6); PG8_BAR;
    }
    for (;;) {
        const bool has_next = S.next(ui + 1, nxt);
        const char* nA = has_next ? (const char*)g.A + (size_t)nxt.pm * tstepA : cA; const char* nB = has_next ? (const char*)g.Bt + (size_t)nxt.pn * tstepB : cB;
        for (int t = 0; t < nt; t += 2) {
            const bool last = (t == nt - 2);
            const char* a1 = cA + (size_t)(t + 1) * kstep;
            const char* a2 = last ? nA : cA + (size_t)(t + 2) * kstep; const char* b2 = last ? nB : cB + (size_t)(t + 2) * kstep;
            const char* a3 = a2 + kstep; const char* b3 = b2 + kstep;
            if (last && has_next) S.a_ready(nxt);
            if constexpr (SP2) {
            PG8_LDB(B0, 0, 0); PG8_LDB(B1, 0, 1); PG8_SCHED; PG8_LDA(At, 0, 0); PG8_STAGE(PG8_SA(1, 1), a1 + hstepA, voffA);
            PG8_WAIT_V(8); PG8_WAIT_L(0); PG8_BAR; PG8_MMA(0, 0, At, B0); PG8_MMA(0, 1, At, B1); PG8_BAR; PG8_SCHED;
            PG8_LDA(At, 0, 1); PG8_STAGE(PG8_SB(0, 0), b2, voffB); PG8_STAGE(PG8_SB(0, 1), b2 + hstepB, voffB); PG8_STAGE(PG8_SA(0, 0), a2, voffA);
            PG8_WAIT_V(8); PG8_WAIT_L(0); PG8_BAR; PG8_MMA(1, 0, At, B0); PG8_MMA(1, 1, At, B1); PG8_BAR; PG8_SCHED;
            PG8_LDB(B0, 1, 0); PG8_LDB(B1, 1, 1); PG8_SCHED; PG8_LDA(At, 1, 0); PG8_STAGE(PG8_SA(0, 1), a2 + hstepA, voffA);
            PG8_WAIT_V(8); PG8_WAIT_L(0); PG8_BAR; PG8_MMA(0, 0, At, B0); PG8_MMA(0, 1, At, B1); PG8_BAR; PG8_SCHED;
            PG8_LDA(At, 1, 1); PG8_STAGE(PG8_SB(1, 0), b3, voffB); PG8_STAGE(PG8_SB(1, 1), b3 + hstepB, voffB); PG8_STAGE(PG8_SA(1, 0), a3, voffA);
            PG8_WAIT_V(8); PG8_WAIT_L(0); PG8_BAR; PG8_MMA(1, 0, At, B0); PG8_MMA(1, 1, At, B1); PG8_BAR; PG8_SCHED;
            } else {
            PG8_LDB(B0, 0, 0); PG8_SCHED; PG8_LDA(At, 0, 0); PG8_STAGE(PG8_SA(1, 1), a1 + hstepA, voffA);
            PG8_WAIT_L(8); PG8_BAR; PG8_WAIT_L(0); PG8_MMA(0, 0, At, B0); PG8_BAR; PG8_SCHED;
            PG8_LDB(B1, 0, 1); PG8_STAGE(PG8_SB(0, 0), b2, voffB);
            PG8_BAR; PG8_WAIT_L(0); PG8_MMA(0, 1, At, B1); PG8_BAR;
            PG8_LDA(At, 0, 1); PG8_STAGE(PG8_SA(0, 0), a2, voffA);
            PG8_BAR; PG8_WAIT_L(0); PG8_MMA(1, 0, At, B0); PG8_BAR; PG8_SCHED;
            PG8_STAGE(PG8_SB(0, 1), b2 + hstepB, voffB);
            PG8_WAIT_V(6); PG8_BAR; PG8_MMA(1, 1, At, B1); PG8_BAR;
            PG8_LDB(B0, 1, 0); PG8_SCHED; PG8_LDA(At, 1, 0); PG8_STAGE(PG8_SA(0, 1), a2 + hstepA, voffA);
            PG8_WAIT_L(8); PG8_BAR; PG8_WAIT_L(0); PG8_MMA(0, 0, At, B0); PG8_BAR; PG8_SCHED;
            PG8_LDB(B1, 1, 1); PG8_STAGE(PG8_SB(1, 0), b3, voffB);
            PG8_BAR; PG8_WAIT_L(0); PG8_MMA(0, 1, At, B1); PG8_BAR;
            PG8_LDA(At, 1, 1); PG8_STAGE(PG8_SA(1, 0), a3, voffA);
            PG8_BAR; PG8_WAIT_L(0); PG8_MMA(1, 0, At, B0); PG8_BAR; PG8_SCHED;
            PG8_STAGE(PG8_SB(1, 1), b3 + hstepB, voffB);
            PG8_WAIT_V(6); PG8_BAR; PG8_MMA(1, 1, At, B1); PG8_BAR;
            }
        }
        if constexpr (ALIGN_EPI) { if (wr == 0) PG8_BAR; }
        if constexpr (!Epi::AFTER_DRAIN) { E(acc, cur, wr, wc, fr, fq); S.done(cur); }
        if (!has_next) break;
#pragma unroll
        for (int a = 0; a < 2; ++a)
#pragma unroll
            for (int b = 0; b < 2; ++b)
#pragma unroll
                for (int m = 0; m < 4; ++m)
#pragma unroll
                    for (int n = 0; n < 2; ++n) acc[a][b][m][n] = (f32x4){0.f, 0.f, 0.f, 0.f};
        cur = nxt; cA = nA; cB = nB; ++ui;
        if constexpr (ALIGN_EPI) { if (wr == 1) PG8_BAR; }
    }
    PG8_WAIT_V(0);
    if constexpr (!ALIGN_EPI) { if (wr == 0) PG8_BAR; }
    PG8_BAR;
    if constexpr (Epi::AFTER_DRAIN) { E.fused(acc, cur, wr, wc, fr, fq, lds, wid, lane); S.done(cur); }
#undef PG8_SA
#undef PG8_SB
#undef PG8_STAGE
#undef PG8_LDA
#undef PG8_LDB
#undef PG8_MMA
#undef PG8_WAIT_V
#undef PG8_WAIT_L
#undef PG8_BAR
#undef PG8_SCHED
}
}

namespace att {
typedef unsigned short bf16_t;
using bf16x8 = __attribute__((ext_vector_type(8))) short;
using s16x4  = __attribute__((ext_vector_type(4))) short;
using f32x16 = __attribute__((ext_vector_type(16))) float;
using u32x4  = __attribute__((ext_vector_type(4))) unsigned;
constexpr int NW = 8, QBLK = 32, KVBLK = 64;
constexpr float SCALE = 0.10206207261596575f;
constexpr float THR = 8.f;
constexpr int LDQ = 768, LDKN = 512, LDKR = 32, LDV = 512, LDO = 1024;
constexpr int SHM_V = 64 * 128 * 2, SHM_K = 64 * 128 * 2;
#define KSWZ(row, colB) ((row) * 256 + ((colB) ^ (((row) & 7) << 4)))
#define SBAR() __builtin_amdgcn_sched_barrier(0)
__device__ __forceinline__ int crow(int r, int hi) { return (r & 3) + 8 * (r >> 2) + 4 * hi; }
__device__ __forceinline__ unsigned cvtpk(float lo, float hi) { unsigned r; asm volatile("v_cvt_pk_bf16_f32 %0, %1, %2" : "=v"(r) : "v"(lo), "v"(hi)); return r; }
template <bool FIRST> __device__ __forceinline__ void partialSM(f32x16& p0, f32x16& p1, float& m_ref, f32x16& negm, float& alpha) {
  constexpr float THR2 = THR * 1.4426950408889634f;
  float pmax = p0[0];
#pragma unroll
  for (int r = 1; r < 16; ++r) pmax = fmaxf(pmax, p0[r]);
#pragma unroll
  for (int r = 0; r < 16; ++r) pmax = fmaxf(pmax, p1[r]);
  { auto rr = __builtin_amdgcn_permlane32_swap(__float_as_uint(pmax), __float_as_uint(pmax), false, false);
    pmax = fmaxf(__uint_as_float(rr[0]), __uint_as_float(rr[1])); }
  alpha = 1.f;
  if (FIRST || !__builtin_expect(__all(pmax <= THR2), 1)) {
    const float dl = FIRST ? pmax : fmaxf(pmax, 0.f);
    m_ref += dl; alpha = FIRST ? 1.f : __builtin_amdgcn_exp2f(-dl);
#pragma unroll
    for (int r = 0; r < 16; ++r) { p0[r] -= dl; p1[r] -= dl; }
#pragma unroll
    for (int r = 0; r < 16; ++r) negm[r] = -m_ref;
    asm volatile("" : "+v"(negm));
  }
#pragma unroll
  for (int r = 0; r < 16; ++r) p0[r] = __builtin_amdgcn_exp2f(p0[r]);
}
__device__ __forceinline__ void finishSM(f32x16& p0, f32x16& p1, bf16x8& pa0, bf16x8& pa1, bf16x8& pa2, bf16x8& pa3) {
#pragma unroll
  for (int r = 0; r < 16; ++r) p1[r] = __builtin_amdgcn_exp2f(p1[r]);
#define PK4(P, BASE, OUT) do { unsigned a0 = cvtpk(P[BASE + 0], P[BASE + 1]), a1 = cvtpk(P[BASE + 2], P[BASE + 3]);   \
    unsigned b0 = cvtpk(P[BASE + 4], P[BASE + 5]), b1 = cvtpk(P[BASE + 6], P[BASE + 7]);                              \
    auto r0 = __builtin_amdgcn_permlane32_swap(a0, b0, false, false); auto r1 = __builtin_amdgcn_permlane32_swap(a1, b1, false, false); \
    u32x4 w = {r0[0], r1[0], r0[1], r1[1]}; OUT = *reinterpret_cast<bf16x8*>(&w); } while (0)
  PK4(p0, 0, pa0); PK4(p0, 8, pa1); PK4(p1, 0, pa2); PK4(p1, 8, pa3);
#undef PK4
}
__device__ __forceinline__ void qkt(f32x16& p0, f32x16& p1, const bf16_t* Ks, const bf16x8* qr, const f32x16& negm, int r32, int hi) {
#pragma unroll
  for (int d0 = 0; d0 < 6; ++d0) { int cb = (d0 * 16 + hi * 8) * 2;
    bf16x8 b0 = *reinterpret_cast<const bf16x8*>((const char*)Ks + KSWZ(r32, cb));
    bf16x8 b1 = *reinterpret_cast<const bf16x8*>((const char*)Ks + KSWZ(32 + r32, cb));
    if (d0 == 0) { p0 = __builtin_amdgcn_mfma_f32_32x32x16_bf16(b0, qr[0], negm, 0, 0, 0); p1 = __builtin_amdgcn_mfma_f32_32x32x16_bf16(b1, qr[0], negm, 0, 0, 0); }
    else { p0 = __builtin_amdgcn_mfma_f32_32x32x16_bf16(b0, qr[d0], p0, 0, 0, 0); p1 = __builtin_amdgcn_mfma_f32_32x32x16_bf16(b1, qr[d0], p1, 0, 0, 0); } }
}
__device__ __forceinline__ int v_st(int k, int c) { const int kk = (k & ~0xC) | ((k & 4) << 1) | ((k & 8) >> 1); return ((kk >> 3) * 4 + (c >> 5)) * 512 + ((kk & 7) * 32 + (c & 31)) * 2; }
__device__ __forceinline__ int v_rd_base(int lane) { return ((lane & 3) << 3) | (((lane >> 2) & 3) << 6) | (((lane >> 4) & 1) << 5) | (((lane >> 5) & 1) << 8); }
constexpr int v_rd_off(int d0, int ks, int half) { return d0 * 512 + ks * 4096 + half * 2048; }
template <int OFF> __device__ __forceinline__ s16x4 tr_read(int vb) {
  s16x4 r; asm volatile("ds_read_b64_tr_b16 %0, %1 offset:%2" : "=&v"(r) : "v"(vb), "i"(OFF) : "memory"); return r;
}
template <int D0> __device__ __forceinline__ void pv_one(f32x16& od, int vb, bf16x8 pa0, bf16x8 pa1, bf16x8 pa2, bf16x8 pa3) {
  const s16x4 l0 = tr_read<v_rd_off(D0, 0, 0)>(vb), h0 = tr_read<v_rd_off(D0, 0, 1)>(vb), l1 = tr_read<v_rd_off(D0, 1, 0)>(vb), h1 = tr_read<v_rd_off(D0, 1, 1)>(vb);
  const s16x4 l2 = tr_read<v_rd_off(D0, 2, 0)>(vb), h2 = tr_read<v_rd_off(D0, 2, 1)>(vb), l3 = tr_read<v_rd_off(D0, 3, 0)>(vb), h3 = tr_read<v_rd_off(D0, 3, 1)>(vb);
  asm volatile("s_waitcnt lgkmcnt(0)" ::: "memory"); SBAR();
#define PK(L, H) (bf16x8){L[0], L[1], L[2], L[3], H[0], H[1], H[2], H[3]}
  od = __builtin_amdgcn_mfma_f32_32x32x16_bf16(pa0, PK(l0, h0), od, 0, 0, 0);
  od = __builtin_amdgcn_mfma_f32_32x32x16_bf16(pa1, PK(l1, h1), od, 0, 0, 0);
  od = __builtin_amdgcn_mfma_f32_32x32x16_bf16(pa2, PK(l2, h2), od, 0, 0, 0);
  od = __builtin_amdgcn_mfma_f32_32x32x16_bf16(pa3, PK(l3, h3), od, 0, 0, 0);
#undef PK
}
__device__ __forceinline__ void pv_d0(f32x16* o, f32x16& osum, int vb, bf16x8 pa0, bf16x8 pa1, bf16x8 pa2, bf16x8 pa3) {
  pv_one<0>(o[0], vb, pa0, pa1, pa2, pa3); pv_one<1>(o[1], vb, pa0, pa1, pa2, pa3);
  const short one = (short)0x3F80; const bf16x8 ones = {one, one, one, one, one, one, one, one};
  osum = __builtin_amdgcn_mfma_f32_32x32x16_bf16(pa0, ones, osum, 0, 0, 0); osum = __builtin_amdgcn_mfma_f32_32x32x16_bf16(pa1, ones, osum, 0, 0, 0);
  osum = __builtin_amdgcn_mfma_f32_32x32x16_bf16(pa2, ones, osum, 0, 0, 0); osum = __builtin_amdgcn_mfma_f32_32x32x16_bf16(pa3, ones, osum, 0, 0, 0);
}
__device__ __forceinline__ void attn_unit(const bf16_t* __restrict__ Qb, const bf16_t* __restrict__ KNh, const bf16_t* __restrict__ KRb, const bf16_t* __restrict__ Vh,
                                          bf16_t* __restrict__ Ob, int seq, int qrow0, const float* __restrict__ ropec, const float* __restrict__ ropes, char* lds) {
  int tid_ = threadIdx.x; asm volatile("" : "+v"(tid_)); const int tid = tid_, wid = __builtin_amdgcn_readfirstlane(tid >> 6), lane = tid & 63, r32 = lane & 31, hi = lane >> 5;
  bf16_t* V_lds = (bf16_t*)lds; bf16_t* K_lds = (bf16_t*)(lds + 3 * SHM_V);
  float* ws = (float*)(lds + 3 * SHM_V + 3 * SHM_K) + wid * 64; float* al_l = ws + 32;
  float m_ref = 0.f; f32x16 o[2] = {}; f32x16 osum = {}; f32x16 negm = {}; asm volatile("" : "+v"(negm)); bf16x8 qr[6];
  const int srow = tid >> 3, sch = tid & 7, srow2 = tid >> 2, sch2 = tid & 3;
  const bf16_t* kp = KNh + (long)srow * LDKN + 8 * sch; const bf16_t* vp = Vh + (long)srow * LDV + 8 * sch; const bf16_t* rp = KRb + (long)(srow2 & 63) * LDKR + 8 * sch2;
  const int kst = KSWZ(srow, 16 * sch), vst = v_st(srow, 8 * sch), rst = KSWZ(srow2 & 63, 128 + 16 * sch2);
  const bool has_r = wid < 4;
  constexpr int BUF = SHM_V;
  const int vb0 = (int)(uintptr_t)V_lds + v_rd_base(lane);
  struct { bf16x8 v, k, r; } sr_[2];
#define SLOAD(i, k0) do { sr_[i].v = *reinterpret_cast<const bf16x8*>(vp + (long)(k0) * LDV); sr_[i].k = *reinterpret_cast<const bf16x8*>(kp + (long)(k0) * LDKN); \
    if (has_r) sr_[i].r = *reinterpret_cast<const bf16x8*>(rp + (long)(k0) * LDKR); } while (0)
#define SWRITE(off, i) do { *(bf16x8*)((char*)V_lds + (off) + vst) = sr_[i].v; *(bf16x8*)((char*)K_lds + (off) + kst) = sr_[i].k; \
    if (has_r) *(bf16x8*)((char*)K_lds + (off) + rst) = sr_[i].r; } while (0)
#define SWAIT() do { if (has_r) asm volatile("s_waitcnt vmcnt(3)" ::: "memory"); else asm volatile("s_waitcnt vmcnt(2)" ::: "memory"); } while (0)
  constexpr int SE = 0, SO = 1;
  const int NT = seq / KVBLK;
  SLOAD(SE, 0); SLOAD(SO, KVBLK);
  const bf16_t* Qw = Qb + (long)(wid * QBLK + r32) * LDQ + hi * 8;
#pragma unroll
  for (int d0 = 0; d0 < 6; ++d0) qr[d0] = *reinterpret_cast<const bf16x8*>(Qw + d0 * 16);
  {
    const int pos = row_pos(qrow0 + wid * QBLK + r32); const float* cp = ropec + pos * 16 + 8 * hi; const float* sp = ropes + pos * 16 + 8 * hi;
    unsigned w1[4], w2[4];
#pragma unroll
    for (int e = 0; e < 8; e += 2) { float o1[2], o2[2];
#pragma unroll
      for (int f = 0; f < 2; ++f) { const float x1 = __uint_as_float(((unsigned)(unsigned short)qr[4][e + f]) << 16), x2 = __uint_as_float(((unsigned)(unsigned short)qr[5][e + f]) << 16); const float c = cp[e + f], s = sp[e + f];
        o1[f] = x1 * c - x2 * s; o2[f] = x1 * s + x2 * c; }
      w1[e >> 1] = cvtpk(o1[0], o1[1]); w2[e >> 1] = cvtpk(o2[0], o2[1]); }
    u32x4 v1 = {w1[0], w1[1], w1[2], w1[3]}, v2 = {w2[0], w2[1], w2[2], w2[3]}; qr[4] = *reinterpret_cast<bf16x8*>(&v1); qr[5] = *reinterpret_cast<bf16x8*>(&v2); }
#define RESC(a) do { if (__any((a) < 1.f)) { if (hi == 0) al_l[r32] = (a); asm volatile("s_waitcnt lgkmcnt(0)" ::: "memory"); \
    _Pragma("unroll") for (int r = 0; r < 16; ++r) { const float f_ = al_l[crow(r, hi)]; o[0][r] *= f_; o[1][r] *= f_; osum[r] *= f_; } } } while (0)
#define ROT() do { const int t_ = o_prev; o_prev = o_cur; o_cur = o_next; o_next = t_; } while (0)
  f32x16 pA0, pA1, pB0, pB1; float alA, alB; bf16x8 pa0, pa1, pa2, pa3;
  int o_prev = 2 * BUF, o_cur = 0, o_next = BUF;
  asm volatile("s_waitcnt vmcnt(0)" ::: "memory"); SWRITE(0, SE); __syncthreads();
  qkt(pA0, pA1, K_lds, qr, negm, r32, hi); partialSM<true>(pA0, pA1, m_ref, negm, alA);
  if (2 < NT) SLOAD(SE, 2 * KVBLK);
  SWAIT(); SWRITE(BUF, SO); __syncthreads();
  ROT();
  for (int j = 1; j + 1 < NT; j += 2) {
    SBAR(); qkt(pB0, pB1, (bf16_t*)((char*)K_lds + o_cur), qr, negm, r32, hi);
    finishSM(pA0, pA1, pa0, pa1, pa2, pa3); SBAR();
    SLOAD(SO, (j + 2) * KVBLK); SBAR();
    pv_d0(o, osum, vb0 + o_prev, pa0, pa1, pa2, pa3); partialSM<false>(pB0, pB1, m_ref, negm, alB);
    SWAIT(); SWRITE(o_next, SE);
    RESC(alB); __syncthreads(); ROT();
    SBAR(); qkt(pA0, pA1, (bf16_t*)((char*)K_lds + o_cur), qr, negm, r32, hi);
    finishSM(pB0, pB1, pa0, pa1, pa2, pa3); SBAR();
    if (j + 3 < NT) SLOAD(SE, (j + 3) * KVBLK); SBAR();
    pv_d0(o, osum, vb0 + o_prev, pa0, pa1, pa2, pa3); partialSM<false>(pA0, pA1, m_ref, negm, alA);
    SWAIT(); SWRITE(o_next, SO);
    RESC(alA); __syncthreads(); ROT();
  }
  SBAR(); qkt(pB0, pB1, (bf16_t*)((char*)K_lds + o_cur), qr, negm, r32, hi);
  finishSM(pA0, pA1, pa0, pa1, pa2, pa3); SBAR();
  pv_d0(o, osum, vb0 + o_prev, pa0, pa1, pa2, pa3); partialSM<false>(pB0, pB1, m_ref, negm, alB);
  RESC(alB);
  finishSM(pB0, pB1, pa0, pa1, pa2, pa3); SBAR();
  pv_d0(o, osum, vb0 + o_cur, pa0, pa1, pa2, pa3);
  float rli[16];
#pragma unroll
  for (int r = 0; r < 16; ++r) rli[r] = __builtin_amdgcn_rcpf(osum[r]);
  bf16_t* Ow = Ob + (long)(wid * QBLK) * LDO;
#pragma unroll
  for (int r = 0; r < 16; ++r) { int orow = crow(r, hi);
#pragma unroll
    for (int d0 = 0; d0 < 2; ++d0) { const unsigned w = cvtpk(o[d0][r] * rli[r], 0.f); Ow[(long)orow * LDO + d0 * 32 + r32] = (bf16_t)(w & 0xffffu); } }
  __syncthreads();
#undef SLOAD
#undef SWRITE
#undef SWAIT
#undef RESC
#undef ROT
}
#undef KSWZ
#undef SBAR
}
namespace hg {
typedef unsigned short bf16_t;
using bf16x8 = __attribute__((ext_vector_type(8))) short;
using f32x16 = __attribute__((ext_vector_type(16))) float;
using f32x4  = __attribute__((ext_vector_type(4))) float;
using u32x4  = __attribute__((ext_vector_type(4))) unsigned;
#define SWZ256(row, colB) ((row) * 256 + ((colB) ^ (((row) & 7) << 4)))
#define SWZ128(row, colB) ((row) * 128 + ((colB) ^ (((((row) >> 4) ^ (row)) & 7) << 4)))
constexpr int GS = 132;
constexpr int L_ST = 0, L_QH = 32768, L_KH = 49152, L_KT = 65536, L_VT = 81920, L_GB = 98304, L_SEG = 98304 + 64 * GS * 4, L_DD = L_SEG + 2048, L_LB = L_DD + 512;
__device__ __forceinline__ int crow(int r, int hi) { return (r & 3) + 8 * (r >> 2) + 4 * hi; }
__device__ __forceinline__ unsigned cvtpk(float lo, float hi) { unsigned r; asm volatile("v_cvt_pk_bf16_f32 %0, %1, %2" : "=v"(r) : "v"(lo), "v"(hi)); return r; }
__device__ __forceinline__ float bf2f(unsigned short h) { return __uint_as_float(((unsigned)h) << 16); }
template <int MODE> __device__ __forceinline__ void chain(const bf16_t* __restrict__ U, float* __restrict__ OP, const float* __restrict__ hg_lb, int rowbase, int S, int h, int dir, int tau0, int nchunk,
                                                   const float* __restrict__ slot_in, float* __restrict__ slot_out, float* __restrict__ dseg_out, char* lds) {
  int tid_ = threadIdx.x; asm volatile("" : "+v"(tid_)); const int tid = tid_, wid = __builtin_amdgcn_readfirstlane(tid >> 6), lane = tid & 63, r32 = lane & 31, hi = lane >> 5;
  float* GB = (float*)(lds + L_GB); float* SEG = (float*)(lds + L_SEG); float* DD = (float*)(lds + L_DD); float* LB = (float*)(lds + L_LB);
  char* ST = lds + L_ST; char* QH = lds + L_QH; char* KH = lds + L_KH; char* KT = lds + L_KT; char* VT = lds + L_VT; char* AL = lds + L_GB;
  if (tid < 128) { const float a0 = hg_lb[dir * 1024 + h * 128 + tid], a1 = hg_lb[dir * 1024 + 512 + h * 128 + tid]; LB[tid] = 1.0f / (1.0f + __expf(a1 - a0)); }
  f32x16 sacc[2]; sacc[0] = f32x16{}; sacc[1] = f32x16{};
  if (MODE == 3) {
    if (slot_in) {
#pragma unroll
      for (int i = 0; i < 2; ++i)
#pragma unroll
        for (int r = 0; r < 16; ++r) sacc[i][r] = slot_in[(32 * (wid & 3) + crow(r, hi)) * 128 + 32 * (2 * (wid >> 2) + i) + r32];
    }
#pragma unroll
    for (int i = 0; i < 2; ++i)
#pragma unroll
      for (int r = 0; r < 16; ++r) *(bf16_t*)(ST + SWZ256(32 * (wid & 3) + crow(r, hi), 2 * (32 * (2 * (wid >> 2) + i) + r32))) = (bf16_t)(cvtpk(sacc[i][r], 0.f) & 0xffffu);
  }
  float dseg = 1.0f;
  const int tau = tid >> 3, c0 = (tid & 7) * 16, segt = tau >> 4;
  const bf16_t* Ub = U + (size_t)rowbase * 2560 + h * 128 + c0;
  const size_t offq = 0, offv = 512, offf = (size_t)(2 + dir) * 512;
  float* OPd = OP + (size_t)dir * T_ALL * 512;
  bf16x8 nq0 = {}, nq1 = {}, nv0, nv1, nf0, nf1;
  { const int t1 = tau0 + tau; const int tok = dir ? (S - 1 - t1) : t1; const bf16_t* p = Ub + (size_t)tok * 2560;
    if (MODE == 3) { nq0 = *(const bf16x8*)(p + offq); nq1 = *(const bf16x8*)(p + offq + 8); } nv0 = *(const bf16x8*)(p + offv); nv1 = *(const bf16x8*)(p + offv + 8); nf0 = *(const bf16x8*)(p + offf); nf1 = *(const bf16x8*)(p + offf + 8); }
  __syncthreads();
  for (int ci = 0; ci < nchunk; ++ci) {
    const bf16x8 qv[2] = {nq0, nq1}, vv[2] = {nv0, nv1}, fv[2] = {nf0, nf1};
    { const int cn = (ci + 1 < nchunk) ? ci + 1 : ci; const int t2 = tau0 + cn * 64 + tau; const int tok = dir ? (S - 1 - t2) : t2; const bf16_t* p = Ub + (size_t)tok * 2560;
      if (MODE == 3) { nq0 = *(const bf16x8*)(p + offq); nq1 = *(const bf16x8*)(p + offq + 8); } nv0 = *(const bf16x8*)(p + offv); nv1 = *(const bf16x8*)(p + offv + 8); nf0 = *(const bf16x8*)(p + offf); nf1 = *(const bf16x8*)(p + offf + 8); }
    float qq[16], kk[16];
#pragma unroll
    for (int j = 0; j < 16; ++j) {
      const float z = bf2f((unsigned short)fv[j >> 3][j & 7]); const float x = bf2f((unsigned short)qv[j >> 3][j & 7]);
      const float lbv = LB[c0 + j]; const float sg = __builtin_amdgcn_rcpf(1.0f + __builtin_amdgcn_exp2f(-1.4426950408889634f * z)); const float f = lbv + (1.0f - lbv) * sg;
      kk[j] = 1.0f - f; qq[j] = (MODE == 3) ? x * __builtin_amdgcn_rcpf(1.0f + __builtin_amdgcn_exp2f(-1.4426950408889634f * x)) : 0.f;
      GB[tau * GS + c0 + j] = __builtin_amdgcn_logf(f);
    }
    __syncthreads();
    { const int k = tid & 127, seg = tid >> 7; float run = 0.f;
#pragma unroll
      for (int j = 0; j < 16; ++j) { run += GB[(16 * seg + j) * GS + k]; GB[(16 * seg + j) * GS + k] = run; }
      SEG[seg * 128 + k] = run; }
    __syncthreads();
    { unsigned qh[8] = {}, kh[8] = {};
#pragma unroll
      for (int j = 0; j < 16; j += 2) {
        float g2[2], gl2[2];
#pragma unroll
        for (int e = 0; e < 2; ++e) { const int col = c0 + j + e; const float s0 = SEG[col], s1 = SEG[128 + col], s2 = SEG[256 + col];
          const float off = (segt >= 1 ? s0 : 0.f) + (segt >= 2 ? s1 : 0.f) + (segt >= 3 ? s2 : 0.f);
          g2[e] = GB[tau * GS + col] + off; gl2[e] = GB[63 * GS + col] + ((s0 + s1) + s2); }
        if (MODE == 3) { const float ea = __builtin_amdgcn_exp2f(g2[0]), eb = __builtin_amdgcn_exp2f(g2[1]);
          qh[j >> 1] = cvtpk(qq[j] * ea, qq[j + 1] * eb);
          kh[j >> 1] = cvtpk(kk[j] * __builtin_amdgcn_exp2f(fminf(-g2[0], 115.f)), kk[j + 1] * __builtin_amdgcn_exp2f(fminf(-g2[1], 115.f))); }
        const unsigned kt = cvtpk(kk[j] * __builtin_amdgcn_exp2f(gl2[0] - g2[0]), kk[j + 1] * __builtin_amdgcn_exp2f(gl2[1] - g2[1]));
        *(bf16_t*)(KT + SWZ128(c0 + j, 2 * tau)) = (bf16_t)(kt & 0xffffu); *(bf16_t*)(KT + SWZ128(c0 + j + 1, 2 * tau)) = (bf16_t)(kt >> 16);
        *(bf16_t*)(VT + SWZ128(c0 + j, 2 * tau)) = (bf16_t)vv[j >> 3][j & 7]; *(bf16_t*)(VT + SWZ128(c0 + j + 1, 2 * tau)) = (bf16_t)vv[(j + 1) >> 3][(j + 1) & 7];
        if (tau == 63) { DD[c0 + j] = __builtin_amdgcn_exp2f(gl2[0]); DD[c0 + j + 1] = __builtin_amdgcn_exp2f(gl2[1]); }
      }
      if (MODE == 3) {
      *(u32x4*)(QH + SWZ256(tau, 2 * c0)) = (u32x4){qh[0], qh[1], qh[2], qh[3]}; *(u32x4*)(QH + SWZ256(tau, 2 * c0 + 16)) = (u32x4){qh[4], qh[5], qh[6], qh[7]};
      *(u32x4*)(KH + SWZ256(tau, 2 * c0)) = (u32x4){kh[0], kh[1], kh[2], kh[3]}; *(u32x4*)(KH + SWZ256(tau, 2 * c0 + 16)) = (u32x4){kh[4], kh[5], kh[6], kh[7]}; }
    }
    __syncthreads();
    if (MODE == 3 && wid < 4 && wid != 1) { const int ti = wid >> 1, si = wid & 1; f32x16 a = f32x16{};
#pragma unroll
      for (int k8 = 0; k8 < 8; ++k8) { const int cb = (16 * k8 + 8 * hi) * 2;
        const bf16x8 av = *(const bf16x8*)(QH + SWZ256(32 * ti + r32, cb)); const bf16x8 bv = *(const bf16x8*)(KH + SWZ256(32 * si + r32, cb));
        a = __builtin_amdgcn_mfma_f32_32x32x16_bf16(av, bv, a, 0, 0, 0); }
#pragma unroll
      for (int r = 0; r < 16; ++r) { const int tl = 32 * ti + crow(r, hi), sl = 32 * si + r32; const float val = (sl <= tl) ? a[r] : 0.f;
        *(bf16_t*)(AL + SWZ128(tl, 2 * sl)) = (bf16_t)(cvtpk(val, 0.f) & 0xffffu); } }
    if (MODE == 3) __syncthreads();
    { const int th = wid >> 2, vb = wid & 3;
      if (MODE == 3) { f32x16 o = f32x16{};
      const int nks = th ? 4 : 2;
      for (int ks = 0; ks < nks; ++ks) { const int cb = (16 * ks + 8 * hi) * 2;
        const bf16x8 av = *(const bf16x8*)(AL + SWZ128(32 * th + r32, cb)); const bf16x8 bv = *(const bf16x8*)(VT + SWZ128(32 * vb + r32, cb));
        o = __builtin_amdgcn_mfma_f32_32x32x16_bf16(av, bv, o, 0, 0, 0); }
#pragma unroll
      for (int k8 = 0; k8 < 8; ++k8) { const int cb = (16 * k8 + 8 * hi) * 2;
        const bf16x8 av = *(const bf16x8*)(QH + SWZ256(32 * th + r32, cb)); const bf16x8 bv = *(const bf16x8*)(ST + SWZ256(32 * vb + r32, cb));
        o = __builtin_amdgcn_mfma_f32_32x32x16_bf16(av, bv, o, 0, 0, 0); }
#pragma unroll
      for (int r = 0; r < 16; ++r) { const int t2 = tau0 + ci * 64 + 32 * th + crow(r, hi); const int tok = dir ? (S - 1 - t2) : t2;
        OPd[(size_t)(rowbase + tok) * 512 + h * 128 + 32 * vb + r32] = o[r]; }
      } else { if (tid < 128) dseg *= DD[tid]; }
#pragma unroll
      for (int i = 0; i < 2; ++i) { const int kb = 2 * th + i; const float dk = DD[32 * kb + r32];
#pragma unroll
        for (int r = 0; r < 16; ++r) sacc[i][r] *= dk;
#pragma unroll
        for (int ks = 0; ks < 4; ++ks) { const int cb = (16 * ks + 8 * hi) * 2;
          const bf16x8 av = *(const bf16x8*)(VT + SWZ128(32 * vb + r32, cb)); const bf16x8 bv = *(const bf16x8*)(KT + SWZ128(32 * kb + r32, cb));
          sacc[i] = __builtin_amdgcn_mfma_f32_32x32x16_bf16(av, bv, sacc[i], 0, 0, 0); } }
    }
    __syncthreads();
    if (MODE == 3) { const int th = wid >> 2, vb = wid & 3;
#pragma unroll
      for (int i = 0; i < 2; ++i) { const int kb = 2 * th + i;
#pragma unroll
        for (int r = 0; r < 16; ++r) *(bf16_t*)(ST + SWZ256(32 * vb + crow(r, hi), 2 * (32 * kb + r32))) = (bf16_t)(cvtpk(sacc[i][r], 0.f) & 0xffffu); } }
  }
  if (MODE == 1) {
#pragma unroll
    for (int i = 0; i < 2; ++i)
#pragma unroll
      for (int r = 0; r < 16; ++r) slot_out[(32 * (wid & 3) + crow(r, hi)) * 128 + 32 * (2 * (wid >> 2) + i) + r32] = sacc[i][r];
    if (tid < 128) dseg_out[tid] = dseg;
  }
  __syncthreads();
}
#undef SWZ256
#undef SWZ128
}
typedef unsigned short bf16_t;
typedef float f32x4 __attribute__((ext_vector_type(4)));
typedef unsigned u32x4 __attribute__((ext_vector_type(4)));
typedef unsigned u32x2 __attribute__((ext_vector_type(2)));
typedef short bf16x8 __attribute__((ext_vector_type(8)));
#define LAS __attribute__((address_space(3)))
constexpr size_t MiB = 1u << 20;
constexpr size_t WS_SS = 0;
constexpr size_t WS_ROPEC = 4 * MiB, WS_ROPES = 5 * MiB;
constexpr size_t WS_W1GU = 16 * MiB, WS_W1D = 27 * MiB, WS_WIN = 33 * MiB, WS_WUQ = 40 * MiB, WS_WUKV = 41 * MiB, WS_WO = 42 * MiB, WS_W2GU = 44 * MiB, WS_W2D = 55 * MiB, WS_WPG = 61 * MiB, WS_WPP = 63 * MiB;
constexpr size_t WS_HB = 64 * MiB;
constexpr size_t WS_BIG = 256 * MiB;
constexpr size_t WS_UHG = WS_BIG, WS_UMLA = WS_BIG + 480 * MiB, WS_MIX = WS_BIG + 480 * MiB, WS_ACT = WS_BIG, WS_PROJ = WS_BIG;
constexpr size_t WS_PB = 928 * MiB;
constexpr size_t WS_SLOT = 976 * MiB;
constexpr size_t WS_DSEG = 8 * MiB;
constexpr size_t WS_END = 1024 * MiB;
constexpr size_t DO_Q = 0, DO_KN = 144 * MiB, DO_V = 240 * MiB, DO_KR = 336 * MiB;
constexpr int LDS_BYTES = 147456;
constexpr int LDS_BARST = 147392;
constexpr size_t WS_BAR = 12 * MiB;
#define XB_TMO      128
#define XB_XCNT(j)  (256  + 64 * (j))
#define XB_XSUB(j)  (1280 + 64 * (j))
#define XB_XGEN(j)  (2304 + 64 * (j))
#define XB_TOP      3328
#define XB_TOPGEN   3392
#define XCD_BAR_WORDS 3456
#define XB_SPIN_CAP (1u << 18)

__device__ __forceinline__ unsigned xb_ld(unsigned* p)              { return __hip_atomic_load(p, __ATOMIC_RELAXED, __HIP_MEMORY_SCOPE_AGENT); }
__device__ __forceinline__ unsigned xb_add(unsigned* p, unsigned v) { return __hip_atomic_fetch_add(p, v, __ATOMIC_RELAXED, __HIP_MEMORY_SCOPE_AGENT); }
__device__ __forceinline__ unsigned xb_xcc_id() { return (unsigned)__builtin_amdgcn_s_getreg((3 << 11) | 20) & 0xFu; }
#define XB_SPIN(cond, bar) do { unsigned _sp = 0; while (cond) { __builtin_amdgcn_s_sleep(1); \
    if ((++_sp & 255u) == 0u) { if (xb_ld(&(bar)[XB_TMO])) break; if (_sp > XB_SPIN_CAP) { atomicAdd(&(bar)[XB_TMO], 1u); break; } } } } while (0)

struct XcdBarrier {
    unsigned* bar; unsigned x;
    volatile LAS unsigned* st;
};

__device__ __forceinline__ XcdBarrier xcd_barrier_post(unsigned* bar, volatile LAS unsigned* st) {
    XcdBarrier b; b.bar = bar; b.x = xb_xcc_id(); b.st = st;
    if (threadIdx.x == 0) (void)xb_add(&bar[XB_XCNT(b.x)], 1u);
    return b;
}
__device__ __forceinline__ void xcd_barrier_complete(unsigned* bar, unsigned x, unsigned& nloc, unsigned& nx) {
    const unsigned G = gridDim.x * gridDim.y * gridDim.z;
    unsigned sum, cnt, mine, sp = 0u;
    for (;;) {
        sum = 0u; cnt = 0u; mine = 0u;
#pragma unroll
        for (unsigned j = 0; j < 16; ++j) { const unsigned c = xb_ld(&bar[XB_XCNT(j)]); sum += c; cnt += (c > 0u) ? 1u : 0u; mine = (j == x) ? c : mine; }
        if (sum == G) break;
        __builtin_amdgcn_s_sleep(1);
        if ((++sp & 255u) == 0u) { if (xb_ld(&bar[XB_TMO])) break; if (sp > XB_SPIN_CAP) { atomicAdd(&bar[XB_TMO], 1u); break; } }
    }
    nloc = mine > 0u ? mine : 1u; nx = cnt > 0u ? cnt : 1u;
}

__device__ __forceinline__ void xcd_barrier(const XcdBarrier& b) {
    asm volatile("s_waitcnt vmcnt(0)" ::: "memory");
    __syncthreads();
    if (threadIdx.x == 0) {
        unsigned* bar = b.bar;
        __builtin_amdgcn_s_waitcnt(0);
        unsigned nloc = b.st[0], nx = b.st[1];
        if (nloc == 0u) { xcd_barrier_complete(bar, b.x, nloc, nx); b.st[0] = nloc; b.st[1] = nx; }
        const unsigned old = xb_add(&bar[XB_XSUB(b.x)], 1u);
        const unsigned gen = old / nloc;
        if (old + 1u == (gen + 1u) * nloc) {
            __builtin_amdgcn_fence(__ATOMIC_RELEASE, "agent");
            asm volatile("s_waitcnt vmcnt(0)" ::: "memory");
            const unsigned og = xb_add(&bar[XB_TOP], 1u);
            const unsigned tg = og / nx;
            if (og + 1u == (tg + 1u) * nx) xb_add(&bar[XB_TOPGEN], 1u);
            else XB_SPIN(xb_ld(&bar[XB_TOPGEN]) == tg, bar);
            __builtin_amdgcn_fence(__ATOMIC_ACQUIRE, "agent");
            xb_add(&bar[XB_XGEN(b.x)], 1u);
            asm volatile("s_waitcnt vmcnt(0)" ::: "memory");
        } else {
            XB_SPIN(xb_ld(&bar[XB_XGEN(b.x)]) == gen, bar);
            __builtin_amdgcn_fence(__ATOMIC_ACQUIRE, "agent");
            asm volatile("s_waitcnt vmcnt(0)" ::: "memory");
        }
    }
    __syncthreads();
}


struct Params {
  const float* in[26];
  float* out; unsigned char* ws;
};

__device__ __forceinline__ unsigned f2bf(float f) { unsigned u = __builtin_bit_cast(unsigned, f); return (u + 0x7fffu + ((u >> 16) & 1u)) >> 16; }
__device__ __forceinline__ unsigned pk2(float lo, float hi) { return f2bf(lo) | (f2bf(hi) << 16); }
__device__ __forceinline__ float wave_sum(float v) {
#pragma unroll
  for (int o = 1; o < 64; o <<= 1) v += __shfl_xor(v, o);
  return v;
}
__device__ __forceinline__ void prep_item(const float* W, int ld, int col0, const float* fold, bf16_t* WT, int K, int n0, int k0, float* scr, int lane, bool perm) {
#pragma unroll 16
  for (int i = 0; i < 32; ++i) { const int kk = 2 * i + (lane >> 5); float v = 0.f; if (W) { const int p_ = lane & 31; const int cc = perm ? (16 * ((p_ >> 2) & 1) + 4 * (p_ >> 3) + (p_ & 3)) : p_; v = W[(size_t)(k0 + kk) * ld + col0 + cc]; if (fold) v *= fold[k0 + kk]; } scr[kk * 33 + (lane & 31)] = v; }
  asm volatile("s_waitcnt lgkmcnt(0)" ::: "memory");
  const int c = lane & 7;
#pragma unroll
  for (int j = 0; j < 4; ++j) { const int n = (lane >> 3) + 8 * j; const float* s = scr + (8 * c) * 33 + n;
    u32x4 o; o.x = pk2(s[0 * 33], s[1 * 33]); o.y = pk2(s[2 * 33], s[3 * 33]); o.z = pk2(s[4 * 33], s[5 * 33]); o.w = pk2(s[6 * 33], s[7 * 33]);
    *(u32x4*)(WT + (size_t)(n0 + n) * K + k0 + 8 * c) = o; }
  asm volatile("s_waitcnt lgkmcnt(0)" ::: "memory");
}
__device__ __forceinline__ void sincos_d(double x, float& s, float& c) {
  const double TWO_PI = 6.283185307179586476925286766559, INV_2PI = 0.15915494309189533576888376337251;
  double k = __builtin_rint(x * INV_2PI); double r = x - k * TWO_PI;
  const double HALF_PI = 1.5707963267948966192313216916398;
  double q = __builtin_rint(r * 0.63661977236758134308); double y = r - q * HALF_PI; int qi = ((int)q) & 3;
  double y2 = y * y;
  double sp = y * (1.0 + y2 * (-1.0 / 6 + y2 * (1.0 / 120 + y2 * (-1.0 / 5040 + y2 * (1.0 / 362880 + y2 * (-1.0 / 39916800 + y2 * (1.0 / 6227020800.0)))))));
  double cp = 1.0 + y2 * (-0.5 + y2 * (1.0 / 24 + y2 * (-1.0 / 720 + y2 * (1.0 / 40320 + y2 * (-1.0 / 3628800 + y2 * (1.0 / 479001600.0 + y2 * (-1.0 / 87178291200.0)))))));
  double ss, cc;
  if (qi == 0) { ss = sp; cc = cp; } else if (qi == 1) { ss = cp; cc = -sp; } else if (qi == 2) { ss = -sp; cc = -cp; } else { ss = -cp; cc = sp; }
  s = (float)ss; c = (float)cc;
}

__device__ __forceinline__ void p0_prologue(const Params& P, unsigned char* ws, char* lds) {
  int tid_ = threadIdx.x; asm volatile("" : "+v"(tid_)); const int tid = tid_, lane = tid & 63, wave = tid >> 6;
  const int gw = blockIdx.x * 8 + wave, NGW = gridDim.x * 8;
  float* scr = (float*)(lds + wave * 16384);
  constexpr int NJ = 10;
  const int jN[NJ] = {NGU, 1024, NIN, 768, 1024, 1024, NGU, 1024, 1024, 1024};
  const int jK[NJ] = {1024, DFF, 1024, 384, 256, 1024, 1024, DFF, 1024, 256};
  int total = 0;
#pragma unroll
  for (int j = 0; j < NJ; ++j) total += (jN[j] / 32) * (jK[j] / 64);
  const int gwp = blockIdx.x * 4 + (wave & 3), NGWP = gridDim.x * 4;
  if (wave < 4)
  for (int it = gwp; it < total; it += NGWP) {
    int r = it, job = 0;
#pragma unroll
    for (int j = 0; j < NJ; ++j) { const int cnt = (jN[j] / 32) * (jK[j] / 64); if (job == j && r >= cnt) { r -= cnt; job = j + 1; } }
    int N = 0, K = 0;
#pragma unroll
    for (int j = 0; j < NJ; ++j) if (job == j) { N = jN[j]; K = jK[j]; }
    const int nblk = N / 32, kb = r / nblk, nb = r % nblk, k0 = 64 * kb, n0 = 32 * nb;
    const float* W = nullptr; int ld = 0, col0 = 0; const float* fold = nullptr; bf16_t* WT = nullptr;
    if (job == 0 || job == 6) { const int t = n0 >> 8, half = (n0 >> 7) & 1, j0 = n0 & 127; const int b = (job == 0) ? 5 : 19;
      W = P.in[b + half]; ld = DFF; col0 = 128 * t + j0; fold = P.in[(job == 0) ? 4 : 18]; WT = (bf16_t*)(ws + ((job == 0) ? WS_W1GU : WS_W2GU)); }
    else if (job == 1 || job == 7) { W = P.in[(job == 1) ? 7 : 21]; ld = 1024; col0 = n0; WT = (bf16_t*)(ws + ((job == 1) ? WS_W1D : WS_W2D)); }
    else if (job == 2) { ld = 3232; fold = P.in[8]; WT = (bf16_t*)(ws + WS_WIN); W = P.in[9];
      if (n0 < 384) col0 = n0; else if (n0 < 416) col0 = 640 + (n0 - 384); else if (n0 < 512) W = nullptr; else if (n0 < 768) col0 = 384 + (n0 - 512); else col0 = 672 + (n0 - 768); }
    else if (job == 3) { W = P.in[11]; ld = 768; col0 = n0; fold = P.in[10]; WT = (bf16_t*)(ws + WS_WUQ); }
    else if (job == 4) { if (n0 < 512) { W = P.in[13]; col0 = n0; } else { W = P.in[14]; col0 = n0 - 512; } ld = 512; fold = P.in[12]; WT = (bf16_t*)(ws + WS_WUKV); }
    else if (job == 5) { W = P.in[17]; ld = 1024; col0 = n0; WT = (bf16_t*)(ws + WS_WO); }
    else if (job == 8) { W = P.in[23]; ld = 1024; col0 = n0; fold = P.in[22]; WT = (bf16_t*)(ws + WS_WPG); }
    else { W = P.in[24]; ld = 1024; col0 = n0; WT = (bf16_t*)(ws + WS_WPP); }
    prep_item(W, ld, col0, fold, WT, K, n0, k0, scr, lane, job == 2 && n0 == 384);
  }
  float* ss = (float*)(ws + WS_SS); bf16_t* HB = (bf16_t*)(ws + WS_HB); bf16_t* PB = (bf16_t*)(ws + WS_PB);
  if (wave >= 4)
  for (int m0 = gwp; m0 < T_ALL; m0 += 2 * NGWP) {
    f32x4 v[2][4], pv[2]; bool ok[2];
#pragma unroll
    for (int q = 0; q < 2; ++q) { const int m = m0 + q * NGWP; ok[q] = m < T_ALL; const int mm = ok[q] ? m : m0;
      const float* xr = (mm < T_P) ? P.in[0] + (size_t)mm * DM : P.in[1] + (size_t)(mm - T_P) * DM; const f32x4* x4 = (const f32x4*)xr + lane;
#pragma unroll
      for (int j = 0; j < 4; ++j) v[q][j] = x4[64 * j];
      const float* pr = (mm < T_P) ? P.in[2] + (size_t)mm * PLE : P.in[3] + (size_t)(mm - T_P) * PLE; pv[q] = ((const f32x4*)pr)[lane]; }
#pragma unroll
    for (int q = 0; q < 2; ++q) { const int m = m0 + q * NGWP; if (!ok[q]) continue; float s = 0.f;
#pragma unroll
      for (int j = 0; j < 4; ++j) s += (v[q][j][0] * v[q][j][0] + v[q][j][1] * v[q][j][1]) + (v[q][j][2] * v[q][j][2] + v[q][j][3] * v[q][j][3]);
      s = wave_sum(s);
      u32x2* o8 = (u32x2*)(HB + (size_t)m * DM) + lane;
#pragma unroll
      for (int j = 0; j < 4; ++j) { u32x2 w; w.x = pk2(v[q][j][0], v[q][j][1]); w.y = pk2(v[q][j][2], v[q][j][3]); o8[64 * j] = w; }
      u32x2 w; w.x = pk2(pv[q][0], pv[q][1]); w.y = pk2(pv[q][2], pv[q][3]); ((u32x2*)(PB + (size_t)m * PLE))[lane] = w;
      if (lane < 7) ss[(size_t)lane * T_ALL + m] = (lane == 0) ? s : 0.f; }
  }
  float* rc = (float*)(ws + WS_ROPEC); float* rs = (float*)(ws + WS_ROPES);
  for (int e = blockIdx.x * 512 + tid; e < S_P * 16; e += gridDim.x * 512) {
    const int pos = e >> 4, i = e & 15;
    const float cst = (float)(-9.210340371976184 / 32.0); const float arg = (float)(2 * i) * cst;
    const double a = (double)arg; const double nn = __builtin_rint(a * 1.4426950408889634); const double rr = a - nn * 0.69314718055994530942;
    double ex = 1.0 + rr * (1.0 + rr * (0.5 + rr * (1.0 / 6 + rr * (1.0 / 24 + rr * (1.0 / 120 + rr * (1.0 / 720 + rr * (1.0 / 5040 + rr * (1.0 / 40320 + rr * (1.0 / 362880 + rr * (1.0 / 3628800 + rr * (1.0 / 39916800)))))))))));
    ex = ex * __builtin_ldexp(1.0, (int)nn);
    const float invf = (float)ex; const float ang = (float)pos * invf;
    float sv, cv; sincos_d((double)ang, sv, cv); rc[e] = cv; rs[e] = sv;
  }
}
__device__ __forceinline__ void hg_combine(const float* OP, const bf16_t* U, const float* hg_norm, bf16_t* MIX) {
  int tid_ = threadIdx.x; asm volatile("" : "+v"(tid_)); const int lane = tid_ & 63, wave = tid_ >> 6; const int gw = blockIdx.x * 8 + wave, NGW = gridDim.x * 8;
  f32x4 gn0 = *(const f32x4*)(hg_norm + 8 * lane), gn1 = *(const f32x4*)(hg_norm + 8 * lane + 4);
  for (int m = gw; m < T_ALL; m += NGW) {
    const float* a = OP + (size_t)m * 512 + 8 * lane; const float* b = a + (size_t)T_ALL * 512;
    f32x4 o0 = *(const f32x4*)a + *(const f32x4*)b, o1 = *(const f32x4*)(a + 4) + *(const f32x4*)(b + 4);
    float s = (o0[0] * o0[0] + o0[1] * o0[1]) + (o0[2] * o0[2] + o0[3] * o0[3]) + (o1[0] * o1[0] + o1[1] * o1[1]) + (o1[2] * o1[2] + o1[3] * o1[3]);
    s += __shfl_xor(s, 1); s += __shfl_xor(s, 2); s += __shfl_xor(s, 4); s += __shfl_xor(s, 8);
    const float r = rsqrtf(s * (1.0f / 128.0f) + EPS);
    const bf16x8 g = *(const bf16x8*)(U + (size_t)m * 2560 + 2048 + 8 * lane);
    float ov[8] = {o0[0], o0[1], o0[2], o0[3], o1[0], o1[1], o1[2], o1[3]}; float gnv[8] = {gn0[0], gn0[1], gn0[2], gn0[3], gn1[0], gn1[1], gn1[2], gn1[3]};
    unsigned w[4];
#pragma unroll
    for (int j = 0; j < 8; j += 2) { float r2[2];
#pragma unroll
      for (int e = 0; e < 2; ++e) { const float x = __uint_as_float(((unsigned)(unsigned short)g[j + e]) << 16); const float sl = x * __builtin_amdgcn_rcpf(1.0f + __builtin_amdgcn_exp2f(-1.4426950408889634f * x)); r2[e] = ov[j + e] * r * gnv[j + e] * sl; }
      w[j >> 1] = pk2(r2[0], r2[1]); }
    *(u32x4*)(MIX + (size_t)m * 1024 + 512 + 8 * lane) = (u32x4){w[0], w[1], w[2], w[3]};
  }
}
__device__ __forceinline__ void final_norm(float* out, const bf16_t* h4, const float* ss4, const float* fn) {
  int tid_ = threadIdx.x; asm volatile("" : "+v"(tid_)); const int lane = tid_ & 63, wave = tid_ >> 6; const int gw = blockIdx.x * 8 + wave, NGW = gridDim.x * 8;
  f32x4 g[2][2];
#pragma unroll
  for (int j = 0; j < 2; ++j) { g[j][0] = *(const f32x4*)(fn + 512 * j + 8 * lane); g[j][1] = *(const f32x4*)(fn + 512 * j + 8 * lane + 4); }
  for (int m0 = gw; m0 < T_ALL; m0 += 2 * NGW) {
    u32x4 h[2][2]; float r[2]; bool ok[2];
#pragma unroll
    for (int q = 0; q < 2; ++q) { const int m = m0 + q * NGW; ok[q] = m < T_ALL; const int mm = ok[q] ? m : m0; r[q] = ss4[mm];
#pragma unroll
      for (int j = 0; j < 2; ++j) h[q][j] = *(const u32x4*)(h4 + (size_t)mm * DM + 512 * j + 8 * lane); }
#pragma unroll
    for (int q = 0; q < 2; ++q) { const int m = m0 + q * NGW; if (!ok[q]) continue; const float rr = rsqrtf(r[q] * (1.0f / 1024.0f) + EPS);
#pragma unroll
      for (int j = 0; j < 2; ++j) { const u32x4 hh = h[q][j];
        f32x4 a, b; a[0] = __uint_as_float(hh.x << 16); a[1] = __uint_as_float(hh.x & 0xffff0000u); a[2] = __uint_as_float(hh.y << 16); a[3] = __uint_as_float(hh.y & 0xffff0000u);
        b[0] = __uint_as_float(hh.z << 16); b[1] = __uint_as_float(hh.z & 0xffff0000u); b[2] = __uint_as_float(hh.w << 16); b[3] = __uint_as_float(hh.w & 0xffff0000u);
        float* o = out + (size_t)m * DM + 512 * j + 8 * lane; *(f32x4*)o = a * rr * g[j][0]; *(f32x4*)(o + 4) = b * rr * g[j][1]; } }
  }
}

#define GSYNC() xcd_barrier(xbar)

template <class Epi> __device__ __forceinline__ void run_gemm(LAS unsigned char* lds, const bf16_t* A, int lda, const bf16_t* Bt, int ldb, int N, int K, const Epi& E) {
  pg8::Gemm g{A, Bt, T_ALL, N, K, lda, ldb}; pg8::StaticOrder S; S.init(T_ALL, N, (int)gridDim.x, (int)blockIdx.x);
  pg8::gemm_phase<Epi, pg8::StaticOrder, true, true>(lds, g, S, E);
}

__global__ void __launch_bounds__(512, 2) mk_fwd(Params P) {
  extern __shared__ __attribute__((aligned(16))) unsigned char lds[];
  unsigned char* ws = P.ws; float* out = P.out; unsigned char* dob = (unsigned char*)P.out;
  LAS unsigned char* l3 = (LAS unsigned char*)lds;
  float* ss = (float*)(ws + WS_SS);
  float* ss0 = ss, *ss1 = ss + T_ALL, *ss2 = ss + 2 * (size_t)T_ALL, *ss3 = ss + 3 * (size_t)T_ALL, *ss4 = ss + 4 * (size_t)T_ALL, *ssq = ss + 5 * (size_t)T_ALL, *sskv = ss + 6 * (size_t)T_ALL;
  const float* ropec = (const float*)(ws + WS_ROPEC); const float* ropes = (const float*)(ws + WS_ROPES);
  bf16_t* HB = (bf16_t*)(ws + WS_HB); bf16_t* ACT = (bf16_t*)(ws + WS_ACT); bf16_t* UHG = (bf16_t*)(ws + WS_UHG); bf16_t* UMLA = (bf16_t*)(ws + WS_UMLA);
  bf16_t* MIX = (bf16_t*)(ws + WS_MIX); bf16_t* H4B = (bf16_t*)(ws + WS_MIX);     bf16_t* PROJ = (bf16_t*)P.out;     bf16_t* PB = (bf16_t*)(ws + WS_PB);
  bf16_t* Qb = (bf16_t*)(dob + DO_Q); bf16_t* KN = (bf16_t*)(dob + DO_KN); bf16_t* Vb = (bf16_t*)(dob + DO_V); bf16_t* KR = (bf16_t*)(dob + DO_KR);

  if (threadIdx.x < 16) ((LAS unsigned*)(l3 + LDS_BARST))[threadIdx.x] = 0u;
  if (blockIdx.x == 0) { for (int i = threadIdx.x; i < XCD_BAR_WORDS; i += 512) __hip_atomic_store((unsigned*)(ws + WS_BAR) + i, 0u, __ATOMIC_RELAXED, __HIP_MEMORY_SCOPE_AGENT); }
  p0_prologue(P, ws, (char*)lds);
  cg::this_grid().sync();
  const XcdBarrier xbar = xcd_barrier_post((unsigned*)(ws + WS_BAR), (volatile LAS unsigned*)(l3 + LDS_BARST));
  { pg8::EpiSwiGLU E{ACT, ss0}; run_gemm(l3, HB, 1024, (const bf16_t*)(ws + WS_W1GU), 1024, NGU, 1024, E); }
  GSYNC();
  { pg8::EpiRes<2> E{nullptr, nullptr, HB, nullptr, ss1, nullptr, nullptr}; run_gemm(l3, ACT, DFF, (const bf16_t*)(ws + WS_W1D), DFF, 1024, DFF, E); }
  GSYNC();
  { pg8::EpiWin E{UMLA, UHG, KR, ss1, ssq, sskv, ropec, ropes}; run_gemm(l3, HB, 1024, (const bf16_t*)(ws + WS_WIN), 1024, NIN, 1024, E); }
  GSYNC();
  { pg8::EpiBf E{Qb, Qb, 768, 1000, ssq, 1.0f / 384.0f, att::SCALE * 1.4426950408889634f}; run_gemm(l3, UMLA, 768, (const bf16_t*)(ws + WS_WUQ), 384, 768, 384, E); }
  { pg8::EpiBf E{KN, Vb, 512, 2, sskv, 1.0f / 256.0f, 1.0f}; run_gemm(l3, UMLA + 512, 768, (const bf16_t*)(ws + WS_WUKV), 256, 1024, 256, E); }
  {
    float* SLOT = (float*)(ws + WS_SLOT); float* DSEG = (float*)(ws + WS_DSEG);
    for (int u = blockIdx.x; u < 768; u += gridDim.x) {
      int chainid, seg, nseg;
      if (u < 256) { chainid = u >> 4; seg = u & 15; nseg = 16; } else { const int u2 = u - 256; chainid = 16 + (u2 >> 2); seg = u2 & 3; nseg = 4; }
      if (seg == nseg - 1) continue;
      int rowbase, S, h, dir;
      if (chainid < 16) { const int b = chainid >> 3; h = (chainid >> 1) & 3; dir = chainid & 1; rowbase = b * S_P; S = S_P; }
      else { const int c2 = chainid - 16; const int b = c2 >> 3; h = (c2 >> 1) & 3; dir = c2 & 1; rowbase = T_P + b * S_S; S = S_S; }
      hg::chain<1>(UHG, out, P.in[15], rowbase, S, h, dir, seg * 1024, 16, nullptr, SLOT + (size_t)u * 16384, DSEG + (size_t)u * 128, (char*)lds);
    }
  }
  GSYNC();
  {
    float* SLOT = (float*)(ws + WS_SLOT); const float* DSEG = (const float*)(ws + WS_DSEG);
    int tid_ = threadIdx.x; asm volatile("" : "+v"(tid_));
    for (int e = blockIdx.x * 512 + tid_; e < 144 * 16384; e += gridDim.x * 512) {
      const int chainid = e >> 14, el = e & 16383, k = el & 127;
      int u0, nseg; if (chainid < 16) { u0 = chainid * 16; nseg = 16; } else { u0 = 256 + (chainid - 16) * 4; nseg = 4; }
      float Sv = 0.f;
      if (nseg == 16) { float slv[15], dv[15];
#pragma unroll
        for (int s = 0; s < 15; ++s) { slv[s] = SLOT[(size_t)(u0 + s) * 16384 + el]; dv[s] = DSEG[(size_t)(u0 + s) * 128 + k]; }
#pragma unroll
        for (int s = 0; s < 15; ++s) { Sv = dv[s] * Sv + slv[s]; SLOT[(size_t)(u0 + s) * 16384 + el] = Sv; } }
      else { float slv[3], dv[3];
#pragma unroll
        for (int s = 0; s < 3; ++s) { slv[s] = SLOT[(size_t)(u0 + s) * 16384 + el]; dv[s] = DSEG[(size_t)(u0 + s) * 128 + k]; }
#pragma unroll
        for (int s = 0; s < 3; ++s) { Sv = dv[s] * Sv + slv[s]; SLOT[(size_t)(u0 + s) * 16384 + el] = Sv; } }
    }
  }
  {
    const int G = gridDim.x, bx = blockIdx.x;
    if (G == 256) {
      const int xcd = bx & 7, idx = bx >> 3;
      for (int i = 0; i < 12; ++i) {
        int rowbase, seq, h, qb;
        if (i < 4) { const int pair = 2 * xcd + (i >> 1); const int b = pair >> 3; h = pair & 7; qb = idx * 2 + (i & 1); rowbase = b * S_P; seq = S_P; }
        else { const int j = i - 4; const int pair = 16 * xcd + 2 * j + (idx >> 4); const int b = pair >> 3; h = pair & 7; qb = idx & 15; rowbase = T_P + b * S_S; seq = S_S; }
        att::attn_unit(Qb + (size_t)(rowbase + qb * 256) * 768 + h * 96, KN + (size_t)rowbase * 512 + h * 64, KR + (size_t)rowbase * 32, Vb + (size_t)rowbase * 512 + h * 64,
                       MIX + (size_t)(rowbase + qb * 256) * 1024 + h * 64, seq, rowbase + qb * 256, ropec, ropes, (char*)lds);
      }
    } else {
      for (int u = bx; u < 3072; u += G) {
        int rowbase, seq, h, qb;
        if (u < 1024) { const int pair = u >> 6; const int b = pair >> 3; h = pair & 7; qb = u & 63; rowbase = b * S_P; seq = S_P; }
        else { const int v = u - 1024; const int pair = v >> 4; const int b = pair >> 3; h = pair & 7; qb = v & 15; rowbase = T_P + b * S_S; seq = S_S; }
        att::attn_unit(Qb + (size_t)(rowbase + qb * 256) * 768 + h * 96, KN + (size_t)rowbase * 512 + h * 64, KR + (size_t)rowbase * 32, Vb + (size_t)rowbase * 512 + h * 64,
                       MIX + (size_t)(rowbase + qb * 256) * 1024 + h * 64, seq, rowbase + qb * 256, ropec, ropes, (char*)lds);
      }
    }
  }
  GSYNC();
  {
    const float* SLOT = (const float*)(ws + WS_SLOT);
    for (int u = blockIdx.x; u < 768; u += gridDim.x) {
      int chainid, seg;
      if (u < 256) { chainid = u >> 4; seg = u & 15; } else { const int u2 = u - 256; chainid = 16 + (u2 >> 2); seg = u2 & 3; }
      int rowbase, S, h, dir;
      if (chainid < 16) { const int b = chainid >> 3; h = (chainid >> 1) & 3; dir = chainid & 1; rowbase = b * S_P; S = S_P; }
      else { const int c2 = chainid - 16; const int b = c2 >> 3; h = (c2 >> 1) & 3; dir = c2 & 1; rowbase = T_P + b * S_S; S = S_S; }
      hg::chain<3>(UHG, out, P.in[15], rowbase, S, h, dir, seg * 1024, 16, seg ? SLOT + (size_t)(u - 1) * 16384 : nullptr, nullptr, nullptr, (char*)lds);
    }
  }
  GSYNC();
  hg_combine(out, UHG, P.in[16], MIX);
  GSYNC();
  { pg8::EpiRes<1> E{nullptr, nullptr, HB, nullptr, ss2, nullptr, nullptr}; run_gemm(l3, MIX, 1024, (const bf16_t*)(ws + WS_WO), 1024, 1024, 1024, E); }
  GSYNC();
  { pg8::EpiSwiGLU E{ACT, ss2}; run_gemm(l3, HB, 1024, (const bf16_t*)(ws + WS_W2GU), 1024, NGU, 1024, E); }
  GSYNC();
  { pg8::EpiRes<2> E{nullptr, nullptr, HB, nullptr, ss3, nullptr, nullptr}; run_gemm(l3, ACT, DFF, (const bf16_t*)(ws + WS_W2D), DFF, 1024, DFF, E); }
  { pg8::EpiBf E{PROJ, PROJ, 1024, 1000, nullptr, 0.f, 1.0f}; run_gemm(l3, PB, 256, (const bf16_t*)(ws + WS_WPP), 256, 1024, 256, E); }
  GSYNC();
  { pg8::EpiRes<3> E{nullptr, nullptr, HB, H4B, ss4, ss3, PROJ}; run_gemm(l3, HB, 1024, (const bf16_t*)(ws + WS_WPG), 1024, 1024, 1024, E); }
  GSYNC();
  final_norm(out, H4B, ss4, P.in[25]);
}

extern "C" void kernel_launch(void* const* d_in, const int* in_sizes, int n_in, void* d_out, int out_size, void* d_ws, size_t ws_size, hipStream_t stream) {
  static int grid = 0;
  if (grid == 0) {
    if (n_in != 26 || out_size != T_ALL * DM || ws_size < WS_END) { fprintf(stderr, "kernel_launch: unexpected shapes n_in %d out %d ws %zu\n", n_in, out_size, ws_size); grid = -1; return; }
    int dev = 0, cus = 0, per_cu = 0;
    if (hipGetDevice(&dev) != hipSuccess || hipDeviceGetAttribute(&cus, hipDeviceAttributeMultiprocessorCount, dev) != hipSuccess) { grid = -1; return; }
    if (hipFuncSetAttribute((const void*)mk_fwd, hipFuncAttributeMaxDynamicSharedMemorySize, LDS_BYTES) != hipSuccess) { fprintf(stderr, "kernel_launch: LDS attribute failed\n"); grid = -1; return; }
    if (hipOccupancyMaxActiveBlocksPerMultiprocessor(&per_cu, (const void*)mk_fwd, 512, LDS_BYTES) != hipSuccess || per_cu < 1) { fprintf(stderr, "kernel_launch: occupancy query says %d\n", per_cu); per_cu = 1; }
    (void)hipGetLastError();
    grid = cus;
  }
  if (grid < 0) return;
  Params p{};
  for (int i = 0; i < 26; ++i) p.in[i] = (const float*)d_in[i];
  p.out = (float*)d_out; p.ws = (unsigned char*)d_ws;
  void* args[] = {&p};
  hipError_t e = hipLaunchCooperativeKernel((void*)mk_fwd, dim3(grid), dim3(512), args, LDS_BYTES, stream);
  if (e != hipSuccess) fprintf(stderr, "cooperative launch failed: %s (grid %d)\n", hipGetErrorString(e), grid);
}
```

```cpp
#include <hip/hip_runtime.h>
#include <hip/hip_cooperative_groups.h>
#include <cstdio>
#include <cstdint>
namespace cg = cooperative_groups;

constexpr int DM = 1024, T_P = 32768, T_ALL = 98304, S_P = 16384, S_S = 4096;
constexpr int DFF = 2816, NGU = 5632, NIN = 3328, NMLA = 768, NHG = 2560, PLE = 256;
constexpr float EPS = 1e-6f;
__device__ __forceinline__ int row_pos(int row) { return row < T_P ? (row & (S_P - 1)) : (row & (S_S - 1)); }

namespace pg8 {
#define PG8_LAS __attribute__((address_space(3)))
typedef unsigned short bf16_t;
typedef short bf16x8 __attribute__((ext_vector_type(8)));
typedef float f32x4 __attribute__((ext_vector_type(4)));
typedef unsigned u32x4 __attribute__((ext_vector_type(4)));
constexpr int BM = 256, BK = 64, HALF = 128, HTB = HALF * BK * 2  , STAGE_BYTES = 8 * HTB, NXCD = 8, WGM = 8;

__host__ __device__ __forceinline__ int lds_byte(int r, int c) { const int st = (r >> 4) * 2 + (c >> 5), rr = r & 15, cc = c & 31, ob = rr * 64 + cc * 2; return st * 1024 + (ob ^ (((ob >> 9) & 1) << 5)); }
__host__ __device__ __forceinline__ void stage_rc(int b, int& R, int& C) { const int st = b / 1024, sb = b % 1024, swz = sb ^ (((sb >> 9) & 1) << 5); R = (st >> 1) * 16 + swz / 64; C = (st & 1) * 32 + (swz % 64) / 2; }
__host__ __device__ __forceinline__ int perm32(int rho) { const int n = rho >> 4, i = rho & 15; return 8 * (i >> 2) + 4 * n + (i & 3); }

struct Unit { int pm, pn; };
struct Gemm { const bf16_t* A; const bf16_t* Bt; int M, N, K, lda, ldb; };

struct StaticOrder {
    int nM, nN, nwg, G, c;
    __host__ __device__ void init(int M, int N, int G_, int c_) { nM = M / BM; nN = N / BM; nwg = nM * nN; G = G_; c = c_; }
    __host__ __device__ bool next(int i, Unit& u) const {
        const long L = (long)i * G + c; if (L >= nwg) return false;
        int wgid = (int)L; { const int q = nwg / NXCD, r = nwg % NXCD, xcd = wgid % NXCD, off = wgid / NXCD; wgid = (xcd < r ? xcd * (q + 1) : r * (q + 1) + (xcd - r) * q) + off; }
        const int nig = WGM * nN, gid = wgid / nig, fm = gid * WGM, gsz = (nM - fm) < WGM ? (nM - fm) : WGM;
        u.pm = fm + ((wgid % nig) % gsz); u.pn = (wgid % nig) / gsz; return true;
    }
    __device__ __forceinline__ void a_ready(const Unit&) const {}
    __device__ __forceinline__ void done(const Unit&) const {}
};
__device__ __forceinline__ unsigned cvt_pk_bf16(float lo, float hi) { unsigned r; asm volatile("v_cvt_pk_bf16_f32 %0, %1, %2" : "=v"(r) : "v"(lo), "v"(hi)); return r; }
typedef unsigned u32x2 __attribute__((ext_vector_type(2)));
__device__ __forceinline__ float bf2f(unsigned short h) { return __uint_as_float(((unsigned)h) << 16); }
__device__ __forceinline__ float fsigmoid(float x) { return __builtin_amdgcn_rcpf(1.0f + __builtin_amdgcn_exp2f(-1.4426950408889634f * x)); }
typedef unsigned ss_t;
__device__ __forceinline__ float ss_f(ss_t v) { return (float)v * (1.0f / 4096.0f); }
__device__ __forceinline__ void ss_add(ss_t* p, float v) { atomicAdd(p, (ss_t)(v * 4096.0f + 0.5f)); }
__device__ __forceinline__ float row_sum4(float s) { s += __shfl_xor(s, 16); s += __shfl_xor(s, 32); return s; }

struct EpiSwiGLU {
    static constexpr bool PERM = true, AFTER_DRAIN = false;
    bf16_t* O; const ss_t* ss;
    __device__ __forceinline__ void operator()(const f32x4 (&acc)[2][2][4][2], const Unit& u, int wr, int wc, int fr, int fq) const {
        const int row0 = u.pm * BM + wr * 64 + fr; const int col0 = u.pn * HALF + wc * 32 + 8 * fq;
        float ssv[2][4];
#pragma unroll
        for (int ai = 0; ai < 2; ++ai)
#pragma unroll
            for (int m = 0; m < 4; ++m) ssv[ai][m] = ss_f(ss[row0 + ai * HALF + m * 16]);
#pragma unroll
        for (int ai = 0; ai < 2; ++ai)
#pragma unroll
            for (int m = 0; m < 4; ++m) { const int row = row0 + ai * HALF + m * 16; const float r = __builtin_amdgcn_rsqf(ssv[ai][m] * (1.0f / 1024.0f) + 1e-6f);
                const float c1 = -1.4426950408889634f * r, r2 = r * r;
                f32x4 vv[2];
#pragma unroll
                for (int n = 0; n < 2; ++n) { const f32x4 a = acc[ai][0][m][n], b = acc[ai][1][m][n]; const f32x4 m1 = a * c1; f32x4 d;
                    d[0] = __builtin_amdgcn_exp2f(m1[0]); d[1] = __builtin_amdgcn_exp2f(m1[1]); d[2] = __builtin_amdgcn_exp2f(m1[2]); d[3] = __builtin_amdgcn_exp2f(m1[3]);
                    d = d + 1.0f; f32x4 inv; inv[0] = __builtin_amdgcn_rcpf(d[0]); inv[1] = __builtin_amdgcn_rcpf(d[1]); inv[2] = __builtin_amdgcn_rcpf(d[2]); inv[3] = __builtin_amdgcn_rcpf(d[3]);
                    vv[n] = (a * b) * (inv * r2); }
                u32x4 w; w.x = cvt_pk_bf16(vv[0][0], vv[0][1]); w.y = cvt_pk_bf16(vv[0][2], vv[0][3]); w.z = cvt_pk_bf16(vv[1][0], vv[1][1]); w.w = cvt_pk_bf16(vv[1][2], vv[1][3]);
                __builtin_nontemporal_store(w, (u32x4*)(O + (size_t)row * 2816 + col0)); }
    }
};
template <int MODE> struct EpiRes {
    static constexpr bool PERM = true, AFTER_DRAIN = false;
    const float* xp; const float* xs; bf16_t* hb; bf16_t* hout; ss_t* ssout; const ss_t* ssin; const bf16_t* proj;
    __device__ __forceinline__ void operator()(const f32x4 (&acc)[2][2][4][2], const Unit& u, int wr, int wc, int fr, int fq) const {
        const int row0 = u.pm * BM + wr * 64 + fr; const int col0 = u.pn * BM + wc * 32 + 8 * fq;
        float s3v[2][4];
        if (MODE == 3) {
#pragma unroll
            for (int ai = 0; ai < 2; ++ai)
#pragma unroll
                for (int m = 0; m < 4; ++m) s3v[ai][m] = ss_f(ssin[row0 + ai * HALF + m * 16]); }
#pragma unroll
        for (int ai = 0; ai < 2; ++ai) {
            u32x4 hpre[4][2];
            if (MODE != 0) {
#pragma unroll
                for (int m = 0; m < 4; ++m)
#pragma unroll
                    for (int bj = 0; bj < 2; ++bj) hpre[m][bj] = *(const u32x4*)(hb + (size_t)(row0 + ai * HALF + m * 16) * 1024 + col0 + bj * HALF); }
#pragma unroll
            for (int m = 0; m < 4; ++m) { const int row = row0 + ai * HALF + m * 16; float sq = 0.f; float r3 = 0.f;
                if (MODE == 3) r3 = __builtin_amdgcn_rsqf(s3v[ai][m] * (1.0f / 1024.0f) + 1e-6f);
#pragma unroll
                for (int bj = 0; bj < 2; ++bj) { const size_t off = (size_t)row * 1024 + col0 + bj * HALF; float b[8], v[8];
                    if (MODE == 0) { const float* xr = (row < 32768) ? (xp + off) : (xs + (off - (size_t)32768 * 1024)); const f32x4 b0 = *(const f32x4*)xr, b1 = *(const f32x4*)(xr + 4);
                        b[0] = b0[0]; b[1] = b0[1]; b[2] = b0[2]; b[3] = b0[3]; b[4] = b1[0]; b[5] = b1[1]; b[6] = b1[2]; b[7] = b1[3]; }
                    else { const u32x4 h4 = hpre[m][bj];
                        b[0] = __uint_as_float(h4.x << 16); b[1] = __uint_as_float(h4.x & 0xffff0000u); b[2] = __uint_as_float(h4.y << 16); b[3] = __uint_as_float(h4.y & 0xffff0000u);
                        b[4] = __uint_as_float(h4.z << 16); b[5] = __uint_as_float(h4.z & 0xffff0000u); b[6] = __uint_as_float(h4.w << 16); b[7] = __uint_as_float(h4.w & 0xffff0000u); }
                    if (MODE == 3) { const u32x4 p4 = *(const u32x4*)(proj + off); float pr[8];
                        pr[0] = __uint_as_float(p4.x << 16); pr[1] = __uint_as_float(p4.x & 0xffff0000u); pr[2] = __uint_as_float(p4.y << 16); pr[3] = __uint_as_float(p4.y & 0xffff0000u);
                        pr[4] = __uint_as_float(p4.z << 16); pr[5] = __uint_as_float(p4.z & 0xffff0000u); pr[6] = __uint_as_float(p4.w << 16); pr[7] = __uint_as_float(p4.w & 0xffff0000u);
#pragma unroll
                        for (int j = 0; j < 8; ++j) v[j] = b[j] + fsigmoid(acc[ai][bj][m][j >> 2][j & 3] * r3) * pr[j]; }
                    else {
#pragma unroll
                        for (int j = 0; j < 8; ++j) v[j] = b[j] + acc[ai][bj][m][j >> 2][j & 3] * ((MODE == 1) ? 1.0f : 0.5f); }
#pragma unroll
                    for (int j = 0; j < 8; ++j) sq += v[j] * v[j];
                    u32x4 w; w.x = cvt_pk_bf16(v[0], v[1]); w.y = cvt_pk_bf16(v[2], v[3]); w.z = cvt_pk_bf16(v[4], v[5]); w.w = cvt_pk_bf16(v[6], v[7]);
                    *(u32x4*)(((MODE == 3) ? hout : hb) + off) = w; }
                sq = row_sum4(sq);
                if (fq == 0) ss_add(ssout + row, sq); }
        }
    }
};
struct EpiWin {
    static constexpr bool PERM = true, AFTER_DRAIN = false;
    bf16_t* umla; bf16_t* uhg; bf16_t* kr; const ss_t* ss1; ss_t* ssq; ss_t* sskv; const float* ropec; const float* ropes;
    __device__ __forceinline__ void operator()(const f32x4 (&acc)[2][2][4][2], const Unit& u, int wr, int wc, int fr, int fq) const {
        const int row0 = u.pm * BM + wr * 64 + fr; const int pn = u.pn;
        bf16_t* dst; int ld, colt;
        if (pn < 3) { dst = umla; ld = 768; colt = pn * BM; } else { dst = uhg; ld = 2560; colt = (pn - 3) * BM; }
        const int col0 = colt + wc * 32 + 8 * fq;
        float ssv[2][4];
#pragma unroll
        for (int ai = 0; ai < 2; ++ai)
#pragma unroll
            for (int m = 0; m < 4; ++m) ssv[ai][m] = ss_f(ss1[row0 + ai * HALF + m * 16]);
#pragma unroll
        for (int ai = 0; ai < 2; ++ai)
#pragma unroll
            for (int m = 0; m < 4; ++m) { const int row = row0 + ai * HALF + m * 16; const float r = __builtin_amdgcn_rsqf(ssv[ai][m] * (1.0f / 1024.0f) + 1e-6f);
                float sq0 = 0.f, sq1 = 0.f; f32x4 v[2][2];
#pragma unroll
                for (int bj = 0; bj < 2; ++bj) {
#pragma unroll
                    for (int n = 0; n < 2; ++n) { v[bj][n] = acc[ai][bj][m][n] * r; const f32x4 x = v[bj][n]; const float s = (x[0] * x[0] + x[1] * x[1]) + (x[2] * x[2] + x[3] * x[3]); if (bj == 0) sq0 += s; else sq1 += s; }
                    u32x4 w; w.x = cvt_pk_bf16(v[bj][0][0], v[bj][0][1]); w.y = cvt_pk_bf16(v[bj][0][2], v[bj][0][3]); w.z = cvt_pk_bf16(v[bj][1][0], v[bj][1][1]); w.w = cvt_pk_bf16(v[bj][1][2], v[bj][1][3]);
                    __builtin_nontemporal_store(w, (u32x4*)(dst + (size_t)row * ld + col0 + bj * HALF)); }
                if (pn < 3) { float s = (pn == 1) ? sq0 : (sq0 + sq1); s = row_sum4(s); if (fq == 0) ss_add((pn == 2 ? sskv : ssq) + row, s); }
                if (pn == 1 && wc == 0) {
                    const int pos = row_pos(row); const f32x4 cs = *(const f32x4*)(ropec + pos * 16 + 4 * fq), sn = *(const f32x4*)(ropes + pos * 16 + 4 * fq);
                    const f32x4 x1 = v[1][0], x2 = v[1][1]; const f32x4 o1 = x1 * cs - x2 * sn, o2 = x1 * sn + x2 * cs;
                    u32x2 w1, w2; w1.x = cvt_pk_bf16(o1[0], o1[1]); w1.y = cvt_pk_bf16(o1[2], o1[3]); w2.x = cvt_pk_bf16(o2[0], o2[1]); w2.y = cvt_pk_bf16(o2[2], o2[3]);
                    *(u32x2*)(kr + (size_t)row * 32 + 4 * fq) = w1; *(u32x2*)(kr + (size_t)row * 32 + 16 + 4 * fq) = w2; } }
    }
};
struct EpiBf {
    static constexpr bool PERM = true, AFTER_DRAIN = false;
    bf16_t* O0; bf16_t* O1; int ld; int split; const ss_t* ss; float inv_n; float mul;
    __device__ __forceinline__ void operator()(const f32x4 (&acc)[2][2][4][2], const Unit& u, int wr, int wc, int fr, int fq) const {
        const int row0 = u.pm * BM + wr * 64 + fr; bf16_t* base = O0; int colt = u.pn * BM; if (u.pn >= split) { base = O1; colt = (u.pn - split) * BM; }
        const int col0 = colt + wc * 32 + 8 * fq;
#pragma unroll
        for (int ai = 0; ai < 2; ++ai)
#pragma unroll
            for (int m = 0; m < 4; ++m) { const int row = row0 + ai * HALF + m * 16; const float r = (ss ? rsqrtf(ss_f(ss[row]) * inv_n + 1e-6f) : 1.0f) * mul;
#pragma unroll
                for (int bj = 0; bj < 2; ++bj) { const f32x4 v0 = acc[ai][bj][m][0] * r, v1 = acc[ai][bj][m][1] * r;
                    u32x4 w; w.x = cvt_pk_bf16(v0[0], v0[1]); w.y = cvt_pk_bf16(v0[2], v0[3]); w.z = cvt_pk_bf16(v1[0], v1[1]); w.w = cvt_pk_bf16(v1[2], v1[3]);
                    *(u32x4*)(base + (size_t)row * ld + col0 + bj * HALF) = w; } }
    }
};
template <class Epi, class Sched, bool ALIGN_EPI = false, bool SP2 = false>
__device__ __forceinline__ void gemm_phase(PG8_LAS unsigned char* lds, const Gemm g, const Sched& S, const Epi& E) {
    int tid_ = threadIdx.x; asm volatile("" : "+v"(tid_)); const int tid = tid_, wid = __builtin_amdgcn_readfirstlane(tid >> 6), lane = tid & 63, wr = wid >> 2, wc = wid & 3, fr = lane & 15, fq = lane >> 4;
    const int K = g.K, nt = K / BK;
    unsigned voffA[2], voffB[2];
#pragma unroll
    for (int i = 0; i < 2; ++i) { int R, C; stage_rc(tid * 16 + i * 8192, R, C); const int Rb = Epi::PERM ? ((R & ~31) + perm32(R & 31)) : R;
        voffA[i] = (unsigned)(R * g.lda + C) * 2u; voffB[i] = (unsigned)(Rb * g.ldb + C) * 2u; }
    const size_t kstep = (size_t)(BK * 2);
    const size_t hstepA = (size_t)HALF * g.lda * 2, hstepB = (size_t)HALF * g.ldb * 2;
    const size_t tstepA = 2 * hstepA, tstepB = 2 * hstepB;
    const unsigned ldsw = (unsigned)wid * 1024u;
    const int aoff = lds_byte(wr * 64 + fr, fq * 8), boff = lds_byte(wc * 32 + fr, fq * 8);
#define PG8_SA(b, h) (((b) * 2 + (h)) * HTB)
#define PG8_SB(b, h) ((4 + (b) * 2 + (h)) * HTB)
#define PG8_STAGE(bufoff, gbase, voff) do { _Pragma("unroll") for (int _i = 0; _i < 2; ++_i) \
        __builtin_amdgcn_global_load_lds((const unsigned*)((const char*)(gbase) + (voff)[_i]), (PG8_LAS unsigned*)(lds + (bufoff) + ldsw + _i * 8192), 16, 0, 0); } while (0)
#define PG8_LDA(dst, b, h) do { _Pragma("unroll") for (int m = 0; m < 4; ++m) _Pragma("unroll") for (int k = 0; k < 2; ++k) dst[m][k] = *(const PG8_LAS bf16x8*)(lds + PG8_SA(b, h) + aoff + m * 2048 + k * 1024); } while (0)
#define PG8_LDB(dst, b, h) do { _Pragma("unroll") for (int n = 0; n < 2; ++n) _Pragma("unroll") for (int k = 0; k < 2; ++k) dst[n][k] = *(const PG8_LAS bf16x8*)(lds + PG8_SB(b, h) + boff + n * 2048 + k * 1024); } while (0)
#define PG8_MMA(ai, bj, At, Bt) do { __builtin_amdgcn_s_setprio(1); _Pragma("unroll") for (int m = 0; m < 4; ++m) _Pragma("unroll") for (int n = 0; n < 2; ++n) _Pragma("unroll") for (int k = 0; k < 2; ++k) \
        acc[ai][bj][m][n] = __builtin_amdgcn_mfma_f32_16x16x32_bf16(Bt[n][k], At[m][k], acc[ai][bj][m][n], 0, 0, 0); __builtin_amdgcn_s_setprio(0); } while (0)
#define PG8_WAIT_V(n) asm volatile("s_waitcnt vmcnt(" #n ")" ::: "memory")
#define PG8_WAIT_L(n) asm volatile("s_waitcnt lgkmcnt(" #n ")" ::: "memory")
#define PG8_BAR __builtin_amdgcn_s_barrier()
#define PG8_SCHED __builtin_amdgcn_sched_barrier(0)
    Unit cur, nxt; int ui = 0;
    if (!S.next(0, cur)) return;
    f32x4 acc[2][2][4][2];
#pragma unroll
    for (int a = 0; a < 2; ++a)
#pragma unroll
        for (int b = 0; b < 2; ++b)
#pragma unroll
            for (int m = 0; m < 4; ++m)
#pragma unroll
                for (int n = 0; n < 2; ++n) acc[a][b][m][n] = (f32x4){0.f, 0.f, 0.f, 0.f};
    bf16x8 At[4][2], B0[2][2], B1[2][2];
    const char* cA = (const char*)g.A + (size_t)cur.pm * tstepA; const char* cB = (const char*)g.Bt + (size_t)cur.pn * tstepB;
    S.a_ready(cur);
    if constexpr (SP2) {
        PG8_STAGE(PG8_SB(0, 0), cB, voffB); PG8_STAGE(PG8_SB(0, 1), cB + hstepB, voffB); PG8_STAGE(PG8_SA(0, 0), cA, voffA); PG8_STAGE(PG8_SA(0, 1), cA + hstepA, voffA);
        if (wr == 1) PG8_BAR;
        PG8_WAIT_V(2); PG8_BAR;
        PG8_STAGE(PG8_SB(1, 0), cB + kstep, voffB); PG8_STAGE(PG8_SA(1, 0), cA + kstep, voffA); PG8_STAGE(PG8_SB(1, 1), cB + hstepB + kstep, voffB);
        PG8_WAIT_V(6); PG8_BAR;
    } else {
        PG8_STAGE(PG8_SB(0, 0), cB, voffB); PG8_STAGE(PG8_SA(0, 0), cA, voffA); PG8_STAGE(PG8_SB(0, 1), cB + hstepB, voffB); PG8_STAGE(PG8_SA(0, 1), cA + hstepA, voffA);
        if (wr == 1) PG8_BAR;
        PG8_WAIT_V(4); PG8_BAR;
        PG8_STAGE(PG8_SB(1, 0), cB + kstep, voffB); PG8_STAGE(PG8_SA(1, 0), cA + kstep, voffA); PG8_STAGE(PG8_SB(1, 1), cB + hstepB + kstep, voffB);
        PG8_WAIT_V(6); PG8_BAR;
    }
    for (;;) {
        const bool has_next = S.next(ui + 1, nxt);
        const char* nA = has_next ? (const char*)g.A + (size_t)nxt.pm * tstepA : cA; const char* nB = has_next ? (const char*)g.Bt + (size_t)nxt.pn * tstepB : cB;
        for (int t = 0; t < nt; t += 2) {
            const bool last = (t == nt - 2);
            const char* a1 = cA + (size_t)(t + 1) * kstep;
            const char* a2 = last ? nA : cA + (size_t)(t + 2) * kstep; const char* b2 = last ? nB : cB + (size_t)(t + 2) * kstep;
            const char* a3 = a2 + kstep; const char* b3 = b2 + kstep;
            if (last && has_next) S.a_ready(nxt);
            if constexpr (SP2) {
            PG8_LDB(B0, 0, 0); PG8_LDB(B1, 0, 1); PG8_SCHED; PG8_LDA(At, 0, 0); PG8_STAGE(PG8_SA(1, 1), a1 + hstepA, voffA);
            PG8_WAIT_V(8); PG8_WAIT_L(0); PG8_BAR; PG8_MMA(0, 0, At, B0); PG8_MMA(0, 1, At, B1); PG8_BAR; PG8_SCHED;
            PG8_LDA(At, 0, 1); PG8_STAGE(PG8_SB(0, 0), b2, voffB); PG8_STAGE(PG8_SB(0, 1), b2 + hstepB, voffB); PG8_STAGE(PG8_SA(0, 0), a2, voffA);
            PG8_WAIT_V(8); PG8_WAIT_L(0); PG8_BAR; PG8_MMA(1, 0, At, B0); PG8_MMA(1, 1, At, B1); PG8_BAR; PG8_SCHED;
            PG8_LDB(B0, 1, 0); PG8_LDB(B1, 1, 1); PG8_SCHED; PG8_LDA(At, 1, 0); PG8_STAGE(PG8_SA(0, 1), a2 + hstepA, voffA);
            PG8_WAIT_V(8); PG8_WAIT_L(0); PG8_BAR; PG8_MMA(0, 0, At, B0); PG8_MMA(0, 1, At, B1); PG8_BAR; PG8_SCHED;
            PG8_LDA(At, 1, 1); PG8_STAGE(PG8_SB(1, 0), b3, voffB); PG8_STAGE(PG8_SB(1, 1), b3 + hstepB, voffB); PG8_STAGE(PG8_SA(1, 0), a3, voffA);
            PG8_WAIT_V(8); PG8_WAIT_L(0); PG8_BAR; PG8_MMA(1, 0, At, B0); PG8_MMA(1, 1, At, B1); PG8_BAR; PG8_SCHED;
            } else {
            PG8_LDB(B0, 0, 0); PG8_SCHED; PG8_LDA(At, 0, 0); PG8_STAGE(PG8_SA(1, 1), a1 + hstepA, voffA);
            PG8_WAIT_L(8); PG8_BAR; PG8_WAIT_L(0); PG8_MMA(0, 0, At, B0); PG8_BAR; PG8_SCHED;
            PG8_LDB(B1, 0, 1); PG8_STAGE(PG8_SB(0, 0), b2, voffB);
            PG8_BAR; PG8_WAIT_L(0); PG8_MMA(0, 1, At, B1); PG8_BAR;
            PG8_LDA(At, 0, 1); PG8_STAGE(PG8_SA(0, 0), a2, voffA);
            PG8_BAR; PG8_WAIT_L(0); PG8_MMA(1, 0, At, B0); PG8_BAR; PG8_SCHED;
            PG8_STAGE(PG8_SB(0, 1), b2 + hstepB, voffB);
            PG8_WAIT_V(6); PG8_BAR; PG8_MMA(1, 1, At, B1); PG8_BAR;
            PG8_LDB(B0, 1, 0); PG8_SCHED; PG8_LDA(At, 1, 0); PG8_STAGE(PG8_SA(0, 1), a2 + hstepA, voffA);
            PG8_WAIT_L(8); PG8_BAR; PG8_WAIT_L(0); PG8_MMA(0, 0, At, B0); PG8_BAR; PG8_SCHED;
            PG8_LDB(B1, 1, 1); PG8_STAGE(PG8_SB(1, 0), b3, voffB);
            PG8_BAR; PG8_WAIT_L(0); PG8_MMA(0, 1, At, B1); PG8_BAR;
            PG8_LDA(At, 1, 1); PG8_STAGE(PG8_SA(1, 0), a3, voffA);
            PG8_BAR; PG8_WAIT_L(0); PG8_MMA(1, 0, At, B0); PG8_BAR; PG8_SCHED;
            PG8_STAGE(PG8_SB(1, 1), b3 + hstepB, voffB);
            PG8_WAIT_V(6); PG8_BAR; PG8_MMA(1, 1, At, B1); PG8_BAR;
            }
        }
        if constexpr (ALIGN_EPI) { if (wr == 0) PG8_BAR; }
        if constexpr (!Epi::AFTER_DRAIN) { E(acc, cur, wr, wc, fr, fq); S.done(cur); }
        if (!has_next) break;
#pragma unroll
        for (int a = 0; a < 2; ++a)
#pragma unroll
            for (int b = 0; b < 2; ++b)
#pragma unroll
                for (int m = 0; m < 4; ++m)
#pragma unroll
                    for (int n = 0; n < 2; ++n) acc[a][b][m][n] = (f32x4){0.f, 0.f, 0.f, 0.f};
        cur = nxt; cA = nA; cB = nB; ++ui;
        if constexpr (ALIGN_EPI) { if (wr == 1) PG8_BAR; }
    }
    PG8_WAIT_V(0);
    if constexpr (!ALIGN_EPI) { if (wr == 0) PG8_BAR; }
    PG8_BAR;
    if constexpr (Epi::AFTER_DRAIN) { E.fused(acc, cur, wr, wc, fr, fq, lds, wid, lane); S.done(cur); }
#undef PG8_SA
#undef PG8_SB
#undef PG8_STAGE
#undef PG8_LDA
#undef PG8_LDB
#undef PG8_MMA
#undef PG8_WAIT_V
#undef PG8_WAIT_L
#undef PG8_BAR
#undef PG8_SCHED
}
}

namespace att {
typedef unsigned short bf16_t;
using bf16x8 = __attribute__((ext_vector_type(8))) short;
using s16x4  = __attribute__((ext_vector_type(4))) short;
using f32x16 = __attribute__((ext_vector_type(16))) float;
using u32x4  = __attribute__((ext_vector_type(4))) unsigned;
constexpr int NW = 8, QBLK = 32, KVBLK = 64;
constexpr float SCALE = 0.10206207261596575f;
constexpr float THR = 8.f;
constexpr int LDQ = 768, LDKN = 512, LDKR = 32, LDV = 512, LDO = 1024;
constexpr int SHM_V = 64 * 128 * 2, SHM_K = 64 * 128 * 2;
#define KSWZ(row, colB) ((row) * 256 + ((colB) ^ (((row) & 7) << 4)))
#define SBAR() __builtin_amdgcn_sched_barrier(0)
__device__ __forceinline__ int crow(int r, int hi) { return (r & 3) + 8 * (r >> 2) + 4 * hi; }
__device__ __forceinline__ unsigned cvtpk(float lo, float hi) { unsigned r; asm volatile("v_cvt_pk_bf16_f32 %0, %1, %2" : "=v"(r) : "v"(lo), "v"(hi)); return r; }
template <bool FIRST> __device__ __forceinline__ void partialSM(f32x16& p0, f32x16& p1, float& m_ref, f32x16& negm, float& alpha) {
  constexpr float THR2 = THR * 1.4426950408889634f;
  float pmax = p0[0];
#pragma unroll
  for (int r = 1; r < 16; ++r) pmax = fmaxf(pmax, p0[r]);
#pragma unroll
  for (int r = 0; r < 16; ++r) pmax = fmaxf(pmax, p1[r]);
  { auto rr = __builtin_amdgcn_permlane32_swap(__float_as_uint(pmax), __float_as_uint(pmax), false, false);
    pmax = fmaxf(__uint_as_float(rr[0]), __uint_as_float(rr[1])); }
  alpha = 1.f;
  if (FIRST || !__builtin_expect(__all(pmax <= THR2), 1)) {
    const float dl = FIRST ? pmax : fmaxf(pmax, 0.f);
    m_ref += dl; alpha = FIRST ? 1.f : __builtin_amdgcn_exp2f(-dl);
#pragma unroll
    for (int r = 0; r < 16; ++r) { p0[r] -= dl; p1[r] -= dl; }
#pragma unroll
    for (int r = 0; r < 16; ++r) negm[r] = -m_ref;
    asm volatile("" : "+v"(negm));
  }
#pragma unroll
  for (int r = 0; r < 16; ++r) p0[r] = __builtin_amdgcn_exp2f(p0[r]);
}
__device__ __forceinline__ void finishSM(f32x16& p0, f32x16& p1, bf16x8& pa0, bf16x8& pa1, bf16x8& pa2, bf16x8& pa3) {
#pragma unroll
  for (int r = 0; r < 16; ++r) p1[r] = __builtin_amdgcn_exp2f(p1[r]);
#define PK4(P, BASE, OUT) do { unsigned a0 = cvtpk(P[BASE + 0], P[BASE + 1]), a1 = cvtpk(P[BASE + 2], P[BASE + 3]);   \
    unsigned b0 = cvtpk(P[BASE + 4], P[BASE + 5]), b1 = cvtpk(P[BASE + 6], P[BASE + 7]);                              \
    auto r0 = __builtin_amdgcn_permlane32_swap(a0, b0, false, false); auto r1 = __builtin_amdgcn_permlane32_swap(a1, b1, false, false); \
    u32x4 w = {r0[0], r1[0], r0[1], r1[1]}; OUT = *reinterpret_cast<bf16x8*>(&w); } while (0)
  PK4(p0, 0, pa0); PK4(p0, 8, pa1); PK4(p1, 0, pa2); PK4(p1, 8, pa3);
#undef PK4
}
__device__ __forceinline__ void qkt(f32x16& p0, f32x16& p1, const bf16_t* Ks, const bf16x8* qr, const f32x16& negm, int r32, int hi) {
#pragma unroll
  for (int d0 = 0; d0 < 6; ++d0) { int cb = (d0 * 16 + hi * 8) * 2;
    bf16x8 b0 = *reinterpret_cast<const bf16x8*>((const char*)Ks + KSWZ(r32, cb));
    bf16x8 b1 = *reinterpret_cast<const bf16x8*>((const char*)Ks + KSWZ(32 + r32, cb));
    if (d0 == 0) { p0 = __builtin_amdgcn_mfma_f32_32x32x16_bf16(b0, qr[0], negm, 0, 0, 0); p1 = __builtin_amdgcn_mfma_f32_32x32x16_bf16(b1, qr[0], negm, 0, 0, 0); }
    else { p0 = __builtin_amdgcn_mfma_f32_32x32x16_bf16(b0, qr[d0], p0, 0, 0, 0); p1 = __builtin_amdgcn_mfma_f32_32x32x16_bf16(b1, qr[d0], p1, 0, 0, 0); } }
}
__device__ __forceinline__ int v_st(int k, int c) { const int kk = (k & ~0xC) | ((k & 4) << 1) | ((k & 8) >> 1); return ((kk >> 3) * 4 + (c >> 5)) * 512 + ((kk & 7) * 32 + (c & 31)) * 2; }
__device__ __forceinline__ int v_rd_base(int lane) { return ((lane & 3) << 3) | (((lane >> 2) & 3) << 6) | (((lane >> 4) & 1) << 5) | (((lane >> 5) & 1) << 8); }
constexpr int v_rd_off(int d0, int ks, int half) { return d0 * 512 + ks * 4096 + half * 2048; }
template <int OFF> __device__ __forceinline__ s16x4 tr_read(int vb) {
  s16x4 r; asm volatile("ds_read_b64_tr_b16 %0, %1 offset:%2" : "=&v"(r) : "v"(vb), "i"(OFF) : "memory"); return r;
}
template <int D0> __device__ __forceinline__ void pv_one(f32x16& od, int vb, bf16x8 pa0, bf16x8 pa1, bf16x8 pa2, bf16x8 pa3) {
  const s16x4 l0 = tr_read<v_rd_off(D0, 0, 0)>(vb), h0 = tr_read<v_rd_off(D0, 0, 1)>(vb), l1 = tr_read<v_rd_off(D0, 1, 0)>(vb), h1 = tr_read<v_rd_off(D0, 1, 1)>(vb);
  const s16x4 l2 = tr_read<v_rd_off(D0, 2, 0)>(vb), h2 = tr_read<v_rd_off(D0, 2, 1)>(vb), l3 = tr_read<v_rd_off(D0, 3, 0)>(vb), h3 = tr_read<v_rd_off(D0, 3, 1)>(vb);
  asm volatile("s_waitcnt lgkmcnt(0)" ::: "memory"); SBAR();
#define PK(L, H) (bf16x8){L[0], L[1], L[2], L[3], H[0], H[1], H[2], H[3]}
  od = __builtin_amdgcn_mfma_f32_32x32x16_bf16(pa0, PK(l0, h0), od, 0, 0, 0);
  od = __builtin_amdgcn_mfma_f32_32x32x16_bf16(pa1, PK(l1, h1), od, 0, 0, 0);
  od = __builtin_amdgcn_mfma_f32_32x32x16_bf16(pa2, PK(l2, h2), od, 0, 0, 0);
  od = __builtin_amdgcn_mfma_f32_32x32x16_bf16(pa3, PK(l3, h3), od, 0, 0, 0);
#undef PK
}
__device__ __forceinline__ void pv_d0(f32x16* o, f32x16& osum, int vb, bf16x8 pa0, bf16x8 pa1, bf16x8 pa2, bf16x8 pa3) {
  pv_one<0>(o[0], vb, pa0, pa1, pa2, pa3); pv_one<1>(o[1], vb, pa0, pa1, pa2, pa3);
  const short one = (short)0x3F80; const bf16x8 ones = {one, one, one, one, one, one, one, one};
  osum = __builtin_amdgcn_mfma_f32_32x32x16_bf16(pa0, ones, osum, 0, 0, 0); osum = __builtin_amdgcn_mfma_f32_32x32x16_bf16(pa1, ones, osum, 0, 0, 0);
  osum = __builtin_amdgcn_mfma_f32_32x32x16_bf16(pa2, ones, osum, 0, 0, 0); osum = __builtin_amdgcn_mfma_f32_32x32x16_bf16(pa3, ones, osum, 0, 0, 0);
}
__device__ __forceinline__ void attn_unit(const bf16_t* __restrict__ Qb, const bf16_t* __restrict__ KNh, const bf16_t* __restrict__ KRb, const bf16_t* __restrict__ Vh,
                                          bf16_t* __restrict__ Ob, int seq, int qrow0, const float* __restrict__ ropec, const float* __restrict__ ropes, char* lds) {
  int tid_ = threadIdx.x; asm volatile("" : "+v"(tid_)); const int tid = tid_, wid = __builtin_amdgcn_readfirstlane(tid >> 6), lane = tid & 63, r32 = lane & 31, hi = lane >> 5;
  bf16_t* V_lds = (bf16_t*)lds; bf16_t* K_lds = (bf16_t*)(lds + 3 * SHM_V);
  float* ws = (float*)(lds + 3 * SHM_V + 3 * SHM_K) + wid * 64; float* al_l = ws + 32;
  float m_ref = 0.f; f32x16 o[2] = {}; f32x16 osum = {}; f32x16 negm = {}; asm volatile("" : "+v"(negm)); bf16x8 qr[6];
  const int srow = tid >> 3, sch = tid & 7, srow2 = tid >> 2, sch2 = tid & 3;
  const bf16_t* kp = KNh + (long)srow * LDKN + 8 * sch; const bf16_t* vp = Vh + (long)srow * LDV + 8 * sch; const bf16_t* rp = KRb + (long)(srow2 & 63) * LDKR + 8 * sch2;
  const int kst = KSWZ(srow, 16 * sch), vst = v_st(srow, 8 * sch), rst = KSWZ(srow2 & 63, 128 + 16 * sch2);
  const bool has_r = wid < 4;
  constexpr int BUF = SHM_V;
  const int vb0 = (int)(uintptr_t)V_lds + v_rd_base(lane);
  struct { bf16x8 v, k, r; } sr_[2];
#define SLOAD(i, k0) do { sr_[i].v = *reinterpret_cast<const bf16x8*>(vp + (long)(k0) * LDV); sr_[i].k = *reinterpret_cast<const bf16x8*>(kp + (long)(k0) * LDKN); \
    if (has_r) sr_[i].r = *reinterpret_cast<const bf16x8*>(rp + (long)(k0) * LDKR); } while (0)
#define SWRITE(off, i) do { *(bf16x8*)((char*)V_lds + (off) + vst) = sr_[i].v; *(bf16x8*)((char*)K_lds + (off) + kst) = sr_[i].k; \
    if (has_r) *(bf16x8*)((char*)K_lds + (off) + rst) = sr_[i].r; } while (0)
#define SWAIT() do { if (has_r) asm volatile("s_waitcnt vmcnt(3)" ::: "memory"); else asm volatile("s_waitcnt vmcnt(2)" ::: "memory"); } while (0)
  constexpr int SE = 0, SO = 1;
  const int NT = seq / KVBLK;
  SLOAD(SE, 0); SLOAD(SO, KVBLK);
  const bf16_t* Qw = Qb + (long)(wid * QBLK + r32) * LDQ + hi * 8;
#pragma unroll
  for (int d0 = 0; d0 < 6; ++d0) qr[d0] = *reinterpret_cast<const bf16x8*>(Qw + d0 * 16);
  {
    const int pos = row_pos(qrow0 + wid * QBLK + r32); const float* cp = ropec + pos * 16 + 8 * hi; const float* sp = ropes + pos * 16 + 8 * hi;
    unsigned w1[4], w2[4];
#pragma unroll
    for (int e = 0; e < 8; e += 2) { float o1[2], o2[2];
#pragma unroll
      for (int f = 0; f < 2; ++f) { const float x1 = __uint_as_float(((unsigned)(unsigned short)qr[4][e + f]) << 16), x2 = __uint_as_float(((unsigned)(unsigned short)qr[5][e + f]) << 16); const float c = cp[e + f], s = sp[e + f];
        o1[f] = x1 * c - x2 * s; o2[f] = x1 * s + x2 * c; }
      w1[e >> 1] = cvtpk(o1[0], o1[1]); w2[e >> 1] = cvtpk(o2[0], o2[1]); }
    u32x4 v1 = {w1[0], w1[1], w1[2], w1[3]}, v2 = {w2[0], w2[1], w2[2], w2[3]}; qr[4] = *reinterpret_cast<bf16x8*>(&v1); qr[5] = *reinterpret_cast<bf16x8*>(&v2); }
#define RESC(a) do { if (__any((a) < 1.f)) { if (hi == 0) al_l[r32] = (a); asm volatile("s_waitcnt lgkmcnt(0)" ::: "memory"); \
    _Pragma("unroll") for (int r = 0; r < 16; ++r) { const float f_ = al_l[crow(r, hi)]; o[0][r] *= f_; o[1][r] *= f_; osum[r] *= f_; } } } while (0)
#define ROT() do { const int t_ = o_prev; o_prev = o_cur; o_cur = o_next; o_next = t_; } while (0)
  f32x16 pA0, pA1, pB0, pB1; float alA, alB; bf16x8 pa0, pa1, pa2, pa3;
  int o_prev = 2 * BUF, o_cur = 0, o_next = BUF;
  asm volatile("s_waitcnt vmcnt(0)" ::: "memory"); SWRITE(0, SE); __syncthreads();
  qkt(pA0, pA1, K_lds, qr, negm, r32, hi); partialSM<true>(pA0, pA1, m_ref, negm, alA);
  if (2 < NT) SLOAD(SE, 2 * KVBLK);
  SWAIT(); SWRITE(BUF, SO); __syncthreads();
  ROT();
  for (int j = 1; j + 1 < NT; j += 2) {
    SBAR(); qkt(pB0, pB1, (bf16_t*)((char*)K_lds + o_cur), qr, negm, r32, hi);
    finishSM(pA0, pA1, pa0, pa1, pa2, pa3); SBAR();
    SLOAD(SO, (j + 2) * KVBLK); SBAR();
    pv_d0(o, osum, vb0 + o_prev, pa0, pa1, pa2, pa3); partialSM<false>(pB0, pB1, m_ref, negm, alB);
    SWAIT(); SWRITE(o_next, SE);
    RESC(alB); __syncthreads(); ROT();
    SBAR(); qkt(pA0, pA1, (bf16_t*)((char*)K_lds + o_cur), qr, negm, r32, hi);
    finishSM(pB0, pB1, pa0, pa1, pa2, pa3); SBAR();
    if (j + 3 < NT) SLOAD(SE, (j + 3) * KVBLK); SBAR();
    pv_d0(o, osum, vb0 + o_prev, pa0, pa1, pa2, pa3); partialSM<false>(pA0, pA1, m_ref, negm, alA);
    SWAIT(); SWRITE(o_next, SO);
    RESC(alA); __syncthreads(); ROT();
  }
  SBAR(); qkt(pB0, pB1, (bf16_t*)((char*)K_lds + o_cur), qr, negm, r32, hi);
  finishSM(pA0, pA1, pa0, pa1, pa2, pa3); SBAR();
  pv_d0(o, osum, vb0 + o_prev, pa0, pa1, pa2, pa3); partialSM<false>(pB0, pB1, m_ref, negm, alB);
  RESC(alB);
  finishSM(pB0, pB1, pa0, pa1, pa2, pa3); SBAR();
  pv_d0(o, osum, vb0 + o_cur, pa0, pa1, pa2, pa3);
  float rli[16];
#pragma unroll
  for (int r = 0; r < 16; ++r) rli[r] = __builtin_amdgcn_rcpf(osum[r]);
  bf16_t* Ow = Ob + (long)(wid * QBLK) * LDO;
#pragma unroll
  for (int r = 0; r < 16; ++r) { int orow = crow(r, hi);
#pragma unroll
    for (int d0 = 0; d0 < 2; ++d0) { const unsigned w = cvtpk(o[d0][r] * rli[r], 0.f); Ow[(long)orow * LDO + d0 * 32 + r32] = (bf16_t)(w & 0xffffu); } }
  __syncthreads();
#undef SLOAD
#undef SWRITE
#undef SWAIT
#undef RESC
#undef ROT
}
#undef KSWZ
#undef SBAR
}
namespace hg {
typedef unsigned short bf16_t;
using bf16x8 = __attribute__((ext_vector_type(8))) short;
using f32x16 = __attribute__((ext_vector_type(16))) float;
using f32x4  = __attribute__((ext_vector_type(4))) float;
using u32x4  = __attribute__((ext_vector_type(4))) unsigned;
#define SWZ256(row, colB) ((row) * 256 + ((colB) ^ (((row) & 7) << 4)))
#define SWZ128(row, colB) ((row) * 128 + ((colB) ^ (((((row) >> 4) ^ (row)) & 7) << 4)))
constexpr int GS = 132;
constexpr int L_ST = 0, L_QH = 32768, L_KH = 49152, L_KT = 65536, L_VT = 81920, L_GB = 98304, L_SEG = 98304 + 64 * GS * 4, L_DD = L_SEG + 2048, L_LB = L_DD + 512;
__device__ __forceinline__ int crow(int r, int hi) { return (r & 3) + 8 * (r >> 2) + 4 * hi; }
__device__ __forceinline__ unsigned cvtpk(float lo, float hi) { unsigned r; asm volatile("v_cvt_pk_bf16_f32 %0, %1, %2" : "=v"(r) : "v"(lo), "v"(hi)); return r; }
__device__ __forceinline__ float bf2f(unsigned short h) { return __uint_as_float(((unsigned)h) << 16); }
template <int MODE> __device__ __forceinline__ void chain(const bf16_t* __restrict__ U, float* __restrict__ OP, const float* __restrict__ hg_lb, int rowbase, int S, int h, int dir, int tau0, int nchunk,
                                                   const float* __restrict__ slot_in, float* __restrict__ slot_out, float* __restrict__ dseg_out, char* lds) {
  int tid_ = threadIdx.x; asm volatile("" : "+v"(tid_)); const int tid = tid_, wid = __builtin_amdgcn_readfirstlane(tid >> 6), lane = tid & 63, r32 = lane & 31, hi = lane >> 5;
  float* GB = (float*)(lds + L_GB); float* SEG = (float*)(lds + L_SEG); float* DD = (float*)(lds + L_DD); float* LB = (float*)(lds + L_LB);
  char* ST = lds + L_ST; char* QH = lds + L_QH; char* KH = lds + L_KH; char* KT = lds + L_KT; char* VT = lds + L_VT; char* AL = lds + L_GB;
  if (tid < 128) { const float a0 = hg_lb[dir * 1024 + h * 128 + tid], a1 = hg_lb[dir * 1024 + 512 + h * 128 + tid]; LB[tid] = 1.0f / (1.0f + __expf(a1 - a0)); }
  f32x16 sacc[2]; sacc[0] = f32x16{}; sacc[1] = f32x16{};
  if (MODE == 3) {
    if (slot_in) {
#pragma unroll
      for (int i = 0; i < 2; ++i)
#pragma unroll
        for (int r = 0; r < 16; ++r) sacc[i][r] = slot_in[(32 * (wid & 3) + crow(r, hi)) * 128 + 32 * (2 * (wid >> 2) + i) + r32];
    }
#pragma unroll
    for (int i = 0; i < 2; ++i)
#pragma unroll
      for (int r = 0; r < 16; ++r) *(bf16_t*)(ST + SWZ256(32 * (wid & 3) + crow(r, hi), 2 * (32 * (2 * (wid >> 2) + i) + r32))) = (bf16_t)(cvtpk(sacc[i][r], 0.f) & 0xffffu);
  }
  float dseg = 1.0f;
  const int tau = tid >> 3, c0 = (tid & 7) * 16, segt = tau >> 4;
  const bf16_t* Ub = U + (size_t)rowbase * 2560 + h * 128 + c0;
  const size_t offq = 0, offv = 512, offf = (size_t)(2 + dir) * 512;
  float* OPd = OP + (size_t)dir * T_ALL * 512;
  bf16x8 nq0 = {}, nq1 = {}, nv0, nv1, nf0, nf1;
  { const int t1 = tau0 + tau; const int tok = dir ? (S - 1 - t1) : t1; const bf16_t* p = Ub + (size_t)tok * 2560;
    if (MODE == 3) { nq0 = *(const bf16x8*)(p + offq); nq1 = *(const bf16x8*)(p + offq + 8); } nv0 = *(const bf16x8*)(p + offv); nv1 = *(const bf16x8*)(p + offv + 8); nf0 = *(const bf16x8*)(p + offf); nf1 = *(const bf16x8*)(p + offf + 8); }
  __syncthreads();
  for (int ci = 0; ci < nchunk; ++ci) {
    const bf16x8 qv[2] = {nq0, nq1}, vv[2] = {nv0, nv1}, fv[2] = {nf0, nf1};
    { const int cn = (ci + 1 < nchunk) ? ci + 1 : ci; const int t2 = tau0 + cn * 64 + tau; const int tok = dir ? (S - 1 - t2) : t2; const bf16_t* p = Ub + (size_t)tok * 2560;
      if (MODE == 3) { nq0 = *(const bf16x8*)(p + offq); nq1 = *(const bf16x8*)(p + offq + 8); } nv0 = *(const bf16x8*)(p + offv); nv1 = *(const bf16x8*)(p + offv + 8); nf0 = *(const bf16x8*)(p + offf); nf1 = *(const bf16x8*)(p + offf + 8); }
    float qq[16], kk[16];
#pragma unroll
    for (int j = 0; j < 16; ++j) {
      const float z = bf2f((unsigned short)fv[j >> 3][j & 7]); const float x = bf2f((unsigned short)qv[j >> 3][j & 7]);
      const float lbv = LB[c0 + j]; const float sg = __builtin_amdgcn_rcpf(1.0f + __builtin_amdgcn_exp2f(-1.4426950408889634f * z)); const float f = lbv + (1.0f - lbv) * sg;
      kk[j] = 1.0f - f; qq[j] = (MODE == 3) ? x * __builtin_amdgcn_rcpf(1.0f + __builtin_amdgcn_exp2f(-1.4426950408889634f * x)) : 0.f;
      GB[tau * GS + c0 + j] = __builtin_amdgcn_logf(f);
    }
    __syncthreads();
    { const int k = tid & 127, seg = tid >> 7; float run = 0.f;
#pragma unroll
      for (int j = 0; j < 16; ++j) { run += GB[(16 * seg + j) * GS + k]; GB[(16 * seg + j) * GS + k] = run; }
      SEG[seg * 128 + k] = run; }
    __syncthreads();
    { unsigned qh[8] = {}, kh[8] = {};
#pragma unroll
      for (int j = 0; j < 16; j += 2) {
        float g2[2], gl2[2];
#pragma unroll
        for (int e = 0; e < 2; ++e) { const int col = c0 + j + e; const float s0 = SEG[col], s1 = SEG[128 + col], s2 = SEG[256 + col];
          const float off = (segt >= 1 ? s0 : 0.f) + (segt >= 2 ? s1 : 0.f) + (segt >= 3 ? s2 : 0.f);
          g2[e] = GB[tau * GS + col] + off; gl2[e] = GB[63 * GS + col] + ((s0 + s1) + s2); }
        if (MODE == 3) { const float ea = __builtin_amdgcn_exp2f(g2[0]), eb = __builtin_amdgcn_exp2f(g2[1]);
          qh[j >> 1] = cvtpk(qq[j] * ea, qq[j + 1] * eb);
          kh[j >> 1] = cvtpk(kk[j] * __builtin_amdgcn_exp2f(fminf(-g2[0], 115.f)), kk[j + 1] * __builtin_amdgcn_exp2f(fminf(-g2[1], 115.f))); }
        const unsigned kt = cvtpk(kk[j] * __builtin_amdgcn_exp2f(gl2[0] - g2[0]), kk[j + 1] * __builtin_amdgcn_exp2f(gl2[1] - g2[1]));
        *(bf16_t*)(KT + SWZ128(c0 + j, 2 * tau)) = (bf16_t)(kt & 0xffffu); *(bf16_t*)(KT + SWZ128(c0 + j + 1, 2 * tau)) = (bf16_t)(kt >> 16);
        *(bf16_t*)(VT + SWZ128(c0 + j, 2 * tau)) = (bf16_t)vv[j >> 3][j & 7]; *(bf16_t*)(VT + SWZ128(c0 + j + 1, 2 * tau)) = (bf16_t)vv[(j + 1) >> 3][(j + 1) & 7];
        if (tau == 63) { DD[c0 + j] = __builtin_amdgcn_exp2f(gl2[0]); DD[c0 + j + 1] = __builtin_amdgcn_exp2f(gl2[1]); }
      }
      if (MODE == 3) {
      *(u32x4*)(QH + SWZ256(tau, 2 * c0)) = (u32x4){qh[0], qh[1], qh[2], qh[3]}; *(u32x4*)(QH + SWZ256(tau, 2 * c0 + 16)) = (u32x4){qh[4], qh[5], qh[6], qh[7]};
      *(u32x4*)(KH + SWZ256(tau, 2 * c0)) = (u32x4){kh[0], kh[1], kh[2], kh[3]}; *(u32x4*)(KH + SWZ256(tau, 2 * c0 + 16)) = (u32x4){kh[4], kh[5], kh[6], kh[7]}; }
    }
    __syncthreads();
    if (MODE == 3 && wid < 4 && wid != 1) { const int ti = wid >> 1, si = wid & 1; f32x16 a = f32x16{};
#pragma unroll
      for (int k8 = 0; k8 < 8; ++k8) { const int cb = (16 * k8 + 8 * hi) * 2;
        const bf16x8 av = *(const bf16x8*)(QH + SWZ256(32 * ti + r32, cb)); const bf16x8 bv = *(const bf16x8*)(KH + SWZ256(32 * si + r32, cb));
        a = __builtin_amdgcn_mfma_f32_32x32x16_bf16(av, bv, a, 0, 0, 0); }
#pragma unroll
      for (int r = 0; r < 16; ++r) { const int tl = 32 * ti + crow(r, hi), sl = 32 * si + r32; const float val = (sl <= tl) ? a[r] : 0.f;
        *(bf16_t*)(AL + SWZ128(tl, 2 * sl)) = (bf16_t)(cvtpk(val, 0.f) & 0xffffu); } }
    if (MODE == 3) __syncthreads();
    { const int th = wid >> 2, vb = wid & 3;
      if (MODE == 3) { f32x16 o = f32x16{};
      const int nks = th ? 4 : 2;
      for (int ks = 0; ks < nks; ++ks) { const int cb = (16 * ks + 8 * hi) * 2;
        const bf16x8 av = *(const bf16x8*)(AL + SWZ128(32 * th + r32, cb)); const bf16x8 bv = *(const bf16x8*)(VT + SWZ128(32 * vb + r32, cb));
        o = __builtin_amdgcn_mfma_f32_32x32x16_bf16(av, bv, o, 0, 0, 0); }
#pragma unroll
      for (int k8 = 0; k8 < 8; ++k8) { const int cb = (16 * k8 + 8 * hi) * 2;
        const bf16x8 av = *(const bf16x8*)(QH + SWZ256(32 * th + r32, cb)); const bf16x8 bv = *(const bf16x8*)(ST + SWZ256(32 * vb + r32, cb));
        o = __builtin_amdgcn_mfma_f32_32x32x16_bf16(av, bv, o, 0, 0, 0); }
#pragma unroll
      for (int r = 0; r < 16; ++r) { const int t2 = tau0 + ci * 64 + 32 * th + crow(r, hi); const int tok = dir ? (S - 1 - t2) : t2;
        OPd[(size_t)(rowbase + tok) * 512 + h * 128 + 32 * vb + r32] = o[r]; }
      } else { if (tid < 128) dseg *= DD[tid]; }
#pragma unroll
      for (int i = 0; i < 2; ++i) { const int kb = 2 * th + i; const float dk = DD[32 * kb + r32];
#pragma unroll
        for (int r = 0; r < 16; ++r) sacc[i][r] *= dk;
#pragma unroll
        for (int ks = 0; ks < 4; ++ks) { const int cb = (16 * ks + 8 * hi) * 2;
          const bf16x8 av = *(const bf16x8*)(VT + SWZ128(32 * vb + r32, cb)); const bf16x8 bv = *(const bf16x8*)(KT + SWZ128(32 * kb + r32, cb));
          sacc[i] = __builtin_amdgcn_mfma_f32_32x32x16_bf16(av, bv, sacc[i], 0, 0, 0); } }
    }
    __syncthreads();
    if (MODE == 3) { const int th = wid >> 2, vb = wid & 3;
#pragma unroll
      for (int i = 0; i < 2; ++i) { const int kb = 2 * th + i;
#pragma unroll
        for (int r = 0; r < 16; ++r) *(bf16_t*)(ST + SWZ256(32 * vb + crow(r, hi), 2 * (32 * kb + r32))) = (bf16_t)(cvtpk(sacc[i][r], 0.f) & 0xffffu); } }
  }
  if (MODE == 1) {
#pragma unroll
    for (int i = 0; i < 2; ++i)
#pragma unroll
      for (int r = 0; r < 16; ++r) slot_out[(32 * (wid & 3) + crow(r, hi)) * 128 + 32 * (2 * (wid >> 2) + i) + r32] = sacc[i][r];
    if (tid < 128) dseg_out[tid] = dseg;
  }
  __syncthreads();
}
#undef SWZ256
#undef SWZ128
}
typedef unsigned short bf16_t;
typedef float f32x4 __attribute__((ext_vector_type(4)));
typedef unsigned u32x4 __attribute__((ext_vector_type(4)));
typedef unsigned u32x2 __attribute__((ext_vector_type(2)));
typedef short bf16x8 __attribute__((ext_vector_type(8)));
#define LAS __attribute__((address_space(3)))
constexpr size_t MiB = 1u << 20;
constexpr size_t WS_SS = 0;
constexpr size_t WS_ROPEC = 6 * MiB, WS_ROPES = 7 * MiB;
constexpr size_t WS_W1GU = 16 * MiB, WS_W1D = 27 * MiB, WS_WIN = 33 * MiB, WS_WUQ = 40 * MiB, WS_WUKV = 41 * MiB, WS_WO = 42 * MiB, WS_W2GU = 44 * MiB, WS_W2D = 55 * MiB, WS_WPG = 61 * MiB, WS_WPP = 63 * MiB;
constexpr size_t WS_HB = 64 * MiB;
constexpr size_t WS_BIG = 256 * MiB;
constexpr size_t WS_UHG = WS_BIG, WS_UMLA = WS_BIG + 480 * MiB, WS_MIX = WS_BIG + 480 * MiB, WS_ACT = WS_BIG, WS_PROJ = WS_BIG;
constexpr size_t WS_PB = 928 * MiB;
constexpr size_t WS_SLOT = 976 * MiB;
constexpr size_t WS_DSEG = 8 * MiB;
constexpr size_t WS_END = 1024 * MiB;
constexpr size_t DO_Q = 0, DO_KN = 144 * MiB, DO_V = 240 * MiB, DO_KR = 336 * MiB;
constexpr int LDS_BYTES = 147456;
constexpr int LDS_BARST = 147392;
constexpr size_t WS_BAR = 12 * MiB;
#define XB_TMO      128
#define XB_XCNT(j)  (256  + 64 * (j))
#define XB_XSUB(j)  (1280 + 64 * (j))
#define XB_XGEN(j)  (2304 + 64 * (j))
#define XB_TOP      3328
#define XB_TOPGEN   3392
#define XCD_BAR_WORDS 3456
#define XB_SPIN_CAP (1u << 18)

__device__ __forceinline__ unsigned xb_ld(unsigned* p)              { return __hip_atomic_load(p, __ATOMIC_RELAXED, __HIP_MEMORY_SCOPE_AGENT); }
__device__ __forceinline__ unsigned xb_add(unsigned* p, unsigned v) { return __hip_atomic_fetch_add(p, v, __ATOMIC_RELAXED, __HIP_MEMORY_SCOPE_AGENT); }
__device__ __forceinline__ unsigned xb_xcc_id() { return (unsigned)__builtin_amdgcn_s_getreg((3 << 11) | 20) & 0xFu; }
#define XB_SPIN(cond, bar) do { unsigned _sp = 0; while (cond) { __builtin_amdgcn_s_sleep(1); \
    if ((++_sp & 255u) == 0u) { if (xb_ld(&(bar)[XB_TMO])) break; if (_sp > XB_SPIN_CAP) { atomicAdd(&(bar)[XB_TMO], 1u); break; } } } } while (0)

struct XcdBarrier {
    unsigned* bar; unsigned x;
    volatile LAS unsigned* st;
};

__device__ __forceinline__ XcdBarrier xcd_barrier_post(unsigned* bar, volatile LAS unsigned* st) {
    XcdBarrier b; b.bar = bar; b.x = xb_xcc_id(); b.st = st;
    if (threadIdx.x == 0) (void)xb_add(&bar[XB_XCNT(b.x)], 1u);
    return b;
}
__device__ __forceinline__ void xcd_barrier_complete(unsigned* bar, unsigned x, unsigned& nloc, unsigned& nx) {
    const unsigned G = gridDim.x * gridDim.y * gridDim.z;
    unsigned sum, cnt, mine, sp = 0u;
    for (;;) {
        sum = 0u; cnt = 0u; mine = 0u;
#pragma unroll
        for (unsigned j = 0; j < 16; ++j) { const unsigned c = xb_ld(&bar[XB_XCNT(j)]); sum += c; cnt += (c > 0u) ? 1u : 0u; mine = (j == x) ? c : mine; }
        if (sum == G) break;
        __builtin_amdgcn_s_sleep(1);
        if ((++sp & 255u) == 0u) { if (xb_ld(&bar[XB_TMO])) break; if (sp > XB_SPIN_CAP) { atomicAdd(&bar[XB_TMO], 1u); break; } }
    }
    nloc = mine > 0u ? mine : 1u; nx = cnt > 0u ? cnt : 1u;
}

__device__ __forceinline__ void xcd_barrier(const XcdBarrier& b) {
    asm volatile("s_waitcnt vmcnt(0)" ::: "memory");
    __syncthreads();
    if (threadIdx.x == 0) {
        unsigned* bar = b.bar;
        __builtin_amdgcn_s_waitcnt(0);
        unsigned nloc = b.st[0], nx = b.st[1];
        if (nloc == 0u) { xcd_barrier_complete(bar, b.x, nloc, nx); b.st[0] = nloc; b.st[1] = nx; }
        const unsigned old = xb_add(&bar[XB_XSUB(b.x)], 1u);
        const unsigned gen = old / nloc;
        if (old + 1u == (gen + 1u) * nloc) {
            __builtin_amdgcn_fence(__ATOMIC_RELEASE, "agent");
            asm volatile("s_waitcnt vmcnt(0)" ::: "memory");
            const unsigned og = xb_add(&bar[XB_TOP], 1u);
            const unsigned tg = og / nx;
            if (og + 1u == (tg + 1u) * nx) xb_add(&bar[XB_TOPGEN], 1u);
            else XB_SPIN(xb_ld(&bar[XB_TOPGEN]) == tg, bar);
            __builtin_amdgcn_fence(__ATOMIC_ACQUIRE, "agent");
            xb_add(&bar[XB_XGEN(b.x)], 1u);
            asm volatile("s_waitcnt vmcnt(0)" ::: "memory");
        } else {
            XB_SPIN(xb_ld(&bar[XB_XGEN(b.x)]) == gen, bar);
            __builtin_amdgcn_fence(__ATOMIC_ACQUIRE, "agent");
            asm volatile("s_waitcnt vmcnt(0)" ::: "memory");
        }
    }
    __syncthreads();
}


struct Params {
  const float* in[26];
  float* out; unsigned char* ws;
};

__device__ __forceinline__ unsigned f2bf(float f) { unsigned u = __builtin_bit_cast(unsigned, f); return (u + 0x7fffu + ((u >> 16) & 1u)) >> 16; }
__device__ __forceinline__ unsigned pk2(float lo, float hi) { return f2bf(lo) | (f2bf(hi) << 16); }
__device__ __forceinline__ float wave_sum(float v) {
#pragma unroll
  for (int o = 1; o < 64; o <<= 1) v += __shfl_xor(v, o);
  return v;
}
__device__ __forceinline__ void prep_item(const float* W, int ld, int col0, const float* fold, bf16_t* WT, int K, int n0, int k0, float* scr, int lane, bool perm) {
#pragma unroll 16
  for (int i = 0; i < 32; ++i) { const int kk = 2 * i + (lane >> 5); float v = 0.f; if (W) { const int p_ = lane & 31; const int cc = perm ? (16 * ((p_ >> 2) & 1) + 4 * (p_ >> 3) + (p_ & 3)) : p_; v = W[(size_t)(k0 + kk) * ld + col0 + cc]; if (fold) v *= fold[k0 + kk]; } scr[kk * 33 + (lane & 31)] = v; }
  asm volatile("s_waitcnt lgkmcnt(0)" ::: "memory");
  const int c = lane & 7;
#pragma unroll
  for (int j = 0; j < 4; ++j) { const int n = (lane >> 3) + 8 * j; const float* s = scr + (8 * c) * 33 + n;
    u32x4 o; o.x = pk2(s[0 * 33], s[1 * 33]); o.y = pk2(s[2 * 33], s[3 * 33]); o.z = pk2(s[4 * 33], s[5 * 33]); o.w = pk2(s[6 * 33], s[7 * 33]);
    *(u32x4*)(WT + (size_t)(n0 + n) * K + k0 + 8 * c) = o; }
  asm volatile("s_waitcnt lgkmcnt(0)" ::: "memory");
}
__device__ __forceinline__ void sincos_d(double x, float& s, float& c) {
  const double TWO_PI = 6.283185307179586476925286766559, INV_2PI = 0.15915494309189533576888376337251;
  double k = __builtin_rint(x * INV_2PI); double r = x - k * TWO_PI;
  const double HALF_PI = 1.5707963267948966192313216916398;
  double q = __builtin_rint(r * 0.63661977236758134308); double y = r - q * HALF_PI; int qi = ((int)q) & 3;
  double y2 = y * y;
  double sp = y * (1.0 + y2 * (-1.0 / 6 + y2 * (1.0 / 120 + y2 * (-1.0 / 5040 + y2 * (1.0 / 362880 + y2 * (-1.0 / 39916800 + y2 * (1.0 / 6227020800.0)))))));
  double cp = 1.0 + y2 * (-0.5 + y2 * (1.0 / 24 + y2 * (-1.0 / 720 + y2 * (1.0 / 40320 + y2 * (-1.0 / 3628800 + y2 * (1.0 / 479001600.0 + y2 * (-1.0 / 87178291200.0)))))));
  double ss, cc;
  if (qi == 0) { ss = sp; cc = cp; } else if (qi == 1) { ss = cp; cc = -sp; } else if (qi == 2) { ss = -sp; cc = -cp; } else { ss = -cp; cc = sp; }
  s = (float)ss; c = (float)cc;
}

__device__ __forceinline__ void p0_prologue(const Params& P, unsigned char* ws, char* lds) {
  int tid_ = threadIdx.x; asm volatile("" : "+v"(tid_)); const int tid = tid_, lane = tid & 63, wave = tid >> 6;
  const int gw = blockIdx.x * 8 + wave, NGW = gridDim.x * 8;
  float* scr = (float*)(lds + wave * 16384);
  constexpr int NJ = 10;
  const int jN[NJ] = {NGU, 1024, NIN, 768, 1024, 1024, NGU, 1024, 1024, 1024};
  const int jK[NJ] = {1024, DFF, 1024, 384, 256, 1024, 1024, DFF, 1024, 256};
  int total = 0;
#pragma unroll
  for (int j = 0; j < NJ; ++j) total += (jN[j] / 32) * (jK[j] / 64);
  const int gwp = blockIdx.x * 4 + (wave & 3), NGWP = gridDim.x * 4;
  if (wave < 4)
  for (int it = gwp; it < total; it += NGWP) {
    int r = it, job = 0;
#pragma unroll
    for (int j = 0; j < NJ; ++j) { const int cnt = (jN[j] / 32) * (jK[j] / 64); if (job == j && r >= cnt) { r -= cnt; job = j + 1; } }
    int N = 0, K = 0;
#pragma unroll
    for (int j = 0; j < NJ; ++j) if (job == j) { N = jN[j]; K = jK[j]; }
    const int nblk = N / 32, kb = r / nblk, nb = r % nblk, k0 = 64 * kb, n0 = 32 * nb;
    const float* W = nullptr; int ld = 0, col0 = 0; const float* fold = nullptr; bf16_t* WT = nullptr;
    if (job == 0 || job == 6) { const int t = n0 >> 8, half = (n0 >> 7) & 1, j0 = n0 & 127; const int b = (job == 0) ? 5 : 19;
      W = P.in[b + half]; ld = DFF; col0 = 128 * t + j0; fold = P.in[(job == 0) ? 4 : 18]; WT = (bf16_t*)(ws + ((job == 0) ? WS_W1GU : WS_W2GU)); }
    else if (job == 1 || job == 7) { W = P.in[(job == 1) ? 7 : 21]; ld = 1024; col0 = n0; WT = (bf16_t*)(ws + ((job == 1) ? WS_W1D : WS_W2D)); }
    else if (job == 2) { ld = 3232; fold = P.in[8]; WT = (bf16_t*)(ws + WS_WIN); W = P.in[9];
      if (n0 < 384) col0 = n0; else if (n0 < 416) col0 = 640 + (n0 - 384); else if (n0 < 512) W = nullptr; else if (n0 < 768) col0 = 384 + (n0 - 512); else col0 = 672 + (n0 - 768); }
    else if (job == 3) { W = P.in[11]; ld = 768; col0 = n0; fold = P.in[10]; WT = (bf16_t*)(ws + WS_WUQ); }
    else if (job == 4) { if (n0 < 512) { W = P.in[13]; col0 = n0; } else { W = P.in[14]; col0 = n0 - 512; } ld = 512; fold = P.in[12]; WT = (bf16_t*)(ws + WS_WUKV); }
    else if (job == 5) { W = P.in[17]; ld = 1024; col0 = n0; WT = (bf16_t*)(ws + WS_WO); }
    else if (job == 8) { W = P.in[23]; ld = 1024; col0 = n0; fold = P.in[22]; WT = (bf16_t*)(ws + WS_WPG); }
    else { W = P.in[24]; ld = 1024; col0 = n0; WT = (bf16_t*)(ws + WS_WPP); }
    prep_item(W, ld, col0, fold, WT, K, n0, k0, scr, lane, job == 2 && n0 == 384);
  }
  unsigned* ss = (unsigned*)(ws + WS_SS); bf16_t* HB = (bf16_t*)(ws + WS_HB); bf16_t* PB = (bf16_t*)(ws + WS_PB);
  if (wave >= 4)
  for (int m0 = gwp; m0 < T_ALL; m0 += 2 * NGWP) {
    f32x4 v[2][4], pv[2]; bool ok[2];
#pragma unroll
    for (int q = 0; q < 2; ++q) { const int m = m0 + q * NGWP; ok[q] = m < T_ALL; const int mm = ok[q] ? m : m0;
      const float* xr = (mm < T_P) ? P.in[0] + (size_t)mm * DM : P.in[1] + (size_t)(mm - T_P) * DM; const f32x4* x4 = (const f32x4*)xr + lane;
#pragma unroll
      for (int j = 0; j < 4; ++j) v[q][j] = x4[64 * j];
      const float* pr = (mm < T_P) ? P.in[2] + (size_t)mm * PLE : P.in[3] + (size_t)(mm - T_P) * PLE; pv[q] = ((const f32x4*)pr)[lane]; }
#pragma unroll
    for (int q = 0; q < 2; ++q) { const int m = m0 + q * NGWP; if (!ok[q]) continue; float s = 0.f;
#pragma unroll
      for (int j = 0; j < 4; ++j) s += (v[q][j][0] * v[q][j][0] + v[q][j][1] * v[q][j][1]) + (v[q][j][2] * v[q][j][2] + v[q][j][3] * v[q][j][3]);
      s = wave_sum(s);
      u32x2* o8 = (u32x2*)(HB + (size_t)m * DM) + lane;
#pragma unroll
      for (int j = 0; j < 4; ++j) { u32x2 w; w.x = pk2(v[q][j][0], v[q][j][1]); w.y = pk2(v[q][j][2], v[q][j][3]); o8[64 * j] = w; }
      u32x2 w; w.x = pk2(pv[q][0], pv[q][1]); w.y = pk2(pv[q][2], pv[q][3]); ((u32x2*)(PB + (size_t)m * PLE))[lane] = w;
      if (lane < 7) ss[(size_t)lane * T_ALL + m] = (lane == 0) ? (unsigned)(s * 4096.0f + 0.5f) : 0u; }
  }
  float* rc = (float*)(ws + WS_ROPEC); float* rs = (float*)(ws + WS_ROPES);
  for (int e = blockIdx.x * 512 + tid; e < S_P * 16; e += gridDim.x * 512) {
    const int pos = e >> 4, i = e & 15;
    const float cst = (float)(-9.210340371976184 / 32.0); const float arg = (float)(2 * i) * cst;
    const double a = (double)arg; const double nn = __builtin_rint(a * 1.4426950408889634); const double rr = a - nn * 0.69314718055994530942;
    double ex = 1.0 + rr * (1.0 + rr * (0.5 + rr * (1.0 / 6 + rr * (1.0 / 24 + rr * (1.0 / 120 + rr * (1.0 / 720 + rr * (1.0 / 5040 + rr * (1.0 / 40320 + rr * (1.0 / 362880 + rr * (1.0 / 3628800 + rr * (1.0 / 39916800)))))))))));
    ex = ex * __builtin_ldexp(1.0, (int)nn);
    const float invf = (float)ex; const float ang = (float)pos * invf;
    float sv, cv; sincos_d((double)ang, sv, cv); rc[e] = cv; rs[e] = sv;
  }
}
__device__ __forceinline__ void hg_combine(const float* OP, const bf16_t* U, const float* hg_norm, bf16_t* MIX) {
  int tid_ = threadIdx.x; asm volatile("" : "+v"(tid_)); const int lane = tid_ & 63, wave = tid_ >> 6; const int gw = blockIdx.x * 8 + wave, NGW = gridDim.x * 8;
  f32x4 gn0 = *(const f32x4*)(hg_norm + 8 * lane), gn1 = *(const f32x4*)(hg_norm + 8 * lane + 4);
  for (int m = gw; m < T_ALL; m += NGW) {
    const float* a = OP + (size_t)m * 512 + 8 * lane; const float* b = a + (size_t)T_ALL * 512;
    f32x4 o0 = *(const f32x4*)a + *(const f32x4*)b, o1 = *(const f32x4*)(a + 4) + *(const f32x4*)(b + 4);
    float s = (o0[0] * o0[0] + o0[1] * o0[1]) + (o0[2] * o0[2] + o0[3] * o0[3]) + (o1[0] * o1[0] + o1[1] * o1[1]) + (o1[2] * o1[2] + o1[3] * o1[3]);
    s += __shfl_xor(s, 1); s += __shfl_xor(s, 2); s += __shfl_xor(s, 4); s += __shfl_xor(s, 8);
    const float r = rsqrtf(s * (1.0f / 128.0f) + EPS);
    const bf16x8 g = *(const bf16x8*)(U + (size_t)m * 2560 + 2048 + 8 * lane);
    float ov[8] = {o0[0], o0[1], o0[2], o0[3], o1[0], o1[1], o1[2], o1[3]}; float gnv[8] = {gn0[0], gn0[1], gn0[2], gn0[3], gn1[0], gn1[1], gn1[2], gn1[3]};
    unsigned w[4];
#pragma unroll
    for (int j = 0; j < 8; j += 2) { float r2[2];
#pragma unroll
      for (int e = 0; e < 2; ++e) { const float x = __uint_as_float(((unsigned)(unsigned short)g[j + e]) << 16); const float sl = x * __builtin_amdgcn_rcpf(1.0f + __builtin_amdgcn_exp2f(-1.4426950408889634f * x)); r2[e] = ov[j + e] * r * gnv[j + e] * sl; }
      w[j >> 1] = pk2(r2[0], r2[1]); }
    *(u32x4*)(MIX + (size_t)m * 1024 + 512 + 8 * lane) = (u32x4){w[0], w[1], w[2], w[3]};
  }
}
__device__ __forceinline__ void final_norm(float* out, const bf16_t* h4, const unsigned* ss4, const float* fn) {
  int tid_ = threadIdx.x; asm volatile("" : "+v"(tid_)); const int lane = tid_ & 63, wave = tid_ >> 6; const int gw = blockIdx.x * 8 + wave, NGW = gridDim.x * 8;
  f32x4 g[2][2];
#pragma unroll
  for (int j = 0; j < 2; ++j) { g[j][0] = *(const f32x4*)(fn + 512 * j + 8 * lane); g[j][1] = *(const f32x4*)(fn + 512 * j + 8 * lane + 4); }
  for (int m0 = gw; m0 < T_ALL; m0 += 2 * NGW) {
    u32x4 h[2][2]; float r[2]; bool ok[2];
#pragma unroll
    for (int q = 0; q < 2; ++q) { const int m = m0 + q * NGW; ok[q] = m < T_ALL; const int mm = ok[q] ? m : m0; r[q] = (float)ss4[mm] * (1.0f / 4096.0f);
#pragma unroll
      for (int j = 0; j < 2; ++j) h[q][j] = *(const u32x4*)(h4 + (size_t)mm * DM + 512 * j + 8 * lane); }
#pragma unroll
    for (int q = 0; q < 2; ++q) { const int m = m0 + q * NGW; if (!ok[q]) continue; const float rr = rsqrtf(r[q] * (1.0f / 1024.0f) + EPS);
#pragma unroll
      for (int j = 0; j < 2; ++j) { const u32x4 hh = h[q][j];
        f32x4 a, b; a[0] = __uint_as_float(hh.x << 16); a[1] = __uint_as_float(hh.x & 0xffff0000u); a[2] = __uint_as_float(hh.y << 16); a[3] = __uint_as_float(hh.y & 0xffff0000u);
        b[0] = __uint_as_float(hh.z << 16); b[1] = __uint_as_float(hh.z & 0xffff0000u); b[2] = __uint_as_float(hh.w << 16); b[3] = __uint_as_float(hh.w & 0xffff0000u);
        float* o = out + (size_t)m * DM + 512 * j + 8 * lane; *(f32x4*)o = a * rr * g[j][0]; *(f32x4*)(o + 4) = b * rr * g[j][1]; } }
  }
}

#define GSYNC() xcd_barrier(xbar)

template <class Epi> __device__ __forceinline__ void run_gemm(LAS unsigned char* lds, const bf16_t* A, int lda, const bf16_t* Bt, int ldb, int N, int K, const Epi& E) {
  pg8::Gemm g{A, Bt, T_ALL, N, K, lda, ldb}; pg8::StaticOrder S; S.init(T_ALL, N, (int)gridDim.x, (int)blockIdx.x);
  pg8::gemm_phase<Epi, pg8::StaticOrder, true, true>(lds, g, S, E);
}

__global__ void __launch_bounds__(512, 2) mk_fwd(Params P) {
  extern __shared__ __attribute__((aligned(16))) unsigned char lds[];
  unsigned char* ws = P.ws; float* out = P.out; unsigned char* dob = (unsigned char*)P.out;
  LAS unsigned char* l3 = (LAS unsigned char*)lds;
  pg8::ss_t* ss = (pg8::ss_t*)(ws + WS_SS);
  pg8::ss_t* ss0 = ss, *ss1 = ss + T_ALL, *ss2 = ss + 2 * (size_t)T_ALL, *ss3 = ss + 3 * (size_t)T_ALL, *ss4 = ss + 4 * (size_t)T_ALL, *ssq = ss + 5 * (size_t)T_ALL, *sskv = ss + 6 * (size_t)T_ALL;
  const float* ropec = (const float*)(ws + WS_ROPEC); const float* ropes = (const float*)(ws + WS_ROPES);
  bf16_t* HB = (bf16_t*)(ws + WS_HB); bf16_t* ACT = (bf16_t*)(ws + WS_ACT); bf16_t* UHG = (bf16_t*)(ws + WS_UHG); bf16_t* UMLA = (bf16_t*)(ws + WS_UMLA);
  bf16_t* MIX = (bf16_t*)(ws + WS_MIX); bf16_t* H4B = (bf16_t*)(ws + WS_MIX);     bf16_t* PROJ = (bf16_t*)P.out;     bf16_t* PB = (bf16_t*)(ws + WS_PB);
  bf16_t* Qb = (bf16_t*)(dob + DO_Q); bf16_t* KN = (bf16_t*)(dob + DO_KN); bf16_t* Vb = (bf16_t*)(dob + DO_V); bf16_t* KR = (bf16_t*)(dob + DO_KR);

  if (threadIdx.x < 16) ((LAS unsigned*)(l3 + LDS_BARST))[threadIdx.x] = 0u;
  if (blockIdx.x == 0) { for (int i = threadIdx.x; i < XCD_BAR_WORDS; i += 512) __hip_atomic_store((unsigned*)(ws + WS_BAR) + i, 0u, __ATOMIC_RELAXED, __HIP_MEMORY_SCOPE_AGENT); }
  p0_prologue(P, ws, (char*)lds);
  cg::this_grid().sync();
  const XcdBarrier xbar = xcd_barrier_post((unsigned*)(ws + WS_BAR), (volatile LAS unsigned*)(l3 + LDS_BARST));
  { pg8::EpiSwiGLU E{ACT, ss0}; run_gemm(l3, HB, 1024, (const bf16_t*)(ws + WS_W1GU), 1024, NGU, 1024, E); }
  GSYNC();
  { pg8::EpiRes<2> E{nullptr, nullptr, HB, nullptr, ss1, nullptr, nullptr}; run_gemm(l3, ACT, DFF, (const bf16_t*)(ws + WS_W1D), DFF, 1024, DFF, E); }
  GSYNC();
  { pg8::EpiWin E{UMLA, UHG, KR, ss1, ssq, sskv, ropec, ropes}; run_gemm(l3, HB, 1024, (const bf16_t*)(ws + WS_WIN), 1024, NIN, 1024, E); }
  GSYNC();
  { pg8::EpiBf E{Qb, Qb, 768, 1000, ssq, 1.0f / 384.0f, att::SCALE * 1.4426950408889634f}; run_gemm(l3, UMLA, 768, (const bf16_t*)(ws + WS_WUQ), 384, 768, 384, E); }
  { pg8::EpiBf E{KN, Vb, 512, 2, sskv, 1.0f / 256.0f, 1.0f}; run_gemm(l3, UMLA + 512, 768, (const bf16_t*)(ws + WS_WUKV), 256, 1024, 256, E); }
  {
    float* SLOT = (float*)(ws + WS_SLOT); float* DSEG = (float*)(ws + WS_DSEG);
    for (int u = blockIdx.x; u < 768; u += gridDim.x) {
      int chainid, seg, nseg;
      if (u < 256) { chainid = u >> 4; seg = u & 15; nseg = 16; } else { const int u2 = u - 256; chainid = 16 + (u2 >> 2); seg = u2 & 3; nseg = 4; }
      if (seg == nseg - 1) continue;
      int rowbase, S, h, dir;
      if (chainid < 16) { const int b = chainid >> 3; h = (chainid >> 1) & 3; dir = chainid & 1; rowbase = b * S_P; S = S_P; }
      else { const int c2 = chainid - 16; const int b = c2 >> 3; h = (c2 >> 1) & 3; dir = c2 & 1; rowbase = T_P + b * S_S; S = S_S; }
      hg::chain<1>(UHG, out, P.in[15], rowbase, S, h, dir, seg * 1024, 16, nullptr, SLOT + (size_t)u * 16384, DSEG + (size_t)u * 128, (char*)lds);
    }
  }
  GSYNC();
  {
    float* SLOT = (float*)(ws + WS_SLOT); const float* DSEG = (const float*)(ws + WS_DSEG);
    int tid_ = threadIdx.x; asm volatile("" : "+v"(tid_));
    for (int e = blockIdx.x * 512 + tid_; e < 144 * 16384; e += gridDim.x * 512) {
      const int chainid = e >> 14, el = e & 16383, k = el & 127;
      int u0, nseg; if (chainid < 16) { u0 = chainid * 16; nseg = 16; } else { u0 = 256 + (chainid - 16) * 4; nseg = 4; }
      float Sv = 0.f;
      if (nseg == 16) { float slv[15], dv[15];
#pragma unroll
        for (int s = 0; s < 15; ++s) { slv[s] = SLOT[(size_t)(u0 + s) * 16384 + el]; dv[s] = DSEG[(size_t)(u0 + s) * 128 + k]; }
#pragma unroll
        for (int s = 0; s < 15; ++s) { Sv = dv[s] * Sv + slv[s]; SLOT[(size_t)(u0 + s) * 16384 + el] = Sv; } }
      else { float slv[3], dv[3];
#pragma unroll
        for (int s = 0; s < 3; ++s) { slv[s] = SLOT[(size_t)(u0 + s) * 16384 + el]; dv[s] = DSEG[(size_t)(u0 + s) * 128 + k]; }
#pragma unroll
        for (int s = 0; s < 3; ++s) { Sv = dv[s] * Sv + slv[s]; SLOT[(size_t)(u0 + s) * 16384 + el] = Sv; } }
    }
  }
  {
    const int G = gridDim.x, bx = blockIdx.x;
    if (G == 256) {
      const int xcd = bx & 7, idx = bx >> 3;
      for (int i = 0; i < 12; ++i) {
        int rowbase, seq, h, qb;
        if (i < 4) { const int pair = 2 * xcd + (i >> 1); const int b = pair >> 3; h = pair & 7; qb = idx * 2 + (i & 1); rowbase = b * S_P; seq = S_P; }
        else { const int j = i - 4; const int pair = 16 * xcd + 2 * j + (idx >> 4); const int b = pair >> 3; h = pair & 7; qb = idx & 15; rowbase = T_P + b * S_S; seq = S_S; }
        att::attn_unit(Qb + (size_t)(rowbase + qb * 256) * 768 + h * 96, KN + (size_t)rowbase * 512 + h * 64, KR + (size_t)rowbase * 32, Vb + (size_t)rowbase * 512 + h * 64,
                       MIX + (size_t)(rowbase + qb * 256) * 1024 + h * 64, seq, rowbase + qb * 256, ropec, ropes, (char*)lds);
      }
    } else {
      for (int u = bx; u < 3072; u += G) {
        int rowbase, seq, h, qb;
        if (u < 1024) { const int pair = u >> 6; const int b = pair >> 3; h = pair & 7; qb = u & 63; rowbase = b * S_P; seq = S_P; }
        else { const int v = u - 1024; const int pair = v >> 4; const int b = pair >> 3; h = pair & 7; qb = v & 15; rowbase = T_P + b * S_S; seq = S_S; }
        att::attn_unit(Qb + (size_t)(rowbase + qb * 256) * 768 + h * 96, KN + (size_t)rowbase * 512 + h * 64, KR + (size_t)rowbase * 32, Vb + (size_t)rowbase * 512 + h * 64,
                       MIX + (size_t)(rowbase + qb * 256) * 1024 + h * 64, seq, rowbase + qb * 256, ropec, ropes, (char*)lds);
      }
    }
  }
  GSYNC();
  {
    const float* SLOT = (const float*)(ws + WS_SLOT);
    for (int u = blockIdx.x; u < 768; u += gridDim.x) {
      int chainid, seg;
      if (u < 256) { chainid = u >> 4; seg = u & 15; } else { const int u2 = u - 256; chainid = 16 + (u2 >> 2); seg = u2 & 3; }
      int rowbase, S, h, dir;
      if (chainid < 16) { const int b = chainid >> 3; h = (chainid >> 1) & 3; dir = chainid & 1; rowbase = b * S_P; S = S_P; }
      else { const int c2 = chainid - 16; const int b = c2 >> 3; h = (c2 >> 1) & 3; dir = c2 & 1; rowbase = T_P + b * S_S; S = S_S; }
      hg::chain<3>(UHG, out, P.in[15], rowbase, S, h, dir, seg * 1024, 16, seg ? SLOT + (size_t)(u - 1) * 16384 : nullptr, nullptr, nullptr, (char*)lds);
    }
  }
  GSYNC();
  hg_combine(out, UHG, P.in[16], MIX);
  GSYNC();
  { pg8::EpiRes<1> E{nullptr, nullptr, HB, nullptr, ss2, nullptr, nullptr}; run_gemm(l3, MIX, 1024, (const bf16_t*)(ws + WS_WO), 1024, 1024, 1024, E); }
  GSYNC();
  { pg8::EpiSwiGLU E{ACT, ss2}; run_gemm(l3, HB, 1024, (const bf16_t*)(ws + WS_W2GU), 1024, NGU, 1024, E); }
  GSYNC();
  { pg8::EpiRes<2> E{nullptr, nullptr, HB, nullptr, ss3, nullptr, nullptr}; run_gemm(l3, ACT, DFF, (const bf16_t*)(ws + WS_W2D), DFF, 1024, DFF, E); }
  { pg8::EpiBf E{PROJ, PROJ, 1024, 1000, nullptr, 0.f, 1.0f}; run_gemm(l3, PB, 256, (const bf16_t*)(ws + WS_WPP), 256, 1024, 256, E); }
  GSYNC();
  { pg8::EpiRes<3> E{nullptr, nullptr, HB, H4B, ss4, ss3, PROJ}; run_gemm(l3, HB, 1024, (const bf16_t*)(ws + WS_WPG), 1024, 1024, 1024, E); }
  GSYNC();
  final_norm(out, H4B, ss4, P.in[25]);
}

extern "C" void kernel_launch(void* const* d_in, const int* in_sizes, int n_in, void* d_out, int out_size, void* d_ws, size_t ws_size, hipStream_t stream) {
  static int grid = 0;
  if (grid == 0) {
    if (n_in != 26 || out_size != T_ALL * DM || ws_size < WS_END) { fprintf(stderr, "kernel_launch: unexpected shapes n_in %d out %d ws %zu\n", n_in, out_size, ws_size); grid = -1; return; }
    int dev = 0, cus = 0, per_cu = 0;
    if (hipGetDevice(&dev) != hipSuccess || hipDeviceGetAttribute(&cus, hipDeviceAttributeMultiprocessorCount, dev) != hipSuccess) { grid = -1; return; }
    if (hipFuncSetAttribute((const void*)mk_fwd, hipFuncAttributeMaxDynamicSharedMemorySize, LDS_BYTES) != hipSuccess) { fprintf(stderr, "kernel_launch: LDS attribute failed\n"); grid = -1; return; }
    if (hipOccupancyMaxActiveBlocksPerMultiprocessor(&per_cu, (const void*)mk_fwd, 512, LDS_BYTES) != hipSuccess || per_cu < 1) { fprintf(stderr, "kernel_launch: occupancy query says %d\n", per_cu); per_cu = 1; }
    (void)hipGetLastError();
    grid = cus;
  }
  if (grid < 0) return;
  Params p{};
  for (int i = 0; i < 26; ++i) p.in[i] = (const float*)d_in[i];
  p.out = (float*)d_out; p.ws = (unsigned char*)d_ws;
  void* args[] = {&p};
  hipError_t e = hipLaunchCooperativeKernel((void*)mk_fwd, dim3(grid), dim3(512), args, LDS_BYTES, stream);
  if (e != hipSuccess) fprintf(stderr, "cooperative launch failed: %s (grid %d)\n", hipGetErrorString(e), grid);
}
```

```cpp
#include <hip/hip_runtime.h>
#include <hip/hip_cooperative_groups.h>
#include <cstdio>
#include <cstdint>
namespace cg = cooperative_groups;

constexpr int DM = 1024, T_P = 32768, T_ALL = 98304, S_P = 16384, S_S = 4096;
constexpr int DFF = 2816, NGU = 5632, NIN = 3328, NMLA = 768, NHG = 2560, PLE = 256;
constexpr float EPS = 1e-6f;
__device__ __forceinline__ int row_pos(int row) { return row < T_P ? (row & (S_P - 1)) : (row & (S_S - 1)); }

namespace pg8 {
#define PG8_LAS __attribute__((address_space(3)))
typedef unsigned short bf16_t;
typedef short bf16x8 __attribute__((ext_vector_type(8)));
typedef float f32x4 __attribute__((ext_vector_type(4)));
typedef unsigned u32x4 __attribute__((ext_vector_type(4)));
constexpr int BM = 256, BK = 64, HALF = 128, HTB = HALF * BK * 2  , STAGE_BYTES = 8 * HTB, NXCD = 8, WGM = 8;

__host__ __device__ __forceinline__ int lds_byte(int r, int c) { const int st = (r >> 4) * 2 + (c >> 5), rr = r & 15, cc = c & 31, ob = rr * 64 + cc * 2; return st * 1024 + (ob ^ (((ob >> 9) & 1) << 5)); }
__host__ __device__ __forceinline__ void stage_rc(int b, int& R, int& C) { const int st = b / 1024, sb = b % 1024, swz = sb ^ (((sb >> 9) & 1) << 5); R = (st >> 1) * 16 + swz / 64; C = (st & 1) * 32 + (swz % 64) / 2; }
__host__ __device__ __forceinline__ int perm32(int rho) { const int n = rho >> 4, i = rho & 15; return 8 * (i >> 2) + 4 * n + (i & 3); }

struct Unit { int pm, pn; };
struct Gemm { const bf16_t* A; const bf16_t* Bt; int M, N, K, lda, ldb; };

struct StaticOrder {
    int nM, nN, nwg, G, c;
    __host__ __device__ void init(int M, int N, int G_, int c_) { nM = M / BM; nN = N / BM; nwg = nM * nN; G = G_; c = c_; }
    __host__ __device__ bool next(int i, Unit& u) const {
        const long L = (long)i * G + c; if (L >= nwg) return false;
        int wgid = (int)L; { const int q = nwg / NXCD, r = nwg % NXCD, xcd = wgid % NXCD, off = wgid / NXCD; wgid = (xcd < r ? xcd * (q + 1) : r * (q + 1) + (xcd - r) * q) + off; }
        const int nig = WGM * nN, gid = wgid / nig, fm = gid * WGM, gsz = (nM - fm) < WGM ? (nM - fm) : WGM;
        u.pm = fm + ((wgid % nig) % gsz); u.pn = (wgid % nig) / gsz; return true;
    }
    __device__ __forceinline__ void a_ready(const Unit&) const {}
    __device__ __forceinline__ void done(const Unit&) const {}
};
__device__ __forceinline__ unsigned cvt_pk_bf16(float lo, float hi) { unsigned r; asm volatile("v_cvt_pk_bf16_f32 %0, %1, %2" : "=v"(r) : "v"(lo), "v"(hi)); return r; }
typedef unsigned u32x2 __attribute__((ext_vector_type(2)));
__device__ __forceinline__ float bf2f(unsigned short h) { return __uint_as_float(((unsigned)h) << 16); }
__device__ __forceinline__ float fsigmoid(float x) { return __builtin_amdgcn_rcpf(1.0f + __builtin_amdgcn_exp2f(-1.4426950408889634f * x)); }
typedef unsigned ss_t;
__device__ __forceinline__ float ss_f(ss_t v) { return (float)v * (1.0f / 4096.0f); }
__device__ __forceinline__ void ss_add(ss_t* p, float v) { atomicAdd(p, (ss_t)(v * 4096.0f + 0.5f)); }
__device__ __forceinline__ float row_sum4(float s) { s += __shfl_xor(s, 16); s += __shfl_xor(s, 32); return s; }

struct EpiSwiGLU {
    static constexpr bool PERM = true, AFTER_DRAIN = false;
    bf16_t* O; const ss_t* ss;
    __device__ __forceinline__ void operator()(const f32x4 (&acc)[2][2][4][2], const Unit& u, int wr, int wc, int fr, int fq) const {
        const int row0 = u.pm * BM + wr * 64 + fr; const int col0 = u.pn * HALF + wc * 32 + 8 * fq;
        float ssv[2][4];
#pragma unroll
        for (int ai = 0; ai < 2; ++ai)
#pragma unroll
            for (int m = 0; m < 4; ++m) ssv[ai][m] = ss_f(ss[row0 + ai * HALF + m * 16]);
#pragma unroll
        for (int ai = 0; ai < 2; ++ai)
#pragma unroll
            for (int m = 0; m < 4; ++m) { const int row = row0 + ai * HALF + m * 16; const float r = __builtin_amdgcn_rsqf(ssv[ai][m] * (1.0f / 1024.0f) + 1e-6f);
                const float c1 = -1.4426950408889634f * r, r2 = r * r;
                f32x4 vv[2];
#pragma unroll
                for (int n = 0; n < 2; ++n) { const f32x4 a = acc[ai][0][m][n], b = acc[ai][1][m][n]; const f32x4 m1 = a * c1; f32x4 d;
                    d[0] = __builtin_amdgcn_exp2f(m1[0]); d[1] = __builtin_amdgcn_exp2f(m1[1]); d[2] = __builtin_amdgcn_exp2f(m1[2]); d[3] = __builtin_amdgcn_exp2f(m1[3]);
                    d = d + 1.0f; f32x4 inv; inv[0] = __builtin_amdgcn_rcpf(d[0]); inv[1] = __builtin_amdgcn_rcpf(d[1]); inv[2] = __builtin_amdgcn_rcpf(d[2]); inv[3] = __builtin_amdgcn_rcpf(d[3]);
                    vv[n] = (a * b) * (inv * r2); }
                u32x4 w; w.x = cvt_pk_bf16(vv[0][0], vv[0][1]); w.y = cvt_pk_bf16(vv[0][2], vv[0][3]); w.z = cvt_pk_bf16(vv[1][0], vv[1][1]); w.w = cvt_pk_bf16(vv[1][2], vv[1][3]);
                __builtin_nontemporal_store(w, (u32x4*)(O + (size_t)row * 2816 + col0)); }
    }
};
template <int MODE> struct EpiRes {
    static constexpr bool PERM = true, AFTER_DRAIN = false;
    const float* xp; const float* xs; bf16_t* hb; bf16_t* hout; ss_t* ssout; const ss_t* ssin; const bf16_t* proj;
    __device__ __forceinline__ void operator()(const f32x4 (&acc)[2][2][4][2], const Unit& u, int wr, int wc, int fr, int fq) const {
        const int row0 = u.pm * BM + wr * 64 + fr; const int col0 = u.pn * BM + wc * 32 + 8 * fq;
        float s3v[2][4];
        if (MODE == 3) {
#pragma unroll
            for (int ai = 0; ai < 2; ++ai)
#pragma unroll
                for (int m = 0; m < 4; ++m) s3v[ai][m] = ss_f(ssin[row0 + ai * HALF + m * 16]); }
#pragma unroll
        for (int ai = 0; ai < 2; ++ai) {
            u32x4 hpre[4][2];
            if (MODE != 0) {
#pragma unroll
                for (int m = 0; m < 4; ++m)
#pragma unroll
                    for (int bj = 0; bj < 2; ++bj) hpre[m][bj] = *(const u32x4*)(hb + (size_t)(row0 + ai * HALF + m * 16) * 1024 + col0 + bj * HALF); }
#pragma unroll
            for (int m = 0; m < 4; ++m) { const int row = row0 + ai * HALF + m * 16; float sq = 0.f; float r3 = 0.f;
                if (MODE == 3) r3 = __builtin_amdgcn_rsqf(s3v[ai][m] * (1.0f / 1024.0f) + 1e-6f);
#pragma unroll
                for (int bj = 0; bj < 2; ++bj) { const size_t off = (size_t)row * 1024 + col0 + bj * HALF; float b[8], v[8];
                    if (MODE == 0) { const float* xr = (row < 32768) ? (xp + off) : (xs + (off - (size_t)32768 * 1024)); const f32x4 b0 = *(const f32x4*)xr, b1 = *(const f32x4*)(xr + 4);
                        b[0] = b0[0]; b[1] = b0[1]; b[2] = b0[2]; b[3] = b0[3]; b[4] = b1[0]; b[5] = b1[1]; b[6] = b1[2]; b[7] = b1[3]; }
                    else { const u32x4 h4 = hpre[m][bj];
                        b[0] = __uint_as_float(h4.x << 16); b[1] = __uint_as_float(h4.x & 0xffff0000u); b[2] = __uint_as_float(h4.y << 16); b[3] = __uint_as_float(h4.y & 0xffff0000u);
                        b[4] = __uint_as_float(h4.z << 16); b[5] = __uint_as_float(h4.z & 0xffff0000u); b[6] = __uint_as_float(h4.w << 16); b[7] = __uint_as_float(h4.w & 0xffff0000u); }
                    if (MODE == 3) { const u32x4 p4 = *(const u32x4*)(proj + off); float pr[8];
                        pr[0] = __uint_as_float(p4.x << 16); pr[1] = __uint_as_float(p4.x & 0xffff0000u); pr[2] = __uint_as_float(p4.y << 16); pr[3] = __uint_as_float(p4.y & 0xffff0000u);
                        pr[4] = __uint_as_float(p4.z << 16); pr[5] = __uint_as_float(p4.z & 0xffff0000u); pr[6] = __uint_as_float(p4.w << 16); pr[7] = __uint_as_float(p4.w & 0xffff0000u);
#pragma unroll
                        for (int j = 0; j < 8; ++j) v[j] = b[j] + fsigmoid(acc[ai][bj][m][j >> 2][j & 3] * r3) * pr[j]; }
                    else {
#pragma unroll
                        for (int j = 0; j < 8; ++j) v[j] = b[j] + acc[ai][bj][m][j >> 2][j & 3] * ((MODE == 1) ? 1.0f : 0.5f); }
#pragma unroll
                    for (int j = 0; j < 8; ++j) sq += v[j] * v[j];
                    u32x4 w; w.x = cvt_pk_bf16(v[0], v[1]); w.y = cvt_pk_bf16(v[2], v[3]); w.z = cvt_pk_bf16(v[4], v[5]); w.w = cvt_pk_bf16(v[6], v[7]);
                    *(u32x4*)(((MODE == 3) ? hout : hb) + off) = w; }
                sq = row_sum4(sq);
                if (fq == 0) ss_add(ssout + row, sq); }
        }
    }
};
struct EpiWin {
    static constexpr bool PERM = true, AFTER_DRAIN = false;
    bf16_t* umla; bf16_t* uhg; bf16_t* kr; const ss_t* ss1; ss_t* ssq; ss_t* sskv; const float* ropec; const float* ropes;
    __device__ __forceinline__ void operator()(const f32x4 (&acc)[2][2][4][2], const Unit& u, int wr, int wc, int fr, int fq) const {
        const int row0 = u.pm * BM + wr * 64 + fr; const int pn = u.pn;
        bf16_t* dst; int ld, colt;
        if (pn < 3) { dst = umla; ld = 768; colt = pn * BM; } else { dst = uhg; ld = 2560; colt = (pn - 3) * BM; }
        const int col0 = colt + wc * 32 + 8 * fq;
        float ssv[2][4];
#pragma unroll
        for (int ai = 0; ai < 2; ++ai)
#pragma unroll
            for (int m = 0; m < 4; ++m) ssv[ai][m] = ss_f(ss1[row0 + ai * HALF + m * 16]);
#pragma unroll
        for (int ai = 0; ai < 2; ++ai)
#pragma unroll
            for (int m = 0; m < 4; ++m) { const int row = row0 + ai * HALF + m * 16; const float r = __builtin_amdgcn_rsqf(ssv[ai][m] * (1.0f / 1024.0f) + 1e-6f);
                float sq0 = 0.f, sq1 = 0.f; f32x4 v[2][2];
#pragma unroll
                for (int bj = 0; bj < 2; ++bj) {
#pragma unroll
                    for (int n = 0; n < 2; ++n) { v[bj][n] = acc[ai][bj][m][n] * r; const f32x4 x = v[bj][n]; const float s = (x[0] * x[0] + x[1] * x[1]) + (x[2] * x[2] + x[3] * x[3]); if (bj == 0) sq0 += s; else sq1 += s; }
                    u32x4 w; w.x = cvt_pk_bf16(v[bj][0][0], v[bj][0][1]); w.y = cvt_pk_bf16(v[bj][0][2], v[bj][0][3]); w.z = cvt_pk_bf16(v[bj][1][0], v[bj][1][1]); w.w = cvt_pk_bf16(v[bj][1][2], v[bj][1][3]);
                    __builtin_nontemporal_store(w, (u32x4*)(dst + (size_t)row * ld + col0 + bj * HALF)); }
                if (pn < 3) { float s = (pn == 1) ? sq0 : (sq0 + sq1); s = row_sum4(s); if (fq == 0) ss_add((pn == 2 ? sskv : ssq) + row, s); }
                if (pn == 1 && wc == 0) {
                    const int pos = row_pos(row); const f32x4 cs = *(const f32x4*)(ropec + pos * 16 + 4 * fq), sn = *(const f32x4*)(ropes + pos * 16 + 4 * fq);
                    const f32x4 x1 = v[1][0], x2 = v[1][1]; const f32x4 o1 = x1 * cs - x2 * sn, o2 = x1 * sn + x2 * cs;
                    u32x2 w1, w2; w1.x = cvt_pk_bf16(o1[0], o1[1]); w1.y = cvt_pk_bf16(o1[2], o1[3]); w2.x = cvt_pk_bf16(o2[0], o2[1]); w2.y = cvt_pk_bf16(o2[2], o2[3]);
                    *(u32x2*)(kr + (size_t)row * 32 + 4 * fq) = w1; *(u32x2*)(kr + (size_t)row * 32 + 16 + 4 * fq) = w2; } }
    }
};
struct EpiBf {
    static constexpr bool PERM = true, AFTER_DRAIN = false;
    bf16_t* O0; bf16_t* O1; int ld; int split; const ss_t* ss; float inv_n; float mul;
    __device__ __forceinline__ void operator()(const f32x4 (&acc)[2][2][4][2], const Unit& u, int wr, int wc, int fr, int fq) const {
        const int row0 = u.pm * BM + wr * 64 + fr; bf16_t* base = O0; int colt = u.pn * BM; if (u.pn >= split) { base = O1; colt = (u.pn - split) * BM; }
        const int col0 = colt + wc * 32 + 8 * fq;
#pragma unroll
        for (int ai = 0; ai < 2; ++ai)
#pragma unroll
            for (int m = 0; m < 4; ++m) { const int row = row0 + ai * HALF + m * 16; const float r = (ss ? rsqrtf(ss_f(ss[row]) * inv_n + 1e-6f) : 1.0f) * mul;
#pragma unroll
                for (int bj = 0; bj < 2; ++bj) { const f32x4 v0 = acc[ai][bj][m][0] * r, v1 = acc[ai][bj][m][1] * r;
                    u32x4 w; w.x = cvt_pk_bf16(v0[0], v0[1]); w.y = cvt_pk_bf16(v0[2], v0[3]); w.z = cvt_pk_bf16(v1[0], v1[1]); w.w = cvt_pk_bf16(v1[2], v1[3]);
                    *(u32x4*)(base + (size_t)row * ld + col0 + bj * HALF) = w; } }
    }
};
template <class Epi, class Sched, bool ALIGN_EPI = false, bool SP2 = false>
__device__ __forceinline__ void gemm_phase(PG8_LAS unsigned char* lds, const Gemm g, const Sched& S, const Epi& E) {
    int tid_ = threadIdx.x; asm volatile("" : "+v"(tid_)); const int tid = tid_, wid = __builtin_amdgcn_readfirstlane(tid >> 6), lane = tid & 63, wr = wid >> 2, wc = wid & 3, fr = lane & 15, fq = lane >> 4;
    const int K = g.K, nt = K / BK;
    unsigned voffA[2], voffB[2];
#pragma unroll
    for (int i = 0; i < 2; ++i) { int R, C; stage_rc(tid * 16 + i * 8192, R, C); const int Rb = Epi::PERM ? ((R & ~31) + perm32(R & 31)) : R;
        voffA[i] = (unsigned)(R * g.lda + C) * 2u; voffB[i] = (unsigned)(Rb * g.ldb + C) * 2u; }
    const size_t kstep = (size_t)(BK * 2);
    const size_t hstepA = (size_t)HALF * g.lda * 2, hstepB = (size_t)HALF * g.ldb * 2;
    const size_t tstepA = 2 * hstepA, tstepB = 2 * hstepB;
    const unsigned ldsw = (unsigned)wid * 1024u;
    const int aoff = lds_byte(wr * 64 + fr, fq * 8), boff = lds_byte(wc * 32 + fr, fq * 8);
#define PG8_SA(b, h) (((b) * 2 + (h)) * HTB)
#define PG8_SB(b, h) ((4 + (b) * 2 + (h)) * HTB)
#define PG8_STAGE(bufoff, gbase, voff) do { _Pragma("unroll") for (int _i = 0; _i < 2; ++_i) \
        __builtin_amdgcn_global_load_lds((const unsigned*)((const char*)(gbase) + (voff)[_i]), (PG8_LAS unsigned*)(lds + (bufoff) + ldsw + _i * 8192), 16, 0, 0); } while (0)
#define PG8_LDA(dst, b, h) do { _Pragma("unroll") for (int m = 0; m < 4; ++m) _Pragma("unroll") for (int k = 0; k < 2; ++k) dst[m][k] = *(const PG8_LAS bf16x8*)(lds + PG8_SA(b, h) + aoff + m * 2048 + k * 1024); } while (0)
#define PG8_LDB(dst, b, h) do { _Pragma("unroll") for (int n = 0; n < 2; ++n) _Pragma("unroll") for (int k = 0; k < 2; ++k) dst[n][k] = *(const PG8_LAS bf16x8*)(lds + PG8_SB(b, h) + boff + n * 2048 + k * 1024); } while (0)
#define PG8_MMA(ai, bj, At, Bt) do { __builtin_amdgcn_s_setprio(1); _Pragma("unroll") for (int m = 0; m < 4; ++m) _Pragma("unroll") for (int n = 0; n < 2; ++n) _Pragma("unroll") for (int k = 0; k < 2; ++k) \
        acc[ai][bj][m][n] = __builtin_amdgcn_mfma_f32_16x16x32_bf16(Bt[n][k], At[m][k], acc[ai][bj][m][n], 0, 0, 0); __builtin_amdgcn_s_setprio(0); } while (0)
#define PG8_WAIT_V(n) asm volatile("s_waitcnt vmcnt(" #n ")" ::: "memory")
#define PG8_WAIT_L(n) asm volatile("s_waitcnt lgkmcnt(" #n ")" ::: "memory")
#define PG8_BAR __builtin_amdgcn_s_barrier()
#define PG8_SCHED __builtin_amdgcn_sched_barrier(0)
    Unit cur, nxt; int ui = 0;
    if (!S.next(0, cur)) return;
    f32x4 acc[2][2][4][2];
#pragma unroll
    for (int a = 0; a < 2; ++a)
#pragma unroll
        for (int b = 0; b < 2; ++b)
#pragma unroll
            for (int m = 0; m < 4; ++m)
#pragma unroll
                for (int n = 0; n < 2; ++n) acc[a][b][m][n] = (f32x4){0.f, 0.f, 0.f, 0.f};
    bf16x8 At[4][2], B0[2][2], B1[2][2];
    const char* cA = (const char*)g.A + (size_t)cur.pm * tstepA; const char* cB = (const char*)g.Bt + (size_t)cur.pn * tstepB;
    S.a_ready(cur);
    if constexpr (SP2) {
        PG8_STAGE(PG8_SB(0, 0), cB, voffB); PG8_STAGE(PG8_SB(0, 1), cB + hstepB, voffB); PG8_STAGE(PG8_SA(0, 0), cA, voffA); PG8_STAGE(PG8_SA(0, 1), cA + hstepA, voffA);
        if (wr == 1) PG8_BAR;
        PG8_WAIT_V(2); PG8_BAR;
        PG8_STAGE(PG8_SB(1, 0), cB + kstep, voffB); PG8_STAGE(PG8_SA(1, 0), cA + kstep, voffA); PG8_STAGE(PG8_SB(1, 1), cB + hstepB + kstep, voffB);
        PG8_WAIT_V(6); PG8_BAR;
    } else {
        PG8_STAGE(PG8_SB(0, 0), cB, voffB); PG8_STAGE(PG8_SA(0, 0), cA, voffA); PG8_STAGE(PG8_SB(0, 1), cB + hstepB, voffB); PG8_STAGE(PG8_SA(0, 1), cA + hstepA, voffA);
        if (wr == 1) PG8_BAR;
        PG8_WAIT_V(4); PG8_BAR;
        PG8_STAGE(PG8_SB(1, 0), cB + kstep, voffB); PG8_STAGE(PG8_SA(1, 0), cA + kstep, voffA); PG8_STAGE(PG8_SB(1, 1), cB + hstepB + kstep, voffB);
        PG8_WAIT_V(6); PG8_BAR;
    }
    for (;;) {
        const bool has_next = S.next(ui + 1, nxt);
        const char* nA = has_next ? (const char*)g.A + (size_t)nxt.pm * tstepA : cA; const char* nB = has_next ? (const char*)g.Bt + (size_t)nxt.pn * tstepB : cB;
        for (int t = 0; t < nt; t += 2) {
            const bool last = (t == nt - 2);
            const char* a1 = cA + (size_t)(t + 1) * kstep;
            const char* a2 = last ? nA : cA + (size_t)(t + 2) * kstep; const char* b2 = last ? nB : cB + (size_t)(t + 2) * kstep;
            const char* a3 = a2 + kstep; const char* b3 = b2 + kstep;
            if (last && has_next) S.a_ready(nxt);
            if constexpr (SP2) {
            PG8_LDB(B0, 0, 0); PG8_LDB(B1, 0, 1); PG8_SCHED; PG8_LDA(At, 0, 0); PG8_STAGE(PG8_SA(1, 1), a1 + hstepA, voffA);
            PG8_WAIT_V(8); PG8_WAIT_L(0); PG8_BAR; PG8_MMA(0, 0, At, B0); PG8_MMA(0, 1, At, B1); PG8_BAR; PG8_SCHED;
            PG8_LDA(At, 0, 1); PG8_STAGE(PG8_SB(0, 0), b2, voffB); PG8_STAGE(PG8_SB(0, 1), b2 + hstepB, voffB); PG8_STAGE(PG8_SA(0, 0), a2, voffA);
            PG8_WAIT_V(8); PG8_WAIT_L(0); PG8_BAR; PG8_MMA(1, 0, At, B0); PG8_MMA(1, 1, At, B1); PG8_BAR; PG8_SCHED;
            PG8_LDB(B0, 1, 0); PG8_LDB(B1, 1, 1); PG8_SCHED; PG8_LDA(At, 1, 0); PG8_STAGE(PG8_SA(0, 1), a2 + hstepA, voffA);
            PG8_WAIT_V(8); PG8_WAIT_L(0); PG8_BAR; PG8_MMA(0, 0, At, B0); PG8_MMA(0, 1, At, B1); PG8_BAR; PG8_SCHED;
            PG8_LDA(At, 1, 1); PG8_STAGE(PG8_SB(1, 0), b3, voffB); PG8_STAGE(PG8_SB(1, 1), b3 + hstepB, voffB); PG8_STAGE(PG8_SA(1, 0), a3, voffA);
            PG8_WAIT_V(8); PG8_WAIT_L(0); PG8_BAR; PG8_MMA(1, 0, At, B0); PG8_MMA(1, 1, At, B1); PG8_BAR; PG8_SCHED;
            } else {
            PG8_LDB(B0, 0, 0); PG8_SCHED; PG8_LDA(At, 0, 0); PG8_STAGE(PG8_SA(1, 1), a1 + hstepA, voffA);
            PG8_WAIT_L(8); PG8_BAR; PG8_WAIT_L(0); PG8_MMA(0, 0, At, B0); PG8_BAR; PG8_SCHED;
            PG8_LDB(B1, 0, 1); PG8_STAGE(PG8_SB(0, 0), b2, voffB);
            PG8_BAR; PG8_WAIT_L(0); PG8_MMA(0, 1, At, B1); PG8_BAR;
            PG8_LDA(At, 0, 1); PG8_STAGE(PG8_SA(0, 0), a2, voffA);
            PG8_BAR; PG8_WAIT_L(0); PG8_MMA(1, 0, At, B0); PG8_BAR; PG8_SCHED;
            PG8_STAGE(PG8_SB(0, 1), b2 + hstepB, voffB);
            PG8_WAIT_V(6); PG8_BAR; PG8_MMA(1, 1, At, B1); PG8_BAR;
            PG8_LDB(B0, 1, 0); PG8_SCHED; PG8_LDA(At, 1, 0); PG8_STAGE(PG8_SA(0, 1), a2 + hstepA, voffA);
            PG8_WAIT_L(8); PG8_BAR; PG8_WAIT_L(0); PG8_MMA(0, 0, At, B0); PG8_BAR; PG8_SCHED;
            PG8_LDB(B1, 1, 1); PG8_STAGE(PG8_SB(1, 0), b3, voffB);
            PG8_BAR; PG8_WAIT_L(0); PG8_MMA(0, 1, At, B1); PG8_BAR;
            PG8_LDA(At, 1, 1); PG8_STAGE(PG8_SA(1, 0), a3, voffA);
            PG8_BAR; PG8_WAIT_L(0); PG8_MMA(1, 0, At, B0); PG8_BAR; PG8_SCHED;
            PG8_STAGE(PG8_SB(1, 1), b3 + hstepB, voffB);
            PG8_WAIT_V(6); PG8_BAR; PG8_MMA(1, 1, At, B1); PG8_BAR;
            }
        }
        if constexpr (ALIGN_EPI) { if (wr == 0) PG8_BAR; }
        if constexpr (!Epi::AFTER_DRAIN) { E(acc, cur, wr, wc, fr, fq); S.done(cur); }
        if (!has_next) break;
#pragma unroll
        for (int a = 0; a < 2; ++a)
#pragma unroll
            for (int b = 0; b < 2; ++b)
#pragma unroll
                for (int m = 0; m < 4; ++m)
#pragma unroll
                    for (int n = 0; n < 2; ++n) acc[a][b][m][n] = (f32x4){0.f, 0.f, 0.f, 0.f};
        cur = nxt; cA = nA; cB = nB; ++ui;
        if constexpr (ALIGN_EPI) { if (wr == 1) PG8_BAR; }
    }
    PG8_WAIT_V(0);
    if constexpr (!ALIGN_EPI) { if (wr == 0) PG8_BAR; }
    PG8_BAR;
    if constexpr (Epi::AFTER_DRAIN) { E.fused(acc, cur, wr, wc, fr, fq, lds, wid, lane); S.done(cur); }
#undef PG8_SA
#undef PG8_SB
#undef PG8_STAGE
#undef PG8_LDA
#undef PG8_LDB
#undef PG8_MMA
#undef PG8_WAIT_V
#undef PG8_WAIT_L
#undef PG8_BAR
#undef PG8_SCHED
}
}

namespace att {
typedef unsigned short bf16_t;
using bf16x8 = __attribute__((ext_vector_type(8))) short;
using s16x4  = __attribute__((ext_vector_type(4))) short;
using f32x16 = __attribute__((ext_vector_type(16))) float;
using u32x4  = __attribute__((ext_vector_type(4))) unsigned;
constexpr int NW = 8, QBLK = 32, KVBLK = 64;
constexpr float SCALE = 0.10206207261596575f;
constexpr float THR = 8.f;
constexpr int LDQ = 768, LDKN = 512, LDKR = 32, LDV = 512, LDO = 1024;
constexpr int SHM_V = 64 * 128 * 2, SHM_K = 64 * 128 * 2;
#define KSWZ(row, colB) ((row) * 256 + ((colB) ^ (((row) & 7) << 4)))
#define SBAR() __builtin_amdgcn_sched_barrier(0)
__device__ __forceinline__ int crow(int r, int hi) { return (r & 3) + 8 * (r >> 2) + 4 * hi; }
__device__ __forceinline__ unsigned cvtpk(float lo, float hi) { unsigned r; asm volatile("v_cvt_pk_bf16_f32 %0, %1, %2" : "=v"(r) : "v"(lo), "v"(hi)); return r; }
template <bool FIRST> __device__ __forceinline__ void partialSM(f32x16& p0, f32x16& p1, float& m_ref, f32x16& negm, float& alpha) {
  constexpr float THR2 = THR * 1.4426950408889634f;
  float pmax = p0[0];
#pragma unroll
  for (int r = 1; r < 16; ++r) pmax = fmaxf(pmax, p0[r]);
#pragma unroll
  for (int r = 0; r < 16; ++r) pmax = fmaxf(pmax, p1[r]);
  { auto rr = __builtin_amdgcn_permlane32_swap(__float_as_uint(pmax), __float_as_uint(pmax), false, false);
    pmax = fmaxf(__uint_as_float(rr[0]), __uint_as_float(rr[1])); }
  alpha = 1.f;
  if (FIRST || !__builtin_expect(__all(pmax <= THR2), 1)) {
    const float dl = FIRST ? pmax : fmaxf(pmax, 0.f);
    m_ref += dl; alpha = FIRST ? 1.f : __builtin_amdgcn_exp2f(-dl);
#pragma unroll
    for (int r = 0; r < 16; ++r) { p0[r] -= dl; p1[r] -= dl; }
#pragma unroll
    for (int r = 0; r < 16; ++r) negm[r] = -m_ref;
    asm volatile("" : "+v"(negm));
  }
#pragma unroll
  for (int r = 0; r < 16; ++r) p0[r] = __builtin_amdgcn_exp2f(p0[r]);
}
__device__ __forceinline__ void finishSM(f32x16& p0, f32x16& p1, bf16x8& pa0, bf16x8& pa1, bf16x8& pa2, bf16x8& pa3) {
#pragma unroll
  for (int r = 0; r < 16; ++r) p1[r] = __builtin_amdgcn_exp2f(p1[r]);
#define PK4(P, BASE, OUT) do { unsigned a0 = cvtpk(P[BASE + 0], P[BASE + 1]), a1 = cvtpk(P[BASE + 2], P[BASE + 3]);   \
    unsigned b0 = cvtpk(P[BASE + 4], P[BASE + 5]), b1 = cvtpk(P[BASE + 6], P[BASE + 7]);                              \
    auto r0 = __builtin_amdgcn_permlane32_swap(a0, b0, false, false); auto r1 = __builtin_amdgcn_permlane32_swap(a1, b1, false, false); \
    u32x4 w = {r0[0], r1[0], r0[1], r1[1]}; OUT = *reinterpret_cast<bf16x8*>(&w); } while (0)
  PK4(p0, 0, pa0); PK4(p0, 8, pa1); PK4(p1, 0, pa2); PK4(p1, 8, pa3);
#undef PK4
}
__device__ __forceinline__ void qkt(f32x16& p0, f32x16& p1, const bf16_t* Ks, const bf16x8* qr, const f32x16& negm, int r32, int hi) {
#pragma unroll
  for (int d0 = 0; d0 < 6; ++d0) { int cb = (d0 * 16 + hi * 8) * 2;
    bf16x8 b0 = *reinterpret_cast<const bf16x8*>((const char*)Ks + KSWZ(r32, cb));
    bf16x8 b1 = *reinterpret_cast<const bf16x8*>((const char*)Ks + KSWZ(32 + r32, cb));
    if (d0 == 0) { p0 = __builtin_amdgcn_mfma_f32_32x32x16_bf16(b0, qr[0], negm, 0, 0, 0); p1 = __builtin_amdgcn_mfma_f32_32x32x16_bf16(b1, qr[0], negm, 0, 0, 0); }
    else { p0 = __builtin_amdgcn_mfma_f32_32x32x16_bf16(b0, qr[d0], p0, 0, 0, 0); p1 = __builtin_amdgcn_mfma_f32_32x32x16_bf16(b1, qr[d0], p1, 0, 0, 0); } }
}
__device__ __forceinline__ int v_st(int k, int c) { const int kk = (k & ~0xC) | ((k & 4) << 1) | ((k & 8) >> 1); return ((kk >> 3) * 4 + (c >> 5)) * 512 + ((kk & 7) * 32 + (c & 31)) * 2; }
__device__ __forceinline__ int v_rd_base(int lane) { return ((lane & 3) << 3) | (((lane >> 2) & 3) << 6) | (((lane >> 4) & 1) << 5) | (((lane >> 5) & 1) << 8); }
constexpr int v_rd_off(int d0, int ks, int half) { return d0 * 512 + ks * 4096 + half * 2048; }
template <int OFF> __device__ __forceinline__ s16x4 tr_read(int vb) {
  s16x4 r; asm volatile("ds_read_b64_tr_b16 %0, %1 offset:%2" : "=&v"(r) : "v"(vb), "i"(OFF) : "memory"); return r;
}
template <int D0> __device__ __forceinline__ void pv_one(f32x16& od, int vb, bf16x8 pa0, bf16x8 pa1, bf16x8 pa2, bf16x8 pa3) {
  const s16x4 l0 = tr_read<v_rd_off(D0, 0, 0)>(vb), h0 = tr_read<v_rd_off(D0, 0, 1)>(vb), l1 = tr_read<v_rd_off(D0, 1, 0)>(vb), h1 = tr_read<v_rd_off(D0, 1, 1)>(vb);
  const s16x4 l2 = tr_read<v_rd_off(D0, 2, 0)>(vb), h2 = tr_read<v_rd_off(D0, 2, 1)>(vb), l3 = tr_read<v_rd_off(D0, 3, 0)>(vb), h3 = tr_read<v_rd_off(D0, 3, 1)>(vb);
  asm volatile("s_waitcnt lgkmcnt(0)" ::: "memory"); SBAR();
#define PK(L, H) (bf16x8){L[0], L[1], L[2], L[3], H[0], H[1], H[2], H[3]}
  od = __builtin_amdgcn_mfma_f32_32x32x16_bf16(pa0, PK(l0, h0), od, 0, 0, 0);
  od = __builtin_amdgcn_mfma_f32_32x32x16_bf16(pa1, PK(l1, h1), od, 0, 0, 0);
  od = __builtin_amdgcn_mfma_f32_32x32x16_bf16(pa2, PK(l2, h2), od, 0, 0, 0);
  od = __builtin_amdgcn_mfma_f32_32x32x16_bf16(pa3, PK(l3, h3), od, 0, 0, 0);
#undef PK
}
__device__ __forceinline__ void pv_d0(f32x16* o, f32x16& osum, int vb, bf16x8 pa0, bf16x8 pa1, bf16x8 pa2, bf16x8 pa3) {
  pv_one<0>(o[0], vb, pa0, pa1, pa2, pa3); pv_one<1>(o[1], vb, pa0, pa1, pa2, pa3);
  const short one = (short)0x3F80; const bf16x8 ones = {one, one, one, one, one, one, one, one};
  osum = __builtin_amdgcn_mfma_f32_32x32x16_bf16(pa0, ones, osum, 0, 0, 0); osum = __builtin_amdgcn_mfma_f32_32x32x16_bf16(pa1, ones, osum, 0, 0, 0);
  osum = __builtin_amdgcn_mfma_f32_32x32x16_bf16(pa2, ones, osum, 0, 0, 0); osum = __builtin_amdgcn_mfma_f32_32x32x16_bf16(pa3, ones, osum, 0, 0, 0);
}
__device__ __forceinline__ void attn_unit(const bf16_t* __restrict__ Qb, const bf16_t* __restrict__ KNh, const bf16_t* __restrict__ KRb, const bf16_t* __restrict__ Vh,
                                          bf16_t* __restrict__ Ob, int seq, int qrow0, const float* __restrict__ ropec, const float* __restrict__ ropes, char* lds) {
  int tid_ = threadIdx.x; asm volatile("" : "+v"(tid_)); const int tid = tid_, wid = __builtin_amdgcn_readfirstlane(tid >> 6), lane = tid & 63, r32 = lane & 31, hi = lane >> 5;
  bf16_t* V_lds = (bf16_t*)lds; bf16_t* K_lds = (bf16_t*)(lds + 3 * SHM_V);
  float* ws = (float*)(lds + 3 * SHM_V + 3 * SHM_K) + wid * 64; float* al_l = ws + 32;
  float m_ref = 0.f; f32x16 o[2] = {}; f32x16 osum = {}; f32x16 negm = {}; asm volatile("" : "+v"(negm)); bf16x8 qr[6];
  const int srow = tid >> 3, sch = tid & 7, srow2 = tid >> 2, sch2 = tid & 3;
  const bf16_t* kp = KNh + (long)srow * LDKN + 8 * sch; const bf16_t* vp = Vh + (long)srow * LDV + 8 * sch; const bf16_t* rp = KRb + (long)(srow2 & 63) * LDKR + 8 * sch2;
  const int kst = KSWZ(srow, 16 * sch), vst = v_st(srow, 8 * sch), rst = KSWZ(srow2 & 63, 128 + 16 * sch2);
  const bool has_r = wid < 4;
  constexpr int BUF = SHM_V;
  const int vb0 = (int)(uintptr_t)V_lds + v_rd_base(lane);
  struct { bf16x8 v, k, r; } sr_[2];
#define SLOAD(i, k0) do { sr_[i].v = *reinterpret_cast<const bf16x8*>(vp + (long)(k0) * LDV); sr_[i].k = *reinterpret_cast<const bf16x8*>(kp + (long)(k0) * LDKN); \
    if (has_r) sr_[i].r = *reinterpret_cast<const bf16x8*>(rp + (long)(k0) * LDKR); } while (0)
#define SWRITE(off, i) do { *(bf16x8*)((char*)V_lds + (off) + vst) = sr_[i].v; *(bf16x8*)((char*)K_lds + (off) + kst) = sr_[i].k; \
    if (has_r) *(bf16x8*)((char*)K_lds + (off) + rst) = sr_[i].r; } while (0)
#define SWAIT() do { if (has_r) asm volatile("s_waitcnt vmcnt(3)" ::: "memory"); else asm volatile("s_waitcnt vmcnt(2)" ::: "memory"); } while (0)
  constexpr int SE = 0, SO = 1;
  const int NT = seq / KVBLK;
  SLOAD(SE, 0); SLOAD(SO, KVBLK);
  const bf16_t* Qw = Qb + (long)(wid * QBLK + r32) * LDQ + hi * 8;
#pragma unroll
  for (int d0 = 0; d0 < 6; ++d0) qr[d0] = *reinterpret_cast<const bf16x8*>(Qw + d0 * 16);
  {
    const int pos = row_pos(qrow0 + wid * QBLK + r32); const float* cp = ropec + pos * 16 + 8 * hi; const float* sp = ropes + pos * 16 + 8 * hi;
    unsigned w1[4], w2[4];
#pragma unroll
    for (int e = 0; e < 8; e += 2) { float o1[2], o2[2];
#pragma unroll
      for (int f = 0; f < 2; ++f) { const float x1 = __uint_as_float(((unsigned)(unsigned short)qr[4][e + f]) << 16), x2 = __uint_as_float(((unsigned)(unsigned short)qr[5][e + f]) << 16); const float c = cp[e + f], s = sp[e + f];
        o1[f] = x1 * c - x2 * s; o2[f] = x1 * s + x2 * c; }
      w1[e >> 1] = cvtpk(o1[0], o1[1]); w2[e >> 1] = cvtpk(o2[0], o2[1]); }
    u32x4 v1 = {w1[0], w1[1], w1[2], w1[3]}, v2 = {w2[0], w2[1], w2[2], w2[3]}; qr[4] = *reinterpret_cast<bf16x8*>(&v1); qr[5] = *reinterpret_cast<bf16x8*>(&v2); }
#define RESC(a) do { if (__any((a) < 1.f)) { if (hi == 0) al_l[r32] = (a); asm volatile("s_waitcnt lgkmcnt(0)" ::: "memory"); \
    _Pragma("unroll") for (int r = 0; r < 16; ++r) { const float f_ = al_l[crow(r, hi)]; o[0][r] *= f_; o[1][r] *= f_; osum[r] *= f_; } } } while (0)
#define ROT() do { const int t_ = o_prev; o_prev = o_cur; o_cur = o_next; o_next = t_; } while (0)
  f32x16 pA0, pA1, pB0, pB1; float alA, alB; bf16x8 pa0, pa1, pa2, pa3;
  int o_prev = 2 * BUF, o_cur = 0, o_next = BUF;
  asm volatile("s_waitcnt vmcnt(0)" ::: "memory"); SWRITE(0, SE); __syncthreads();
  qkt(pA0, pA1, K_lds, qr, negm, r32, hi); partialSM<true>(pA0, pA1, m_ref, negm, alA);
  if (2 < NT) SLOAD(SE, 2 * KVBLK);
  SWAIT(); SWRITE(BUF, SO); __syncthreads();
  ROT();
  for (int j = 1; j + 1 < NT; j += 2) {
    SBAR(); qkt(pB0, pB1, (bf16_t*)((char*)K_lds + o_cur), qr, negm, r32, hi);
    finishSM(pA0, pA1, pa0, pa1, pa2, pa3); SBAR();
    SLOAD(SO, (j + 2) * KVBLK); SBAR();
    pv_d0(o, osum, vb0 + o_prev, pa0, pa1, pa2, pa3); partialSM<false>(pB0, pB1, m_ref, negm, alB);
    SWAIT(); SWRITE(o_next, SE);
    RESC(alB); __syncthreads(); ROT();
    SBAR(); qkt(pA0, pA1, (bf16_t*)((char*)K_lds + o_cur), qr, negm, r32, hi);
    finishSM(pB0, pB1, pa0, pa1, pa2, pa3); SBAR();
    if (j + 3 < NT) SLOAD(SE, (j + 3) * KVBLK); SBAR();
    pv_d0(o, osum, vb0 + o_prev, pa0, pa1, pa2, pa3); partialSM<false>(pA0, pA1, m_ref, negm, alA);
    SWAIT(); SWRITE(o_next, SO);
    RESC(alA); __syncthreads(); ROT();
  }
  SBAR(); qkt(pB0, pB1, (bf16_t*)((char*)K_lds + o_cur), qr, negm, r32, hi);
  finishSM(pA0, pA1, pa0, pa1, pa2, pa3); SBAR();
  pv_d0(o, osum, vb0 + o_prev, pa0, pa1, pa2, pa3); partialSM<false>(pB0, pB1, m_ref, negm, alB);
  RESC(alB);
  finishSM(pB0, pB1, pa0, pa1, pa2, pa3); SBAR();
  pv_d0(o, osum, vb0 + o_cur, pa0, pa1, pa2, pa3);
  float rli[16];
#pragma unroll
  for (int r = 0; r < 16; ++r) rli[r] = __builtin_amdgcn_rcpf(osum[r]);
  bf16_t* Ow = Ob + (long)(wid * QBLK) * LDO;
#pragma unroll
  for (int r = 0; r < 16; ++r) { int orow = crow(r, hi);
#pragma unroll
    for (int d0 = 0; d0 < 2; ++d0) { const unsigned w = cvtpk(o[d0][r] * rli[r], 0.f); Ow[(long)orow * LDO + d0 * 32 + r32] = (bf16_t)(w & 0xffffu); } }
  __syncthreads();
#undef SLOAD
#undef SWRITE
#undef SWAIT
#undef RESC
#undef ROT
}
#undef KSWZ
#undef SBAR
}
namespace hg {
typedef unsigned short bf16_t;
using bf16x8 = __attribute__((ext_vector_type(8))) short;
using f32x16 = __attribute__((ext_vector_type(16))) float;
using f32x4  = __attribute__((ext_vector_type(4))) float;
using u32x4  = __attribute__((ext_vector_type(4))) unsigned;
#define SWZ256(row, colB) ((row) * 256 + ((colB) ^ (((row) & 7) << 4)))
#define SWZ128(row, colB) ((row) * 128 + ((colB) ^ (((((row) >> 4) ^ (row)) & 7) << 4)))
constexpr int GS = 132;
constexpr int L_ST = 0, L_QH = 32768, L_KH = 49152, L_KT = 65536, L_VT = 81920, L_GB = 98304, L_SEG = 98304 + 64 * GS * 4, L_DD = L_SEG + 2048, L_LB = L_DD + 512;
__device__ __forceinline__ int crow(int r, int hi) { return (r & 3) + 8 * (r >> 2) + 4 * hi; }
__device__ __forceinline__ unsigned cvtpk(float lo, float hi) { unsigned r; asm volatile("v_cvt_pk_bf16_f32 %0, %1, %2" : "=v"(r) : "v"(lo), "v"(hi)); return r; }
__device__ __forceinline__ float bf2f(unsigned short h) { return __uint_as_float(((unsigned)h) << 16); }
typedef float f32x2_t __attribute__((ext_vector_type(2))); typedef __bf16 bf16x2_t __attribute__((ext_vector_type(2)));
__device__ __forceinline__ unsigned cvtpk_m(float lo, float hi) { f32x2_t v = {lo, hi}; bf16x2_t b = __builtin_convertvector(v, bf16x2_t); return __builtin_bit_cast(unsigned, b); }
template <int MODE> __device__ __forceinline__ void chain(const bf16_t* __restrict__ U, bf16_t* __restrict__ OP, const float* __restrict__ hg_lb, int rowbase, int S, int h, int dir, int tau0, int nchunk,
                                                   const float* __restrict__ slot_in, float* __restrict__ slot_out, float* __restrict__ dseg_out, char* lds) {
  int tid_ = threadIdx.x; asm volatile("" : "+v"(tid_)); const int tid = tid_, wid = __builtin_amdgcn_readfirstlane(tid >> 6), lane = tid & 63, r32 = lane & 31, hi = lane >> 5;
  float* GB = (float*)(lds + L_GB); float* SEG = (float*)(lds + L_SEG); float* DD = (float*)(lds + L_DD); float* LB = (float*)(lds + L_LB);
  char* ST = lds + L_ST; char* QH = lds + L_QH; char* KH = lds + L_KH; char* KT = lds + L_KT; char* VT = lds + L_VT; char* AL = lds + L_GB;
  if (tid < 128) { const float a0 = hg_lb[dir * 1024 + h * 128 + tid], a1 = hg_lb[dir * 1024 + 512 + h * 128 + tid]; LB[tid] = 1.0f / (1.0f + __expf(a1 - a0)); }
  f32x16 sacc[2]; sacc[0] = f32x16{}; sacc[1] = f32x16{};
  if (MODE == 3) {
    if (slot_in) {
#pragma unroll
      for (int i = 0; i < 2; ++i)
#pragma unroll
        for (int r = 0; r < 16; ++r) sacc[i][r] = slot_in[(32 * (wid & 3) + crow(r, hi)) * 128 + 32 * (2 * (wid >> 2) + i) + r32];
    }
#pragma unroll
    for (int i = 0; i < 2; ++i)
#pragma unroll
      for (int r = 0; r < 16; ++r) *(bf16_t*)(ST + SWZ256(32 * (wid & 3) + crow(r, hi), 2 * (32 * (2 * (wid >> 2) + i) + r32))) = (bf16_t)(cvtpk(sacc[i][r], 0.f) & 0xffffu);
  }
  float dseg = 1.0f;
  const int tau = tid >> 3, c0 = (tid & 7) * 16, segt = tau >> 4;
  const bf16_t* Ub = U + (size_t)rowbase * 2560 + h * 128 + c0;
  const size_t offq = 0, offv = 512, offf = (size_t)(2 + dir) * 512;
  bf16_t* OPd = OP + (size_t)dir * T_ALL * 512;
  bf16x8 nq0 = {}, nq1 = {}, nv0, nv1, nf0, nf1;
  { const int t1 = tau0 + tau; const int tok = dir ? (S - 1 - t1) : t1; const bf16_t* p = Ub + (size_t)tok * 2560;
    if (MODE == 3) { nq0 = *(const bf16x8*)(p + offq); nq1 = *(const bf16x8*)(p + offq + 8); } nv0 = *(const bf16x8*)(p + offv); nv1 = *(const bf16x8*)(p + offv + 8); nf0 = *(const bf16x8*)(p + offf); nf1 = *(const bf16x8*)(p + offf + 8); }
  __syncthreads();
  for (int ci = 0; ci < nchunk; ++ci) {
    const bf16x8 qv[2] = {nq0, nq1}, vv[2] = {nv0, nv1}, fv[2] = {nf0, nf1};
    { const int cn = (ci + 1 < nchunk) ? ci + 1 : ci; const int t2 = tau0 + cn * 64 + tau; const int tok = dir ? (S - 1 - t2) : t2; const bf16_t* p = Ub + (size_t)tok * 2560;
      if (MODE == 3) { nq0 = *(const bf16x8*)(p + offq); nq1 = *(const bf16x8*)(p + offq + 8); } nv0 = *(const bf16x8*)(p + offv); nv1 = *(const bf16x8*)(p + offv + 8); nf0 = *(const bf16x8*)(p + offf); nf1 = *(const bf16x8*)(p + offf + 8); }
    float qq[16], kk[16];
#pragma unroll
    for (int j = 0; j < 16; ++j) {
      const float z = bf2f((unsigned short)fv[j >> 3][j & 7]); const float x = bf2f((unsigned short)qv[j >> 3][j & 7]);
      const float lbv = LB[c0 + j]; const float sg = __builtin_amdgcn_rcpf(1.0f + __builtin_amdgcn_exp2f(-1.4426950408889634f * z)); const float f = lbv + (1.0f - lbv) * sg;
      kk[j] = 1.0f - f; qq[j] = (MODE == 3) ? x * __builtin_amdgcn_rcpf(1.0f + __builtin_amdgcn_exp2f(-1.4426950408889634f * x)) : 0.f;
      GB[tau * GS + c0 + j] = __builtin_amdgcn_logf(f);
    }
    __syncthreads();
    { const int k = tid & 127, seg = tid >> 7; float run = 0.f;
#pragma unroll
      for (int j = 0; j < 16; ++j) { run += GB[(16 * seg + j) * GS + k]; GB[(16 * seg + j) * GS + k] = run; }
      SEG[seg * 128 + k] = run; }
    __syncthreads();
    { unsigned qh[8] = {}, kh[8] = {};
#pragma unroll
      for (int j = 0; j < 16; j += 2) {
        float g2[2], gl2[2];
#pragma unroll
        for (int e = 0; e < 2; ++e) { const int col = c0 + j + e; const float s0 = SEG[col], s1 = SEG[128 + col], s2 = SEG[256 + col];
          const float off = (segt >= 1 ? s0 : 0.f) + (segt >= 2 ? s1 : 0.f) + (segt >= 3 ? s2 : 0.f);
          g2[e] = GB[tau * GS + col] + off; gl2[e] = GB[63 * GS + col] + ((s0 + s1) + s2); }
        if (MODE == 3) { const float ea = __builtin_amdgcn_exp2f(g2[0]), eb = __builtin_amdgcn_exp2f(g2[1]);
          qh[j >> 1] = cvtpk(qq[j] * ea, qq[j + 1] * eb);
          kh[j >> 1] = cvtpk(kk[j] * __builtin_amdgcn_exp2f(fminf(-g2[0], 115.f)), kk[j + 1] * __builtin_amdgcn_exp2f(fminf(-g2[1], 115.f))); }
        const unsigned kt = cvtpk(kk[j] * __builtin_amdgcn_exp2f(gl2[0] - g2[0]), kk[j + 1] * __builtin_amdgcn_exp2f(gl2[1] - g2[1]));
        *(bf16_t*)(KT + SWZ128(c0 + j, 2 * tau)) = (bf16_t)(kt & 0xffffu); *(bf16_t*)(KT + SWZ128(c0 + j + 1, 2 * tau)) = (bf16_t)(kt >> 16);
        *(bf16_t*)(VT + SWZ128(c0 + j, 2 * tau)) = (bf16_t)vv[j >> 3][j & 7]; *(bf16_t*)(VT + SWZ128(c0 + j + 1, 2 * tau)) = (bf16_t)vv[(j + 1) >> 3][(j + 1) & 7];
        if (tau == 63) { DD[c0 + j] = __builtin_amdgcn_exp2f(gl2[0]); DD[c0 + j + 1] = __builtin_amdgcn_exp2f(gl2[1]); }
      }
      if (MODE == 3) {
      *(u32x4*)(QH + SWZ256(tau, 2 * c0)) = (u32x4){qh[0], qh[1], qh[2], qh[3]}; *(u32x4*)(QH + SWZ256(tau, 2 * c0 + 16)) = (u32x4){qh[4], qh[5], qh[6], qh[7]};
      *(u32x4*)(KH + SWZ256(tau, 2 * c0)) = (u32x4){kh[0], kh[1], kh[2], kh[3]}; *(u32x4*)(KH + SWZ256(tau, 2 * c0 + 16)) = (u32x4){kh[4], kh[5], kh[6], kh[7]}; }
    }
    __syncthreads();
    if (MODE == 3 && wid < 4 && wid != 1) { const int ti = wid >> 1, si = wid & 1; f32x16 a = f32x16{};
#pragma unroll
      for (int k8 = 0; k8 < 8; ++k8) { const int cb = (16 * k8 + 8 * hi) * 2;
        const bf16x8 av = *(const bf16x8*)(QH + SWZ256(32 * ti + r32, cb)); const bf16x8 bv = *(const bf16x8*)(KH + SWZ256(32 * si + r32, cb));
        a = __builtin_amdgcn_mfma_f32_32x32x16_bf16(av, bv, a, 0, 0, 0); }
#pragma unroll
      for (int r = 0; r < 16; ++r) { const int tl = 32 * ti + crow(r, hi), sl = 32 * si + r32; const float val = (sl <= tl) ? a[r] : 0.f;
        *(bf16_t*)(AL + SWZ128(tl, 2 * sl)) = (bf16_t)(cvtpk(val, 0.f) & 0xffffu); } }
    if (MODE == 3) __syncthreads();
    { const int th = wid >> 2, vb = wid & 3;
      if (MODE == 3) { f32x16 o = f32x16{};
      const int nks = th ? 4 : 2;
      for (int ks = 0; ks < nks; ++ks) { const int cb = (16 * ks + 8 * hi) * 2;
        const bf16x8 av = *(const bf16x8*)(AL + SWZ128(32 * th + r32, cb)); const bf16x8 bv = *(const bf16x8*)(VT + SWZ128(32 * vb + r32, cb));
        o = __builtin_amdgcn_mfma_f32_32x32x16_bf16(av, bv, o, 0, 0, 0); }
#pragma unroll
      for (int k8 = 0; k8 < 8; ++k8) { const int cb = (16 * k8 + 8 * hi) * 2;
        const bf16x8 av = *(const bf16x8*)(QH + SWZ256(32 * th + r32, cb)); const bf16x8 bv = *(const bf16x8*)(ST + SWZ256(32 * vb + r32, cb));
        o = __builtin_amdgcn_mfma_f32_32x32x16_bf16(av, bv, o, 0, 0, 0); }
#pragma unroll
      for (int r = 0; r < 16; ++r) { const int t2 = tau0 + ci * 64 + 32 * th + crow(r, hi); const int tok = dir ? (S - 1 - t2) : t2;
        OPd[(size_t)(rowbase + tok) * 512 + h * 128 + 32 * vb + r32] = (bf16_t)(cvtpk_m(o[r], 0.f) & 0xffffu); }
      } else { if (tid < 128) dseg *= DD[tid]; }
#pragma unroll
      for (int i = 0; i < 2; ++i) { const int kb = 2 * th + i; const float dk = DD[32 * kb + r32];
#pragma unroll
        for (int r = 0; r < 16; ++r) sacc[i][r] *= dk;
#pragma unroll
        for (int ks = 0; ks < 4; ++ks) { const int cb = (16 * ks + 8 * hi) * 2;
          const bf16x8 av = *(const bf16x8*)(VT + SWZ128(32 * vb + r32, cb)); const bf16x8 bv = *(const bf16x8*)(KT + SWZ128(32 * kb + r32, cb));
          sacc[i] = __builtin_amdgcn_mfma_f32_32x32x16_bf16(av, bv, sacc[i], 0, 0, 0); } }
    }
    __syncthreads();
    if (MODE == 3) { const int th = wid >> 2, vb = wid & 3;
#pragma unroll
      for (int i = 0; i < 2; ++i) { const int kb = 2 * th + i;
#pragma unroll
        for (int r = 0; r < 16; ++r) *(bf16_t*)(ST + SWZ256(32 * vb + crow(r, hi), 2 * (32 * kb + r32))) = (bf16_t)(cvtpk(sacc[i][r], 0.f) & 0xffffu); } }
  }
  if (MODE == 1) {
#pragma unroll
    for (int i = 0; i < 2; ++i)
#pragma unroll
      for (int r = 0; r < 16; ++r) slot_out[(32 * (wid & 3) + crow(r, hi)) * 128 + 32 * (2 * (wid >> 2) + i) + r32] = sacc[i][r];
    if (tid < 128) dseg_out[tid] = dseg;
  }
  __syncthreads();
}
#undef SWZ256
#undef SWZ128
}
typedef unsigned short bf16_t;
typedef float f32x4 __attribute__((ext_vector_type(4)));
typedef unsigned u32x4 __attribute__((ext_vector_type(4)));
typedef unsigned u32x2 __attribute__((ext_vector_type(2)));
typedef short bf16x8 __attribute__((ext_vector_type(8)));
#define LAS __attribute__((address_space(3)))
constexpr size_t MiB = 1u << 20;
constexpr size_t WS_SS = 0;
constexpr size_t WS_ROPEC = 6 * MiB, WS_ROPES = 7 * MiB;
constexpr size_t WS_W1GU = 16 * MiB, WS_W1D = 27 * MiB, WS_WIN = 33 * MiB, WS_WUQ = 40 * MiB, WS_WUKV = 41 * MiB, WS_WO = 42 * MiB, WS_W2GU = 44 * MiB, WS_W2D = 55 * MiB, WS_WPG = 61 * MiB, WS_WPP = 63 * MiB;
constexpr size_t WS_HB = 64 * MiB;
constexpr size_t WS_BIG = 256 * MiB;
constexpr size_t WS_UHG = WS_BIG, WS_UMLA = WS_BIG + 480 * MiB, WS_MIX = WS_BIG + 480 * MiB, WS_ACT = WS_BIG, WS_PROJ = WS_BIG;
constexpr size_t WS_PB = 928 * MiB;
constexpr size_t WS_SLOT = 976 * MiB;
constexpr size_t WS_DSEG = 8 * MiB;
constexpr size_t WS_END = 1024 * MiB;
constexpr size_t DO_Q = 0, DO_KN = 144 * MiB, DO_V = 240 * MiB, DO_KR = 336 * MiB;
constexpr int LDS_BYTES = 147456;
constexpr int LDS_BARST = 147392;
constexpr size_t WS_BAR = 12 * MiB;
#define XB_TMO      128
#define XB_XCNT(j)  (256  + 64 * (j))
#define XB_XSUB(j)  (1280 + 64 * (j))
#define XB_XGEN(j)  (2304 + 64 * (j))
#define XB_TOP      3328
#define XB_TOPGEN   3392
#define XCD_BAR_WORDS 3456
#define XB_SPIN_CAP (1u << 18)

__device__ __forceinline__ unsigned xb_ld(unsigned* p)              { return __hip_atomic_load(p, __ATOMIC_RELAXED, __HIP_MEMORY_SCOPE_AGENT); }
__device__ __forceinline__ unsigned xb_add(unsigned* p, unsigned v) { return __hip_atomic_fetch_add(p, v, __ATOMIC_RELAXED, __HIP_MEMORY_SCOPE_AGENT); }
__device__ __forceinline__ unsigned xb_xcc_id() { return (unsigned)__builtin_amdgcn_s_getreg((3 << 11) | 20) & 0xFu; }
#define XB_SPIN(cond, bar) do { unsigned _sp = 0; while (cond) { __builtin_amdgcn_s_sleep(1); \
    if ((++_sp & 255u) == 0u) { if (xb_ld(&(bar)[XB_TMO])) break; if (_sp > XB_SPIN_CAP) { atomicAdd(&(bar)[XB_TMO], 1u); break; } } } } while (0)

struct XcdBarrier {
    unsigned* bar; unsigned x;
    volatile LAS unsigned* st;
};

__device__ __forceinline__ XcdBarrier xcd_barrier_post(unsigned* bar, volatile LAS unsigned* st) {
    XcdBarrier b; b.bar = bar; b.x = xb_xcc_id(); b.st = st;
    if (threadIdx.x == 0) (void)xb_add(&bar[XB_XCNT(b.x)], 1u);
    return b;
}
__device__ __forceinline__ void xcd_barrier_complete(unsigned* bar, unsigned x, unsigned& nloc, unsigned& nx) {
    const unsigned G = gridDim.x * gridDim.y * gridDim.z;
    unsigned sum, cnt, mine, sp = 0u;
    for (;;) {
        sum = 0u; cnt = 0u; mine = 0u;
#pragma unroll
        for (unsigned j = 0; j < 16; ++j) { const unsigned c = xb_ld(&bar[XB_XCNT(j)]); sum += c; cnt += (c > 0u) ? 1u : 0u; mine = (j == x) ? c : mine; }
        if (sum == G) break;
        __builtin_amdgcn_s_sleep(1);
        if ((++sp & 255u) == 0u) { if (xb_ld(&bar[XB_TMO])) break; if (sp > XB_SPIN_CAP) { atomicAdd(&bar[XB_TMO], 1u); break; } }
    }
    nloc = mine > 0u ? mine : 1u; nx = cnt > 0u ? cnt : 1u;
}

__device__ __forceinline__ void xcd_barrier(const XcdBarrier& b) {
    asm volatile("s_waitcnt vmcnt(0)" ::: "memory");
    __syncthreads();
    if (threadIdx.x == 0) {
        unsigned* bar = b.bar;
        __builtin_amdgcn_s_waitcnt(0);
        unsigned nloc = b.st[0], nx = b.st[1];
        if (nloc == 0u) { xcd_barrier_complete(bar, b.x, nloc, nx); b.st[0] = nloc; b.st[1] = nx; }
        const unsigned old = xb_add(&bar[XB_XSUB(b.x)], 1u);
        const unsigned gen = old / nloc;
        if (old + 1u == (gen + 1u) * nloc) {
            __builtin_amdgcn_fence(__ATOMIC_RELEASE, "agent");
            asm volatile("s_waitcnt vmcnt(0)" ::: "memory");
            const unsigned og = xb_add(&bar[XB_TOP], 1u);
            const unsigned tg = og / nx;
            if (og + 1u == (tg + 1u) * nx) xb_add(&bar[XB_TOPGEN], 1u);
            else XB_SPIN(xb_ld(&bar[XB_TOPGEN]) == tg, bar);
            __builtin_amdgcn_fence(__ATOMIC_ACQUIRE, "agent");
            xb_add(&bar[XB_XGEN(b.x)], 1u);
            asm volatile("s_waitcnt vmcnt(0)" ::: "memory");
        } else {
            XB_SPIN(xb_ld(&bar[XB_XGEN(b.x)]) == gen, bar);
            __builtin_amdgcn_fence(__ATOMIC_ACQUIRE, "agent");
            asm volatile("s_waitcnt vmcnt(0)" ::: "memory");
        }
    }
    __syncthreads();
}


struct Params {
  const float* in[26];
  float* out; unsigned char* ws;
};

__device__ __forceinline__ unsigned f2bf(float f) { unsigned u = __builtin_bit_cast(unsigned, f); return (u + 0x7fffu + ((u >> 16) & 1u)) >> 16; }
__device__ __forceinline__ unsigned pk2(float lo, float hi) { return f2bf(lo) | (f2bf(hi) << 16); }
__device__ __forceinline__ float wave_sum(float v) {
#pragma unroll
  for (int o = 1; o < 64; o <<= 1) v += __shfl_xor(v, o);
  return v;
}
__device__ __forceinline__ void prep_item(const float* W, int ld, int col0, const float* fold, bf16_t* WT, int K, int n0, int k0, float* scr, int lane, bool perm) {
#pragma unroll 16
  for (int i = 0; i < 32; ++i) { const int kk = 2 * i + (lane >> 5); float v = 0.f; if (W) { const int p_ = lane & 31; const int cc = perm ? (16 * ((p_ >> 2) & 1) + 4 * (p_ >> 3) + (p_ & 3)) : p_; v = W[(size_t)(k0 + kk) * ld + col0 + cc]; if (fold) v *= fold[k0 + kk]; } scr[kk * 33 + (lane & 31)] = v; }
  asm volatile("s_waitcnt lgkmcnt(0)" ::: "memory");
  const int c = lane & 7;
#pragma unroll
  for (int j = 0; j < 4; ++j) { const int n = (lane >> 3) + 8 * j; const float* s = scr + (8 * c) * 33 + n;
    u32x4 o; o.x = pk2(s[0 * 33], s[1 * 33]); o.y = pk2(s[2 * 33], s[3 * 33]); o.z = pk2(s[4 * 33], s[5 * 33]); o.w = pk2(s[6 * 33], s[7 * 33]);
    *(u32x4*)(WT + (size_t)(n0 + n) * K + k0 + 8 * c) = o; }
  asm volatile("s_waitcnt lgkmcnt(0)" ::: "memory");
}
__device__ __forceinline__ void sincos_d(double x, float& s, float& c) {
  const double TWO_PI = 6.283185307179586476925286766559, INV_2PI = 0.15915494309189533576888376337251;
  double k = __builtin_rint(x * INV_2PI); double r = x - k * TWO_PI;
  const double HALF_PI = 1.5707963267948966192313216916398;
  double q = __builtin_rint(r * 0.63661977236758134308); double y = r - q * HALF_PI; int qi = ((int)q) & 3;
  double y2 = y * y;
  double sp = y * (1.0 + y2 * (-1.0 / 6 + y2 * (1.0 / 120 + y2 * (-1.0 / 5040 + y2 * (1.0 / 362880 + y2 * (-1.0 / 39916800 + y2 * (1.0 / 6227020800.0)))))));
  double cp = 1.0 + y2 * (-0.5 + y2 * (1.0 / 24 + y2 * (-1.0 / 720 + y2 * (1.0 / 40320 + y2 * (-1.0 / 3628800 + y2 * (1.0 / 479001600.0 + y2 * (-1.0 / 87178291200.0)))))));
  double ss, cc;
  if (qi == 0) { ss = sp; cc = cp; } else if (qi == 1) { ss = cp; cc = -sp; } else if (qi == 2) { ss = -sp; cc = -cp; } else { ss = -cp; cc = sp; }
  s = (float)ss; c = (float)cc;
}

__device__ __forceinline__ void p0_prologue(const Params& P, unsigned char* ws, char* lds) {
  int tid_ = threadIdx.x; asm volatile("" : "+v"(tid_)); const int tid = tid_, lane = tid & 63, wave = tid >> 6;
  const int gw = blockIdx.x * 8 + wave, NGW = gridDim.x * 8;
  float* scr = (float*)(lds + wave * 16384);
  constexpr int NJ = 10;
  const int jN[NJ] = {NGU, 1024, NIN, 768, 1024, 1024, NGU, 1024, 1024, 1024};
  const int jK[NJ] = {1024, DFF, 1024, 384, 256, 1024, 1024, DFF, 1024, 256};
  int total = 0;
#pragma unroll
  for (int j = 0; j < NJ; ++j) total += (jN[j] / 32) * (jK[j] / 64);
  const int gwp = blockIdx.x * 4 + (wave & 3), NGWP = gridDim.x * 4;
  if (wave < 4)
  for (int it = gwp; it < total; it += NGWP) {
    int r = it, job = 0;
#pragma unroll
    for (int j = 0; j < NJ; ++j) { const int cnt = (jN[j] / 32) * (jK[j] / 64); if (job == j && r >= cnt) { r -= cnt; job = j + 1; } }
    int N = 0, K = 0;
#pragma unroll
    for (int j = 0; j < NJ; ++j) if (job == j) { N = jN[j]; K = jK[j]; }
    const int nblk = N / 32, kb = r / nblk, nb = r % nblk, k0 = 64 * kb, n0 = 32 * nb;
    const float* W = nullptr; int ld = 0, col0 = 0; const float* fold = nullptr; bf16_t* WT = nullptr;
    if (job == 0 || job == 6) { const int t = n0 >> 8, half = (n0 >> 7) & 1, j0 = n0 & 127; const int b = (job == 0) ? 5 : 19;
      W = P.in[b + half]; ld = DFF; col0 = 128 * t + j0; fold = P.in[(job == 0) ? 4 : 18]; WT = (bf16_t*)(ws + ((job == 0) ? WS_W1GU : WS_W2GU)); }
    else if (job == 1 || job == 7) { W = P.in[(job == 1) ? 7 : 21]; ld = 1024; col0 = n0; WT = (bf16_t*)(ws + ((job == 1) ? WS_W1D : WS_W2D)); }
    else if (job == 2) { ld = 3232; fold = P.in[8]; WT = (bf16_t*)(ws + WS_WIN); W = P.in[9];
      if (n0 < 384) col0 = n0; else if (n0 < 416) col0 = 640 + (n0 - 384); else if (n0 < 512) W = nullptr; else if (n0 < 768) col0 = 384 + (n0 - 512); else col0 = 672 + (n0 - 768); }
    else if (job == 3) { W = P.in[11]; ld = 768; col0 = n0; fold = P.in[10]; WT = (bf16_t*)(ws + WS_WUQ); }
    else if (job == 4) { if (n0 < 512) { W = P.in[13]; col0 = n0; } else { W = P.in[14]; col0 = n0 - 512; } ld = 512; fold = P.in[12]; WT = (bf16_t*)(ws + WS_WUKV); }
    else if (job == 5) { W = P.in[17]; ld = 1024; col0 = n0; WT = (bf16_t*)(ws + WS_WO); }
    else if (job == 8) { W = P.in[23]; ld = 1024; col0 = n0; fold = P.in[22]; WT = (bf16_t*)(ws + WS_WPG); }
    else { W = P.in[24]; ld = 1024; col0 = n0; WT = (bf16_t*)(ws + WS_WPP); }
    prep_item(W, ld, col0, fold, WT, K, n0, k0, scr, lane, job == 2 && n0 == 384);
  }
  unsigned* ss = (unsigned*)(ws + WS_SS); bf16_t* HB = (bf16_t*)(ws + WS_HB); bf16_t* PB = (bf16_t*)(ws + WS_PB);
  if (wave >= 4)
  for (int m0 = gwp; m0 < T_ALL; m0 += 2 * NGWP) {
    f32x4 v[2][4], pv[2]; bool ok[2];
#pragma unroll
    for (int q = 0; q < 2; ++q) { const int m = m0 + q * NGWP; ok[q] = m < T_ALL; const int mm = ok[q] ? m : m0;
      const float* xr = (mm < T_P) ? P.in[0] + (size_t)mm * DM : P.in[1] + (size_t)(mm - T_P) * DM; const f32x4* x4 = (const f32x4*)xr + lane;
#pragma unroll
      for (int j = 0; j < 4; ++j) v[q][j] = x4[64 * j];
      const float* pr = (mm < T_P) ? P.in[2] + (size_t)mm * PLE : P.in[3] + (size_t)(mm - T_P) * PLE; pv[q] = ((const f32x4*)pr)[lane]; }
#pragma unroll
    for (int q = 0; q < 2; ++q) { const int m = m0 + q * NGWP; if (!ok[q]) continue; float s = 0.f;
#pragma unroll
      for (int j = 0; j < 4; ++j) s += (v[q][j][0] * v[q][j][0] + v[q][j][1] * v[q][j][1]) + (v[q][j][2] * v[q][j][2] + v[q][j][3] * v[q][j][3]);
      s = wave_sum(s);
      u32x2* o8 = (u32x2*)(HB + (size_t)m * DM) + lane;
#pragma unroll
      for (int j = 0; j < 4; ++j) { u32x2 w; w.x = pk2(v[q][j][0], v[q][j][1]); w.y = pk2(v[q][j][2], v[q][j][3]); o8[64 * j] = w; }
      u32x2 w; w.x = pk2(pv[q][0], pv[q][1]); w.y = pk2(pv[q][2], pv[q][3]); ((u32x2*)(PB + (size_t)m * PLE))[lane] = w;
      if (lane < 7) ss[(size_t)lane * T_ALL + m] = (lane == 0) ? (unsigned)(s * 4096.0f + 0.5f) : 0u; }
  }
  float* rc = (float*)(ws + WS_ROPEC); float* rs = (float*)(ws + WS_ROPES);
  for (int e = blockIdx.x * 512 + tid; e < S_P * 16; e += gridDim.x * 512) {
    const int pos = e >> 4, i = e & 15;
    const float cst = (float)(-9.210340371976184 / 32.0); const float arg = (float)(2 * i) * cst;
    const double a = (double)arg; const double nn = __builtin_rint(a * 1.4426950408889634); const double rr = a - nn * 0.69314718055994530942;
    double ex = 1.0 + rr * (1.0 + rr * (0.5 + rr * (1.0 / 6 + rr * (1.0 / 24 + rr * (1.0 / 120 + rr * (1.0 / 720 + rr * (1.0 / 5040 + rr * (1.0 / 40320 + rr * (1.0 / 362880 + rr * (1.0 / 3628800 + rr * (1.0 / 39916800)))))))))));
    ex = ex * __builtin_ldexp(1.0, (int)nn);
    const float invf = (float)ex; const float ang = (float)pos * invf;
    float sv, cv; sincos_d((double)ang, sv, cv); rc[e] = cv; rs[e] = sv;
  }
}
__device__ __forceinline__ void hg_combine(const bf16_t* OP, const bf16_t* U, const float* hg_norm, bf16_t* MIX) {
  int tid_ = threadIdx.x; asm volatile("" : "+v"(tid_)); const int lane = tid_ & 63, wave = tid_ >> 6; const int gw = blockIdx.x * 8 + wave, NGW = gridDim.x * 8;
  f32x4 gn0 = *(const f32x4*)(hg_norm + 8 * lane), gn1 = *(const f32x4*)(hg_norm + 8 * lane + 4);
  const float gnv[8] = {gn0[0], gn0[1], gn0[2], gn0[3], gn1[0], gn1[1], gn1[2], gn1[3]};
  for (int m = gw; m < T_ALL; m += NGW) {
    const bf16x8 a = *(const bf16x8*)(OP + (size_t)m * 512 + 8 * lane), b = *(const bf16x8*)(OP + (size_t)T_ALL * 512 + (size_t)m * 512 + 8 * lane);
    const bf16x8 g = *(const bf16x8*)(U + (size_t)m * 2560 + 2048 + 8 * lane);
    float ov[8]; float s = 0.f;
#pragma unroll
    for (int j = 0; j < 8; ++j) { ov[j] = __uint_as_float(((unsigned)(unsigned short)a[j]) << 16) + __uint_as_float(((unsigned)(unsigned short)b[j]) << 16); s += ov[j] * ov[j]; }
    s += __shfl_xor(s, 1); s += __shfl_xor(s, 2); s += __shfl_xor(s, 4); s += __shfl_xor(s, 8);
    const float r = rsqrtf(s * (1.0f / 128.0f) + EPS);
    unsigned w[4];
#pragma unroll
    for (int j = 0; j < 8; j += 2) { float r2[2];
#pragma unroll
      for (int e = 0; e < 2; ++e) { const float x = __uint_as_float(((unsigned)(unsigned short)g[j + e]) << 16); const float sl = x * __builtin_amdgcn_rcpf(1.0f + __builtin_amdgcn_exp2f(-1.4426950408889634f * x)); r2[e] = ov[j + e] * r * gnv[j + e] * sl; }
      w[j >> 1] = pk2(r2[0], r2[1]); }
    *(u32x4*)(MIX + (size_t)m * 1024 + 512 + 8 * lane) = (u32x4){w[0], w[1], w[2], w[3]};
  }
}
__device__ __forceinline__ void final_norm(float* out, const bf16_t* h4, const unsigned* ss4, const float* fn) {
  int tid_ = threadIdx.x; asm volatile("" : "+v"(tid_)); const int lane = tid_ & 63, wave = tid_ >> 6; const int gw = blockIdx.x * 8 + wave, NGW = gridDim.x * 8;
  f32x4 g[2][2];
#pragma unroll
  for (int j = 0; j < 2; ++j) { g[j][0] = *(const f32x4*)(fn + 512 * j + 8 * lane); g[j][1] = *(const f32x4*)(fn + 512 * j + 8 * lane + 4); }
  for (int m0 = gw; m0 < T_ALL; m0 += 2 * NGW) {
    u32x4 h[2][2]; float r[2]; bool ok[2];
#pragma unroll
    for (int q = 0; q < 2; ++q) { const int m = m0 + q * NGW; ok[q] = m < T_ALL; const int mm = ok[q] ? m : m0; r[q] = (float)ss4[mm] * (1.0f / 4096.0f);
#pragma unroll
      for (int j = 0; j < 2; ++j) h[q][j] = *(const u32x4*)(h4 + (size_t)mm * DM + 512 * j + 8 * lane); }
#pragma unroll
    for (int q = 0; q < 2; ++q) { const int m = m0 + q * NGW; if (!ok[q]) continue; const float rr = rsqrtf(r[q] * (1.0f / 1024.0f) + EPS);
#pragma unroll
      for (int j = 0; j < 2; ++j) { const u32x4 hh = h[q][j];
        f32x4 a, b; a[0] = __uint_as_float(hh.x << 16); a[1] = __uint_as_float(hh.x & 0xffff0000u); a[2] = __uint_as_float(hh.y << 16); a[3] = __uint_as_float(hh.y & 0xffff0000u);
        b[0] = __uint_as_float(hh.z << 16); b[1] = __uint_as_float(hh.z & 0xffff0000u); b[2] = __uint_as_float(hh.w << 16); b[3] = __uint_as_float(hh.w & 0xffff0000u);
        float* o = out + (size_t)m * DM + 512 * j + 8 * lane; *(f32x4*)o = a * rr * g[j][0]; *(f32x4*)(o + 4) = b * rr * g[j][1]; } }
  }
}

#define GSYNC() xcd_barrier(xbar)

template <class Epi> __device__ __forceinline__ void run_gemm(LAS unsigned char* lds, const bf16_t* A, int lda, const bf16_t* Bt, int ldb, int N, int K, const Epi& E) {
  pg8::Gemm g{A, Bt, T_ALL, N, K, lda, ldb}; pg8::StaticOrder S; S.init(T_ALL, N, (int)gridDim.x, (int)blockIdx.x);
  pg8::gemm_phase<Epi, pg8::StaticOrder, true, true>(lds, g, S, E);
}

__global__ void __launch_bounds__(512, 2) mk_fwd(Params P) {
  extern __shared__ __attribute__((aligned(16))) unsigned char lds[];
  unsigned char* ws = P.ws; float* out = P.out; unsigned char* dob = (unsigned char*)P.out;
  LAS unsigned char* l3 = (LAS unsigned char*)lds;
  pg8::ss_t* ss = (pg8::ss_t*)(ws + WS_SS);
  pg8::ss_t* ss0 = ss, *ss1 = ss + T_ALL, *ss2 = ss + 2 * (size_t)T_ALL, *ss3 = ss + 3 * (size_t)T_ALL, *ss4 = ss + 4 * (size_t)T_ALL, *ssq = ss + 5 * (size_t)T_ALL, *sskv = ss + 6 * (size_t)T_ALL;
  const float* ropec = (const float*)(ws + WS_ROPEC); const float* ropes = (const float*)(ws + WS_ROPES);
  bf16_t* HB = (bf16_t*)(ws + WS_HB); bf16_t* ACT = (bf16_t*)(ws + WS_ACT); bf16_t* UHG = (bf16_t*)(ws + WS_UHG); bf16_t* UMLA = (bf16_t*)(ws + WS_UMLA);
  bf16_t* MIX = (bf16_t*)(ws + WS_MIX); bf16_t* H4B = (bf16_t*)(ws + WS_MIX);     bf16_t* PROJ = (bf16_t*)P.out;     bf16_t* PB = (bf16_t*)(ws + WS_PB);
  bf16_t* Qb = (bf16_t*)(dob + DO_Q); bf16_t* KN = (bf16_t*)(dob + DO_KN); bf16_t* Vb = (bf16_t*)(dob + DO_V); bf16_t* KR = (bf16_t*)(dob + DO_KR);

  if (threadIdx.x < 16) ((LAS unsigned*)(l3 + LDS_BARST))[threadIdx.x] = 0u;
  if (blockIdx.x == 0) { for (int i = threadIdx.x; i < XCD_BAR_WORDS; i += 512) __hip_atomic_store((unsigned*)(ws + WS_BAR) + i, 0u, __ATOMIC_RELAXED, __HIP_MEMORY_SCOPE_AGENT); }
  p0_prologue(P, ws, (char*)lds);
  cg::this_grid().sync();
  const XcdBarrier xbar = xcd_barrier_post((unsigned*)(ws + WS_BAR), (volatile LAS unsigned*)(l3 + LDS_BARST));
  { pg8::EpiSwiGLU E{ACT, ss0}; run_gemm(l3, HB, 1024, (const bf16_t*)(ws + WS_W1GU), 1024, NGU, 1024, E); }
  GSYNC();
  { pg8::EpiRes<2> E{nullptr, nullptr, HB, nullptr, ss1, nullptr, nullptr}; run_gemm(l3, ACT, DFF, (const bf16_t*)(ws + WS_W1D), DFF, 1024, DFF, E); }
  GSYNC();
  { pg8::EpiWin E{UMLA, UHG, KR, ss1, ssq, sskv, ropec, ropes}; run_gemm(l3, HB, 1024, (const bf16_t*)(ws + WS_WIN), 1024, NIN, 1024, E); }
  GSYNC();
  { pg8::EpiBf E{Qb, Qb, 768, 1000, ssq, 1.0f / 384.0f, att::SCALE * 1.4426950408889634f}; run_gemm(l3, UMLA, 768, (const bf16_t*)(ws + WS_WUQ), 384, 768, 384, E); }
  { pg8::EpiBf E{KN, Vb, 512, 2, sskv, 1.0f / 256.0f, 1.0f}; run_gemm(l3, UMLA + 512, 768, (const bf16_t*)(ws + WS_WUKV), 256, 1024, 256, E); }
  {
    float* SLOT = (float*)(ws + WS_SLOT); float* DSEG = (float*)(ws + WS_DSEG);
    for (int u = blockIdx.x; u < 768; u += gridDim.x) {
      int chainid, seg, nseg;
      if (u < 256) { chainid = u >> 4; seg = u & 15; nseg = 16; } else { const int u2 = u - 256; chainid = 16 + (u2 >> 2); seg = u2 & 3; nseg = 4; }
      if (seg == nseg - 1) continue;
      int rowbase, S, h, dir;
      if (chainid < 16) { const int b = chainid >> 3; h = (chainid >> 1) & 3; dir = chainid & 1; rowbase = b * S_P; S = S_P; }
      else { const int c2 = chainid - 16; const int b = c2 >> 3; h = (c2 >> 1) & 3; dir = c2 & 1; rowbase = T_P + b * S_S; S = S_S; }
      hg::chain<1>(UHG, (bf16_t*)out, P.in[15], rowbase, S, h, dir, seg * 1024, 16, nullptr, SLOT + (size_t)u * 16384, DSEG + (size_t)u * 128, (char*)lds);
    }
  }
  GSYNC();
  {
    float* SLOT = (float*)(ws + WS_SLOT); const float* DSEG = (const float*)(ws + WS_DSEG);
    int tid_ = threadIdx.x; asm volatile("" : "+v"(tid_));
    for (int e = blockIdx.x * 512 + tid_; e < 144 * 16384; e += gridDim.x * 512) {
      const int chainid = e >> 14, el = e & 16383, k = el & 127;
      int u0, nseg; if (chainid < 16) { u0 = chainid * 16; nseg = 16; } else { u0 = 256 + (chainid - 16) * 4; nseg = 4; }
      float Sv = 0.f;
      if (nseg == 16) { float slv[15], dv[15];
#pragma unroll
        for (int s = 0; s < 15; ++s) { slv[s] = SLOT[(size_t)(u0 + s) * 16384 + el]; dv[s] = DSEG[(size_t)(u0 + s) * 128 + k]; }
#pragma unroll
        for (int s = 0; s < 15; ++s) { Sv = dv[s] * Sv + slv[s]; SLOT[(size_t)(u0 + s) * 16384 + el] = Sv; } }
      else { float slv[3], dv[3];
#pragma unroll
        for (int s = 0; s < 3; ++s) { slv[s] = SLOT[(size_t)(u0 + s) * 16384 + el]; dv[s] = DSEG[(size_t)(u0 + s) * 128 + k]; }
#pragma unroll
        for (int s = 0; s < 3; ++s) { Sv = dv[s] * Sv + slv[s]; SLOT[(size_t)(u0 + s) * 16384 + el] = Sv; } }
    }
  }
  {
    const int G = gridDim.x, bx = blockIdx.x;
    if (G == 256) {
      const int xcd = bx & 7, idx = bx >> 3;
      for (int i = 0; i < 12; ++i) {
        int rowbase, seq, h, qb;
        if (i < 4) { const int pair = 2 * xcd + (i >> 1); const int b = pair >> 3; h = pair & 7; qb = idx * 2 + (i & 1); rowbase = b * S_P; seq = S_P; }
        else { const int j = i - 4; const int pair = 16 * xcd + 2 * j + (idx >> 4); const int b = pair >> 3; h = pair & 7; qb = idx & 15; rowbase = T_P + b * S_S; seq = S_S; }
        att::attn_unit(Qb + (size_t)(rowbase + qb * 256) * 768 + h * 96, KN + (size_t)rowbase * 512 + h * 64, KR + (size_t)rowbase * 32, Vb + (size_t)rowbase * 512 + h * 64,
                       MIX + (size_t)(rowbase + qb * 256) * 1024 + h * 64, seq, rowbase + qb * 256, ropec, ropes, (char*)lds);
      }
    } else {
      for (int u = bx; u < 3072; u += G) {
        int rowbase, seq, h, qb;
        if (u < 1024) { const int pair = u >> 6; const int b = pair >> 3; h = pair & 7; qb = u & 63; rowbase = b * S_P; seq = S_P; }
        else { const int v = u - 1024; const int pair = v >> 4; const int b = pair >> 3; h = pair & 7; qb = v & 15; rowbase = T_P + b * S_S; seq = S_S; }
        att::attn_unit(Qb + (size_t)(rowbase + qb * 256) * 768 + h * 96, KN + (size_t)rowbase * 512 + h * 64, KR + (size_t)rowbase * 32, Vb + (size_t)rowbase * 512 + h * 64,
                       MIX + (size_t)(rowbase + qb * 256) * 1024 + h * 64, seq, rowbase + qb * 256, ropec, ropes, (char*)lds);
      }
    }
  }
  GSYNC();
  {
    const float* SLOT = (const float*)(ws + WS_SLOT);
    for (int u = blockIdx.x; u < 768; u += gridDim.x) {
      int chainid, seg;
      if (u < 256) { chainid = u >> 4; seg = u & 15; } else { const int u2 = u - 256; chainid = 16 + (u2 >> 2); seg = u2 & 3; }
      int rowbase, S, h, dir;
      if (chainid < 16) { const int b = chainid >> 3; h = (chainid >> 1) & 3; dir = chainid & 1; rowbase = b * S_P; S = S_P; }
      else { const int c2 = chainid - 16; const int b = c2 >> 3; h = (c2 >> 1) & 3; dir = c2 & 1; rowbase = T_P + b * S_S; S = S_S; }
      hg::chain<3>(UHG, (bf16_t*)out, P.in[15], rowbase, S, h, dir, seg * 1024, 16, seg ? SLOT + (size_t)(u - 1) * 16384 : nullptr, nullptr, nullptr, (char*)lds);
    }
  }
  GSYNC();
  hg_combine((const bf16_t*)out, UHG, P.in[16], MIX);
  GSYNC();
  { pg8::EpiRes<1> E{nullptr, nullptr, HB, nullptr, ss2, nullptr, nullptr}; run_gemm(l3, MIX, 1024, (const bf16_t*)(ws + WS_WO), 1024, 1024, 1024, E); }
  GSYNC();
  { pg8::EpiSwiGLU E{ACT, ss2}; run_gemm(l3, HB, 1024, (const bf16_t*)(ws + WS_W2GU), 1024, NGU, 1024, E); }
  GSYNC();
  { pg8::EpiRes<2> E{nullptr, nullptr, HB, nullptr, ss3, nullptr, nullptr}; run_gemm(l3, ACT, DFF, (const bf16_t*)(ws + WS_W2D), DFF, 1024, DFF, E); }
  { pg8::EpiBf E{PROJ, PROJ, 1024, 1000, nullptr, 0.f, 1.0f}; run_gemm(l3, PB, 256, (const bf16_t*)(ws + WS_WPP), 256, 1024, 256, E); }
  GSYNC();
  { pg8::EpiRes<3> E{nullptr, nullptr, HB, H4B, ss4, ss3, PROJ}; run_gemm(l3, HB, 1024, (const bf16_t*)(ws + WS_WPG), 1024, 1024, 1024, E); }
  GSYNC();
  final_norm(out, H4B, ss4, P.in[25]);
}

extern "C" void kernel_launch(void* const* d_in, const int* in_sizes, int n_in, void* d_out, int out_size, void* d_ws, size_t ws_size, hipStream_t stream) {
  static int grid = 0;
  if (grid == 0) {
    if (n_in != 26 || out_size != T_ALL * DM || ws_size < WS_END) { fprintf(stderr, "kernel_launch: unexpected shapes n_in %d out %d ws %zu\n", n_in, out_size, ws_size); grid = -1; return; }
    int dev = 0, cus = 0, per_cu = 0;
    if (hipGetDevice(&dev) != hipSuccess || hipDeviceGetAttribute(&cus, hipDeviceAttributeMultiprocessorCount, dev) != hipSuccess) { grid = -1; return; }
    if (hipFuncSetAttribute((const void*)mk_fwd, hipFuncAttributeMaxDynamicSharedMemorySize, LDS_BYTES) != hipSuccess) { fprintf(stderr, "kernel_launch: LDS attribute failed\n"); grid = -1; return; }
    if (hipOccupancyMaxActiveBlocksPerMultiprocessor(&per_cu, (const void*)mk_fwd, 512, LDS_BYTES) != hipSuccess || per_cu < 1) { fprintf(stderr, "kernel_launch: occupancy query says %d\n", per_cu); per_cu = 1; }
    (void)hipGetLastError();
    grid = cus;
  }
  if (grid < 0) return;
  Params p{};
  for (int i = 0; i < 26; ++i) p.in[i] = (const float*)d_in[i];
  p.out = (float*)d_out; p.ws = (unsigned char*)d_ws;
  void* args[] = {&p};
  hipError_t e = hipLaunchCooperativeKernel((void*)mk_fwd, dim3(grid), dim3(512), args, LDS_BYTES, stream);
  if (e != hipSuccess) fprintf(stderr, "cooperative launch failed: %s (grid %d)\n", hipGetErrorString(e), grid);
}
```

```cpp
#include <hip/hip_runtime.h>
#include <hip/hip_cooperative_groups.h>
#include <cstdio>
#include <cstdint>
namespace cg = cooperative_groups;

constexpr int DM = 1024, T_P = 32768, T_ALL = 98304, S_P = 16384, S_S = 4096;
constexpr int DFF = 2816, NGU = 5632, NIN = 3328, NMLA = 768, NHG = 2560, PLE = 256;
constexpr float EPS = 1e-6f;
__device__ __forceinline__ int row_pos(int row) { return row < T_P ? (row & (S_P - 1)) : (row & (S_S - 1)); }

namespace pg8 {
#define PG8_LAS __attribute__((address_space(3)))
typedef unsigned short bf16_t;
typedef short bf16x8 __attribute__((ext_vector_type(8)));
typedef float f32x4 __attribute__((ext_vector_type(4)));
typedef unsigned u32x4 __attribute__((ext_vector_type(4)));
constexpr int BM = 256, BK = 64, HALF = 128, HTB = HALF * BK * 2  , STAGE_BYTES = 8 * HTB, NXCD = 8, WGM = 8;

__host__ __device__ __forceinline__ int lds_byte(int r, int c) { const int st = (r >> 4) * 2 + (c >> 5), rr = r & 15, cc = c & 31, ob = rr * 64 + cc * 2; return st * 1024 + (ob ^ (((ob >> 9) & 1) << 5)); }
__host__ __device__ __forceinline__ void stage_rc(int b, int& R, int& C) { const int st = b / 1024, sb = b % 1024, swz = sb ^ (((sb >> 9) & 1) << 5); R = (st >> 1) * 16 + swz / 64; C = (st & 1) * 32 + (swz % 64) / 2; }
__host__ __device__ __forceinline__ int perm32(int rho) { const int n = rho >> 4, i = rho & 15; return 8 * (i >> 2) + 4 * n + (i & 3); }

struct Unit { int pm, pn; };
struct Gemm { const bf16_t* A; const bf16_t* Bt; int M, N, K, lda, ldb; };

struct StaticOrder {
    int nM, nN, nwg, G, c;
    __host__ __device__ void init(int M, int N, int G_, int c_) { nM = M / BM; nN = N / BM; nwg = nM * nN; G = G_; c = c_; }
    __host__ __device__ bool next(int i, Unit& u) const {
        const long L = (long)i * G + c; if (L >= nwg) return false;
        int wgid = (int)L; { const int q = nwg / NXCD, r = nwg % NXCD, xcd = wgid % NXCD, off = wgid / NXCD; wgid = (xcd < r ? xcd * (q + 1) : r * (q + 1) + (xcd - r) * q) + off; }
        const int nig = WGM * nN, gid = wgid / nig, fm = gid * WGM, gsz = (nM - fm) < WGM ? (nM - fm) : WGM;
        u.pm = fm + ((wgid % nig) % gsz); u.pn = (wgid % nig) / gsz; return true;
    }
    __device__ __forceinline__ void a_ready(const Unit&) const {}
    __device__ __forceinline__ void done(const Unit&) const {}
};
__device__ __forceinline__ unsigned cvt_pk_bf16(float lo, float hi) { unsigned r; asm volatile("v_cvt_pk_bf16_f32 %0, %1, %2" : "=v"(r) : "v"(lo), "v"(hi)); return r; }
typedef unsigned u32x2 __attribute__((ext_vector_type(2)));
__device__ __forceinline__ float bf2f(unsigned short h) { return __uint_as_float(((unsigned)h) << 16); }
__device__ __forceinline__ float fsigmoid(float x) { return __builtin_amdgcn_rcpf(1.0f + __builtin_amdgcn_exp2f(-1.4426950408889634f * x)); }
typedef unsigned ss_t;
__device__ __forceinline__ float ss_f(ss_t v) { return (float)v * (1.0f / 4096.0f); }
__device__ __forceinline__ void ss_add(ss_t* p, float v) { atomicAdd(p, (ss_t)(v * 4096.0f + 0.5f)); }
__device__ __forceinline__ float row_sum4(float s) { s += __shfl_xor(s, 16); s += __shfl_xor(s, 32); return s; }

struct EpiSwiGLU {
    static constexpr bool PERM = true, AFTER_DRAIN = false;
    bf16_t* O; const ss_t* ss;
    __device__ __forceinline__ void operator()(const f32x4 (&acc)[2][2][4][2], const Unit& u, int wr, int wc, int fr, int fq) const {
        const int row0 = u.pm * BM + wr * 64 + fr; const int col0 = u.pn * HALF + wc * 32 + 8 * fq;
        float ssv[2][4];
#pragma unroll
        for (int ai = 0; ai < 2; ++ai)
#pragma unroll
            for (int m = 0; m < 4; ++m) ssv[ai][m] = ss_f(ss[row0 + ai * HALF + m * 16]);
#pragma unroll
        for (int ai = 0; ai < 2; ++ai)
#pragma unroll
            for (int m = 0; m < 4; ++m) { const int row = row0 + ai * HALF + m * 16; const float r = __builtin_amdgcn_rsqf(ssv[ai][m] * (1.0f / 1024.0f) + 1e-6f);
                const float c1 = -1.4426950408889634f * r, r2 = r * r;
                f32x4 vv[2];
#pragma unroll
                for (int n = 0; n < 2; ++n) { const f32x4 a = acc[ai][0][m][n], b = acc[ai][1][m][n]; const f32x4 m1 = a * c1; f32x4 d;
                    d[0] = __builtin_amdgcn_exp2f(m1[0]); d[1] = __builtin_amdgcn_exp2f(m1[1]); d[2] = __builtin_amdgcn_exp2f(m1[2]); d[3] = __builtin_amdgcn_exp2f(m1[3]);
                    d = d + 1.0f; f32x4 inv; inv[0] = __builtin_amdgcn_rcpf(d[0]); inv[1] = __builtin_amdgcn_rcpf(d[1]); inv[2] = __builtin_amdgcn_rcpf(d[2]); inv[3] = __builtin_amdgcn_rcpf(d[3]);
                    vv[n] = (a * b) * (inv * r2); }
                u32x4 w; w.x = cvt_pk_bf16(vv[0][0], vv[0][1]); w.y = cvt_pk_bf16(vv[0][2], vv[0][3]); w.z = cvt_pk_bf16(vv[1][0], vv[1][1]); w.w = cvt_pk_bf16(vv[1][2], vv[1][3]);
                __builtin_nontemporal_store(w, (u32x4*)(O + (size_t)row * 2816 + col0)); }
    }
};
template <int MODE> struct EpiRes {
    static constexpr bool PERM = true, AFTER_DRAIN = false;
    const float* xp; const float* xs; bf16_t* hb; bf16_t* hout; ss_t* ssout; const ss_t* ssin; const bf16_t* proj;
    __device__ __forceinline__ void operator()(const f32x4 (&acc)[2][2][4][2], const Unit& u, int wr, int wc, int fr, int fq) const {
        const int row0 = u.pm * BM + wr * 64 + fr; const int col0 = u.pn * BM + wc * 32 + 8 * fq;
        float s3v[2][4];
        if (MODE == 3) {
#pragma unroll
            for (int ai = 0; ai < 2; ++ai)
#pragma unroll
                for (int m = 0; m < 4; ++m) s3v[ai][m] = ss_f(ssin[row0 + ai * HALF + m * 16]); }
#pragma unroll
        for (int ai = 0; ai < 2; ++ai) {
            u32x4 hpre[4][2];
            if (MODE != 0) {
#pragma unroll
                for (int m = 0; m < 4; ++m)
#pragma unroll
                    for (int bj = 0; bj < 2; ++bj) hpre[m][bj] = *(const u32x4*)(hb + (size_t)(row0 + ai * HALF + m * 16) * 1024 + col0 + bj * HALF); }
#pragma unroll
            for (int m = 0; m < 4; ++m) { const int row = row0 + ai * HALF + m * 16; float sq = 0.f; float r3 = 0.f;
                if (MODE == 3) r3 = __builtin_amdgcn_rsqf(s3v[ai][m] * (1.0f / 1024.0f) + 1e-6f);
#pragma unroll
                for (int bj = 0; bj < 2; ++bj) { const size_t off = (size_t)row * 1024 + col0 + bj * HALF; float b[8], v[8];
                    if (MODE == 0) { const float* xr = (row < 32768) ? (xp + off) : (xs + (off - (size_t)32768 * 1024)); const f32x4 b0 = *(const f32x4*)xr, b1 = *(const f32x4*)(xr + 4);
                        b[0] = b0[0]; b[1] = b0[1]; b[2] = b0[2]; b[3] = b0[3]; b[4] = b1[0]; b[5] = b1[1]; b[6] = b1[2]; b[7] = b1[3]; }
                    else { const u32x4 h4 = hpre[m][bj];
                        b[0] = __uint_as_float(h4.x << 16); b[1] = __uint_as_float(h4.x & 0xffff0000u); b[2] = __uint_as_float(h4.y << 16); b[3] = __uint_as_float(h4.y & 0xffff0000u);
                        b[4] = __uint_as_float(h4.z << 16); b[5] = __uint_as_float(h4.z & 0xffff0000u); b[6] = __uint_as_float(h4.w << 16); b[7] = __uint_as_float(h4.w & 0xffff0000u); }
                    if (MODE == 3) { const u32x4 p4 = *(const u32x4*)(proj + off); float pr[8];
                        pr[0] = __uint_as_float(p4.x << 16); pr[1] = __uint_as_float(p4.x & 0xffff0000u); pr[2] = __uint_as_float(p4.y << 16); pr[3] = __uint_as_float(p4.y & 0xffff0000u);
                        pr[4] = __uint_as_float(p4.z << 16); pr[5] = __uint_as_float(p4.z & 0xffff0000u); pr[6] = __uint_as_float(p4.w << 16); pr[7] = __uint_as_float(p4.w & 0xffff0000u);
#pragma unroll
                        for (int j = 0; j < 8; ++j) v[j] = b[j] + fsigmoid(acc[ai][bj][m][j >> 2][j & 3] * r3) * pr[j]; }
                    else {
#pragma unroll
                        for (int j = 0; j < 8; ++j) v[j] = b[j] + acc[ai][bj][m][j >> 2][j & 3] * ((MODE == 1) ? 1.0f : 0.5f); }
#pragma unroll
                    for (int j = 0; j < 8; ++j) sq += v[j] * v[j];
                    u32x4 w; w.x = cvt_pk_bf16(v[0], v[1]); w.y = cvt_pk_bf16(v[2], v[3]); w.z = cvt_pk_bf16(v[4], v[5]); w.w = cvt_pk_bf16(v[6], v[7]);
                    *(u32x4*)(((MODE == 3) ? hout : hb) + off) = w; }
                sq = row_sum4(sq);
                if (fq == 0) ss_add(ssout + row, sq); }
        }
    }
};
struct EpiWin {
    static constexpr bool PERM = true, AFTER_DRAIN = false;
    bf16_t* umla; bf16_t* uhg; bf16_t* kr; const ss_t* ss1; ss_t* ssq; ss_t* sskv; const float* ropec; const float* ropes;
    __device__ __forceinline__ void operator()(const f32x4 (&acc)[2][2][4][2], const Unit& u, int wr, int wc, int fr, int fq) const {
        const int row0 = u.pm * BM + wr * 64 + fr; const int pn = u.pn;
        bf16_t* dst; int ld, colt;
        if (pn < 3) { dst = umla; ld = 768; colt = pn * BM; } else { dst = uhg; ld = 2560; colt = (pn - 3) * BM; }
        const int col0 = colt + wc * 32 + 8 * fq;
        float ssv[2][4];
#pragma unroll
        for (int ai = 0; ai < 2; ++ai)
#pragma unroll
            for (int m = 0; m < 4; ++m) ssv[ai][m] = ss_f(ss1[row0 + ai * HALF + m * 16]);
#pragma unroll
        for (int ai = 0; ai < 2; ++ai)
#pragma unroll
            for (int m = 0; m < 4; ++m) { const int row = row0 + ai * HALF + m * 16; const float r = __builtin_amdgcn_rsqf(ssv[ai][m] * (1.0f / 1024.0f) + 1e-6f);
                float sq0 = 0.f, sq1 = 0.f; f32x4 v[2][2];
#pragma unroll
                for (int bj = 0; bj < 2; ++bj) {
#pragma unroll
                    for (int n = 0; n < 2; ++n) { v[bj][n] = acc[ai][bj][m][n] * r; const f32x4 x = v[bj][n]; const float s = (x[0] * x[0] + x[1] * x[1]) + (x[2] * x[2] + x[3] * x[3]); if (bj == 0) sq0 += s; else sq1 += s; }
                    u32x4 w; w.x = cvt_pk_bf16(v[bj][0][0], v[bj][0][1]); w.y = cvt_pk_bf16(v[bj][0][2], v[bj][0][3]); w.z = cvt_pk_bf16(v[bj][1][0], v[bj][1][1]); w.w = cvt_pk_bf16(v[bj][1][2], v[bj][1][3]);
                    __builtin_nontemporal_store(w, (u32x4*)(dst + (size_t)row * ld + col0 + bj * HALF)); }
                if (pn < 3) { float s = (pn == 1) ? sq0 : (sq0 + sq1); s = row_sum4(s); if (fq == 0) ss_add((pn == 2 ? sskv : ssq) + row, s); }
                if (pn == 1 && wc == 0) {
                    const int pos = row_pos(row); const f32x4 cs = *(const f32x4*)(ropec + pos * 16 + 4 * fq), sn = *(const f32x4*)(ropes + pos * 16 + 4 * fq);
                    const f32x4 x1 = v[1][0], x2 = v[1][1]; const f32x4 o1 = x1 * cs - x2 * sn, o2 = x1 * sn + x2 * cs;
                    u32x2 w1, w2; w1.x = cvt_pk_bf16(o1[0], o1[1]); w1.y = cvt_pk_bf16(o1[2], o1[3]); w2.x = cvt_pk_bf16(o2[0], o2[1]); w2.y = cvt_pk_bf16(o2[2], o2[3]);
                    *(u32x2*)(kr + (size_t)row * 32 + 4 * fq) = w1; *(u32x2*)(kr + (size_t)row * 32 + 16 + 4 * fq) = w2; } }
    }
};
struct EpiBf {
    static constexpr bool PERM = true, AFTER_DRAIN = false;
    bf16_t* O0; bf16_t* O1; int ld; int split; const ss_t* ss; float inv_n; float mul;
    __device__ __forceinline__ void operator()(const f32x4 (&acc)[2][2][4][2], const Unit& u, int wr, int wc, int fr, int fq) const {
        const int row0 = u.pm * BM + wr * 64 + fr; bf16_t* base = O0; int colt = u.pn * BM; if (u.pn >= split) { base = O1; colt = (u.pn - split) * BM; }
        const int col0 = colt + wc * 32 + 8 * fq;
#pragma unroll
        for (int ai = 0; ai < 2; ++ai)
#pragma unroll
            for (int m = 0; m < 4; ++m) { const int row = row0 + ai * HALF + m * 16; const float r = (ss ? rsqrtf(ss_f(ss[row]) * inv_n + 1e-6f) : 1.0f) * mul;
#pragma unroll
                for (int bj = 0; bj < 2; ++bj) { const f32x4 v0 = acc[ai][bj][m][0] * r, v1 = acc[ai][bj][m][1] * r;
                    u32x4 w; w.x = cvt_pk_bf16(v0[0], v0[1]); w.y = cvt_pk_bf16(v0[2], v0[3]); w.z = cvt_pk_bf16(v1[0], v1[1]); w.w = cvt_pk_bf16(v1[2], v1[3]);
                    *(u32x4*)(base + (size_t)row * ld + col0 + bj * HALF) = w; } }
    }
};
template <class Epi, class Sched, bool ALIGN_EPI = false, bool SP2 = false>
__device__ __forceinline__ void gemm_phase(PG8_LAS unsigned char* lds, const Gemm g, const Sched& S, const Epi& E) {
    int tid_ = threadIdx.x; asm volatile("" : "+v"(tid_)); const int tid = tid_, wid = __builtin_amdgcn_readfirstlane(tid >> 6), lane = tid & 63, wr = wid >> 2, wc = wid & 3, fr = lane & 15, fq = lane >> 4;
    const int K = g.K, nt = K / BK;
    unsigned voffA[2], voffB[2];
#pragma unroll
    for (int i = 0; i < 2; ++i) { int R, C; stage_rc(tid * 16 + i * 8192, R, C); const int Rb = Epi::PERM ? ((R & ~31) + perm32(R & 31)) : R;
        voffA[i] = (unsigned)(R * g.lda + C) * 2u; voffB[i] = (unsigned)(Rb * g.ldb + C) * 2u; }
    const size_t kstep = (size_t)(BK * 2);
    const size_t hstepA = (size_t)HALF * g.lda * 2, hstepB = (size_t)HALF * g.ldb * 2;
    const size_t tstepA = 2 * hstepA, tstepB = 2 * hstepB;
    const unsigned ldsw = (unsigned)wid * 1024u;
    const int aoff = lds_byte(wr * 64 + fr, fq * 8), boff = lds_byte(wc * 32 + fr, fq * 8);
#define PG8_SA(b, h) (((b) * 2 + (h)) * HTB)
#define PG8_SB(b, h) ((4 + (b) * 2 + (h)) * HTB)
#define PG8_STAGE(bufoff, gbase, voff) do { _Pragma("unroll") for (int _i = 0; _i < 2; ++_i) \
        __builtin_amdgcn_global_load_lds((const unsigned*)((const char*)(gbase) + (voff)[_i]), (PG8_LAS unsigned*)(lds + (bufoff) + ldsw + _i * 8192), 16, 0, 0); } while (0)
#define PG8_LDA(dst, b, h) do { _Pragma("unroll") for (int m = 0; m < 4; ++m) _Pragma("unroll") for (int k = 0; k < 2; ++k) dst[m][k] = *(const PG8_LAS bf16x8*)(lds + PG8_SA(b, h) + aoff + m * 2048 + k * 1024); } while (0)
#define PG8_LDB(dst, b, h) do { _Pragma("unroll") for (int n = 0; n < 2; ++n) _Pragma("unroll") for (int k = 0; k < 2; ++k) dst[n][k] = *(const PG8_LAS bf16x8*)(lds + PG8_SB(b, h) + boff + n * 2048 + k * 1024); } while (0)
#define PG8_MMA(ai, bj, At, Bt) do { __builtin_amdgcn_s_setprio(1); _Pragma("unroll") for (int m = 0; m < 4; ++m) _Pragma("unroll") for (int n = 0; n < 2; ++n) _Pragma("unroll") for (int k = 0; k < 2; ++k) \
        acc[ai][bj][m][n] = __builtin_amdgcn_mfma_f32_16x16x32_bf16(Bt[n][k], At[m][k], acc[ai][bj][m][n], 0, 0, 0); __builtin_amdgcn_s_setprio(0); } while (0)
#define PG8_WAIT_V(n) asm volatile("s_waitcnt vmcnt(" #n ")" ::: "memory")
#define PG8_WAIT_L(n) asm volatile("s_waitcnt lgkmcnt(" #n ")" ::: "memory")
#define PG8_BAR __builtin_amdgcn_s_barrier()
#define PG8_SCHED __builtin_amdgcn_sched_barrier(0)
    Unit cur, nxt; int ui = 0;
    if (!S.next(0, cur)) return;
    f32x4 acc[2][2][4][2];
#pragma unroll
    for (int a = 0; a < 2; ++a)
#pragma unroll
        for (int b = 0; b < 2; ++b)
#pragma unroll
            for (int m = 0; m < 4; ++m)
#pragma unroll
                for (int n = 0; n < 2; ++n) acc[a][b][m][n] = (f32x4){0.f, 0.f, 0.f, 0.f};
    bf16x8 At[4][2], B0[2][2], B1[2][2];
    const char* cA = (const char*)g.A + (size_t)cur.pm * tstepA; const char* cB = (const char*)g.Bt + (size_t)cur.pn * tstepB;
    S.a_ready(cur);
    if constexpr (SP2) {
        PG8_STAGE(PG8_SB(0, 0), cB, voffB); PG8_STAGE(PG8_SB(0, 1), cB + hstepB, voffB); PG8_STAGE(PG8_SA(0, 0), cA, voffA); PG8_STAGE(PG8_SA(0, 1), cA + hstepA, voffA);
        if (wr == 1) PG8_BAR;
        PG8_WAIT_V(2); PG8_BAR;
        PG8_STAGE(PG8_SB(1, 0), cB + kstep, voffB); PG8_STAGE(PG8_SA(1, 0), cA + kstep, voffA); PG8_STAGE(PG8_SB(1, 1), cB + hstepB + kstep, voffB);
        PG8_WAIT_V(6); PG8_BAR;
    } else {
        PG8_STAGE(PG8_SB(0, 0), cB, voffB); PG8_STAGE(PG8_SA(0, 0), cA, voffA); PG8_STAGE(PG8_SB(0, 1), cB + hstepB, voffB); PG8_STAGE(PG8_SA(0, 1), cA + hstepA, voffA);
        if (wr == 1) PG8_BAR;
        PG8_WAIT_V(4); PG8_BAR;
        PG8_STAGE(PG8_SB(1, 0), cB + kstep, voffB); PG8_STAGE(PG8_SA(1, 0), cA + kstep, voffA); PG8_STAGE(PG8_SB(1, 1), cB + hstepB + kstep, voffB);
        PG8_WAIT_V(6); PG8_BAR;
    }
    for (;;) {
        const bool has_next = S.next(ui + 1, nxt);
        const char* nA = has_next ? (const char*)g.A + (size_t)nxt.pm * tstepA : cA; const char* nB = has_next ? (const char*)g.Bt + (size_t)nxt.pn * tstepB : cB;
        for (int t = 0; t < nt; t += 2) {
            const bool last = (t == nt - 2);
            const char* a1 = cA + (size_t)(t + 1) * kstep;
            const char* a2 = last ? nA : cA + (size_t)(t + 2) * kstep; const char* b2 = last ? nB : cB + (size_t)(t + 2) * kstep;
            const char* a3 = a2 + kstep; const char* b3 = b2 + kstep;
            if (last && has_next) S.a_ready(nxt);
            if constexpr (SP2) {
            PG8_LDB(B0, 0, 0); PG8_LDB(B1, 0, 1); PG8_SCHED; PG8_LDA(At, 0, 0); PG8_STAGE(PG8_SA(1, 1), a1 + hstepA, voffA);
            PG8_WAIT_V(8); PG8_WAIT_L(0); PG8_BAR; PG8_MMA(0, 0, At, B0); PG8_MMA(0, 1, At, B1); PG8_BAR; PG8_SCHED;
            PG8_LDA(At, 0, 1); PG8_STAGE(PG8_SB(0, 0), b2, voffB); PG8_STAGE(PG8_SB(0, 1), b2 + hstepB, voffB); PG8_STAGE(PG8_SA(0, 0), a2, voffA);
            PG8_WAIT_V(8); PG8_WAIT_L(0); PG8_BAR; PG8_MMA(1, 0, At, B0); PG8_MMA(1, 1, At, B1); PG8_BAR; PG8_SCHED;
            PG8_LDB(B0, 1, 0); PG8_LDB(B1, 1, 1); PG8_SCHED; PG8_LDA(At, 1, 0); PG8_STAGE(PG8_SA(0, 1), a2 + hstepA, voffA);
            PG8_WAIT_V(8); PG8_WAIT_L(0); PG8_BAR; PG8_MMA(0, 0, At, B0); PG8_MMA(0, 1, At, B1); PG8_BAR; PG8_SCHED;
            PG8_LDA(At, 1, 1); PG8_STAGE(PG8_SB(1, 0), b3, voffB); PG8_STAGE(PG8_SB(1, 1), b3 + hstepB, voffB); PG8_STAGE(PG8_SA(1, 0), a3, voffA);
            PG8_WAIT_V(8); PG8_WAIT_L(0); PG8_BAR; PG8_MMA(1, 0, At, B0); PG8_MMA(1, 1, At, B1); PG8_BAR; PG8_SCHED;
            } else {
            PG8_LDB(B0, 0, 0); PG8_SCHED; PG8_LDA(At, 0, 0); PG8_STAGE(PG8_SA(1, 1), a1 + hstepA, voffA);
            PG8_WAIT_L(8); PG8_BAR; PG8_WAIT_L(0); PG8_MMA(0, 0, At, B0); PG8_BAR; PG8_SCHED;
            PG8_LDB(B1, 0, 1); PG8_STAGE(PG8_SB(0, 0), b2, voffB);
            PG8_BAR; PG8_WAIT_L(0); PG8_MMA(0, 1, At, B1); PG8_BAR;
            PG8_LDA(At, 0, 1); PG8_STAGE(PG8_SA(0, 0), a2, voffA);
            PG8_BAR; PG8_WAIT_L(0); PG8_MMA(1, 0, At, B0); PG8_BAR; PG8_SCHED;
            PG8_STAGE(PG8_SB(0, 1), b2 + hstepB, voffB);
            PG8_WAIT_V(6); PG8_BAR; PG8_MMA(1, 1, At, B1); PG8_BAR;
            PG8_LDB(B0, 1, 0); PG8_SCHED; PG8_LDA(At, 1, 0); PG8_STAGE(PG8_SA(0, 1), a2 + hstepA, voffA);
            PG8_WAIT_L(8); PG8_BAR; PG8_WAIT_L(0); PG8_MMA(0, 0, At, B0); PG8_BAR; PG8_SCHED;
            PG8_LDB(B1, 1, 1); PG8_STAGE(PG8_SB(1, 0), b3, voffB);
            PG8_BAR; PG8_WAIT_L(0); PG8_MMA(0, 1, At, B1); PG8_BAR;
            PG8_LDA(At, 1, 1); PG8_STAGE(PG8_SA(1, 0), a3, voffA);
            PG8_BAR; PG8_WAIT_L(0); PG8_MMA(1, 0, At, B0); PG8_BAR; PG8_SCHED;
            PG8_STAGE(PG8_SB(1, 1), b3 + hstepB, voffB);
            PG8_WAIT_V(6); PG8_BAR; PG8_MMA(1, 1, At, B1); PG8_BAR;
            }
        }
        if constexpr (ALIGN_EPI) { if (wr == 0) PG8_BAR; }
        if constexpr (!Epi::AFTER_DRAIN) { E(acc, cur, wr, wc, fr, fq); S.done(cur); }
        if (!has_next) break;
#pragma unroll
        for (int a = 0; a < 2; ++a)
#pragma unroll
            for (int b = 0; b < 2; ++b)
#pragma unroll
                for (int m = 0; m < 4; ++m)
#pragma unroll
                    for (int n = 0; n < 2; ++n) acc[a][b][m][n] = (f32x4){0.f, 0.f, 0.f, 0.f};
        cur = nxt; cA = nA; cB = nB; ++ui;
        if constexpr (ALIGN_EPI) { if (wr == 1) PG8_BAR; }
    }
    PG8_WAIT_V(0);
    if constexpr (!ALIGN_EPI) { if (wr == 0) PG8_BAR; }
    PG8_BAR;
    if constexpr (Epi::AFTER_DRAIN) { E.fused(acc, cur, wr, wc, fr, fq, lds, wid, lane); S.done(cur); }
#undef PG8_SA
#undef PG8_SB
#undef PG8_STAGE
#undef PG8_LDA
#undef PG8_LDB
#undef PG8_MMA
#undef PG8_WAIT_V
#undef PG8_WAIT_L
#undef PG8_BAR
#undef PG8_SCHED
}
}

namespace att {
typedef unsigned short bf16_t;
using bf16x8 = __attribute__((ext_vector_type(8))) short;
using s16x4  = __attribute__((ext_vector_type(4))) short;
using f32x16 = __attribute__((ext_vector_type(16))) float;
using u32x4  = __attribute__((ext_vector_type(4))) unsigned;
constexpr int NW = 8, QBLK = 32, KVBLK = 64;
constexpr float SCALE = 0.10206207261596575f;
constexpr float THR = 8.f;
constexpr int LDQ = 768, LDKN = 512, LDKR = 32, LDV = 512, LDO = 1024;
constexpr int SHM_V = 64 * 128 * 2, SHM_K = 64 * 128 * 2;
#define KSWZ(row, colB) ((row) * 256 + ((colB) ^ (((row) & 7) << 4)))
#define SBAR() __builtin_amdgcn_sched_barrier(0)
__device__ __forceinline__ int crow(int r, int hi) { return (r & 3) + 8 * (r >> 2) + 4 * hi; }
__device__ __forceinline__ unsigned cvtpk(float lo, float hi) { unsigned r; asm volatile("v_cvt_pk_bf16_f32 %0, %1, %2" : "=v"(r) : "v"(lo), "v"(hi)); return r; }
template <bool FIRST> __device__ __forceinline__ void partialSM(f32x16& p0, f32x16& p1, float& m_ref, f32x16& negm, float& alpha) {
  constexpr float THR2 = THR * 1.4426950408889634f;
  float pmax = p0[0];
#pragma unroll
  for (int r = 1; r < 16; ++r) pmax = fmaxf(pmax, p0[r]);
#pragma unroll
  for (int r = 0; r < 16; ++r) pmax = fmaxf(pmax, p1[r]);
  { auto rr = __builtin_amdgcn_permlane32_swap(__float_as_uint(pmax), __float_as_uint(pmax), false, false);
    pmax = fmaxf(__uint_as_float(rr[0]), __uint_as_float(rr[1])); }
  alpha = 1.f;
  if (FIRST || !__builtin_expect(__all(pmax <= THR2), 1)) {
    const float dl = FIRST ? pmax : fmaxf(pmax, 0.f);
    m_ref += dl; alpha = FIRST ? 1.f : __builtin_amdgcn_exp2f(-dl);
#pragma unroll
    for (int r = 0; r < 16; ++r) { p0[r] -= dl; p1[r] -= dl; }
#pragma unroll
    for (int r = 0; r < 16; ++r) negm[r] = -m_ref;
    asm volatile("" : "+v"(negm));
  }
#pragma unroll
  for (int r = 0; r < 16; ++r) p0[r] = __builtin_amdgcn_exp2f(p0[r]);
}
__device__ __forceinline__ void finishSM(f32x16& p0, f32x16& p1, bf16x8& pa0, bf16x8& pa1, bf16x8& pa2, bf16x8& pa3) {
#pragma unroll
  for (int r = 0; r < 16; ++r) p1[r] = __builtin_amdgcn_exp2f(p1[r]);
#define PK4(P, BASE, OUT) do { unsigned a0 = cvtpk(P[BASE + 0], P[BASE + 1]), a1 = cvtpk(P[BASE + 2], P[BASE + 3]);   \
    unsigned b0 = cvtpk(P[BASE + 4], P[BASE + 5]), b1 = cvtpk(P[BASE + 6], P[BASE + 7]);                              \
    auto r0 = __builtin_amdgcn_permlane32_swap(a0, b0, false, false); auto r1 = __builtin_amdgcn_permlane32_swap(a1, b1, false, false); \
    u32x4 w = {r0[0], r1[0], r0[1], r1[1]}; OUT = *reinterpret_cast<bf16x8*>(&w); } while (0)
  PK4(p0, 0, pa0); PK4(p0, 8, pa1); PK4(p1, 0, pa2); PK4(p1, 8, pa3);
#undef PK4
}
__device__ __forceinline__ void qkt(f32x16& p0, f32x16& p1, const bf16_t* Ks, const bf16x8* qr, const f32x16& negm, int r32, int hi) {
#pragma unroll
  for (int d0 = 0; d0 < 6; ++d0) { int cb = (d0 * 16 + hi * 8) * 2;
    bf16x8 b0 = *reinterpret_cast<const bf16x8*>((const char*)Ks + KSWZ(r32, cb));
    bf16x8 b1 = *reinterpret_cast<const bf16x8*>((const char*)Ks + KSWZ(32 + r32, cb));
    if (d0 == 0) { p0 = __builtin_amdgcn_mfma_f32_32x32x16_bf16(b0, qr[0], negm, 0, 0, 0); p1 = __builtin_amdgcn_mfma_f32_32x32x16_bf16(b1, qr[0], negm, 0, 0, 0); }
    else { p0 = __builtin_amdgcn_mfma_f32_32x32x16_bf16(b0, qr[d0], p0, 0, 0, 0); p1 = __builtin_amdgcn_mfma_f32_32x32x16_bf16(b1, qr[d0], p1, 0, 0, 0); } }
}
__device__ __forceinline__ int v_st(int k, int c) { const int kk = (k & ~0xC) | ((k & 4) << 1) | ((k & 8) >> 1); return ((kk >> 3) * 4 + (c >> 5)) * 512 + ((kk & 7) * 32 + (c & 31)) * 2; }
__device__ __forceinline__ int v_rd_base(int lane) { return ((lane & 3) << 3) | (((lane >> 2) & 3) << 6) | (((lane >> 4) & 1) << 5) | (((lane >> 5) & 1) << 8); }
constexpr int v_rd_off(int d0, int ks, int half) { return d0 * 512 + ks * 4096 + half * 2048; }
template <int OFF> __device__ __forceinline__ s16x4 tr_read(int vb) {
  s16x4 r; asm volatile("ds_read_b64_tr_b16 %0, %1 offset:%2" : "=&v"(r) : "v"(vb), "i"(OFF) : "memory"); return r;
}
template <int D0> __device__ __forceinline__ void pv_one(f32x16& od, int vb, bf16x8 pa0, bf16x8 pa1, bf16x8 pa2, bf16x8 pa3) {
  const s16x4 l0 = tr_read<v_rd_off(D0, 0, 0)>(vb), h0 = tr_read<v_rd_off(D0, 0, 1)>(vb), l1 = tr_read<v_rd_off(D0, 1, 0)>(vb), h1 = tr_read<v_rd_off(D0, 1, 1)>(vb);
  const s16x4 l2 = tr_read<v_rd_off(D0, 2, 0)>(vb), h2 = tr_read<v_rd_off(D0, 2, 1)>(vb), l3 = tr_read<v_rd_off(D0, 3, 0)>(vb), h3 = tr_read<v_rd_off(D0, 3, 1)>(vb);
  asm volatile("s_waitcnt lgkmcnt(0)" ::: "memory"); SBAR();
#define PK(L, H) (bf16x8){L[0], L[1], L[2], L[3], H[0], H[1], H[2], H[3]}
  od = __builtin_amdgcn_mfma_f32_32x32x16_bf16(pa0, PK(l0, h0), od, 0, 0, 0);
  od = __builtin_amdgcn_mfma_f32_32x32x16_bf16(pa1, PK(l1, h1), od, 0, 0, 0);
  od = __builtin_amdgcn_mfma_f32_32x32x16_bf16(pa2, PK(l2, h2), od, 0, 0, 0);
  od = __builtin_amdgcn_mfma_f32_32x32x16_bf16(pa3, PK(l3, h3), od, 0, 0, 0);
#undef PK
}
__device__ __forceinline__ void pv_d0(f32x16* o, f32x16& osum, int vb, bf16x8 pa0, bf16x8 pa1, bf16x8 pa2, bf16x8 pa3) {
  pv_one<0>(o[0], vb, pa0, pa1, pa2, pa3); pv_one<1>(o[1], vb, pa0, pa1, pa2, pa3);
  const short one = (short)0x3F80; const bf16x8 ones = {one, one, one, one, one, one, one, one};
  osum = __builtin_amdgcn_mfma_f32_32x32x16_bf16(pa0, ones, osum, 0, 0, 0); osum = __builtin_amdgcn_mfma_f32_32x32x16_bf16(pa1, ones, osum, 0, 0, 0);
  osum = __builtin_amdgcn_mfma_f32_32x32x16_bf16(pa2, ones, osum, 0, 0, 0); osum = __builtin_amdgcn_mfma_f32_32x32x16_bf16(pa3, ones, osum, 0, 0, 0);
}
__device__ __forceinline__ void attn_unit(const bf16_t* __restrict__ Qb, const bf16_t* __restrict__ KNh, const bf16_t* __restrict__ KRb, const bf16_t* __restrict__ Vh,
                                          bf16_t* __restrict__ Ob, int seq, int qrow0, const float* __restrict__ ropec, const float* __restrict__ ropes, char* lds) {
  int tid_ = threadIdx.x; asm volatile("" : "+v"(tid_)); const int tid = tid_, wid = __builtin_amdgcn_readfirstlane(tid >> 6), lane = tid & 63, r32 = lane & 31, hi = lane >> 5;
  bf16_t* V_lds = (bf16_t*)lds; bf16_t* K_lds = (bf16_t*)(lds + 3 * SHM_V);
  float* ws = (float*)(lds + 3 * SHM_V + 3 * SHM_K) + wid * 64; float* al_l = ws + 32;
  float m_ref = 0.f; f32x16 o[2] = {}; f32x16 osum = {}; f32x16 negm = {}; asm volatile("" : "+v"(negm)); bf16x8 qr[6];
  const int srow = tid >> 3, sch = tid & 7, srow2 = tid >> 2, sch2 = tid & 3;
  const bf16_t* kp = KNh + (long)srow * LDKN + 8 * sch; const bf16_t* vp = Vh + (long)srow * LDV + 8 * sch; const bf16_t* rp = KRb + (long)(srow2 & 63) * LDKR + 8 * sch2;
  const int kst = KSWZ(srow, 16 * sch), vst = v_st(srow, 8 * sch), rst = KSWZ(srow2 & 63, 128 + 16 * sch2);
  const bool has_r = wid < 4;
  constexpr int BUF = SHM_V;
  const int vb0 = (int)(uintptr_t)V_lds + v_rd_base(lane);
  struct { bf16x8 v, k, r; } sr_[2];
#define SLOAD(i, k0) do { sr_[i].v = *reinterpret_cast<const bf16x8*>(vp + (long)(k0) * LDV); sr_[i].k = *reinterpret_cast<const bf16x8*>(kp + (long)(k0) * LDKN); \
    if (has_r) sr_[i].r = *reinterpret_cast<const bf16x8*>(rp + (long)(k0) * LDKR); } while (0)
#define SWRITE(off, i) do { *(bf16x8*)((char*)V_lds + (off) + vst) = sr_[i].v; *(bf16x8*)((char*)K_lds + (off) + kst) = sr_[i].k; \
    if (has_r) *(bf16x8*)((char*)K_lds + (off) + rst) = sr_[i].r; } while (0)
#define SWAIT() do { if (has_r) asm volatile("s_waitcnt vmcnt(3)" ::: "memory"); else asm volatile("s_waitcnt vmcnt(2)" ::: "memory"); } while (0)
  constexpr int SE = 0, SO = 1;
  const int NT = seq / KVBLK;
  SLOAD(SE, 0); SLOAD(SO, KVBLK);
  const bf16_t* Qw = Qb + (long)(wid * QBLK + r32) * LDQ + hi * 8;
#pragma unroll
  for (int d0 = 0; d0 < 6; ++d0) qr[d0] = *reinterpret_cast<const bf16x8*>(Qw + d0 * 16);
  {
    const int pos = row_pos(qrow0 + wid * QBLK + r32); const float* cp = ropec + pos * 16 + 8 * hi; const float* sp = ropes + pos * 16 + 8 * hi;
    unsigned w1[4], w2[4];
#pragma unroll
    for (int e = 0; e < 8; e += 2) { float o1[2], o2[2];
#pragma unroll
      for (int f = 0; f < 2; ++f) { const float x1 = __uint_as_float(((unsigned)(unsigned short)qr[4][e + f]) << 16), x2 = __uint_as_float(((unsigned)(unsigned short)qr[5][e + f]) << 16); const float c = cp[e + f], s = sp[e + f];
        o1[f] = x1 * c - x2 * s; o2[f] = x1 * s + x2 * c; }
      w1[e >> 1] = cvtpk(o1[0], o1[1]); w2[e >> 1] = cvtpk(o2[0], o2[1]); }
    u32x4 v1 = {w1[0], w1[1], w1[2], w1[3]}, v2 = {w2[0], w2[1], w2[2], w2[3]}; qr[4] = *reinterpret_cast<bf16x8*>(&v1); qr[5] = *reinterpret_cast<bf16x8*>(&v2); }
#define RESC(a) do { if (__any((a) < 1.f)) { if (hi == 0) al_l[r32] = (a); asm volatile("s_waitcnt lgkmcnt(0)" ::: "memory"); \
    _Pragma("unroll") for (int r = 0; r < 16; ++r) { const float f_ = al_l[crow(r, hi)]; o[0][r] *= f_; o[1][r] *= f_; osum[r] *= f_; } } } while (0)
#define ROT() do { const int t_ = o_prev; o_prev = o_cur; o_cur = o_next; o_next = t_; } while (0)
  f32x16 pA0, pA1, pB0, pB1; float alA, alB; bf16x8 pa0, pa1, pa2, pa3;
  int o_prev = 2 * BUF, o_cur = 0, o_next = BUF;
  asm volatile("s_waitcnt vmcnt(0)" ::: "memory"); SWRITE(0, SE); __syncthreads();
  qkt(pA0, pA1, K_lds, qr, negm, r32, hi); partialSM<true>(pA0, pA1, m_ref, negm, alA);
  if (2 < NT) SLOAD(SE, 2 * KVBLK);
  SWAIT(); SWRITE(BUF, SO); __syncthreads();
  ROT();
  for (int j = 1; j + 1 < NT; j += 2) {
    SBAR(); qkt(pB0, pB1, (bf16_t*)((char*)K_lds + o_cur), qr, negm, r32, hi);
    finishSM(pA0, pA1, pa0, pa1, pa2, pa3); SBAR();
    SLOAD(SO, (j + 2) * KVBLK); SBAR();
    pv_d0(o, osum, vb0 + o_prev, pa0, pa1, pa2, pa3); partialSM<false>(pB0, pB1, m_ref, negm, alB);
    SWAIT(); SWRITE(o_next, SE);
    RESC(alB); __syncthreads(); ROT();
    SBAR(); qkt(pA0, pA1, (bf16_t*)((char*)K_lds + o_cur), qr, negm, r32, hi);
    finishSM(pB0, pB1, pa0, pa1, pa2, pa3); SBAR();
    if (j + 3 < NT) SLOAD(SE, (j + 3) * KVBLK); SBAR();
    pv_d0(o, osum, vb0 + o_prev, pa0, pa1, pa2, pa3); partialSM<false>(pA0, pA1, m_ref, negm, alA);
    SWAIT(); SWRITE(o_next, SO);
    RESC(alA); __syncthreads(); ROT();
  }
  SBAR(); qkt(pB0, pB1, (bf16_t*)((char*)K_lds + o_cur), qr, negm, r32, hi);
  finishSM(pA0, pA1, pa0, pa1, pa2, pa3); SBAR();
  pv_d0(o, osum, vb0 + o_prev, pa0, pa1, pa2, pa3); partialSM<false>(pB0, pB1, m_ref, negm, alB);
  RESC(alB);
  finishSM(pB0, pB1, pa0, pa1, pa2, pa3); SBAR();
  pv_d0(o, osum, vb0 + o_cur, pa0, pa1, pa2, pa3);
  float rli[16];
#pragma unroll
  for (int r = 0; r < 16; ++r) rli[r] = __builtin_amdgcn_rcpf(osum[r]);
  bf16_t* Ow = Ob + (long)(wid * QBLK) * LDO;
#pragma unroll
  for (int r = 0; r < 16; ++r) { int orow = crow(r, hi);
#pragma unroll
    for (int d0 = 0; d0 < 2; ++d0) { const unsigned w = cvtpk(o[d0][r] * rli[r], 0.f); Ow[(long)orow * LDO + d0 * 32 + r32] = (bf16_t)(w & 0xffffu); } }
  __syncthreads();
#undef SLOAD
#undef SWRITE
#undef SWAIT
#undef RESC
#undef ROT
}
#undef KSWZ
#undef SBAR
}
namespace hg {
typedef unsigned short bf16_t;
using bf16x8 = __attribute__((ext_vector_type(8))) short;
using f32x16 = __attribute__((ext_vector_type(16))) float;
using f32x4  = __attribute__((ext_vector_type(4))) float;
using u32x4  = __attribute__((ext_vector_type(4))) unsigned;
#define SWZ256(row, colB) ((row) * 256 + ((colB) ^ (((row) & 7) << 4)))
#define SWZ128(row, colB) ((row) * 128 + ((colB) ^ (((((row) >> 4) ^ (row)) & 7) << 4)))
constexpr int GS = 132;
constexpr int L_ST = 0, L_QH = 32768, L_KH = 49152, L_KT = 65536, L_VT = 81920, L_GB = 98304, L_SEG = 98304 + 64 * GS * 4, L_DD = L_SEG + 2048, L_LB = L_DD + 512;
__device__ __forceinline__ int crow(int r, int hi) { return (r & 3) + 8 * (r >> 2) + 4 * hi; }
__device__ __forceinline__ unsigned cvtpk(float lo, float hi) { unsigned r; asm volatile("v_cvt_pk_bf16_f32 %0, %1, %2" : "=v"(r) : "v"(lo), "v"(hi)); return r; }
__device__ __forceinline__ float bf2f(unsigned short h) { return __uint_as_float(((unsigned)h) << 16); }
typedef float f32x2_t __attribute__((ext_vector_type(2))); typedef __bf16 bf16x2_t __attribute__((ext_vector_type(2)));
__device__ __forceinline__ unsigned cvtpk_m(float lo, float hi) { f32x2_t v = {lo, hi}; bf16x2_t b = __builtin_convertvector(v, bf16x2_t); return __builtin_bit_cast(unsigned, b); }
template <int MODE> __device__ __forceinline__ void chain(const bf16_t* __restrict__ U, bf16_t* __restrict__ OP, const float* __restrict__ hg_lb, int rowbase, int S, int h, int dir, int tau0, int nchunk,
                                                   const float* __restrict__ slot_in, float* __restrict__ slot_out, float* __restrict__ dseg_out, char* lds) {
  int tid_ = threadIdx.x; asm volatile("" : "+v"(tid_)); const int tid = tid_, wid = __builtin_amdgcn_readfirstlane(tid >> 6), lane = tid & 63, r32 = lane & 31, hi = lane >> 5;
  float* GB = (float*)(lds + L_GB); float* SEG = (float*)(lds + L_SEG); float* DD = (float*)(lds + L_DD); float* LB = (float*)(lds + L_LB);
  char* ST = lds + L_ST; char* QH = lds + L_QH; char* KH = lds + L_KH; char* KT = lds + L_KT; char* VT = lds + L_VT; char* AL = lds + L_GB;
  if (tid < 128) { const float a0 = hg_lb[dir * 1024 + h * 128 + tid], a1 = hg_lb[dir * 1024 + 512 + h * 128 + tid]; LB[tid] = 1.0f / (1.0f + __expf(a1 - a0)); }
  f32x16 sacc[2]; sacc[0] = f32x16{}; sacc[1] = f32x16{};
  if (MODE == 3) {
    if (slot_in) {
#pragma unroll
      for (int i = 0; i < 2; ++i)
#pragma unroll
        for (int r = 0; r < 16; ++r) sacc[i][r] = slot_in[(32 * (wid & 3) + crow(r, hi)) * 128 + 32 * (2 * (wid >> 2) + i) + r32];
    }
#pragma unroll
    for (int i = 0; i < 2; ++i)
#pragma unroll
      for (int r = 0; r < 16; ++r) *(bf16_t*)(ST + SWZ256(32 * (wid & 3) + crow(r, hi), 2 * (32 * (2 * (wid >> 2) + i) + r32))) = (bf16_t)(cvtpk(sacc[i][r], 0.f) & 0xffffu);
  }
  float dseg = 1.0f;
  const int tau = tid >> 3, c0 = (tid & 7) * 16, segt = tau >> 4;
  const bf16_t* Ub = U + (size_t)rowbase * 2560 + h * 128 + c0;
  const size_t offq = 0, offv = 512, offf = (size_t)(2 + dir) * 512;
  bf16_t* OPd = OP + (size_t)dir * T_ALL * 512;
  bf16x8 nq0 = {}, nq1 = {}, nv0, nv1, nf0, nf1;
  { const int t1 = tau0 + tau; const int tok = dir ? (S - 1 - t1) : t1; const bf16_t* p = Ub + (size_t)tok * 2560;
    if (MODE == 3) { nq0 = *(const bf16x8*)(p + offq); nq1 = *(const bf16x8*)(p + offq + 8); } nv0 = *(const bf16x8*)(p + offv); nv1 = *(const bf16x8*)(p + offv + 8); nf0 = *(const bf16x8*)(p + offf); nf1 = *(const bf16x8*)(p + offf + 8); }
  __syncthreads();
  for (int ci = 0; ci < nchunk; ++ci) {
    const bf16x8 qv[2] = {nq0, nq1}, vv[2] = {nv0, nv1}, fv[2] = {nf0, nf1};
    { const int cn = (ci + 1 < nchunk) ? ci + 1 : ci; const int t2 = tau0 + cn * 64 + tau; const int tok = dir ? (S - 1 - t2) : t2; const bf16_t* p = Ub + (size_t)tok * 2560;
      if (MODE == 3) { nq0 = *(const bf16x8*)(p + offq); nq1 = *(const bf16x8*)(p + offq + 8); } nv0 = *(const bf16x8*)(p + offv); nv1 = *(const bf16x8*)(p + offv + 8); nf0 = *(const bf16x8*)(p + offf); nf1 = *(const bf16x8*)(p + offf + 8); }
    float qq[16], kk[16];
#pragma unroll
    for (int j = 0; j < 16; ++j) {
      const float z = bf2f((unsigned short)fv[j >> 3][j & 7]); const float x = bf2f((unsigned short)qv[j >> 3][j & 7]);
      const float lbv = LB[c0 + j]; const float sg = __builtin_amdgcn_rcpf(1.0f + __builtin_amdgcn_exp2f(-1.4426950408889634f * z)); const float f = lbv + (1.0f - lbv) * sg;
      kk[j] = 1.0f - f; qq[j] = (MODE == 3) ? x * __builtin_amdgcn_rcpf(1.0f + __builtin_amdgcn_exp2f(-1.4426950408889634f * x)) : 0.f;
      GB[tau * GS + c0 + j] = __builtin_amdgcn_logf(f);
    }
    __syncthreads();
    { const int k = tid & 127, seg = tid >> 7; float run = 0.f;
#pragma unroll
      for (int j = 0; j < 16; ++j) { run += GB[(16 * seg + j) * GS + k]; GB[(16 * seg + j) * GS + k] = run; }
      SEG[seg * 128 + k] = run; }
    __syncthreads();
    { unsigned qh[8] = {}, kh[8] = {};
#pragma unroll
      for (int j = 0; j < 16; j += 2) {
        float g2[2], gl2[2];
#pragma unroll
        for (int e = 0; e < 2; ++e) { const int col = c0 + j + e; const float s0 = SEG[col], s1 = SEG[128 + col], s2 = SEG[256 + col];
          const float off = (segt >= 1 ? s0 : 0.f) + (segt >= 2 ? s1 : 0.f) + (segt >= 3 ? s2 : 0.f);
          g2[e] = GB[tau * GS + col] + off; gl2[e] = GB[63 * GS + col] + ((s0 + s1) + s2); }
        if (MODE == 3) { const float ea = __builtin_amdgcn_exp2f(g2[0]), eb = __builtin_amdgcn_exp2f(g2[1]);
          qh[j >> 1] = cvtpk(qq[j] * ea, qq[j + 1] * eb);
          kh[j >> 1] = cvtpk(kk[j] * __builtin_amdgcn_exp2f(fminf(-g2[0], 115.f)), kk[j + 1] * __builtin_amdgcn_exp2f(fminf(-g2[1], 115.f))); }
        const unsigned kt = cvtpk(kk[j] * __builtin_amdgcn_exp2f(gl2[0] - g2[0]), kk[j + 1] * __builtin_amdgcn_exp2f(gl2[1] - g2[1]));
        *(bf16_t*)(KT + SWZ128(c0 + j, 2 * tau)) = (bf16_t)(kt & 0xffffu); *(bf16_t*)(KT + SWZ128(c0 + j + 1, 2 * tau)) = (bf16_t)(kt >> 16);
        *(bf16_t*)(VT + SWZ128(c0 + j, 2 * tau)) = (bf16_t)vv[j >> 3][j & 7]; *(bf16_t*)(VT + SWZ128(c0 + j + 1, 2 * tau)) = (bf16_t)vv[(j + 1) >> 3][(j + 1) & 7];
        if (tau == 63) { DD[c0 + j] = __builtin_amdgcn_exp2f(gl2[0]); DD[c0 + j + 1] = __builtin_amdgcn_exp2f(gl2[1]); }
      }
      if (MODE == 3) {
      *(u32x4*)(QH + SWZ256(tau, 2 * c0)) = (u32x4){qh[0], qh[1], qh[2], qh[3]}; *(u32x4*)(QH + SWZ256(tau, 2 * c0 + 16)) = (u32x4){qh[4], qh[5], qh[6], qh[7]};
      *(u32x4*)(KH + SWZ256(tau, 2 * c0)) = (u32x4){kh[0], kh[1], kh[2], kh[3]}; *(u32x4*)(KH + SWZ256(tau, 2 * c0 + 16)) = (u32x4){kh[4], kh[5], kh[6], kh[7]}; }
    }
    __syncthreads();
    if (MODE == 3 && wid < 4 && wid != 1) { const int ti = wid >> 1, si = wid & 1; f32x16 a = f32x16{};
#pragma unroll
      for (int k8 = 0; k8 < 8; ++k8) { const int cb = (16 * k8 + 8 * hi) * 2;
        const bf16x8 av = *(const bf16x8*)(QH + SWZ256(32 * ti + r32, cb)); const bf16x8 bv = *(const bf16x8*)(KH + SWZ256(32 * si + r32, cb));
        a = __builtin_amdgcn_mfma_f32_32x32x16_bf16(av, bv, a, 0, 0, 0); }
#pragma unroll
      for (int r = 0; r < 16; ++r) { const int tl = 32 * ti + crow(r, hi), sl = 32 * si + r32; const float val = (sl <= tl) ? a[r] : 0.f;
        *(bf16_t*)(AL + SWZ128(tl, 2 * sl)) = (bf16_t)(cvtpk(val, 0.f) & 0xffffu); } }
    if (MODE == 3) __syncthreads();
    { const int th = wid >> 2, vb = wid & 3;
      if (MODE == 3) { f32x16 o = f32x16{};
      const int nks = th ? 4 : 2;
      for (int ks = 0; ks < nks; ++ks) { const int cb = (16 * ks + 8 * hi) * 2;
        const bf16x8 av = *(const bf16x8*)(AL + SWZ128(32 * th + r32, cb)); const bf16x8 bv = *(const bf16x8*)(VT + SWZ128(32 * vb + r32, cb));
        o = __builtin_amdgcn_mfma_f32_32x32x16_bf16(av, bv, o, 0, 0, 0); }
#pragma unroll
      for (int k8 = 0; k8 < 8; ++k8) { const int cb = (16 * k8 + 8 * hi) * 2;
        const bf16x8 av = *(const bf16x8*)(QH + SWZ256(32 * th + r32, cb)); const bf16x8 bv = *(const bf16x8*)(ST + SWZ256(32 * vb + r32, cb));
        o = __builtin_amdgcn_mfma_f32_32x32x16_bf16(av, bv, o, 0, 0, 0); }
#pragma unroll
      for (int r = 0; r < 16; ++r) { const int t2 = tau0 + ci * 64 + 32 * th + crow(r, hi); const int tok = dir ? (S - 1 - t2) : t2;
        OPd[(size_t)(rowbase + tok) * 512 + h * 128 + 32 * vb + r32] = (bf16_t)(cvtpk_m(o[r], 0.f) & 0xffffu); }
      } else { if (tid < 128) dseg *= DD[tid]; }
#pragma unroll
      for (int i = 0; i < 2; ++i) { const int kb = 2 * th + i; const float dk = DD[32 * kb + r32];
#pragma unroll
        for (int r = 0; r < 16; ++r) sacc[i][r] *= dk;
#pragma unroll
        for (int ks = 0; ks < 4; ++ks) { const int cb = (16 * ks + 8 * hi) * 2;
          const bf16x8 av = *(const bf16x8*)(VT + SWZ128(32 * vb + r32, cb)); const bf16x8 bv = *(const bf16x8*)(KT + SWZ128(32 * kb + r32, cb));
          sacc[i] = __builtin_amdgcn_mfma_f32_32x32x16_bf16(av, bv, sacc[i], 0, 0, 0); } }
    }
    __syncthreads();
    if (MODE == 3) { const int th = wid >> 2, vb = wid & 3;
#pragma unroll
      for (int i = 0; i < 2; ++i) { const int kb = 2 * th + i;
#pragma unroll
        for (int r = 0; r < 16; ++r) *(bf16_t*)(ST + SWZ256(32 * vb + crow(r, hi), 2 * (32 * kb + r32))) = (bf16_t)(cvtpk(sacc[i][r], 0.f) & 0xffffu); } }
  }
  if (MODE == 1) {
#pragma unroll
    for (int i = 0; i < 2; ++i)
#pragma unroll
      for (int r = 0; r < 16; ++r) slot_out[(32 * (wid & 3) + crow(r, hi)) * 128 + 32 * (2 * (wid >> 2) + i) + r32] = sacc[i][r];
    if (tid < 128) dseg_out[tid] = dseg;
  }
  __syncthreads();
}
#undef SWZ256
#undef SWZ128
}
typedef unsigned short bf16_t;
typedef float f32x4 __attribute__((ext_vector_type(4)));
typedef unsigned u32x4 __attribute__((ext_vector_type(4)));
typedef unsigned u32x2 __attribute__((ext_vector_type(2)));
typedef short bf16x8 __attribute__((ext_vector_type(8)));
#define LAS __attribute__((address_space(3)))
constexpr size_t MiB = 1u << 20;
constexpr size_t WS_SS = 0;
constexpr size_t WS_ROPEC = 6 * MiB, WS_ROPES = 7 * MiB;
constexpr size_t WS_W1GU = 16 * MiB, WS_W1D = 27 * MiB, WS_WIN = 33 * MiB, WS_WUQ = 40 * MiB, WS_WUKV = 41 * MiB, WS_WO = 42 * MiB, WS_W2GU = 44 * MiB, WS_W2D = 55 * MiB, WS_WPG = 61 * MiB, WS_WPP = 63 * MiB;
constexpr size_t WS_HB = 64 * MiB;
constexpr size_t WS_BIG = 256 * MiB;
constexpr size_t WS_UHG = WS_BIG, WS_UMLA = WS_BIG + 480 * MiB, WS_MIX = WS_BIG + 480 * MiB, WS_ACT = WS_BIG, WS_PROJ = WS_BIG;
constexpr size_t WS_PB = 928 * MiB;
constexpr size_t WS_SLOT = 976 * MiB;
constexpr size_t WS_DSEG = 8 * MiB;
constexpr size_t WS_END = 1024 * MiB;
constexpr size_t DO_Q = 0, DO_KN = 144 * MiB, DO_V = 240 * MiB, DO_KR = 336 * MiB;
constexpr int LDS_BYTES = 147456;
constexpr int LDS_BARST = 147392;
constexpr size_t WS_BAR = 12 * MiB;
#define XB_TMO      128
#define XB_XCNT(j)  (256  + 64 * (j))
#define XB_XSUB(j)  (1280 + 64 * (j))
#define XB_XGEN(j)  (2304 + 64 * (j))
#define XB_TOP      3328
#define XB_TOPGEN   3392
#define XCD_BAR_WORDS 3456
#define XB_SPIN_CAP (1u << 18)

__device__ __forceinline__ unsigned xb_ld(unsigned* p)              { return __hip_atomic_load(p, __ATOMIC_RELAXED, __HIP_MEMORY_SCOPE_AGENT); }
__device__ __forceinline__ unsigned xb_add(unsigned* p, unsigned v) { return __hip_atomic_fetch_add(p, v, __ATOMIC_RELAXED, __HIP_MEMORY_SCOPE_AGENT); }
__device__ __forceinline__ unsigned xb_xcc_id() { return (unsigned)__builtin_amdgcn_s_getreg((3 << 11) | 20) & 0xFu; }
#define XB_SPIN(cond, bar) do { unsigned _sp = 0; while (cond) { __builtin_amdgcn_s_sleep(1); \
    if ((++_sp & 255u) == 0u) { if (xb_ld(&(bar)[XB_TMO])) break; if (_sp > XB_SPIN_CAP) { atomicAdd(&(bar)[XB_TMO], 1u); break; } } } } while (0)

struct XcdBarrier {
    unsigned* bar; unsigned x;
    volatile LAS unsigned* st;
};

__device__ __forceinline__ XcdBarrier xcd_barrier_post(unsigned* bar, volatile LAS unsigned* st) {
    XcdBarrier b; b.bar = bar; b.x = xb_xcc_id(); b.st = st;
    if (threadIdx.x == 0) (void)xb_add(&bar[XB_XCNT(b.x)], 1u);
    return b;
}
__device__ __forceinline__ void xcd_barrier_complete(unsigned* bar, unsigned x, unsigned& nloc, unsigned& nx) {
    const unsigned G = gridDim.x * gridDim.y * gridDim.z;
    unsigned sum, cnt, mine, sp = 0u;
    for (;;) {
        sum = 0u; cnt = 0u; mine = 0u;
#pragma unroll
        for (unsigned j = 0; j < 16; ++j) { const unsigned c = xb_ld(&bar[XB_XCNT(j)]); sum += c; cnt += (c > 0u) ? 1u : 0u; mine = (j == x) ? c : mine; }
        if (sum == G) break;
        __builtin_amdgcn_s_sleep(1);
        if ((++sp & 255u) == 0u) { if (xb_ld(&bar[XB_TMO])) break; if (sp > XB_SPIN_CAP) { atomicAdd(&bar[XB_TMO], 1u); break; } }
    }
    nloc = mine > 0u ? mine : 1u; nx = cnt > 0u ? cnt : 1u;
}

__device__ __forceinline__ void xcd_barrier(const XcdBarrier& b) {
    asm volatile("s_waitcnt vmcnt(0)" ::: "memory");
    __syncthreads();
    if (threadIdx.x == 0) {
        unsigned* bar = b.bar;
        __builtin_amdgcn_s_waitcnt(0);
        unsigned nloc = b.st[0], nx = b.st[1];
        if (nloc == 0u) { xcd_barrier_complete(bar, b.x, nloc, nx); b.st[0] = nloc; b.st[1] = nx; }
        const unsigned old = xb_add(&bar[XB_XSUB(b.x)], 1u);
        const unsigned gen = old / nloc;
        if (old + 1u == (gen + 1u) * nloc) {
            __builtin_amdgcn_fence(__ATOMIC_RELEASE, "agent");
            asm volatile("s_waitcnt vmcnt(0)" ::: "memory");
            const unsigned og = xb_add(&bar[XB_TOP], 1u);
            const unsigned tg = og / nx;
            if (og + 1u == (tg + 1u) * nx) xb_add(&bar[XB_TOPGEN], 1u);
            else XB_SPIN(xb_ld(&bar[XB_TOPGEN]) == tg, bar);
            __builtin_amdgcn_fence(__ATOMIC_ACQUIRE, "agent");
            xb_add(&bar[XB_XGEN(b.x)], 1u);
            asm volatile("s_waitcnt vmcnt(0)" ::: "memory");
        } else {
            XB_SPIN(xb_ld(&bar[XB_XGEN(b.x)]) == gen, bar);
            __builtin_amdgcn_fence(__ATOMIC_ACQUIRE, "agent");
            asm volatile("s_waitcnt vmcnt(0)" ::: "memory");
        }
    }
    __syncthreads();
}


struct Params {
  const float* in[26];
  float* out; unsigned char* ws;
};

__device__ __forceinline__ unsigned f2bf(float f) { unsigned u = __builtin_bit_cast(unsigned, f); return (u + 0x7fffu + ((u >> 16) & 1u)) >> 16; }
__device__ __forceinline__ unsigned pk2(float lo, float hi) { return f2bf(lo) | (f2bf(hi) << 16); }
__device__ __forceinline__ float wave_sum(float v) {
#pragma unroll
  for (int o = 1; o < 64; o <<= 1) v += __shfl_xor(v, o);
  return v;
}
__device__ __forceinline__ void prep_item(const float* W, int ld, int col0, const float* fold, bf16_t* WT, int K, int n0, int k0, float* scr, int lane, bool perm) {
#pragma unroll 16
  for (int i = 0; i < 32; ++i) { const int kk = 2 * i + (lane >> 5); float v = 0.f; if (W) { const int p_ = lane & 31; const int cc = perm ? (16 * ((p_ >> 2) & 1) + 4 * (p_ >> 3) + (p_ & 3)) : p_; v = W[(size_t)(k0 + kk) * ld + col0 + cc]; if (fold) v *= fold[k0 + kk]; } scr[kk * 33 + (lane & 31)] = v; }
  asm volatile("s_waitcnt lgkmcnt(0)" ::: "memory");
  const int c = lane & 7;
#pragma unroll
  for (int j = 0; j < 4; ++j) { const int n = (lane >> 3) + 8 * j; const float* s = scr + (8 * c) * 33 + n;
    u32x4 o; o.x = pk2(s[0 * 33], s[1 * 33]); o.y = pk2(s[2 * 33], s[3 * 33]); o.z = pk2(s[4 * 33], s[5 * 33]); o.w = pk2(s[6 * 33], s[7 * 33]);
    *(u32x4*)(WT + (size_t)(n0 + n) * K + k0 + 8 * c) = o; }
  asm volatile("s_waitcnt lgkmcnt(0)" ::: "memory");
}
__device__ __forceinline__ void sincos_d(double x, float& s, float& c) {
  const double TWO_PI = 6.283185307179586476925286766559, INV_2PI = 0.15915494309189533576888376337251;
  double k = __builtin_rint(x * INV_2PI); double r = x - k * TWO_PI;
  const double HALF_PI = 1.5707963267948966192313216916398;
  double q = __builtin_rint(r * 0.63661977236758134308); double y = r - q * HALF_PI; int qi = ((int)q) & 3;
  double y2 = y * y;
  double sp = y * (1.0 + y2 * (-1.0 / 6 + y2 * (1.0 / 120 + y2 * (-1.0 / 5040 + y2 * (1.0 / 362880 + y2 * (-1.0 / 39916800 + y2 * (1.0 / 6227020800.0)))))));
  double cp = 1.0 + y2 * (-0.5 + y2 * (1.0 / 24 + y2 * (-1.0 / 720 + y2 * (1.0 / 40320 + y2 * (-1.0 / 3628800 + y2 * (1.0 / 479001600.0 + y2 * (-1.0 / 87178291200.0)))))));
  double ss, cc;
  if (qi == 0) { ss = sp; cc = cp; } else if (qi == 1) { ss = cp; cc = -sp; } else if (qi == 2) { ss = -sp; cc = -cp; } else { ss = -cp; cc = sp; }
  s = (float)ss; c = (float)cc;
}

__device__ __forceinline__ void p0_prologue(const Params& P, unsigned char* ws, char* lds) {
  int tid_ = threadIdx.x; asm volatile("" : "+v"(tid_)); const int tid = tid_, lane = tid & 63, wave = tid >> 6;
  const int gw = blockIdx.x * 8 + wave, NGW = gridDim.x * 8;
  float* scr = (float*)(lds + wave * 16384);
  constexpr int NJ = 10;
  const int jN[NJ] = {NGU, 1024, NIN, 768, 1024, 1024, NGU, 1024, 1024, 1024};
  const int jK[NJ] = {1024, DFF, 1024, 384, 256, 1024, 1024, DFF, 1024, 256};
  int total = 0;
#pragma unroll
  for (int j = 0; j < NJ; ++j) total += (jN[j] / 32) * (jK[j] / 64);
  const int gwp = blockIdx.x * 4 + (wave & 3), NGWP = gridDim.x * 4;
  if (wave < 4)
  for (int it = gwp; it < total; it += NGWP) {
    int r = it, job = 0;
#pragma unroll
    for (int j = 0; j < NJ; ++j) { const int cnt = (jN[j] / 32) * (jK[j] / 64); if (job == j && r >= cnt) { r -= cnt; job = j + 1; } }
    int N = 0, K = 0;
#pragma unroll
    for (int j = 0; j < NJ; ++j) if (job == j) { N = jN[j]; K = jK[j]; }
    const int nblk = N / 32, kb = r / nblk, nb = r % nblk, k0 = 64 * kb, n0 = 32 * nb;
    const float* W = nullptr; int ld = 0, col0 = 0; const float* fold = nullptr; bf16_t* WT = nullptr;
    if (job == 0 || job == 6) { const int t = n0 >> 8, half = (n0 >> 7) & 1, j0 = n0 & 127; const int b = (job == 0) ? 5 : 19;
      W = P.in[b + half]; ld = DFF; col0 = 128 * t + j0; fold = P.in[(job == 0) ? 4 : 18]; WT = (bf16_t*)(ws + ((job == 0) ? WS_W1GU : WS_W2GU)); }
    else if (job == 1 || job == 7) { W = P.in[(job == 1) ? 7 : 21]; ld = 1024; col0 = n0; WT = (bf16_t*)(ws + ((job == 1) ? WS_W1D : WS_W2D)); }
    else if (job == 2) { ld = 3232; fold = P.in[8]; WT = (bf16_t*)(ws + WS_WIN); W = P.in[9];
      if (n0 < 384) col0 = n0; else if (n0 < 416) col0 = 640 + (n0 - 384); else if (n0 < 512) W = nullptr; else if (n0 < 768) col0 = 384 + (n0 - 512); else col0 = 672 + (n0 - 768); }
    else if (job == 3) { W = P.in[11]; ld = 768; col0 = n0; fold = P.in[10]; WT = (bf16_t*)(ws + WS_WUQ); }
    else if (job == 4) { if (n0 < 512) { W = P.in[13]; col0 = n0; } else { W = P.in[14]; col0 = n0 - 512; } ld = 512; fold = P.in[12]; WT = (bf16_t*)(ws + WS_WUKV); }
    else if (job == 5) { W = P.in[17]; ld = 1024; col0 = n0; WT = (bf16_t*)(ws + WS_WO); }
    else if (job == 8) { W = P.in[23]; ld = 1024; col0 = n0; fold = P.in[22]; WT = (bf16_t*)(ws + WS_WPG); }
    else { W = P.in[24]; ld = 1024; col0 = n0; WT = (bf16_t*)(ws + WS_WPP); }
    prep_item(W, ld, col0, fold, WT, K, n0, k0, scr, lane, job == 2 && n0 == 384);
  }
  unsigned* ss = (unsigned*)(ws + WS_SS); bf16_t* HB = (bf16_t*)(ws + WS_HB); bf16_t* PB = (bf16_t*)(ws + WS_PB);
  if (wave >= 4)
  for (int m0 = gwp; m0 < T_ALL; m0 += 2 * NGWP) {
    f32x4 v[2][4], pv[2]; bool ok[2];
#pragma unroll
    for (int q = 0; q < 2; ++q) { const int m = m0 + q * NGWP; ok[q] = m < T_ALL; const int mm = ok[q] ? m : m0;
      const float* xr = (mm < T_P) ? P.in[0] + (size_t)mm * DM : P.in[1] + (size_t)(mm - T_P) * DM; const f32x4* x4 = (const f32x4*)xr + lane;
#pragma unroll
      for (int j = 0; j < 4; ++j) v[q][j] = x4[64 * j];
      const float* pr = (mm < T_P) ? P.in[2] + (size_t)mm * PLE : P.in[3] + (size_t)(mm - T_P) * PLE; pv[q] = ((const f32x4*)pr)[lane]; }
#pragma unroll
    for (int q = 0; q < 2; ++q) { const int m = m0 + q * NGWP; if (!ok[q]) continue; float s = 0.f;
#pragma unroll
      for (int j = 0; j < 4; ++j) s += (v[q][j][0] * v[q][j][0] + v[q][j][1] * v[q][j][1]) + (v[q][j][2] * v[q][j][2] + v[q][j][3] * v[q][j][3]);
      s = wave_sum(s);
      u32x2* o8 = (u32x2*)(HB + (size_t)m * DM) + lane;
#pragma unroll
      for (int j = 0; j < 4; ++j) { u32x2 w; w.x = pk2(v[q][j][0], v[q][j][1]); w.y = pk2(v[q][j][2], v[q][j][3]); o8[64 * j] = w; }
      u32x2 w; w.x = pk2(pv[q][0], pv[q][1]); w.y = pk2(pv[q][2], pv[q][3]); ((u32x2*)(PB + (size_t)m * PLE))[lane] = w;
      if (lane < 7) ss[(size_t)lane * T_ALL + m] = (lane == 0) ? (unsigned)(s * 4096.0f + 0.5f) : 0u; }
  }
  float* rc = (float*)(ws + WS_ROPEC); float* rs = (float*)(ws + WS_ROPES);
  for (int e = blockIdx.x * 512 + tid; e < S_P * 16; e += gridDim.x * 512) {
    const int pos = e >> 4, i = e & 15;
    const float cst = (float)(-9.210340371976184 / 32.0); const float arg = (float)(2 * i) * cst;
    const double a = (double)arg; const double nn = __builtin_rint(a * 1.4426950408889634); const double rr = a - nn * 0.69314718055994530942;
    double ex = 1.0 + rr * (1.0 + rr * (0.5 + rr * (1.0 / 6 + rr * (1.0 / 24 + rr * (1.0 / 120 + rr * (1.0 / 720 + rr * (1.0 / 5040 + rr * (1.0 / 40320 + rr * (1.0 / 362880 + rr * (1.0 / 3628800 + rr * (1.0 / 39916800)))))))))));
    ex = ex * __builtin_ldexp(1.0, (int)nn);
    const float invf = (float)ex; const float ang = (float)pos * invf;
    float sv, cv; sincos_d((double)ang, sv, cv); rc[e] = cv; rs[e] = sv;
  }
}
__device__ __forceinline__ void hg_combine(const bf16_t* OP, const bf16_t* U, const float* hg_norm, bf16_t* MIX) {
  int tid_ = threadIdx.x; asm volatile("" : "+v"(tid_)); const int lane = tid_ & 63, wave = tid_ >> 6; const int gw = blockIdx.x * 8 + wave, NGW = gridDim.x * 8;
  f32x4 gn0 = *(const f32x4*)(hg_norm + 8 * lane), gn1 = *(const f32x4*)(hg_norm + 8 * lane + 4);
  const float gnv[8] = {gn0[0], gn0[1], gn0[2], gn0[3], gn1[0], gn1[1], gn1[2], gn1[3]};
  for (int m0 = gw; m0 < T_ALL; m0 += 2 * NGW) {
    bf16x8 a[2], b[2], g[2]; bool ok[2];
#pragma unroll
    for (int q = 0; q < 2; ++q) { const int m = m0 + q * NGW; ok[q] = m < T_ALL; const int mm = ok[q] ? m : m0;
      a[q] = *(const bf16x8*)(OP + (size_t)mm * 512 + 8 * lane); b[q] = *(const bf16x8*)(OP + (size_t)T_ALL * 512 + (size_t)mm * 512 + 8 * lane);
      g[q] = *(const bf16x8*)(U + (size_t)mm * 2560 + 2048 + 8 * lane); }
#pragma unroll
    for (int q = 0; q < 2; ++q) { const int m = m0 + q * NGW; if (!ok[q]) continue;
      float ov[8]; float s = 0.f;
#pragma unroll
      for (int j = 0; j < 8; ++j) { ov[j] = __uint_as_float(((unsigned)(unsigned short)a[q][j]) << 16) + __uint_as_float(((unsigned)(unsigned short)b[q][j]) << 16); s += ov[j] * ov[j]; }
      s += __shfl_xor(s, 1); s += __shfl_xor(s, 2); s += __shfl_xor(s, 4); s += __shfl_xor(s, 8);
      const float r = rsqrtf(s * (1.0f / 128.0f) + EPS);
      unsigned w[4];
#pragma unroll
      for (int j = 0; j < 8; j += 2) { float r2[2];
#pragma unroll
        for (int e = 0; e < 2; ++e) { const float x = __uint_as_float(((unsigned)(unsigned short)g[q][j + e]) << 16); const float sl = x * __builtin_amdgcn_rcpf(1.0f + __builtin_amdgcn_exp2f(-1.4426950408889634f * x)); r2[e] = ov[j + e] * r * gnv[j + e] * sl; }
        w[j >> 1] = pk2(r2[0], r2[1]); }
      *(u32x4*)(MIX + (size_t)m * 1024 + 512 + 8 * lane) = (u32x4){w[0], w[1], w[2], w[3]}; }
  }
}
__device__ __forceinline__ void final_norm(float* out, const bf16_t* h4, const unsigned* ss4, const float* fn) {
  int tid_ = threadIdx.x; asm volatile("" : "+v"(tid_)); const int lane = tid_ & 63, wave = tid_ >> 6; const int gw = blockIdx.x * 8 + wave, NGW = gridDim.x * 8;
  f32x4 g[2][2];
#pragma unroll
  for (int j = 0; j < 2; ++j) { g[j][0] = *(const f32x4*)(fn + 512 * j + 8 * lane); g[j][1] = *(const f32x4*)(fn + 512 * j + 8 * lane + 4); }
  for (int m0 = gw; m0 < T_ALL; m0 += 2 * NGW) {
    u32x4 h[2][2]; float r[2]; bool ok[2];
#pragma unroll
    for (int q = 0; q < 2; ++q) { const int m = m0 + q * NGW; ok[q] = m < T_ALL; const int mm = ok[q] ? m : m0; r[q] = (float)ss4[mm] * (1.0f / 4096.0f);
#pragma unroll
      for (int j = 0; j < 2; ++j) h[q][j] = *(const u32x4*)(h4 + (size_t)mm * DM + 512 * j + 8 * lane); }
#pragma unroll
    for (int q = 0; q < 2; ++q) { const int m = m0 + q * NGW; if (!ok[q]) continue; const float rr = rsqrtf(r[q] * (1.0f / 1024.0f) + EPS);
#pragma unroll
      for (int j = 0; j < 2; ++j) { const u32x4 hh = h[q][j];
        f32x4 a, b; a[0] = __uint_as_float(hh.x << 16); a[1] = __uint_as_float(hh.x & 0xffff0000u); a[2] = __uint_as_float(hh.y << 16); a[3] = __uint_as_float(hh.y & 0xffff0000u);
        b[0] = __uint_as_float(hh.z << 16); b[1] = __uint_as_float(hh.z & 0xffff0000u); b[2] = __uint_as_float(hh.w << 16); b[3] = __uint_as_float(hh.w & 0xffff0000u);
        float* o = out + (size_t)m * DM + 512 * j + 8 * lane; *(f32x4*)o = a * rr * g[j][0]; *(f32x4*)(o + 4) = b * rr * g[j][1]; } }
  }
}

#define GSYNC() xcd_barrier(xbar)

template <class Epi> __device__ __forceinline__ void run_gemm(LAS unsigned char* lds, const bf16_t* A, int lda, const bf16_t* Bt, int ldb, int N, int K, const Epi& E) {
  pg8::Gemm g{A, Bt, T_ALL, N, K, lda, ldb}; pg8::StaticOrder S; S.init(T_ALL, N, (int)gridDim.x, (int)blockIdx.x);
  pg8::gemm_phase<Epi, pg8::StaticOrder, true, true>(lds, g, S, E);
}

__global__ void __launch_bounds__(512, 2) mk_fwd(Params P) {
  extern __shared__ __attribute__((aligned(16))) unsigned char lds[];
  unsigned char* ws = P.ws; float* out = P.out; unsigned char* dob = (unsigned char*)P.out;
  LAS unsigned char* l3 = (LAS unsigned char*)lds;
  pg8::ss_t* ss = (pg8::ss_t*)(ws + WS_SS);
  pg8::ss_t* ss0 = ss, *ss1 = ss + T_ALL, *ss2 = ss + 2 * (size_t)T_ALL, *ss3 = ss + 3 * (size_t)T_ALL, *ss4 = ss + 4 * (size_t)T_ALL, *ssq = ss + 5 * (size_t)T_ALL, *sskv = ss + 6 * (size_t)T_ALL;
  const float* ropec = (const float*)(ws + WS_ROPEC); const float* ropes = (const float*)(ws + WS_ROPES);
  bf16_t* HB = (bf16_t*)(ws + WS_HB); bf16_t* ACT = (bf16_t*)(ws + WS_ACT); bf16_t* UHG = (bf16_t*)(ws + WS_UHG); bf16_t* UMLA = (bf16_t*)(ws + WS_UMLA);
  bf16_t* MIX = (bf16_t*)(ws + WS_MIX); bf16_t* H4B = (bf16_t*)(ws + WS_MIX);     bf16_t* PROJ = (bf16_t*)P.out;     bf16_t* PB = (bf16_t*)(ws + WS_PB);
  bf16_t* Qb = (bf16_t*)(dob + DO_Q); bf16_t* KN = (bf16_t*)(dob + DO_KN); bf16_t* Vb = (bf16_t*)(dob + DO_V); bf16_t* KR = (bf16_t*)(dob + DO_KR);

  if (threadIdx.x < 16) ((LAS unsigned*)(l3 + LDS_BARST))[threadIdx.x] = 0u;
  if (blockIdx.x == 0) { for (int i = threadIdx.x; i < XCD_BAR_WORDS; i += 512) __hip_atomic_store((unsigned*)(ws + WS_BAR) + i, 0u, __ATOMIC_RELAXED, __HIP_MEMORY_SCOPE_AGENT); }
  p0_prologue(P, ws, (char*)lds);
  cg::this_grid().sync();
  const XcdBarrier xbar = xcd_barrier_post((unsigned*)(ws + WS_BAR), (volatile LAS unsigned*)(l3 + LDS_BARST));
  { pg8::EpiSwiGLU E{ACT, ss0}; run_gemm(l3, HB, 1024, (const bf16_t*)(ws + WS_W1GU), 1024, NGU, 1024, E); }
  GSYNC();
  { pg8::EpiRes<2> E{nullptr, nullptr, HB, nullptr, ss1, nullptr, nullptr}; run_gemm(l3, ACT, DFF, (const bf16_t*)(ws + WS_W1D), DFF, 1024, DFF, E); }
  GSYNC();
  { pg8::EpiWin E{UMLA, UHG, KR, ss1, ssq, sskv, ropec, ropes}; run_gemm(l3, HB, 1024, (const bf16_t*)(ws + WS_WIN), 1024, NIN, 1024, E); }
  GSYNC();
  { pg8::EpiBf E{Qb, Qb, 768, 1000, ssq, 1.0f / 384.0f, att::SCALE * 1.4426950408889634f}; run_gemm(l3, UMLA, 768, (const bf16_t*)(ws + WS_WUQ), 384, 768, 384, E); }
  { pg8::EpiBf E{KN, Vb, 512, 2, sskv, 1.0f / 256.0f, 1.0f}; run_gemm(l3, UMLA + 512, 768, (const bf16_t*)(ws + WS_WUKV), 256, 1024, 256, E); }
  {
    float* SLOT = (float*)(ws + WS_SLOT); float* DSEG = (float*)(ws + WS_DSEG);
    for (int u = blockIdx.x; u < 768; u += gridDim.x) {
      int chainid, seg, nseg;
      if (u < 256) { chainid = u >> 4; seg = u & 15; nseg = 16; } else { const int u2 = u - 256; chainid = 16 + (u2 >> 2); seg = u2 & 3; nseg = 4; }
      if (seg == nseg - 1) continue;
      int rowbase, S, h, dir;
      if (chainid < 16) { const int b = chainid >> 3; h = (chainid >> 1) & 3; dir = chainid & 1; rowbase = b * S_P; S = S_P; }
      else { const int c2 = chainid - 16; const int b = c2 >> 3; h = (c2 >> 1) & 3; dir = c2 & 1; rowbase = T_P + b * S_S; S = S_S; }
      hg::chain<1>(UHG, (bf16_t*)out, P.in[15], rowbase, S, h, dir, seg * 1024, 16, nullptr, SLOT + (size_t)u * 16384, DSEG + (size_t)u * 128, (char*)lds);
    }
  }
  GSYNC();
  {
    float* SLOT = (float*)(ws + WS_SLOT); const float* DSEG = (const float*)(ws + WS_DSEG);
    int tid_ = threadIdx.x; asm volatile("" : "+v"(tid_));
    for (int e = blockIdx.x * 512 + tid_; e < 144 * 16384; e += gridDim.x * 512) {
      const int chainid = e >> 14, el = e & 16383, k = el & 127;
      int u0, nseg; if (chainid < 16) { u0 = chainid * 16; nseg = 16; } else { u0 = 256 + (chainid - 16) * 4; nseg = 4; }
      float Sv = 0.f;
      if (nseg == 16) { float slv[15], dv[15];
#pragma unroll
        for (int s = 0; s < 15; ++s) { slv[s] = SLOT[(size_t)(u0 + s) * 16384 + el]; dv[s] = DSEG[(size_t)(u0 + s) * 128 + k]; }
#pragma unroll
        for (int s = 0; s < 15; ++s) { Sv = dv[s] * Sv + slv[s]; SLOT[(size_t)(u0 + s) * 16384 + el] = Sv; } }
      else { float slv[3], dv[3];
#pragma unroll
        for (int s = 0; s < 3; ++s) { slv[s] = SLOT[(size_t)(u0 + s) * 16384 + el]; dv[s] = DSEG[(size_t)(u0 + s) * 128 + k]; }
#pragma unroll
        for (int s = 0; s < 3; ++s) { Sv = dv[s] * Sv + slv[s]; SLOT[(size_t)(u0 + s) * 16384 + el] = Sv; } }
    }
  }
  {
    const int G = gridDim.x, bx = blockIdx.x;
    if (G == 256) {
      const int xcd = bx & 7, idx = bx >> 3;
      for (int i = 0; i < 12; ++i) {
        int rowbase, seq, h, qb;
        if (i < 4) { const int pair = 2 * xcd + (i >> 1); const int b = pair >> 3; h = pair & 7; qb = idx * 2 + (i & 1); rowbase = b * S_P; seq = S_P; }
        else { const int j = i - 4; const int pair = 16 * xcd + 2 * j + (idx >> 4); const int b = pair >> 3; h = pair & 7; qb = idx & 15; rowbase = T_P + b * S_S; seq = S_S; }
        att::attn_unit(Qb + (size_t)(rowbase + qb * 256) * 768 + h * 96, KN + (size_t)rowbase * 512 + h * 64, KR + (size_t)rowbase * 32, Vb + (size_t)rowbase * 512 + h * 64,
                       MIX + (size_t)(rowbase + qb * 256) * 1024 + h * 64, seq, rowbase + qb * 256, ropec, ropes, (char*)lds);
      }
    } else {
      for (int u = bx; u < 3072; u += G) {
        int rowbase, seq, h, qb;
        if (u < 1024) { const int pair = u >> 6; const int b = pair >> 3; h = pair & 7; qb = u & 63; rowbase = b * S_P; seq = S_P; }
        else { const int v = u - 1024; const int pair = v >> 4; const int b = pair >> 3; h = pair & 7; qb = v & 15; rowbase = T_P + b * S_S; seq = S_S; }
        att::attn_unit(Qb + (size_t)(rowbase + qb * 256) * 768 + h * 96, KN + (size_t)rowbase * 512 + h * 64, KR + (size_t)rowbase * 32, Vb + (size_t)rowbase * 512 + h * 64,
                       MIX + (size_t)(rowbase + qb * 256) * 1024 + h * 64, seq, rowbase + qb * 256, ropec, ropes, (char*)lds);
      }
    }
  }
  GSYNC();
  {
    const float* SLOT = (const float*)(ws + WS_SLOT);
    for (int u = blockIdx.x; u < 768; u += gridDim.x) {
      int chainid, seg;
      if (u < 256) { chainid = u >> 4; seg = u & 15; } else { const int u2 = u - 256; chainid = 16 + (u2 >> 2); seg = u2 & 3; }
      int rowbase, S, h, dir;
      if (chainid < 16) { const int b = chainid >> 3; h = (chainid >> 1) & 3; dir = chainid & 1; rowbase = b * S_P; S = S_P; }
      else { const int c2 = chainid - 16; const int b = c2 >> 3; h = (c2 >> 1) & 3; dir = c2 & 1; rowbase = T_P + b * S_S; S = S_S; }
      hg::chain<3>(UHG, (bf16_t*)out, P.in[15], rowbase, S, h, dir, seg * 1024, 16, seg ? SLOT + (size_t)(u - 1) * 16384 : nullptr, nullptr, nullptr, (char*)lds);
    }
  }
  GSYNC();
  hg_combine((const bf16_t*)out, UHG, P.in[16], MIX);
  GSYNC();
  { pg8::EpiRes<1> E{nullptr, nullptr, HB, nullptr, ss2, nullptr, nullptr}; run_gemm(l3, MIX, 1024, (const bf16_t*)(ws + WS_WO), 1024, 1024, 1024, E); }
  GSYNC();
  { pg8::EpiSwiGLU E{ACT, ss2}; run_gemm(l3, HB, 1024, (const bf16_t*)(ws + WS_W2GU), 1024, NGU, 1024, E); }
  GSYNC();
  { pg8::EpiRes<2> E{nullptr, nullptr, HB, nullptr, ss3, nullptr, nullptr}; run_gemm(l3, ACT, DFF, (const bf16_t*)(ws + WS_W2D), DFF, 1024, DFF, E); }
  { pg8::EpiBf E{PROJ, PROJ, 1024, 1000, nullptr, 0.f, 1.0f}; run_gemm(l3, PB, 256, (const bf16_t*)(ws + WS_WPP), 256, 1024, 256, E); }
  GSYNC();
  { pg8::EpiRes<3> E{nullptr, nullptr, HB, H4B, ss4, ss3, PROJ}; run_gemm(l3, HB, 1024, (const bf16_t*)(ws + WS_WPG), 1024, 1024, 1024, E); }
  GSYNC();
  final_norm(out, H4B, ss4, P.in[25]);
}

extern "C" void kernel_launch(void* const* d_in, const int* in_sizes, int n_in, void* d_out, int out_size, void* d_ws, size_t ws_size, hipStream_t stream) {
  static int grid = 0;
  if (grid == 0) {
    if (n_in != 26 || out_size != T_ALL * DM || ws_size < WS_END) { fprintf(stderr, "kernel_launch: unexpected shapes n_in %d out %d ws %zu\n", n_in, out_size, ws_size); grid = -1; return; }
    int dev = 0, cus = 0, per_cu = 0;
    if (hipGetDevice(&dev) != hipSuccess || hipDeviceGetAttribute(&cus, hipDeviceAttributeMultiprocessorCount, dev) != hipSuccess) { grid = -1; return; }
    if (hipFuncSetAttribute((const void*)mk_fwd, hipFuncAttributeMaxDynamicSharedMemorySize, LDS_BYTES) != hipSuccess) { fprintf(stderr, "kernel_launch: LDS attribute failed\n"); grid = -1; return; }
    if (hipOccupancyMaxActiveBlocksPerMultiprocessor(&per_cu, (const void*)mk_fwd, 512, LDS_BYTES) != hipSuccess || per_cu < 1) { fprintf(stderr, "kernel_launch: occupancy query says %d\n", per_cu); per_cu = 1; }
    (void)hipGetLastError();
    grid = cus;
  }
  if (grid < 0) return;
  Params p{};
  for (int i = 0; i < 26; ++i) p.in[i] = (const float*)d_in[i];
  p.out = (float*)d_out; p.ws = (unsigned char*)d_ws;
  void* args[] = {&p};
  hipError_t e = hipLaunchCooperativeKernel((void*)mk_fwd, dim3(grid), dim3(512), args, LDS_BYTES, stream);
  if (e != hipSuccess) fprintf(stderr, "cooperative launch failed: %s (grid %d)\n", hipGetErrorString(e), grid);
}
```

```cpp
#include <hip/hip_runtime.h>
#include <hip/hip_cooperative_groups.h>
#include <cstdio>
#include <cstdint>
namespace cg = cooperative_groups;

constexpr int DM = 1024, T_P = 32768, T_ALL = 98304, S_P = 16384, S_S = 4096;
constexpr int DFF = 2816, NGU = 5632, NIN = 3328, NMLA = 768, NHG = 2560, PLE = 256;
constexpr float EPS = 1e-6f;
__device__ __forceinline__ int row_pos(int row) { return row < T_P ? (row & (S_P - 1)) : (row & (S_S - 1)); }

namespace pg8 {
#define PG8_LAS __attribute__((address_space(3)))
typedef unsigned short bf16_t;
typedef short bf16x8 __attribute__((ext_vector_type(8)));
typedef float f32x4 __attribute__((ext_vector_type(4)));
typedef unsigned u32x4 __attribute__((ext_vector_type(4)));
constexpr int BM = 256, BK = 64, HALF = 128, HTB = HALF * BK * 2  , STAGE_BYTES = 8 * HTB, NXCD = 8, WGM = 8;

__host__ __device__ __forceinline__ int lds_byte(int r, int c) { const int st = (r >> 4) * 2 + (c >> 5), rr = r & 15, cc = c & 31, ob = rr * 64 + cc * 2; return st * 1024 + (ob ^ (((ob >> 9) & 1) << 5)); }
__host__ __device__ __forceinline__ void stage_rc(int b, int& R, int& C) { const int st = b / 1024, sb = b % 1024, swz = sb ^ (((sb >> 9) & 1) << 5); R = (st >> 1) * 16 + swz / 64; C = (st & 1) * 32 + (swz % 64) / 2; }
__host__ __device__ __forceinline__ int perm32(int rho) { const int n = rho >> 4, i = rho & 15; return 8 * (i >> 2) + 4 * n + (i & 3); }

struct Unit { int pm, pn; };
struct Gemm { const bf16_t* A; const bf16_t* Bt; int M, N, K, lda, ldb; };

struct StaticOrder {
    int nM, nN, nwg, G, c;
    __host__ __device__ void init(int M, int N, int G_, int c_) { nM = M / BM; nN = N / BM; nwg = nM * nN; G = G_; c = c_; }
    __host__ __device__ bool next(int i, Unit& u) const {
        const long L = (long)i * G + c; if (L >= nwg) return false;
        int wgid = (int)L; { const int q = nwg / NXCD, r = nwg % NXCD, xcd = wgid % NXCD, off = wgid / NXCD; wgid = (xcd < r ? xcd * (q + 1) : r * (q + 1) + (xcd - r) * q) + off; }
        const int nig = WGM * nN, gid = wgid / nig, fm = gid * WGM, gsz = (nM - fm) < WGM ? (nM - fm) : WGM;
        u.pm = fm + ((wgid % nig) % gsz); u.pn = (wgid % nig) / gsz; return true;
    }
    __device__ __forceinline__ void a_ready(const Unit&) const {}
    __device__ __forceinline__ void done(const Unit&) const {}
};
__device__ __forceinline__ unsigned cvt_pk_bf16(float lo, float hi) { unsigned r; asm volatile("v_cvt_pk_bf16_f32 %0, %1, %2" : "=v"(r) : "v"(lo), "v"(hi)); return r; }
typedef unsigned u32x2 __attribute__((ext_vector_type(2)));
__device__ __forceinline__ float bf2f(unsigned short h) { return __uint_as_float(((unsigned)h) << 16); }
__device__ __forceinline__ float fsigmoid(float x) { return __builtin_amdgcn_rcpf(1.0f + __builtin_amdgcn_exp2f(-1.4426950408889634f * x)); }
typedef unsigned ss_t;
__device__ __forceinline__ float ss_f(ss_t v) { return (float)v * (1.0f / 4096.0f); }
__device__ __forceinline__ void ss_add(ss_t* p, float v) { atomicAdd(p, (ss_t)(v * 4096.0f + 0.5f)); }
__device__ __forceinline__ float row_sum4(float s) { s += __shfl_xor(s, 16); s += __shfl_xor(s, 32); return s; }

struct EpiSwiGLU {
    static constexpr bool PERM = true, AFTER_DRAIN = false;
    bf16_t* O; const ss_t* ss;
    __device__ __forceinline__ void operator()(const f32x4 (&acc)[2][2][4][2], const Unit& u, int wr, int wc, int fr, int fq) const {
        const int row0 = u.pm * BM + wr * 64 + fr; const int col0 = u.pn * HALF + wc * 32 + 8 * fq;
        float ssv[2][4];
#pragma unroll
        for (int ai = 0; ai < 2; ++ai)
#pragma unroll
            for (int m = 0; m < 4; ++m) ssv[ai][m] = ss_f(ss[row0 + ai * HALF + m * 16]);
#pragma unroll
        for (int ai = 0; ai < 2; ++ai)
#pragma unroll
            for (int m = 0; m < 4; ++m) { const int row = row0 + ai * HALF + m * 16; const float r = __builtin_amdgcn_rsqf(ssv[ai][m] * (1.0f / 1024.0f) + 1e-6f);
                const float c1 = -1.4426950408889634f * r, r2 = r * r;
                f32x4 vv[2];
#pragma unroll
                for (int n = 0; n < 2; ++n) { const f32x4 a = acc[ai][0][m][n], b = acc[ai][1][m][n]; const f32x4 m1 = a * c1; f32x4 d;
                    d[0] = __builtin_amdgcn_exp2f(m1[0]); d[1] = __builtin_amdgcn_exp2f(m1[1]); d[2] = __builtin_amdgcn_exp2f(m1[2]); d[3] = __builtin_amdgcn_exp2f(m1[3]);
                    d = d + 1.0f; f32x4 inv; inv[0] = __builtin_amdgcn_rcpf(d[0]); inv[1] = __builtin_amdgcn_rcpf(d[1]); inv[2] = __builtin_amdgcn_rcpf(d[2]); inv[3] = __builtin_amdgcn_rcpf(d[3]);
                    vv[n] = (a * b) * (inv * r2); }
                u32x4 w; w.x = cvt_pk_bf16(vv[0][0], vv[0][1]); w.y = cvt_pk_bf16(vv[0][2], vv[0][3]); w.z = cvt_pk_bf16(vv[1][0], vv[1][1]); w.w = cvt_pk_bf16(vv[1][2], vv[1][3]);
                __builtin_nontemporal_store(w, (u32x4*)(O + (size_t)row * 2816 + col0)); }
    }
};
template <int MODE> struct EpiRes {
    static constexpr bool PERM = true, AFTER_DRAIN = false;
    const float* xp; const float* xs; bf16_t* hb; bf16_t* hout; ss_t* ssout; const ss_t* ssin; const bf16_t* proj;
    __device__ __forceinline__ void operator()(const f32x4 (&acc)[2][2][4][2], const Unit& u, int wr, int wc, int fr, int fq) const {
        const int row0 = u.pm * BM + wr * 64 + fr; const int col0 = u.pn * BM + wc * 32 + 8 * fq;
        float s3v[2][4];
        if (MODE == 3) {
#pragma unroll
            for (int ai = 0; ai < 2; ++ai)
#pragma unroll
                for (int m = 0; m < 4; ++m) s3v[ai][m] = ss_f(ssin[row0 + ai * HALF + m * 16]); }
#pragma unroll
        for (int ai = 0; ai < 2; ++ai) {
            u32x4 hpre[4][2];
            if (MODE != 0) {
#pragma unroll
                for (int m = 0; m < 4; ++m)
#pragma unroll
                    for (int bj = 0; bj < 2; ++bj) hpre[m][bj] = *(const u32x4*)(hb + (size_t)(row0 + ai * HALF + m * 16) * 1024 + col0 + bj * HALF); }
#pragma unroll
            for (int m = 0; m < 4; ++m) { const int row = row0 + ai * HALF + m * 16; float sq = 0.f; float r3 = 0.f;
                if (MODE == 3) r3 = __builtin_amdgcn_rsqf(s3v[ai][m] * (1.0f / 1024.0f) + 1e-6f);
#pragma unroll
                for (int bj = 0; bj < 2; ++bj) { const size_t off = (size_t)row * 1024 + col0 + bj * HALF; float b[8], v[8];
                    if (MODE == 0) { const float* xr = (row < 32768) ? (xp + off) : (xs + (off - (size_t)32768 * 1024)); const f32x4 b0 = *(const f32x4*)xr, b1 = *(const f32x4*)(xr + 4);
                        b[0] = b0[0]; b[1] = b0[1]; b[2] = b0[2]; b[3] = b0[3]; b[4] = b1[0]; b[5] = b1[1]; b[6] = b1[2]; b[7] = b1[3]; }
                    else { const u32x4 h4 = hpre[m][bj];
                        b[0] = __uint_as_float(h4.x << 16); b[1] = __uint_as_float(h4.x & 0xffff0000u); b[2] = __uint_as_float(h4.y << 16); b[3] = __uint_as_float(h4.y & 0xffff0000u);
                        b[4] = __uint_as_float(h4.z << 16); b[5] = __uint_as_float(h4.z & 0xffff0000u); b[6] = __uint_as_float(h4.w << 16); b[7] = __uint_as_float(h4.w & 0xffff0000u); }
                    if (MODE == 3) { const u32x4 p4 = *(const u32x4*)(proj + off); float pr[8];
                        pr[0] = __uint_as_float(p4.x << 16); pr[1] = __uint_as_float(p4.x & 0xffff0000u); pr[2] = __uint_as_float(p4.y << 16); pr[3] = __uint_as_float(p4.y & 0xffff0000u);
                        pr[4] = __uint_as_float(p4.z << 16); pr[5] = __uint_as_float(p4.z & 0xffff0000u); pr[6] = __uint_as_float(p4.w << 16); pr[7] = __uint_as_float(p4.w & 0xffff0000u);
#pragma unroll
                        for (int j = 0; j < 8; ++j) v[j] = b[j] + fsigmoid(acc[ai][bj][m][j >> 2][j & 3] * r3) * pr[j]; }
                    else {
#pragma unroll
                        for (int j = 0; j < 8; ++j) v[j] = b[j] + acc[ai][bj][m][j >> 2][j & 3] * ((MODE == 1) ? 1.0f : 0.5f); }
#pragma unroll
                    for (int j = 0; j < 8; ++j) sq += v[j] * v[j];
                    u32x4 w; w.x = cvt_pk_bf16(v[0], v[1]); w.y = cvt_pk_bf16(v[2], v[3]); w.z = cvt_pk_bf16(v[4], v[5]); w.w = cvt_pk_bf16(v[6], v[7]);
                    *(u32x4*)(((MODE == 3) ? hout : hb) + off) = w; }
                sq = row_sum4(sq);
                if (fq == 0) ss_add(ssout + row, sq); }
        }
    }
};
struct EpiWin {
    static constexpr bool PERM = true, AFTER_DRAIN = false;
    bf16_t* umla; bf16_t* uhg; bf16_t* kr; const ss_t* ss1; ss_t* ssq; ss_t* sskv; const float* ropec; const float* ropes;
    __device__ __forceinline__ void operator()(const f32x4 (&acc)[2][2][4][2], const Unit& u, int wr, int wc, int fr, int fq) const {
        const int row0 = u.pm * BM + wr * 64 + fr; const int pn = u.pn;
        bf16_t* dst; int ld, colt;
        if (pn < 3) { dst = umla; ld = 768; colt = pn * BM; } else { dst = uhg; ld = 2560; colt = (pn - 3) * BM; }
        const int col0 = colt + wc * 32 + 8 * fq;
        float ssv[2][4];
#pragma unroll
        for (int ai = 0; ai < 2; ++ai)
#pragma unroll
            for (int m = 0; m < 4; ++m) ssv[ai][m] = ss_f(ss1[row0 + ai * HALF + m * 16]);
#pragma unroll
        for (int ai = 0; ai < 2; ++ai)
#pragma unroll
            for (int m = 0; m < 4; ++m) { const int row = row0 + ai * HALF + m * 16; const float r = __builtin_amdgcn_rsqf(ssv[ai][m] * (1.0f / 1024.0f) + 1e-6f);
                float sq0 = 0.f, sq1 = 0.f; f32x4 v[2][2];
#pragma unroll
                for (int bj = 0; bj < 2; ++bj) {
#pragma unroll
                    for (int n = 0; n < 2; ++n) { v[bj][n] = acc[ai][bj][m][n] * r; const f32x4 x = v[bj][n]; const float s = (x[0] * x[0] + x[1] * x[1]) + (x[2] * x[2] + x[3] * x[3]); if (bj == 0) sq0 += s; else sq1 += s; }
                    u32x4 w; w.x = cvt_pk_bf16(v[bj][0][0], v[bj][0][1]); w.y = cvt_pk_bf16(v[bj][0][2], v[bj][0][3]); w.z = cvt_pk_bf16(v[bj][1][0], v[bj][1][1]); w.w = cvt_pk_bf16(v[bj][1][2], v[bj][1][3]);
                    __builtin_nontemporal_store(w, (u32x4*)(dst + (size_t)row * ld + col0 + bj * HALF)); }
                if (pn < 3) { float s = (pn == 1) ? sq0 : (sq0 + sq1); s = row_sum4(s); if (fq == 0) ss_add((pn == 2 ? sskv : ssq) + row, s); }
                if (pn == 1 && wc == 0) {
                    const int pos = row_pos(row); const f32x4 cs = *(const f32x4*)(ropec + pos * 16 + 4 * fq), sn = *(const f32x4*)(ropes + pos * 16 + 4 * fq);
                    const f32x4 x1 = v[1][0], x2 = v[1][1]; const f32x4 o1 = x1 * cs - x2 * sn, o2 = x1 * sn + x2 * cs;
                    u32x2 w1, w2; w1.x = cvt_pk_bf16(o1[0], o1[1]); w1.y = cvt_pk_bf16(o1[2], o1[3]); w2.x = cvt_pk_bf16(o2[0], o2[1]); w2.y = cvt_pk_bf16(o2[2], o2[3]);
                    *(u32x2*)(kr + (size_t)row * 32 + 4 * fq) = w1; *(u32x2*)(kr + (size_t)row * 32 + 16 + 4 * fq) = w2; } }
    }
};
struct EpiBf {
    static constexpr bool PERM = true, AFTER_DRAIN = false;
    bf16_t* O0; bf16_t* O1; int ld; int split; const ss_t* ss; float inv_n; float mul;
    __device__ __forceinline__ void operator()(const f32x4 (&acc)[2][2][4][2], const Unit& u, int wr, int wc, int fr, int fq) const {
        const int row0 = u.pm * BM + wr * 64 + fr; bf16_t* base = O0; int colt = u.pn * BM; if (u.pn >= split) { base = O1; colt = (u.pn - split) * BM; }
        const int col0 = colt + wc * 32 + 8 * fq;
#pragma unroll
        for (int ai = 0; ai < 2; ++ai)
#pragma unroll
            for (int m = 0; m < 4; ++m) { const int row = row0 + ai * HALF + m * 16; const float r = (ss ? rsqrtf(ss_f(ss[row]) * inv_n + 1e-6f) : 1.0f) * mul;
#pragma unroll
                for (int bj = 0; bj < 2; ++bj) { const f32x4 v0 = acc[ai][bj][m][0] * r, v1 = acc[ai][bj][m][1] * r;
                    u32x4 w; w.x = cvt_pk_bf16(v0[0], v0[1]); w.y = cvt_pk_bf16(v0[2], v0[3]); w.z = cvt_pk_bf16(v1[0], v1[1]); w.w = cvt_pk_bf16(v1[2], v1[3]);
                    *(u32x4*)(base + (size_t)row * ld + col0 + bj * HALF) = w; } }
    }
};
template <class Epi, class Sched, bool ALIGN_EPI = false, bool SP2 = false>
__device__ __forceinline__ void gemm_phase(PG8_LAS unsigned char* lds, const Gemm g, const Sched& S, const Epi& E) {
    int tid_ = threadIdx.x; asm volatile("" : "+v"(tid_)); const int tid = tid_, wid = __builtin_amdgcn_readfirstlane(tid >> 6), lane = tid & 63, wr = wid >> 2, wc = wid & 3, fr = lane & 15, fq = lane >> 4;
    const int K = g.K, nt = K / BK;
    unsigned voffA[2], voffB[2];
#pragma unroll
    for (int i = 0; i < 2; ++i) { int R, C; stage_rc(tid * 16 + i * 8192, R, C); const int Rb = Epi::PERM ? ((R & ~31) + perm32(R & 31)) : R;
        voffA[i] = (unsigned)(R * g.lda + C) * 2u; voffB[i] = (unsigned)(Rb * g.ldb + C) * 2u; }
    const size_t kstep = (size_t)(BK * 2);
    const size_t hstepA = (size_t)HALF * g.lda * 2, hstepB = (size_t)HALF * g.ldb * 2;
    const size_t tstepA = 2 * hstepA, tstepB = 2 * hstepB;
    const unsigned ldsw = (unsigned)wid * 1024u;
    const int aoff = lds_byte(wr * 64 + fr, fq * 8), boff = lds_byte(wc * 32 + fr, fq * 8);
#define PG8_SA(b, h) (((b) * 2 + (h)) * HTB)
#define PG8_SB(b, h) ((4 + (b) * 2 + (h)) * HTB)
#define PG8_STAGE(bufoff, gbase, voff) do { _Pragma("unroll") for (int _i = 0; _i < 2; ++_i) \
        __builtin_amdgcn_global_load_lds((const unsigned*)((const char*)(gbase) + (voff)[_i]), (PG8_LAS unsigned*)(lds + (bufoff) + ldsw + _i * 8192), 16, 0, 0); } while (0)
#define PG8_LDA(dst, b, h) do { _Pragma("unroll") for (int m = 0; m < 4; ++m) _Pragma("unroll") for (int k = 0; k < 2; ++k) dst[m][k] = *(const PG8_LAS bf16x8*)(lds + PG8_SA(b, h) + aoff + m * 2048 + k * 1024); } while (0)
#define PG8_LDB(dst, b, h) do { _Pragma("unroll") for (int n = 0; n < 2; ++n) _Pragma("unroll") for (int k = 0; k < 2; ++k) dst[n][k] = *(const PG8_LAS bf16x8*)(lds + PG8_SB(b, h) + boff + n * 2048 + k * 1024); } while (0)
#define PG8_MMA(ai, bj, At, Bt) do { __builtin_amdgcn_s_setprio(1); _Pragma("unroll") for (int m = 0; m < 4; ++m) _Pragma("unroll") for (int n = 0; n < 2; ++n) _Pragma("unroll") for (int k = 0; k < 2; ++k) \
        acc[ai][bj][m][n] = __builtin_amdgcn_mfma_f32_16x16x32_bf16(Bt[n][k], At[m][k], acc[ai][bj][m][n], 0, 0, 0); __builtin_amdgcn_s_setprio(0); } while (0)
#define PG8_WAIT_V(n) asm volatile("s_waitcnt vmcnt(" #n ")" ::: "memory")
#define PG8_WAIT_L(n) asm volatile("s_waitcnt lgkmcnt(" #n ")" ::: "memory")
#define PG8_BAR __builtin_amdgcn_s_barrier()
#define PG8_SCHED __builtin_amdgcn_sched_barrier(0)
    Unit cur, nxt; int ui = 0;
    if (!S.next(0, cur)) return;
    f32x4 acc[2][2][4][2];
#pragma unroll
    for (int a = 0; a < 2; ++a)
#pragma unroll
        for (int b = 0; b < 2; ++b)
#pragma unroll
            for (int m = 0; m < 4; ++m)
#pragma unroll
                for (int n = 0; n < 2; ++n) acc[a][b][m][n] = (f32x4){0.f, 0.f, 0.f, 0.f};
    bf16x8 At[4][2], B0[2][2], B1[2][2];
    const char* cA = (const char*)g.A + (size_t)cur.pm * tstepA; const char* cB = (const char*)g.Bt + (size_t)cur.pn * tstepB;
    S.a_ready(cur);
    if constexpr (SP2) {
        PG8_STAGE(PG8_SB(0, 0), cB, voffB); PG8_STAGE(PG8_SB(0, 1), cB + hstepB, voffB); PG8_STAGE(PG8_SA(0, 0), cA, voffA); PG8_STAGE(PG8_SA(0, 1), cA + hstepA, voffA);
        if (wr == 1) PG8_BAR;
        PG8_WAIT_V(2); PG8_BAR;
        PG8_STAGE(PG8_SB(1, 0), cB + kstep, voffB); PG8_STAGE(PG8_SA(1, 0), cA + kstep, voffA); PG8_STAGE(PG8_SB(1, 1), cB + hstepB + kstep, voffB);
        PG8_WAIT_V(6); PG8_BAR;
    } else {
        PG8_STAGE(PG8_SB(0, 0), cB, voffB); PG8_STAGE(PG8_SA(0, 0), cA, voffA); PG8_STAGE(PG8_SB(0, 1), cB + hstepB, voffB); PG8_STAGE(PG8_SA(0, 1), cA + hstepA, voffA);
        if (wr == 1) PG8_BAR;
        PG8_WAIT_V(4); PG8_BAR;
        PG8_STAGE(PG8_SB(1, 0), cB + kstep, voffB); PG8_STAGE(PG8_SA(1, 0), cA + kstep, voffA); PG8_STAGE(PG8_SB(1, 1), cB + hstepB + kstep, voffB);
        PG8_WAIT_V(6); PG8_BAR;
    }
    for (;;) {
        const bool has_next = S.next(ui + 1, nxt);
        const char* nA = has_next ? (const char*)g.A + (size_t)nxt.pm * tstepA : cA; const char* nB = has_next ? (const char*)g.Bt + (size_t)nxt.pn * tstepB : cB;
        for (int t = 0; t < nt; t += 2) {
            const bool last = (t == nt - 2);
            const char* a1 = cA + (size_t)(t + 1) * kstep;
            const char* a2 = last ? nA : cA + (size_t)(t + 2) * kstep; const char* b2 = last ? nB : cB + (size_t)(t + 2) * kstep;
            const char* a3 = a2 + kstep; const char* b3 = b2 + kstep;
            if (last && has_next) S.a_ready(nxt);
            if constexpr (SP2) {
            PG8_LDB(B0, 0, 0); PG8_LDB(B1, 0, 1); PG8_SCHED; PG8_LDA(At, 0, 0); PG8_STAGE(PG8_SA(1, 1), a1 + hstepA, voffA);
            PG8_WAIT_V(8); PG8_WAIT_L(0); PG8_BAR; PG8_MMA(0, 0, At, B0); PG8_MMA(0, 1, At, B1); PG8_BAR; PG8_SCHED;
            PG8_LDA(At, 0, 1); PG8_STAGE(PG8_SB(0, 0), b2, voffB); PG8_STAGE(PG8_SB(0, 1), b2 + hstepB, voffB); PG8_STAGE(PG8_SA(0, 0), a2, voffA);
            PG8_WAIT_V(8); PG8_WAIT_L(0); PG8_BAR; PG8_MMA(1, 0, At, B0); PG8_MMA(1, 1, At, B1); PG8_BAR; PG8_SCHED;
            PG8_LDB(B0, 1, 0); PG8_LDB(B1, 1, 1); PG8_SCHED; PG8_LDA(At, 1, 0); PG8_STAGE(PG8_SA(0, 1), a2 + hstepA, voffA);
            PG8_WAIT_V(8); PG8_WAIT_L(0); PG8_BAR; PG8_MMA(0, 0, At, B0); PG8_MMA(0, 1, At, B1); PG8_BAR; PG8_SCHED;
            PG8_LDA(At, 1, 1); PG8_STAGE(PG8_SB(1, 0), b3, voffB); PG8_STAGE(PG8_SB(1, 1), b3 + hstepB, voffB); PG8_STAGE(PG8_SA(1, 0), a3, voffA);
            PG8_WAIT_V(8); PG8_WAIT_L(0); PG8_BAR; PG8_MMA(1, 0, At, B0); PG8_MMA(1, 1, At, B1); PG8_BAR; PG8_SCHED;
            } else {
            PG8_LDB(B0, 0, 0); PG8_SCHED; PG8_LDA(At, 0, 0); PG8_STAGE(PG8_SA(1, 1), a1 + hstepA, voffA);
            PG8_WAIT_L(8); PG8_BAR; PG8_WAIT_L(0); PG8_MMA(0, 0, At, B0); PG8_BAR; PG8_SCHED;
            PG8_LDB(B1, 0, 1); PG8_STAGE(PG8_SB(0, 0), b2, voffB);
            PG8_BAR; PG8_WAIT_L(0); PG8_MMA(0, 1, At, B1); PG8_BAR;
            PG8_LDA(At, 0, 1); PG8_STAGE(PG8_SA(0, 0), a2, voffA);
            PG8_BAR; PG8_WAIT_L(0); PG8_MMA(1, 0, At, B0); PG8_BAR; PG8_SCHED;
            PG8_STAGE(PG8_SB(0, 1), b2 + hstepB, voffB);
            PG8_WAIT_V(6); PG8_BAR; PG8_MMA(1, 1, At, B1); PG8_BAR;
            PG8_LDB(B0, 1, 0); PG8_SCHED; PG8_LDA(At, 1, 0); PG8_STAGE(PG8_SA(0, 1), a2 + hstepA, voffA);
            PG8_WAIT_L(8); PG8_BAR; PG8_WAIT_L(0); PG8_MMA(0, 0, At, B0); PG8_BAR; PG8_SCHED;
            PG8_LDB(B1, 1, 1); PG8_STAGE(PG8_SB(1, 0), b3, voffB);
            PG8_BAR; PG8_WAIT_L(0); PG8_MMA(0, 1, At, B1); PG8_BAR;
            PG8_LDA(At, 1, 1); PG8_STAGE(PG8_SA(1, 0), a3, voffA);
            PG8_BAR; PG8_WAIT_L(0); PG8_MMA(1, 0, At, B0); PG8_BAR; PG8_SCHED;
            PG8_STAGE(PG8_SB(1, 1), b3 + hstepB, voffB);
            PG8_WAIT_V(6); PG8_BAR; PG8_MMA(1, 1, At, B1); PG8_BAR;
            }
        }
        if constexpr (ALIGN_EPI) { if (wr == 0) PG8_BAR; }
        if constexpr (!Epi::AFTER_DRAIN) { E(acc, cur, wr, wc, fr, fq); S.done(cur); }
        if (!has_next) break;
#pragma unroll
        for (int a = 0; a < 2; ++a)
#pragma unroll
            for (int b = 0; b < 2; ++b)
#pragma unroll
                for (int m = 0; m < 4; ++m)
#pragma unroll
                    for (int n = 0; n < 2; ++n) acc[a][b][m][n] = (f32x4){0.f, 0.f, 0.f, 0.f};
        cur = nxt; cA = nA; cB = nB; ++ui;
        if constexpr (ALIGN_EPI) { if (wr == 1) PG8_BAR; }
    }
    PG8_WAIT_V(0);
    if constexpr (!ALIGN_EPI) { if (wr == 0) PG8_BAR; }
    PG8_BAR;
    if constexpr (Epi::AFTER_DRAIN) { E.fused(acc, cur, wr, wc, fr, fq, lds, wid, lane); S.done(cur); }
#undef PG8_SA
#undef PG8_SB
#undef PG8_STAGE
#undef PG8_LDA
#undef PG8_LDB
#undef PG8_MMA
#undef PG8_WAIT_V
#undef PG8_WAIT_L
#undef PG8_BAR
#undef PG8_SCHED
}
}

namespace att {
typedef unsigned short bf16_t;
using bf16x8 = __attribute__((ext_vector_type(8))) short;
using s16x4  = __attribute__((ext_vector_type(4))) short;
using f32x16 = __attribute__((ext_vector_type(16))) float;
using u32x4  = __attribute__((ext_vector_type(4))) unsigned;
constexpr int NW = 8, QBLK = 32, KVBLK = 64;
constexpr float SCALE = 0.10206207261596575f;
constexpr float THR = 8.f;
constexpr int LDQ = 768, LDKN = 512, LDKR = 32, LDV = 512, LDO = 1024;
constexpr int SHM_V = 64 * 128 * 2, SHM_K = 64 * 128 * 2;
#define KSWZ(row, colB) ((row) * 256 + ((colB) ^ (((row) & 7) << 4)))
#define SBAR() __builtin_amdgcn_sched_barrier(0)
__device__ __forceinline__ int crow(int r, int hi) { return (r & 3) + 8 * (r >> 2) + 4 * hi; }
__device__ __forceinline__ unsigned cvtpk(float lo, float hi) { unsigned r; asm volatile("v_cvt_pk_bf16_f32 %0, %1, %2" : "=v"(r) : "v"(lo), "v"(hi)); return r; }
template <bool FIRST> __device__ __forceinline__ void partialSM(f32x16& p0, f32x16& p1, float& m_ref, f32x16& negm, float& alpha) {
  constexpr float THR2 = THR * 1.4426950408889634f;
  float pmax = p0[0];
#pragma unroll
  for (int r = 1; r < 16; ++r) pmax = fmaxf(pmax, p0[r]);
#pragma unroll
  for (int r = 0; r < 16; ++r) pmax = fmaxf(pmax, p1[r]);
  { auto rr = __builtin_amdgcn_permlane32_swap(__float_as_uint(pmax), __float_as_uint(pmax), false, false);
    pmax = fmaxf(__uint_as_float(rr[0]), __uint_as_float(rr[1])); }
  alpha = 1.f;
  if (FIRST || !__builtin_expect(__all(pmax <= THR2), 1)) {
    const float dl = FIRST ? pmax : fmaxf(pmax, 0.f);
    m_ref += dl; alpha = FIRST ? 1.f : __builtin_amdgcn_exp2f(-dl);
#pragma unroll
    for (int r = 0; r < 16; ++r) { p0[r] -= dl; p1[r] -= dl; }
#pragma unroll
    for (int r = 0; r < 16; ++r) negm[r] = -m_ref;
    asm volatile("" : "+v"(negm));
  }
#pragma unroll
  for (int r = 0; r < 16; ++r) p0[r] = __builtin_amdgcn_exp2f(p0[r]);
}
__device__ __forceinline__ void finishSM(f32x16& p0, f32x16& p1, bf16x8& pa0, bf16x8& pa1, bf16x8& pa2, bf16x8& pa3) {
#pragma unroll
  for (int r = 0; r < 16; ++r) p1[r] = __builtin_amdgcn_exp2f(p1[r]);
#define PK4(P, BASE, OUT) do { unsigned a0 = cvtpk(P[BASE + 0], P[BASE + 1]), a1 = cvtpk(P[BASE + 2], P[BASE + 3]);   \
    unsigned b0 = cvtpk(P[BASE + 4], P[BASE + 5]), b1 = cvtpk(P[BASE + 6], P[BASE + 7]);                              \
    auto r0 = __builtin_amdgcn_permlane32_swap(a0, b0, false, false); auto r1 = __builtin_amdgcn_permlane32_swap(a1, b1, false, false); \
    u32x4 w = {r0[0], r1[0], r0[1], r1[1]}; OUT = *reinterpret_cast<bf16x8*>(&w); } while (0)
  PK4(p0, 0, pa0); PK4(p0, 8, pa1); PK4(p1, 0, pa2); PK4(p1, 8, pa3);
#undef PK4
}
__device__ __forceinline__ void qkt(f32x16& p0, f32x16& p1, const bf16_t* Ks, const bf16x8* qr, const f32x16& negm, int r32, int hi) {
#pragma unroll
  for (int d0 = 0; d0 < 6; ++d0) { int cb = (d0 * 16 + hi * 8) * 2;
    bf16x8 b0 = *reinterpret_cast<const bf16x8*>((const char*)Ks + KSWZ(r32, cb));
    bf16x8 b1 = *reinterpret_cast<const bf16x8*>((const char*)Ks + KSWZ(32 + r32, cb));
    if (d0 == 0) { p0 = __builtin_amdgcn_mfma_f32_32x32x16_bf16(b0, qr[0], negm, 0, 0, 0); p1 = __builtin_amdgcn_mfma_f32_32x32x16_bf16(b1, qr[0], negm, 0, 0, 0); }
    else { p0 = __builtin_amdgcn_mfma_f32_32x32x16_bf16(b0, qr[d0], p0, 0, 0, 0); p1 = __builtin_amdgcn_mfma_f32_32x32x16_bf16(b1, qr[d0], p1, 0, 0, 0); } }
}
__device__ __forceinline__ int v_st(int k, int c) { const int kk = (k & ~0xC) | ((k & 4) << 1) | ((k & 8) >> 1); return ((kk >> 3) * 4 + (c >> 5)) * 512 + ((kk & 7) * 32 + (c & 31)) * 2; }
__device__ __forceinline__ int v_rd_base(int lane) { return ((lane & 3) << 3) | (((lane >> 2) & 3) << 6) | (((lane >> 4) & 1) << 5) | (((lane >> 5) & 1) << 8); }
constexpr int v_rd_off(int d0, int ks, int half) { return d0 * 512 + ks * 4096 + half * 2048; }
template <int OFF> __device__ __forceinline__ s16x4 tr_read(int vb) {
  s16x4 r; asm volatile("ds_read_b64_tr_b16 %0, %1 offset:%2" : "=&v"(r) : "v"(vb), "i"(OFF) : "memory"); return r;
}
template <int D0> __device__ __forceinline__ void pv_one(f32x16& od, int vb, bf16x8 pa0, bf16x8 pa1, bf16x8 pa2, bf16x8 pa3) {
  const s16x4 l0 = tr_read<v_rd_off(D0, 0, 0)>(vb), h0 = tr_read<v_rd_off(D0, 0, 1)>(vb), l1 = tr_read<v_rd_off(D0, 1, 0)>(vb), h1 = tr_read<v_rd_off(D0, 1, 1)>(vb);
  const s16x4 l2 = tr_read<v_rd_off(D0, 2, 0)>(vb), h2 = tr_read<v_rd_off(D0, 2, 1)>(vb), l3 = tr_read<v_rd_off(D0, 3, 0)>(vb), h3 = tr_read<v_rd_off(D0, 3, 1)>(vb);
  asm volatile("s_waitcnt lgkmcnt(0)" ::: "memory"); SBAR();
#define PK(L, H) (bf16x8){L[0], L[1], L[2], L[3], H[0], H[1], H[2], H[3]}
  od = __builtin_amdgcn_mfma_f32_32x32x16_bf16(pa0, PK(l0, h0), od, 0, 0, 0);
  od = __builtin_amdgcn_mfma_f32_32x32x16_bf16(pa1, PK(l1, h1), od, 0, 0, 0);
  od = __builtin_amdgcn_mfma_f32_32x32x16_bf16(pa2, PK(l2, h2), od, 0, 0, 0);
  od = __builtin_amdgcn_mfma_f32_32x32x16_bf16(pa3, PK(l3, h3), od, 0, 0, 0);
#undef PK
}
__device__ __forceinline__ void pv_d0(f32x16* o, f32x16& osum, int vb, bf16x8 pa0, bf16x8 pa1, bf16x8 pa2, bf16x8 pa3) {
  pv_one<0>(o[0], vb, pa0, pa1, pa2, pa3); pv_one<1>(o[1], vb, pa0, pa1, pa2, pa3);
  const short one = (short)0x3F80; const bf16x8 ones = {one, one, one, one, one, one, one, one};
  osum = __builtin_amdgcn_mfma_f32_32x32x16_bf16(pa0, ones, osum, 0, 0, 0); osum = __builtin_amdgcn_mfma_f32_32x32x16_bf16(pa1, ones, osum, 0, 0, 0);
  osum = __builtin_amdgcn_mfma_f32_32x32x16_bf16(pa2, ones, osum, 0, 0, 0); osum = __builtin_amdgcn_mfma_f32_32x32x16_bf16(pa3, ones, osum, 0, 0, 0);
}
__device__ __forceinline__ void attn_unit(const bf16_t* __restrict__ Qb, const bf16_t* __restrict__ KNh, const bf16_t* __restrict__ KRb, const bf16_t* __restrict__ Vh,
                                          bf16_t* __restrict__ Ob, int seq, int qrow0, const float* __restrict__ ropec, const float* __restrict__ ropes, char* lds) {
  int tid_ = threadIdx.x; asm volatile("" : "+v"(tid_)); const int tid = tid_, wid = __builtin_amdgcn_readfirstlane(tid >> 6), lane = tid & 63, r32 = lane & 31, hi = lane >> 5;
  bf16_t* V_lds = (bf16_t*)lds; bf16_t* K_lds = (bf16_t*)(lds + 3 * SHM_V);
  float* ws = (float*)(lds + 3 * SHM_V + 3 * SHM_K) + wid * 64; float* al_l = ws + 32;
  float m_ref = 0.f; f32x16 o[2] = {}; f32x16 osum = {}; f32x16 negm = {}; asm volatile("" : "+v"(negm)); bf16x8 qr[6];
  const int srow = tid >> 3, sch = tid & 7, srow2 = tid >> 2, sch2 = tid & 3;
  const bf16_t* kp = KNh + (long)srow * LDKN + 8 * sch; const bf16_t* vp = Vh + (long)srow * LDV + 8 * sch; const bf16_t* rp = KRb + (long)(srow2 & 63) * LDKR + 8 * sch2;
  const int kst = KSWZ(srow, 16 * sch), vst = v_st(srow, 8 * sch), rst = KSWZ(srow2 & 63, 128 + 16 * sch2);
  const bool has_r = wid < 4;
  constexpr int BUF = SHM_V;
  const int vb0 = (int)(uintptr_t)V_lds + v_rd_base(lane);
  struct { bf16x8 v, k, r; } sr_[2];
#define SLOAD(i, k0) do { sr_[i].v = *reinterpret_cast<const bf16x8*>(vp + (long)(k0) * LDV); sr_[i].k = *reinterpret_cast<const bf16x8*>(kp + (long)(k0) * LDKN); \
    if (has_r) sr_[i].r = *reinterpret_cast<const bf16x8*>(rp + (long)(k0) * LDKR); } while (0)
#define SWRITE(off, i) do { *(bf16x8*)((char*)V_lds + (off) + vst) = sr_[i].v; *(bf16x8*)((char*)K_lds + (off) + kst) = sr_[i].k; \
    if (has_r) *(bf16x8*)((char*)K_lds + (off) + rst) = sr_[i].r; } while (0)
#define SWAIT() do { if (has_r) asm volatile("s_waitcnt vmcnt(3)" ::: "memory"); else asm volatile("s_waitcnt vmcnt(2)" ::: "memory"); } while (0)
  constexpr int SE = 0, SO = 1;
  const int NT = seq / KVBLK;
  SLOAD(SE, 0); SLOAD(SO, KVBLK);
  const bf16_t* Qw = Qb + (long)(wid * QBLK + r32) * LDQ + hi * 8;
#pragma unroll
  for (int d0 = 0; d0 < 6; ++d0) qr[d0] = *reinterpret_cast<const bf16x8*>(Qw + d0 * 16);
  {
    const int pos = row_pos(qrow0 + wid * QBLK + r32); const float* cp = ropec + pos * 16 + 8 * hi; const float* sp = ropes + pos * 16 + 8 * hi;
    unsigned w1[4], w2[4];
#pragma unroll
    for (int e = 0; e < 8; e += 2) { float o1[2], o2[2];
#pragma unroll
      for (int f = 0; f < 2; ++f) { const float x1 = __uint_as_float(((unsigned)(unsigned short)qr[4][e + f]) << 16), x2 = __uint_as_float(((unsigned)(unsigned short)qr[5][e + f]) << 16); const float c = cp[e + f], s = sp[e + f];
        o1[f] = x1 * c - x2 * s; o2[f] = x1 * s + x2 * c; }
      w1[e >> 1] = cvtpk(o1[0], o1[1]); w2[e >> 1] = cvtpk(o2[0], o2[1]); }
    u32x4 v1 = {w1[0], w1[1], w1[2], w1[3]}, v2 = {w2[0], w2[1], w2[2], w2[3]}; qr[4] = *reinterpret_cast<bf16x8*>(&v1); qr[5] = *reinterpret_cast<bf16x8*>(&v2); }
#define RESC(a) do { if (__any((a) < 1.f)) { if (hi == 0) al_l[r32] = (a); asm volatile("s_waitcnt lgkmcnt(0)" ::: "memory"); \
    _Pragma("unroll") for (int r = 0; r < 16; ++r) { const float f_ = al_l[crow(r, hi)]; o[0][r] *= f_; o[1][r] *= f_; osum[r] *= f_; } } } while (0)
#define ROT() do { const int t_ = o_prev; o_prev = o_cur; o_cur = o_next; o_next = t_; } while (0)
  f32x16 pA0, pA1, pB0, pB1; float alA, alB; bf16x8 pa0, pa1, pa2, pa3;
  int o_prev = 2 * BUF, o_cur = 0, o_next = BUF;
  asm volatile("s_waitcnt vmcnt(0)" ::: "memory"); SWRITE(0, SE); __syncthreads();
  qkt(pA0, pA1, K_lds, qr, negm, r32, hi); partialSM<true>(pA0, pA1, m_ref, negm, alA);
  if (2 < NT) SLOAD(SE, 2 * KVBLK);
  SWAIT(); SWRITE(BUF, SO); __syncthreads();
  ROT();
  for (int j = 1; j + 1 < NT; j += 2) {
    SBAR(); qkt(pB0, pB1, (bf16_t*)((char*)K_lds + o_cur), qr, negm, r32, hi);
    finishSM(pA0, pA1, pa0, pa1, pa2, pa3); SBAR();
    SLOAD(SO, (j + 2) * KVBLK); SBAR();
    pv_d0(o, osum, vb0 + o_prev, pa0, pa1, pa2, pa3); partialSM<false>(pB0, pB1, m_ref, negm, alB);
    SWAIT(); SWRITE(o_next, SE);
    RESC(alB); __syncthreads(); ROT();
    SBAR(); qkt(pA0, pA1, (bf16_t*)((char*)K_lds + o_cur), qr, negm, r32, hi);
    finishSM(pB0, pB1, pa0, pa1, pa2, pa3); SBAR();
    if (j + 3 < NT) SLOAD(SE, (j + 3) * KVBLK); SBAR();
    pv_d0(o, osum, vb0 + o_prev, pa0, pa1, pa2, pa3); partialSM<false>(pA0, pA1, m_ref, negm, alA);
    SWAIT(); SWRITE(o_next, SO);
    RESC(alA); __syncthreads(); ROT();
  }
  SBAR(); qkt(pB0, pB1, (bf16_t*)((char*)K_lds + o_cur), qr, negm, r32, hi);
  finishSM(pA0, pA1, pa0, pa1, pa2, pa3); SBAR();
  pv_d0(o, osum, vb0 + o_prev, pa0, pa1, pa2, pa3); partialSM<false>(pB0, pB1, m_ref, negm, alB);
  RESC(alB);
  finishSM(pB0, pB1, pa0, pa1, pa2, pa3); SBAR();
  pv_d0(o, osum, vb0 + o_cur, pa0, pa1, pa2, pa3);
  float rli[16];
#pragma unroll
  for (int r = 0; r < 16; ++r) rli[r] = __builtin_amdgcn_rcpf(osum[r]);
  bf16_t* Ow = Ob + (long)(wid * QBLK) * LDO;
#pragma unroll
  for (int r = 0; r < 16; ++r) { int orow = crow(r, hi);
#pragma unroll
    for (int d0 = 0; d0 < 2; ++d0) { const unsigned w = cvtpk(o[d0][r] * rli[r], 0.f); Ow[(long)orow * LDO + d0 * 32 + r32] = (bf16_t)(w & 0xffffu); } }
  __syncthreads();
#undef SLOAD
#undef SWRITE
#undef SWAIT
#undef RESC
#undef ROT
}
#undef KSWZ
#undef SBAR
}
namespace hg {
typedef unsigned short bf16_t;
using bf16x8 = __attribute__((ext_vector_type(8))) short;
using f32x16 = __attribute__((ext_vector_type(16))) float;
using f32x4  = __attribute__((ext_vector_type(4))) float;
using u32x4  = __attribute__((ext_vector_type(4))) unsigned;
#define SWZ256(row, colB) ((row) * 256 + ((colB) ^ (((row) & 7) << 4)))
#define SWZ128(row, colB) ((row) * 128 + ((colB) ^ (((((row) >> 4) ^ (row)) & 7) << 4)))
constexpr int GS = 132;
constexpr int L_ST = 0, L_QH = 32768, L_KH = 49152, L_KT = 65536, L_VT = 81920, L_GB = 98304, L_SEG = 98304 + 64 * GS * 4, L_DD = L_SEG + 2048, L_LB = L_DD + 512;
__device__ __forceinline__ int crow(int r, int hi) { return (r & 3) + 8 * (r >> 2) + 4 * hi; }
__device__ __forceinline__ unsigned cvtpk(float lo, float hi) { unsigned r; asm volatile("v_cvt_pk_bf16_f32 %0, %1, %2" : "=v"(r) : "v"(lo), "v"(hi)); return r; }
__device__ __forceinline__ float bf2f(unsigned short h) { return __uint_as_float(((unsigned)h) << 16); }
typedef float f32x2_t __attribute__((ext_vector_type(2))); typedef __bf16 bf16x2_t __attribute__((ext_vector_type(2)));
__device__ __forceinline__ unsigned cvtpk_m(float lo, float hi) { f32x2_t v = {lo, hi}; bf16x2_t b = __builtin_convertvector(v, bf16x2_t); return __builtin_bit_cast(unsigned, b); }
template <int MODE> __device__ __forceinline__ void chain(const bf16_t* __restrict__ U, bf16_t* __restrict__ OP, const float* __restrict__ hg_lb, int rowbase, int S, int h, int dir, int tau0, int nchunk,
                                                   const float* __restrict__ slot_in, float* __restrict__ slot_out, float* __restrict__ dseg_out, char* lds) {
  int tid_ = threadIdx.x; asm volatile("" : "+v"(tid_)); const int tid = tid_, wid = __builtin_amdgcn_readfirstlane(tid >> 6), lane = tid & 63, r32 = lane & 31, hi = lane >> 5;
  float* GB = (float*)(lds + L_GB); float* SEG = (float*)(lds + L_SEG); float* DD = (float*)(lds + L_DD); float* LB = (float*)(lds + L_LB);
  char* ST = lds + L_ST; char* QH = lds + L_QH; char* KH = lds + L_KH; char* KT = lds + L_KT; char* VT = lds + L_VT; char* AL = lds + L_GB;
  if (tid < 128) { const float a0 = hg_lb[dir * 1024 + h * 128 + tid], a1 = hg_lb[dir * 1024 + 512 + h * 128 + tid]; LB[tid] = 1.0f / (1.0f + __expf(a1 - a0)); }
  f32x16 sacc[2]; sacc[0] = f32x16{}; sacc[1] = f32x16{};
  if (MODE == 3) {
    if (slot_in) {
#pragma unroll
      for (int i = 0; i < 2; ++i)
#pragma unroll
        for (int r = 0; r < 16; ++r) sacc[i][r] = slot_in[(32 * (wid & 3) + crow(r, hi)) * 128 + 32 * (2 * (wid >> 2) + i) + r32];
    }
#pragma unroll
    for (int i = 0; i < 2; ++i)
#pragma unroll
      for (int r = 0; r < 16; ++r) *(bf16_t*)(ST + SWZ256(32 * (wid & 3) + crow(r, hi), 2 * (32 * (2 * (wid >> 2) + i) + r32))) = (bf16_t)(cvtpk(sacc[i][r], 0.f) & 0xffffu);
  }
  float dseg = 1.0f;
  const int tau = tid >> 3, c0 = (tid & 7) * 16, segt = tau >> 4;
  const bf16_t* Ub = U + (size_t)rowbase * 2560 + h * 128 + c0;
  const size_t offq = 0, offv = 512, offf = (size_t)(2 + dir) * 512;
  bf16_t* OPd = OP + (size_t)dir * T_ALL * 512;
  bf16x8 nq0 = {}, nq1 = {}, nv0, nv1, nf0, nf1;
  { const int t1 = tau0 + tau; const int tok = dir ? (S - 1 - t1) : t1; const bf16_t* p = Ub + (size_t)tok * 2560;
    if (MODE == 3) { nq0 = *(const bf16x8*)(p + offq); nq1 = *(const bf16x8*)(p + offq + 8); } nv0 = *(const bf16x8*)(p + offv); nv1 = *(const bf16x8*)(p + offv + 8); nf0 = *(const bf16x8*)(p + offf); nf1 = *(const bf16x8*)(p + offf + 8); }
  __syncthreads();
  for (int ci = 0; ci < nchunk; ++ci) {
    const bf16x8 qv[2] = {nq0, nq1}, vv[2] = {nv0, nv1}, fv[2] = {nf0, nf1};
    { const int cn = (ci + 1 < nchunk) ? ci + 1 : ci; const int t2 = tau0 + cn * 64 + tau; const int tok = dir ? (S - 1 - t2) : t2; const bf16_t* p = Ub + (size_t)tok * 2560;
      if (MODE == 3) { nq0 = *(const bf16x8*)(p + offq); nq1 = *(const bf16x8*)(p + offq + 8); } nv0 = *(const bf16x8*)(p + offv); nv1 = *(const bf16x8*)(p + offv + 8); nf0 = *(const bf16x8*)(p + offf); nf1 = *(const bf16x8*)(p + offf + 8); }
    float qq[16], kk[16];
#pragma unroll
    for (int j = 0; j < 16; ++j) {
      const float z = bf2f((unsigned short)fv[j >> 3][j & 7]); const float x = bf2f((unsigned short)qv[j >> 3][j & 7]);
      const float lbv = LB[c0 + j]; const float sg = __builtin_amdgcn_rcpf(1.0f + __builtin_amdgcn_exp2f(-1.4426950408889634f * z)); const float f = lbv + (1.0f - lbv) * sg;
      kk[j] = 1.0f - f; qq[j] = (MODE == 3) ? x * __builtin_amdgcn_rcpf(1.0f + __builtin_amdgcn_exp2f(-1.4426950408889634f * x)) : 0.f;
      GB[tau * GS + c0 + j] = __builtin_amdgcn_logf(f);
    }
    __syncthreads();
    { const int k = tid & 127, seg = tid >> 7; float run = 0.f;
#pragma unroll
      for (int j = 0; j < 16; ++j) { run += GB[(16 * seg + j) * GS + k]; GB[(16 * seg + j) * GS + k] = run; }
      SEG[seg * 128 + k] = run; }
    __syncthreads();
    { unsigned qh[8] = {}, kh[8] = {};
#pragma unroll
      for (int j = 0; j < 16; j += 2) {
        float g2[2], gl2[2];
#pragma unroll
        for (int e = 0; e < 2; ++e) { const int col = c0 + j + e; const float s0 = SEG[col], s1 = SEG[128 + col], s2 = SEG[256 + col];
          const float off = (segt >= 1 ? s0 : 0.f) + (segt >= 2 ? s1 : 0.f) + (segt >= 3 ? s2 : 0.f);
          g2[e] = GB[tau * GS + col] + off; gl2[e] = GB[63 * GS + col] + ((s0 + s1) + s2); }
        if (MODE == 3) { const float ea = __builtin_amdgcn_exp2f(g2[0]), eb = __builtin_amdgcn_exp2f(g2[1]);
          qh[j >> 1] = cvtpk(qq[j] * ea, qq[j + 1] * eb);
          kh[j >> 1] = cvtpk(kk[j] * __builtin_amdgcn_exp2f(fminf(-g2[0], 115.f)), kk[j + 1] * __builtin_amdgcn_exp2f(fminf(-g2[1], 115.f))); }
        const unsigned kt = cvtpk(kk[j] * __builtin_amdgcn_exp2f(gl2[0] - g2[0]), kk[j + 1] * __builtin_amdgcn_exp2f(gl2[1] - g2[1]));
        *(bf16_t*)(KT + SWZ128(c0 + j, 2 * tau)) = (bf16_t)(kt & 0xffffu); *(bf16_t*)(KT + SWZ128(c0 + j + 1, 2 * tau)) = (bf16_t)(kt >> 16);
        *(bf16_t*)(VT + SWZ128(c0 + j, 2 * tau)) = (bf16_t)vv[j >> 3][j & 7]; *(bf16_t*)(VT + SWZ128(c0 + j + 1, 2 * tau)) = (bf16_t)vv[(j + 1) >> 3][(j + 1) & 7];
        if (tau == 63) { DD[c0 + j] = __builtin_amdgcn_exp2f(gl2[0]); DD[c0 + j + 1] = __builtin_amdgcn_exp2f(gl2[1]); }
      }
      if (MODE == 3) {
      *(u32x4*)(QH + SWZ256(tau, 2 * c0)) = (u32x4){qh[0], qh[1], qh[2], qh[3]}; *(u32x4*)(QH + SWZ256(tau, 2 * c0 + 16)) = (u32x4){qh[4], qh[5], qh[6], qh[7]};
      *(u32x4*)(KH + SWZ256(tau, 2 * c0)) = (u32x4){kh[0], kh[1], kh[2], kh[3]}; *(u32x4*)(KH + SWZ256(tau, 2 * c0 + 16)) = (u32x4){kh[4], kh[5], kh[6], kh[7]}; }
    }
    __syncthreads();
    if (MODE == 3 && wid < 4 && wid != 1) { const int ti = wid >> 1, si = wid & 1; f32x16 a = f32x16{};
#pragma unroll
      for (int k8 = 0; k8 < 8; ++k8) { const int cb = (16 * k8 + 8 * hi) * 2;
        const bf16x8 av = *(const bf16x8*)(QH + SWZ256(32 * ti + r32, cb)); const bf16x8 bv = *(const bf16x8*)(KH + SWZ256(32 * si + r32, cb));
        a = __builtin_amdgcn_mfma_f32_32x32x16_bf16(av, bv, a, 0, 0, 0); }
#pragma unroll
      for (int r = 0; r < 16; ++r) { const int tl = 32 * ti + crow(r, hi), sl = 32 * si + r32; const float val = (sl <= tl) ? a[r] : 0.f;
        *(bf16_t*)(AL + SWZ128(tl, 2 * sl)) = (bf16_t)(cvtpk(val, 0.f) & 0xffffu); } }
    if (MODE == 3) __syncthreads();
    { const int th = wid >> 2, vb = wid & 3;
      if (MODE == 3) { f32x16 o = f32x16{};
      const int nks = th ? 4 : 2;
      for (int ks = 0; ks < nks; ++ks) { const int cb = (16 * ks + 8 * hi) * 2;
        const bf16x8 av = *(const bf16x8*)(AL + SWZ128(32 * th + r32, cb)); const bf16x8 bv = *(const bf16x8*)(VT + SWZ128(32 * vb + r32, cb));
        o = __builtin_amdgcn_mfma_f32_32x32x16_bf16(av, bv, o, 0, 0, 0); }
#pragma unroll
      for (int k8 = 0; k8 < 8; ++k8) { const int cb = (16 * k8 + 8 * hi) * 2;
        const bf16x8 av = *(const bf16x8*)(QH + SWZ256(32 * th + r32, cb)); const bf16x8 bv = *(const bf16x8*)(ST + SWZ256(32 * vb + r32, cb));
        o = __builtin_amdgcn_mfma_f32_32x32x16_bf16(av, bv, o, 0, 0, 0); }
#pragma unroll
      for (int r = 0; r < 16; ++r) { const int t2 = tau0 + ci * 64 + 32 * th + crow(r, hi); const int tok = dir ? (S - 1 - t2) : t2;
        OPd[(size_t)(rowbase + tok) * 512 + h * 128 + 32 * vb + r32] = (bf16_t)(cvtpk_m(o[r], 0.f) & 0xffffu); }
      } else { if (tid < 128) dseg *= DD[tid]; }
#pragma unroll
      for (int i = 0; i < 2; ++i) { const int kb = 2 * th + i; const float dk = DD[32 * kb + r32];
#pragma unroll
        for (int r = 0; r < 16; ++r) sacc[i][r] *= dk;
#pragma unroll
        for (int ks = 0; ks < 4; ++ks) { const int cb = (16 * ks + 8 * hi) * 2;
          const bf16x8 av = *(const bf16x8*)(VT + SWZ128(32 * vb + r32, cb)); const bf16x8 bv = *(const bf16x8*)(KT + SWZ128(32 * kb + r32, cb));
          sacc[i] = __builtin_amdgcn_mfma_f32_32x32x16_bf16(av, bv, sacc[i], 0, 0, 0); } }
    }
    __syncthreads();
    if (MODE == 3) { const int th = wid >> 2, vb = wid & 3;
#pragma unroll
      for (int i = 0; i < 2; ++i) { const int kb = 2 * th + i;
#pragma unroll
        for (int r = 0; r < 16; ++r) *(bf16_t*)(ST + SWZ256(32 * vb + crow(r, hi), 2 * (32 * kb + r32))) = (bf16_t)(cvtpk(sacc[i][r], 0.f) & 0xffffu); } }
  }
  if (MODE == 1) {
#pragma unroll
    for (int i = 0; i < 2; ++i)
#pragma unroll
      for (int r = 0; r < 16; ++r) slot_out[(32 * (wid & 3) + crow(r, hi)) * 128 + 32 * (2 * (wid >> 2) + i) + r32] = sacc[i][r];
    if (tid < 128) dseg_out[tid] = dseg;
  }
  __syncthreads();
}
#undef SWZ256
#undef SWZ128
}
typedef unsigned short bf16_t;
typedef float f32x4 __attribute__((ext_vector_type(4)));
typedef unsigned u32x4 __attribute__((ext_vector_type(4)));
typedef unsigned u32x2 __attribute__((ext_vector_type(2)));
typedef short bf16x8 __attribute__((ext_vector_type(8)));
#define LAS __attribute__((address_space(3)))
constexpr size_t MiB = 1u << 20;
constexpr size_t WS_SS = 0;
constexpr size_t WS_ROPEC = 6 * MiB, WS_ROPES = 7 * MiB;
constexpr size_t WS_W1GU = 16 * MiB, WS_W1D = 27 * MiB, WS_WIN = 33 * MiB, WS_WUQ = 40 * MiB, WS_WUKV = 41 * MiB, WS_WO = 42 * MiB, WS_W2GU = 44 * MiB, WS_W2D = 55 * MiB, WS_WPG = 61 * MiB, WS_WPP = 63 * MiB;
constexpr size_t WS_HB = 64 * MiB;
constexpr size_t WS_BIG = 256 * MiB;
constexpr size_t WS_UHG = WS_BIG, WS_UMLA = WS_BIG + 480 * MiB, WS_MIX = WS_BIG + 480 * MiB, WS_ACT = WS_BIG, WS_PROJ = WS_BIG;
constexpr size_t WS_PB = 928 * MiB;
constexpr size_t WS_SLOT = 976 * MiB;
constexpr size_t WS_DSEG = 8 * MiB;
constexpr size_t WS_END = 1024 * MiB;
constexpr size_t DO_Q = 0, DO_KN = 144 * MiB, DO_V = 240 * MiB, DO_KR = 336 * MiB;
constexpr int LDS_BYTES = 147456;
constexpr int LDS_BARST = 147392;
constexpr size_t WS_BAR = 12 * MiB;
#define XB_TMO      128
#define XB_XCNT(j)  (256  + 64 * (j))
#define XB_XSUB(j)  (1280 + 64 * (j))
#define XB_XGEN(j)  (2304 + 64 * (j))
#define XB_TOP      3328
#define XB_TOPGEN   3392
#define XCD_BAR_WORDS 3456
#define XB_SPIN_CAP (1u << 18)

__device__ __forceinline__ unsigned xb_ld(unsigned* p)              { return __hip_atomic_load(p, __ATOMIC_RELAXED, __HIP_MEMORY_SCOPE_AGENT); }
__device__ __forceinline__ unsigned xb_add(unsigned* p, unsigned v) { return __hip_atomic_fetch_add(p, v, __ATOMIC_RELAXED, __HIP_MEMORY_SCOPE_AGENT); }
__device__ __forceinline__ unsigned xb_xcc_id() { return (unsigned)__builtin_amdgcn_s_getreg((3 << 11) | 20) & 0xFu; }
#define XB_SPIN(cond, bar) do { unsigned _sp = 0; while (cond) { __builtin_amdgcn_s_sleep(1); \
    if ((++_sp & 255u) == 0u) { if (xb_ld(&(bar)[XB_TMO])) break; if (_sp > XB_SPIN_CAP) { atomicAdd(&(bar)[XB_TMO], 1u); break; } } } } while (0)

struct XcdBarrier {
    unsigned* bar; unsigned x;
    volatile LAS unsigned* st;
};

__device__ __forceinline__ XcdBarrier xcd_barrier_post(unsigned* bar, volatile LAS unsigned* st) {
    XcdBarrier b; b.bar = bar; b.x = xb_xcc_id(); b.st = st;
    if (threadIdx.x == 0) (void)xb_add(&bar[XB_XCNT(b.x)], 1u);
    return b;
}
__device__ __forceinline__ void xcd_barrier_complete(unsigned* bar, unsigned x, unsigned& nloc, unsigned& nx) {
    const unsigned G = gridDim.x * gridDim.y * gridDim.z;
    unsigned sum, cnt, mine, sp = 0u;
    for (;;) {
        sum = 0u; cnt = 0u; mine = 0u;
#pragma unroll
        for (unsigned j = 0; j < 16; ++j) { const unsigned c = xb_ld(&bar[XB_XCNT(j)]); sum += c; cnt += (c > 0u) ? 1u : 0u; mine = (j == x) ? c : mine; }
        if (sum == G) break;
        __builtin_amdgcn_s_sleep(1);
        if ((++sp & 255u) == 0u) { if (xb_ld(&bar[XB_TMO])) break; if (sp > XB_SPIN_CAP) { atomicAdd(&bar[XB_TMO], 1u); break; } }
    }
    nloc = mine > 0u ? mine : 1u; nx = cnt > 0u ? cnt : 1u;
}

__device__ __forceinline__ void xcd_barrier(const XcdBarrier& b) {
    asm volatile("s_waitcnt vmcnt(0)" ::: "memory");
    __syncthreads();
    if (threadIdx.x == 0) {
        unsigned* bar = b.bar;
        __builtin_amdgcn_s_waitcnt(0);
        unsigned nloc = b.st[0], nx = b.st[1];
        if (nloc == 0u) { xcd_barrier_complete(bar, b.x, nloc, nx); b.st[0] = nloc; b.st[1] = nx; }
        const unsigned old = xb_add(&bar[XB_XSUB(b.x)], 1u);
        const unsigned gen = old / nloc;
        if (old + 1u == (gen + 1u) * nloc) {
            __builtin_amdgcn_fence(__ATOMIC_RELEASE, "agent");
            asm volatile("s_waitcnt vmcnt(0)" ::: "memory");
            const unsigned og = xb_add(&bar[XB_TOP], 1u);
            const unsigned tg = og / nx;
            if (og + 1u == (tg + 1u) * nx) xb_add(&bar[XB_TOPGEN], 1u);
            else XB_SPIN(xb_ld(&bar[XB_TOPGEN]) == tg, bar);
            __builtin_amdgcn_fence(__ATOMIC_ACQUIRE, "agent");
            xb_add(&bar[XB_XGEN(b.x)], 1u);
            asm volatile("s_waitcnt vmcnt(0)" ::: "memory");
        } else {
            XB_SPIN(xb_ld(&bar[XB_XGEN(b.x)]) == gen, bar);
            __builtin_amdgcn_fence(__ATOMIC_ACQUIRE, "agent");
            asm volatile("s_waitcnt vmcnt(0)" ::: "memory");
        }
    }
    __syncthreads();
}


struct Params {
  const float* in[26];
  float* out; unsigned char* ws;
};

__device__ __forceinline__ unsigned f2bf(float f) { unsigned u = __builtin_bit_cast(unsigned, f); return (u + 0x7fffu + ((u >> 16) & 1u)) >> 16; }
__device__ __forceinline__ unsigned pk2(float lo, float hi) { return f2bf(lo) | (f2bf(hi) << 16); }
__device__ __forceinline__ float wave_sum(float v) {
#pragma unroll
  for (int o = 1; o < 64; o <<= 1) v += __shfl_xor(v, o);
  return v;
}
__device__ __forceinline__ void prep_item(const float* W, int ld, int col0, const float* fold, bf16_t* WT, int K, int n0, int k0, float* scr, int lane, bool perm) {
#pragma unroll 16
  for (int i = 0; i < 32; ++i) { const int kk = 2 * i + (lane >> 5); float v = 0.f; if (W) { const int p_ = lane & 31; const int cc = perm ? (16 * ((p_ >> 2) & 1) + 4 * (p_ >> 3) + (p_ & 3)) : p_; v = W[(size_t)(k0 + kk) * ld + col0 + cc]; if (fold) v *= fold[k0 + kk]; } scr[kk * 33 + (lane & 31)] = v; }
  asm volatile("s_waitcnt lgkmcnt(0)" ::: "memory");
  const int c = lane & 7;
#pragma unroll
  for (int j = 0; j < 4; ++j) { const int n = (lane >> 3) + 8 * j; const float* s = scr + (8 * c) * 33 + n;
    u32x4 o; o.x = pk2(s[0 * 33], s[1 * 33]); o.y = pk2(s[2 * 33], s[3 * 33]); o.z = pk2(s[4 * 33], s[5 * 33]); o.w = pk2(s[6 * 33], s[7 * 33]);
    *(u32x4*)(WT + (size_t)(n0 + n) * K + k0 + 8 * c) = o; }
  asm volatile("s_waitcnt lgkmcnt(0)" ::: "memory");
}
__device__ __forceinline__ void sincos_d(double x, float& s, float& c) {
  const double TWO_PI = 6.283185307179586476925286766559, INV_2PI = 0.15915494309189533576888376337251;
  double k = __builtin_rint(x * INV_2PI); double r = x - k * TWO_PI;
  const double HALF_PI = 1.5707963267948966192313216916398;
  double q = __builtin_rint(r * 0.63661977236758134308); double y = r - q * HALF_PI; int qi = ((int)q) & 3;
  double y2 = y * y;
  double sp = y * (1.0 + y2 * (-1.0 / 6 + y2 * (1.0 / 120 + y2 * (-1.0 / 5040 + y2 * (1.0 / 362880 + y2 * (-1.0 / 39916800 + y2 * (1.0 / 6227020800.0)))))));
  double cp = 1.0 + y2 * (-0.5 + y2 * (1.0 / 24 + y2 * (-1.0 / 720 + y2 * (1.0 / 40320 + y2 * (-1.0 / 3628800 + y2 * (1.0 / 479001600.0 + y2 * (-1.0 / 87178291200.0)))))));
  double ss, cc;
  if (qi == 0) { ss = sp; cc = cp; } else if (qi == 1) { ss = cp; cc = -sp; } else if (qi == 2) { ss = -sp; cc = -cp; } else { ss = -cp; cc = sp; }
  s = (float)ss; c = (float)cc;
}

__device__ __forceinline__ void p0_prologue(const Params& P, unsigned char* ws, char* lds) {
  int tid_ = threadIdx.x; asm volatile("" : "+v"(tid_)); const int tid = tid_, lane = tid & 63, wave = tid >> 6;
  const int gw = blockIdx.x * 8 + wave, NGW = gridDim.x * 8;
  float* scr = (float*)(lds + wave * 16384);
  constexpr int NJ = 10;
  const int jN[NJ] = {NGU, 1024, NIN, 768, 1024, 1024, NGU, 1024, 1024, 1024};
  const int jK[NJ] = {1024, DFF, 1024, 384, 256, 1024, 1024, DFF, 1024, 256};
  int total = 0;
#pragma unroll
  for (int j = 0; j < NJ; ++j) total += (jN[j] / 32) * (jK[j] / 64);
  const int gwp = blockIdx.x * 4 + (wave & 3), NGWP = gridDim.x * 4;
  if (wave < 4)
  for (int it = gwp; it < total; it += NGWP) {
    int r = it, job = 0;
#pragma unroll
    for (int j = 0; j < NJ; ++j) { const int cnt = (jN[j] / 32) * (jK[j] / 64); if (job == j && r >= cnt) { r -= cnt; job = j + 1; } }
    int N = 0, K = 0;
#pragma unroll
    for (int j = 0; j < NJ; ++j) if (job == j) { N = jN[j]; K = jK[j]; }
    const int nblk = N / 32, kb = r / nblk, nb = r % nblk, k0 = 64 * kb, n0 = 32 * nb;
    const float* W = nullptr; int ld = 0, col0 = 0; const float* fold = nullptr; bf16_t* WT = nullptr;
    if (job == 0 || job == 6) { const int t = n0 >> 8, half = (n0 >> 7) & 1, j0 = n0 & 127; const int b = (job == 0) ? 5 : 19;
      W = P.in[b + half]; ld = DFF; col0 = 128 * t + j0; fold = P.in[(job == 0) ? 4 : 18]; WT = (bf16_t*)(ws + ((job == 0) ? WS_W1GU : WS_W2GU)); }
    else if (job == 1 || job == 7) { W = P.in[(job == 1) ? 7 : 21]; ld = 1024; col0 = n0; WT = (bf16_t*)(ws + ((job == 1) ? WS_W1D : WS_W2D)); }
    else if (job == 2) { ld = 3232; fold = P.in[8]; WT = (bf16_t*)(ws + WS_WIN); W = P.in[9];
      if (n0 < 384) col0 = n0; else if (n0 < 416) col0 = 640 + (n0 - 384); else if (n0 < 512) W = nullptr; else if (n0 < 768) col0 = 384 + (n0 - 512); else col0 = 672 + (n0 - 768); }
    else if (job == 3) { W = P.in[11]; ld = 768; col0 = n0; fold = P.in[10]; WT = (bf16_t*)(ws + WS_WUQ); }
    else if (job == 4) { if (n0 < 512) { W = P.in[13]; col0 = n0; } else { W = P.in[14]; col0 = n0 - 512; } ld = 512; fold = P.in[12]; WT = (bf16_t*)(ws + WS_WUKV); }
    else if (job == 5) { W = P.in[17]; ld = 1024; col0 = n0; WT = (bf16_t*)(ws + WS_WO); }
    else if (job == 8) { W = P.in[23]; ld = 1024; col0 = n0; fold = P.in[22]; WT = (bf16_t*)(ws + WS_WPG); }
    else { W = P.in[24]; ld = 1024; col0 = n0; WT = (bf16_t*)(ws + WS_WPP); }
    prep_item(W, ld, col0, fold, WT, K, n0, k0, scr, lane, job == 2 && n0 == 384);
  }
  unsigned* ss = (unsigned*)(ws + WS_SS); bf16_t* HB = (bf16_t*)(ws + WS_HB); bf16_t* PB = (bf16_t*)(ws + WS_PB);
  if (wave >= 4)
  for (int m0 = gwp; m0 < T_ALL; m0 += 2 * NGWP) {
    f32x4 v[2][4], pv[2]; bool ok[2];
#pragma unroll
    for (int q = 0; q < 2; ++q) { const int m = m0 + q * NGWP; ok[q] = m < T_ALL; const int mm = ok[q] ? m : m0;
      const float* xr = (mm < T_P) ? P.in[0] + (size_t)mm * DM : P.in[1] + (size_t)(mm - T_P) * DM; const f32x4* x4 = (const f32x4*)xr + lane;
#pragma unroll
      for (int j = 0; j < 4; ++j) v[q][j] = x4[64 * j];
      const float* pr = (mm < T_P) ? P.in[2] + (size_t)mm * PLE : P.in[3] + (size_t)(mm - T_P) * PLE; pv[q] = ((const f32x4*)pr)[lane]; }
#pragma unroll
    for (int q = 0; q < 2; ++q) { const int m = m0 + q * NGWP; if (!ok[q]) continue; float s = 0.f;
#pragma unroll
      for (int j = 0; j < 4; ++j) s += (v[q][j][0] * v[q][j][0] + v[q][j][1] * v[q][j][1]) + (v[q][j][2] * v[q][j][2] + v[q][j][3] * v[q][j][3]);
      s = wave_sum(s);
      u32x2* o8 = (u32x2*)(HB + (size_t)m * DM) + lane;
#pragma unroll
      for (int j = 0; j < 4; ++j) { u32x2 w; w.x = pk2(v[q][j][0], v[q][j][1]); w.y = pk2(v[q][j][2], v[q][j][3]); o8[64 * j] = w; }
      u32x2 w; w.x = pk2(pv[q][0], pv[q][1]); w.y = pk2(pv[q][2], pv[q][3]); ((u32x2*)(PB + (size_t)m * PLE))[lane] = w;
      if (lane < 7) ss[(size_t)lane * T_ALL + m] = (lane == 0) ? (unsigned)(s * 4096.0f + 0.5f) : 0u; }
  }
  float* rc = (float*)(ws + WS_ROPEC); float* rs = (float*)(ws + WS_ROPES);
  for (int e = blockIdx.x * 512 + tid; e < S_P * 16; e += gridDim.x * 512) {
    const int pos = e >> 4, i = e & 15;
    const float cst = (float)(-9.210340371976184 / 32.0); const float arg = (float)(2 * i) * cst;
    const double a = (double)arg; const double nn = __builtin_rint(a * 1.4426950408889634); const double rr = a - nn * 0.69314718055994530942;
    double ex = 1.0 + rr * (1.0 + rr * (0.5 + rr * (1.0 / 6 + rr * (1.0 / 24 + rr * (1.0 / 120 + rr * (1.0 / 720 + rr * (1.0 / 5040 + rr * (1.0 / 40320 + rr * (1.0 / 362880 + rr * (1.0 / 3628800 + rr * (1.0 / 39916800)))))))))));
    ex = ex * __builtin_ldexp(1.0, (int)nn);
    const float invf = (float)ex; const float ang = (float)pos * invf;
    float sv, cv; sincos_d((double)ang, sv, cv); rc[e] = cv; rs[e] = sv;
  }
}
__device__ __forceinline__ void hg_combine(const bf16_t* OP, const bf16_t* U, const float* hg_norm, bf16_t* MIX) {
  int tid_ = threadIdx.x; asm volatile("" : "+v"(tid_)); const int lane = tid_ & 63, wave = tid_ >> 6; const int gw = blockIdx.x * 8 + wave, NGW = gridDim.x * 8;
  f32x4 gn0 = *(const f32x4*)(hg_norm + 8 * lane), gn1 = *(const f32x4*)(hg_norm + 8 * lane + 4);
  const float gnv[8] = {gn0[0], gn0[1], gn0[2], gn0[3], gn1[0], gn1[1], gn1[2], gn1[3]};
  for (int m0 = gw; m0 < T_ALL; m0 += 4 * NGW) {
    bf16x8 a[4], b[4], g[4]; bool ok[4];
#pragma unroll
    for (int q = 0; q < 4; ++q) { const int m = m0 + q * NGW; ok[q] = m < T_ALL; const int mm = ok[q] ? m : m0;
      a[q] = *(const bf16x8*)(OP + (size_t)mm * 512 + 8 * lane); b[q] = *(const bf16x8*)(OP + (size_t)T_ALL * 512 + (size_t)mm * 512 + 8 * lane);
      g[q] = *(const bf16x8*)(U + (size_t)mm * 2560 + 2048 + 8 * lane); }
#pragma unroll
    for (int q = 0; q < 4; ++q) { const int m = m0 + q * NGW; if (!ok[q]) continue;
      float ov[8]; float s = 0.f;
#pragma unroll
      for (int j = 0; j < 8; ++j) { ov[j] = __uint_as_float(((unsigned)(unsigned short)a[q][j]) << 16) + __uint_as_float(((unsigned)(unsigned short)b[q][j]) << 16); s += ov[j] * ov[j]; }
      s += __shfl_xor(s, 1); s += __shfl_xor(s, 2); s += __shfl_xor(s, 4); s += __shfl_xor(s, 8);
      const float r = rsqrtf(s * (1.0f / 128.0f) + EPS);
      unsigned w[4];
#pragma unroll
      for (int j = 0; j < 8; j += 2) { float r2[2];
#pragma unroll
        for (int e = 0; e < 2; ++e) { const float x = __uint_as_float(((unsigned)(unsigned short)g[q][j + e]) << 16); const float sl = x * __builtin_amdgcn_rcpf(1.0f + __builtin_amdgcn_exp2f(-1.4426950408889634f * x)); r2[e] = ov[j + e] * r * gnv[j + e] * sl; }
        w[j >> 1] = pk2(r2[0], r2[1]); }
      *(u32x4*)(MIX + (size_t)m * 1024 + 512 + 8 * lane) = (u32x4){w[0], w[1], w[2], w[3]}; }
  }
}
__device__ __forceinline__ void final_norm(float* out, const bf16_t* h4, const unsigned* ss4, const float* fn) {
  int tid_ = threadIdx.x; asm volatile("" : "+v"(tid_)); const int lane = tid_ & 63, wave = tid_ >> 6; const int gw = blockIdx.x * 8 + wave, NGW = gridDim.x * 8;
  f32x4 g[2][2];
#pragma unroll
  for (int j = 0; j < 2; ++j) { g[j][0] = *(const f32x4*)(fn + 512 * j + 8 * lane); g[j][1] = *(const f32x4*)(fn + 512 * j + 8 * lane + 4); }
  for (int m0 = gw; m0 < T_ALL; m0 += 4 * NGW) {
    u32x4 h[4][2]; float r[4]; bool ok[4];
#pragma unroll
    for (int q = 0; q < 4; ++q) { const int m = m0 + q * NGW; ok[q] = m < T_ALL; const int mm = ok[q] ? m : m0; r[q] = (float)ss4[mm] * (1.0f / 4096.0f);
#pragma unroll
      for (int j = 0; j < 2; ++j) h[q][j] = *(const u32x4*)(h4 + (size_t)mm * DM + 512 * j + 8 * lane); }
#pragma unroll
    for (int q = 0; q < 4; ++q) { const int m = m0 + q * NGW; if (!ok[q]) continue; const float rr = rsqrtf(r[q] * (1.0f / 1024.0f) + EPS);
#pragma unroll
      for (int j = 0; j < 2; ++j) { const u32x4 hh = h[q][j];
        f32x4 a, b; a[0] = __uint_as_float(hh.x << 16); a[1] = __uint_as_float(hh.x & 0xffff0000u); a[2] = __uint_as_float(hh.y << 16); a[3] = __uint_as_float(hh.y & 0xffff0000u);
        b[0] = __uint_as_float(hh.z << 16); b[1] = __uint_as_float(hh.z & 0xffff0000u); b[2] = __uint_as_float(hh.w << 16); b[3] = __uint_as_float(hh.w & 0xffff0000u);
        float* o = out + (size_t)m * DM + 512 * j + 8 * lane; *(f32x4*)o = a * rr * g[j][0]; *(f32x4*)(o + 4) = b * rr * g[j][1]; } }
  }
}

#define GSYNC() xcd_barrier(xbar)

template <class Epi> __device__ __forceinline__ void run_gemm(LAS unsigned char* lds, const bf16_t* A, int lda, const bf16_t* Bt, int ldb, int N, int K, const Epi& E) {
  pg8::Gemm g{A, Bt, T_ALL, N, K, lda, ldb}; pg8::StaticOrder S; S.init(T_ALL, N, (int)gridDim.x, (int)blockIdx.x);
  pg8::gemm_phase<Epi, pg8::StaticOrder, true, true>(lds, g, S, E);
}

__global__ void __launch_bounds__(512, 2) mk_fwd(Params P) {
  extern __shared__ __attribute__((aligned(16))) unsigned char lds[];
  unsigned char* ws = P.ws; float* out = P.out; unsigned char* dob = (unsigned char*)P.out;
  LAS unsigned char* l3 = (LAS unsigned char*)lds;
  pg8::ss_t* ss = (pg8::ss_t*)(ws + WS_SS);
  pg8::ss_t* ss0 = ss, *ss1 = ss + T_ALL, *ss2 = ss + 2 * (size_t)T_ALL, *ss3 = ss + 3 * (size_t)T_ALL, *ss4 = ss + 4 * (size_t)T_ALL, *ssq = ss + 5 * (size_t)T_ALL, *sskv = ss + 6 * (size_t)T_ALL;
  const float* ropec = (const float*)(ws + WS_ROPEC); const float* ropes = (const float*)(ws + WS_ROPES);
  bf16_t* HB = (bf16_t*)(ws + WS_HB); bf16_t* ACT = (bf16_t*)(ws + WS_ACT); bf16_t* UHG = (bf16_t*)(ws + WS_UHG); bf16_t* UMLA = (bf16_t*)(ws + WS_UMLA);
  bf16_t* MIX = (bf16_t*)(ws + WS_MIX); bf16_t* H4B = (bf16_t*)(ws + WS_MIX);     bf16_t* PROJ = (bf16_t*)P.out;     bf16_t* PB = (bf16_t*)(ws + WS_PB);
  bf16_t* Qb = (bf16_t*)(dob + DO_Q); bf16_t* KN = (bf16_t*)(dob + DO_KN); bf16_t* Vb = (bf16_t*)(dob + DO_V); bf16_t* KR = (bf16_t*)(dob + DO_KR);

  if (threadIdx.x < 16) ((LAS unsigned*)(l3 + LDS_BARST))[threadIdx.x] = 0u;
  if (blockIdx.x == 0) { for (int i = threadIdx.x; i < XCD_BAR_WORDS; i += 512) __hip_atomic_store((unsigned*)(ws + WS_BAR) + i, 0u, __ATOMIC_RELAXED, __HIP_MEMORY_SCOPE_AGENT); }
  p0_prologue(P, ws, (char*)lds);
  cg::this_grid().sync();
  const XcdBarrier xbar = xcd_barrier_post((unsigned*)(ws + WS_BAR), (volatile LAS unsigned*)(l3 + LDS_BARST));
  { pg8::EpiSwiGLU E{ACT, ss0}; run_gemm(l3, HB, 1024, (const bf16_t*)(ws + WS_W1GU), 1024, NGU, 1024, E); }
  GSYNC();
  { pg8::EpiRes<2> E{nullptr, nullptr, HB, nullptr, ss1, nullptr, nullptr}; run_gemm(l3, ACT, DFF, (const bf16_t*)(ws + WS_W1D), DFF, 1024, DFF, E); }
  GSYNC();
  { pg8::EpiWin E{UMLA, UHG, KR, ss1, ssq, sskv, ropec, ropes}; run_gemm(l3, HB, 1024, (const bf16_t*)(ws + WS_WIN), 1024, NIN, 1024, E); }
  GSYNC();
  { pg8::EpiBf E{Qb, Qb, 768, 1000, ssq, 1.0f / 384.0f, att::SCALE * 1.4426950408889634f}; run_gemm(l3, UMLA, 768, (const bf16_t*)(ws + WS_WUQ), 384, 768, 384, E); }
  { pg8::EpiBf E{KN, Vb, 512, 2, sskv, 1.0f / 256.0f, 1.0f}; run_gemm(l3, UMLA + 512, 768, (const bf16_t*)(ws + WS_WUKV), 256, 1024, 256, E); }
  {
    float* SLOT = (float*)(ws + WS_SLOT); float* DSEG = (float*)(ws + WS_DSEG);
    for (int u = blockIdx.x; u < 768; u += gridDim.x) {
      int chainid, seg, nseg;
      if (u < 256) { chainid = u >> 4; seg = u & 15; nseg = 16; } else { const int u2 = u - 256; chainid = 16 + (u2 >> 2); seg = u2 & 3; nseg = 4; }
      if (seg == nseg - 1) continue;
      int rowbase, S, h, dir;
      if (chainid < 16) { const int b = chainid >> 3; h = (chainid >> 1) & 3; dir = chainid & 1; rowbase = b * S_P; S = S_P; }
      else { const int c2 = chainid - 16; const int b = c2 >> 3; h = (c2 >> 1) & 3; dir = c2 & 1; rowbase = T_P + b * S_S; S = S_S; }
      hg::chain<1>(UHG, (bf16_t*)out, P.in[15], rowbase, S, h, dir, seg * 1024, 16, nullptr, SLOT + (size_t)u * 16384, DSEG + (size_t)u * 128, (char*)lds);
    }
  }
  GSYNC();
  {
    float* SLOT = (float*)(ws + WS_SLOT); const float* DSEG = (const float*)(ws + WS_DSEG);
    int tid_ = threadIdx.x; asm volatile("" : "+v"(tid_));
    for (int e = blockIdx.x * 512 + tid_; e < 144 * 16384; e += gridDim.x * 512) {
      const int chainid = e >> 14, el = e & 16383, k = el & 127;
      int u0, nseg; if (chainid < 16) { u0 = chainid * 16; nseg = 16; } else { u0 = 256 + (chainid - 16) * 4; nseg = 4; }
      float Sv = 0.f;
      if (nseg == 16) { float slv[15], dv[15];
#pragma unroll
        for (int s = 0; s < 15; ++s) { slv[s] = SLOT[(size_t)(u0 + s) * 16384 + el]; dv[s] = DSEG[(size_t)(u0 + s) * 128 + k]; }
#pragma unroll
        for (int s = 0; s < 15; ++s) { Sv = dv[s] * Sv + slv[s]; SLOT[(size_t)(u0 + s) * 16384 + el] = Sv; } }
      else { float slv[3], dv[3];
#pragma unroll
        for (int s = 0; s < 3; ++s) { slv[s] = SLOT[(size_t)(u0 + s) * 16384 + el]; dv[s] = DSEG[(size_t)(u0 + s) * 128 + k]; }
#pragma unroll
        for (int s = 0; s < 3; ++s) { Sv = dv[s] * Sv + slv[s]; SLOT[(size_t)(u0 + s) * 16384 + el] = Sv; } }
    }
  }
  {
    const int G = gridDim.x, bx = blockIdx.x;
    if (G == 256) {
      const int xcd = bx & 7, idx = bx >> 3;
      for (int i = 0; i < 12; ++i) {
        int rowbase, seq, h, qb;
        if (i < 4) { const int pair = 2 * xcd + (i >> 1); const int b = pair >> 3; h = pair & 7; qb = idx * 2 + (i & 1); rowbase = b * S_P; seq = S_P; }
        else { const int j = i - 4; const int pair = 16 * xcd + 2 * j + (idx >> 4); const int b = pair >> 3; h = pair & 7; qb = idx & 15; rowbase = T_P + b * S_S; seq = S_S; }
        att::attn_unit(Qb + (size_t)(rowbase + qb * 256) * 768 + h * 96, KN + (size_t)rowbase * 512 + h * 64, KR + (size_t)rowbase * 32, Vb + (size_t)rowbase * 512 + h * 64,
                       MIX + (size_t)(rowbase + qb * 256) * 1024 + h * 64, seq, rowbase + qb * 256, ropec, ropes, (char*)lds);
      }
    } else {
      for (int u = bx; u < 3072; u += G) {
        int rowbase, seq, h, qb;
        if (u < 1024) { const int pair = u >> 6; const int b = pair >> 3; h = pair & 7; qb = u & 63; rowbase = b * S_P; seq = S_P; }
        else { const int v = u - 1024; const int pair = v >> 4; const int b = pair >> 3; h = pair & 7; qb = v & 15; rowbase = T_P + b * S_S; seq = S_S; }
        att::attn_unit(Qb + (size_t)(rowbase + qb * 256) * 768 + h * 96, KN + (size_t)rowbase * 512 + h * 64, KR + (size_t)rowbase * 32, Vb + (size_t)rowbase * 512 + h * 64,
                       MIX + (size_t)(rowbase + qb * 256) * 1024 + h * 64, seq, rowbase + qb * 256, ropec, ropes, (char*)lds);
      }
    }
  }
  GSYNC();
  {
    const float* SLOT = (const float*)(ws + WS_SLOT);
    for (int u = blockIdx.x; u < 768; u += gridDim.x) {
      int chainid, seg;
      if (u < 256) { chainid = u >> 4; seg = u & 15; } else { const int u2 = u - 256; chainid = 16 + (u2 >> 2); seg = u2 & 3; }
      int rowbase, S, h, dir;
      if (chainid < 16) { const int b = chainid >> 3; h = (chainid >> 1) & 3; dir = chainid & 1; rowbase = b * S_P; S = S_P; }
      else { const int c2 = chainid - 16; const int b = c2 >> 3; h = (c2 >> 1) & 3; dir = c2 & 1; rowbase = T_P + b * S_S; S = S_S; }
      hg::chain<3>(UHG, (bf16_t*)out, P.in[15], rowbase, S, h, dir, seg * 1024, 16, seg ? SLOT + (size_t)(u - 1) * 16384 : nullptr, nullptr, nullptr, (char*)lds);
    }
  }
  GSYNC();
  hg_combine((const bf16_t*)out, UHG, P.in[16], MIX);
  GSYNC();
  { pg8::EpiRes<1> E{nullptr, nullptr, HB, nullptr, ss2, nullptr, nullptr}; run_gemm(l3, MIX, 1024, (const bf16_t*)(ws + WS_WO), 1024, 1024, 1024, E); }
  GSYNC();
  { pg8::EpiSwiGLU E{ACT, ss2}; run_gemm(l3, HB, 1024, (const bf16_t*)(ws + WS_W2GU), 1024, NGU, 1024, E); }
  GSYNC();
  { pg8::EpiRes<2> E{nullptr, nullptr, HB, nullptr, ss3, nullptr, nullptr}; run_gemm(l3, ACT, DFF, (const bf16_t*)(ws + WS_W2D), DFF, 1024, DFF, E); }
  { pg8::EpiBf E{PROJ, PROJ, 1024, 1000, nullptr, 0.f, 1.0f}; run_gemm(l3, PB, 256, (const bf16_t*)(ws + WS_WPP), 256, 1024, 256, E); }
  GSYNC();
  { pg8::EpiRes<3> E{nullptr, nullptr, HB, H4B, ss4, ss3, PROJ}; run_gemm(l3, HB, 1024, (const bf16_t*)(ws + WS_WPG), 1024, 1024, 1024, E); }
  GSYNC();
  final_norm(out, H4B, ss4, P.in[25]);
}

extern "C" void kernel_launch(void* const* d_in, const int* in_sizes, int n_in, void* d_out, int out_size, void* d_ws, size_t ws_size, hipStream_t stream) {
  static int grid = 0;
  if (grid == 0) {
    if (n_in != 26 || out_size != T_ALL * DM || ws_size < WS_END) { fprintf(stderr, "kernel_launch: unexpected shapes n_in %d out %d ws %zu\n", n_in, out_size, ws_size); grid = -1; return; }
    int dev = 0, cus = 0, per_cu = 0;
    if (hipGetDevice(&dev) != hipSuccess || hipDeviceGetAttribute(&cus, hipDeviceAttributeMultiprocessorCount, dev) != hipSuccess) { grid = -1; return; }
    if (hipFuncSetAttribute((const void*)mk_fwd, hipFuncAttributeMaxDynamicSharedMemorySize, LDS_BYTES) != hipSuccess) { fprintf(stderr, "kernel_launch: LDS attribute failed\n"); grid = -1; return; }
    if (hipOccupancyMaxActiveBlocksPerMultiprocessor(&per_cu, (const void*)mk_fwd, 512, LDS_BYTES) != hipSuccess || per_cu < 1) { fprintf(stderr, "kernel_launch: occupancy query says %d\n", per_cu); per_cu = 1; }
    (void)hipGetLastError();
    grid = cus;
  }
  if (grid < 0) return;
  Params p{};
  for (int i = 0; i < 26; ++i) p.in[i] = (const float*)d_in[i];
  p.out = (float*)d_out; p.ws = (unsigned char*)d_ws;
  void* args[] = {&p};
  hipError_t e = hipLaunchCooperativeKernel((void*)mk_fwd, dim3(grid), dim3(512), args, LDS_BYTES, stream);
  if (e != hipSuccess) fprintf(stderr, "cooperative launch failed: %s (grid %d)\n", hipGetErrorString(e), grid);
}
```
